# Optimizing an MI355X kernel written in HIP

```python
import math
import jax, jax.numpy as jnp
from jax import lax
import numpy as np

D_MODEL = 2048
BATCH = 4
SEQ = 2048
DEPTH = 1
DEC_BATCH = 128
DEC_SEQ = 8
PAST_LEN = 16384
PAGE_SIZE = 128

MIX_WIDTH = D_MODEL
RET_HEADS = 4
RET_DK = 256
RET_DV = 256
RET_WIDTH = RET_HEADS * RET_DV
RET_CHUNK = 128
ROPE_BASE = 10000.0
POOL_WINDOWS = (2, 4, 8, 16)
POOL_GROUPS = len(POOL_WINDOWS)
POOL_WIDTH = MIX_WIDTH - RET_WIDTH
POOL_GC = POOL_WIDTH // POOL_GROUPS
POOL_BUF = max(POOL_WINDOWS) - 1
D_FF = int(math.ceil(8 * D_MODEL / 3 / 256) * 256)
IN_WIDTH = 2 * RET_HEADS * RET_DK + 2 * RET_WIDTH + POOL_WIDTH
EPS = 1e-6

kernel_name = "hybrid_retention_pool_decoder_step"


def rms_norm(x, w):
    xf = x.astype(jnp.float32)
    y = xf * lax.rsqrt(jnp.mean(xf * xf, axis=-1, keepdims=True) + EPS)
    return (y * w.astype(jnp.float32)).astype(x.dtype)


def rope(x, pos):
    d = x.shape[-1]
    inv_freq = 1.0 / (ROPE_BASE ** (jnp.arange(0, d, 2, dtype=jnp.float32) / d))
    ang = pos[:, None] * inv_freq[None, :]
    cos = jnp.cos(ang)[None, :, None, :]
    sin = jnp.sin(ang)[None, :, None, :]
    x1, x2 = x[..., : d // 2], x[..., d // 2:]
    return jnp.concatenate([x1 * cos - x2 * sin, x2 * cos + x1 * sin], axis=-1)


def retention_chunk(S, qkv, log_gamma):
    q, k, v = qkv
    C = q.shape[2]
    idx = jnp.arange(C, dtype=jnp.float32)
    diff = idx[:, None] - idx[None, :]
    lg = log_gamma[:, None, None]
    decay = jnp.where(diff[None] >= 0, jnp.exp(jnp.maximum(diff[None], 0.0) * lg), 0.0)
    scores = jnp.einsum('bhid,bhjd->bhij', q, k) * decay[None]
    o_inner = jnp.einsum('bhij,bhje->bhie', scores, v)
    q_dec = jnp.exp((idx[None, :] + 1.0) * log_gamma[:, None])
    o_cross = jnp.einsum('bhid,bhde->bhie', q, S) * q_dec[None, :, :, None]
    k_dec = jnp.exp((C - 1.0 - idx[None, :]) * log_gamma[:, None])
    S_new = jnp.exp(C * log_gamma)[None, :, None, None] * S + jnp.einsum(
        'bhjd,bhje->bhde', k * k_dec[None, :, :, None], v)
    return S_new, o_inner + o_cross


def retention(q, k, v, S0):
    B, H, L, dk = q.shape
    dv = v.shape[-1]
    log_gamma = jnp.log(1.0 - 2.0 ** (-5.0 - jnp.arange(H, dtype=jnp.float32)))
    C = RET_CHUNK if L % RET_CHUNK == 0 else L
    n = L // C

    def to_chunks(t):
        return t.reshape(B, H, n, C, t.shape[-1]).transpose(2, 0, 1, 3, 4)

    S_fin, o = lax.scan(lambda S, c: retention_chunk(S, c, log_gamma), S0,
                        (to_chunks(q), to_chunks(k), to_chunks(v)))
    o = o.transpose(1, 2, 0, 3, 4).reshape(B, H, L, dv)
    return o, S_fin


def multiscale_pool(u, buf, start):
    B, L, _ = u.shape
    xp = jnp.concatenate([buf.astype(jnp.float32), u.astype(jnp.float32)], axis=1)
    cs = jnp.concatenate([jnp.zeros((B, 1, POOL_WIDTH), jnp.float32),
                          jnp.cumsum(xp, axis=1)], axis=1)
    pos = start + jnp.arange(L, dtype=jnp.float32)
    outs = []
    for g, w in enumerate(POOL_WINDOWS):
        sl = slice(g * POOL_GC, (g + 1) * POOL_GC)
        hi = cs[:, POOL_BUF + 1:POOL_BUF + 1 + L, sl]
        lo = cs[:, POOL_BUF + 1 - w:POOL_BUF + 1 - w + L, sl]
        cnt = jnp.minimum(pos + 1.0, float(w))[None, :, None]
        outs.append((hi - lo) / cnt)
    mean = jnp.concatenate(outs, axis=-1)
    pooled = mean - u.astype(jnp.float32)
    new_buf = xp[:, -POOL_BUF:, :]
    return pooled, new_buf


def hybrid_layer(x, S0, pool_buf, start, norm_mix_pre, norm_mix_post, w_in, ret_norm_w,
                 w_pool, pool_scale, w_out, norm_ffn_pre, norm_ffn_post, w_gate, w_up, w_down):
    B, L, _ = x.shape
    pos = start + jnp.arange(L, dtype=jnp.float32)
    h = rms_norm(x, norm_mix_pre)
    proj = h @ w_in
    o1 = RET_HEADS * RET_DK
    o2 = 2 * o1
    o3 = o2 + RET_WIDTH
    o4 = o3 + RET_WIDTH
    q = proj[..., :o1].astype(jnp.float32).reshape(B, L, RET_HEADS, RET_DK)
    k = proj[..., o1:o2].astype(jnp.float32).reshape(B, L, RET_HEADS, RET_DK)
    v = proj[..., o2:o3].astype(jnp.float32).reshape(B, L, RET_HEADS, RET_DV)
    g = proj[..., o3:o4]
    u = proj[..., o4:]
    q = rope(q, pos)
    k = rope(k, pos) * (RET_DK ** -0.5)
    o, S_new = retention(q.transpose(0, 2, 1, 3), k.transpose(0, 2, 1, 3),
                         v.transpose(0, 2, 1, 3), S0.astype(jnp.float32))
    o = o.transpose(0, 2, 1, 3)
    o = o * lax.rsqrt(jnp.mean(o * o, axis=-1, keepdims=True) + EPS)
    o = o * ret_norm_w.astype(jnp.float32).reshape(RET_HEADS, RET_DV)
    ret_out = (jax.nn.silu(g.astype(jnp.float32)) * o.reshape(B, L, RET_WIDTH)).astype(x.dtype)

    pooled, new_buf = multiscale_pool(u, pool_buf, start)
    pooled = pooled.astype(x.dtype).reshape(B, L, POOL_GROUPS, POOL_GC)
    pool_out = jnp.einsum('blgc,gcd->blgd', pooled, w_pool).reshape(B, L, POOL_WIDTH) * pool_scale

    mix = jnp.concatenate([ret_out, pool_out.astype(x.dtype)], axis=-1) @ w_out
    x = x + rms_norm(mix, norm_mix_post)
    hf = rms_norm(x, norm_ffn_pre)
    ff = (jax.nn.silu(hf @ w_gate) * (hf @ w_up)) @ w_down
    x = x + rms_norm(ff, norm_ffn_post)
    return x, S_new, new_buf


def setup_inputs(seed: int = 0) -> dict:
    key = jax.random.key(seed)
    ks = jax.random.split(key, 20)
    f32 = jnp.float32

    def nrm(k, shape, scale):
        return jax.random.normal(k, shape, f32) * scale

    return {
        "x_prompt": nrm(ks[0], (BATCH, SEQ, D_MODEL), 1.0),
        "x_sample": nrm(ks[1], (DEC_BATCH, DEC_SEQ, D_MODEL), 1.0),
        "state_ret": nrm(ks[2], (DEC_BATCH, RET_HEADS, RET_DK, RET_DV), 0.1),
        "state_pool": nrm(ks[3], (DEC_BATCH, POOL_BUF, POOL_WIDTH), 1.0),
        "norm_mix_pre": 1.0 + nrm(ks[4], (D_MODEL,), 0.02),
        "norm_mix_post": 1.0 + nrm(ks[5], (D_MODEL,), 0.02),
        "w_in": nrm(ks[6], (D_MODEL, IN_WIDTH), D_MODEL ** -0.5),
        "ret_norm_w": 1.0 + nrm(ks[7], (RET_WIDTH,), 0.02),
        "w_pool": nrm(ks[8], (POOL_GROUPS, POOL_GC, POOL_GC), POOL_GC ** -0.5),
        "pool_scale": 1.0 + nrm(ks[9], (POOL_WIDTH,), 0.02),
        "w_out": nrm(ks[10], (MIX_WIDTH, D_MODEL), MIX_WIDTH ** -0.5),
        "norm_ffn_pre": 1.0 + nrm(ks[11], (D_MODEL,), 0.02),
        "norm_ffn_post": 1.0 + nrm(ks[12], (D_MODEL,), 0.02),
        "w_gate": nrm(ks[13], (D_MODEL, D_FF), D_MODEL ** -0.5),
        "w_up": nrm(ks[14], (D_MODEL, D_FF), D_MODEL ** -0.5),
        "w_down": nrm(ks[15], (D_FF, D_MODEL), D_FF ** -0.5),
    }


def reference(x_prompt, x_sample, state_ret, state_pool, norm_mix_pre, norm_mix_post, w_in,
              ret_norm_w, w_pool, pool_scale, w_out, norm_ffn_pre, norm_ffn_post,
              w_gate, w_up, w_down):
    weights = (norm_mix_pre, norm_mix_post, w_in, ret_norm_w, w_pool, pool_scale, w_out,
               norm_ffn_pre, norm_ffn_post, w_gate, w_up, w_down)
    yp = x_prompt
    Sp = jnp.zeros((BATCH, RET_HEADS, RET_DK, RET_DV), jnp.float32)
    bp = jnp.zeros((BATCH, POOL_BUF, POOL_WIDTH), x_prompt.dtype)
    for _ in range(DEPTH):
        yp, Sp, bp = hybrid_layer(yp, Sp, bp, 0.0, *weights)
    ys = x_sample
    Ss, bs = state_ret, state_pool
    for _ in range(DEPTH):
        ys, Ss, bs = hybrid_layer(ys, Ss, bs, float(PAST_LEN), *weights)
    new_ret_prompt = Sp.astype(x_prompt.dtype)
    new_pool_prompt = bp.astype(x_prompt.dtype)
    new_ret_sample = Ss.astype(state_ret.dtype)
    new_pool_sample = bs.astype(state_pool.dtype)
    return (yp, ys, new_ret_prompt, new_pool_prompt, new_ret_sample, new_pool_sample)
```

```cpp
#include <hip/hip_runtime.h>
#include <hip/hip_cooperative_groups.h>
#include <cstdio>
#include <cstdint>
namespace cg = cooperative_groups;

#ifndef MK_N_LAUNCHES
#define MK_N_LAUNCHES 1
#endif

#define GAS __attribute__((address_space(1)))
#define LAS __attribute__((address_space(3)))
typedef unsigned short bf16_t;
typedef short bf16x8 __attribute__((ext_vector_type(8)));
typedef float f32x2 __attribute__((ext_vector_type(2)));
typedef float f32x4 __attribute__((ext_vector_type(4)));
typedef float f32x16 __attribute__((ext_vector_type(16)));
typedef unsigned u32x2 __attribute__((ext_vector_type(2)));
typedef unsigned u32x4 __attribute__((ext_vector_type(4)));

constexpr int D = 2048, MP = 8192, MS = 1024, M = MP + MS, SEQ = 2048;
constexpr int INW = 5120, DFF = 5632, NGU = 2 * DFF;
constexpr int NPOS = 2048 + 8;
constexpr float EPS = 1e-6f;
constexpr int NWAVES = 8, NTHR = 512;

constexpr size_t O_Y = 0, O_RETP = (size_t)M * D, O_POOLP = O_RETP + 4 * 4 * 65536, O_RETS = O_POOLP + 4 * 15 * 1024, O_POOLS = O_RETS + (size_t)128 * 4 * 65536, O_END = O_POOLS + 128 * 15 * 1024;

constexpr size_t MiB = 1u << 20;
constexpr size_t WS_CTL = 0, CTL_ZERO_BYTES = 1 * MiB;
constexpr size_t WS_CS = 1 * MiB;
constexpr size_t WS_WPOOL = 4 * MiB;
constexpr size_t WS_WIN = 8 * MiB;
constexpr size_t WS_WOUT = 28 * MiB;
constexpr size_t WS_WGU = 36 * MiB;
constexpr size_t WS_WD = 80 * MiB;
constexpr size_t WS_H = 102 * MiB;
constexpr size_t WS_PROJ = 138 * MiB;
constexpr size_t WS_MIX = 228 * MiB;
constexpr size_t WS_UT = 264 * MiB;
constexpr size_t WS_SCT = 296 * MiB;
constexpr size_t WS_POOLED = 328 * MiB;
constexpr size_t WS_MO = 346 * MiB;
constexpr size_t WS_HID = 138 * MiB;
constexpr size_t WS_FF = 382 * MiB;
constexpr size_t WS_END = 418 * MiB;
static_assert(WS_HID + (size_t)M * DFF * 2 <= WS_UT, "hid overlay");

constexpr int LDS_BYTES = 147456;
constexpr int RING_BYTES = 131072, MISC_OFF = RING_BYTES + 320;

__device__ __forceinline__ unsigned f2bf(float f) { unsigned u = __builtin_bit_cast(unsigned, f); return (u + 0x7fffu + ((u >> 16) & 1u)) >> 16; }
__device__ __forceinline__ unsigned pk2(float lo, float hi) { return f2bf(lo) | (f2bf(hi) << 16); }
__device__ __forceinline__ unsigned cvt_pk_bf16(float lo, float hi) { unsigned r; asm volatile("v_cvt_pk_bf16_f32 %0, %1, %2" : "=v"(r) : "v"(lo), "v"(hi)); return r; }
__device__ __forceinline__ float bflo(unsigned w) { return __builtin_bit_cast(float, w << 16); }
__device__ __forceinline__ float bfhi(unsigned w) { return __builtin_bit_cast(float, w & 0xffff0000u); }
__device__ __forceinline__ float bf2f(bf16_t b) { return __builtin_bit_cast(float, (unsigned)b << 16); }
__device__ __forceinline__ float wave_sum(float v) {
#pragma unroll
    for (int o = 1; o < 64; o <<= 1) v += __shfl_xor(v, o);
    return v;
}
__device__ __forceinline__ float silu(float x) { return x * __builtin_amdgcn_rcpf(1.0f + __builtin_amdgcn_exp2f(-1.4426950408889634f * x)); }
__device__ __forceinline__ float lg2gamma(int h) { return h == 0 ? -0.04580368961312479f : h == 1 ? -0.02272007650008353f : h == 2 ? -0.011315313227834146f : -0.005646563141142063f; }
#define LDS_WAIT() asm volatile("s_waitcnt lgkmcnt(0)" ::: "memory")
__device__ __forceinline__ int opaque(int x) { asm volatile("" : "+v"(x)); return x; }

namespace pg8 {
constexpr int BM = 256, BK = 64, HALF = 128, HTB = HALF * BK * 2, STAGE_BYTES = 8 * HTB, NXCD = 8, WGM = 8;
__host__ __device__ __forceinline__ int lds_byte(int r, int c) { const int st = (r >> 4) * 2 + (c >> 5), rr = r & 15, cc = c & 31, ob = rr * 64 + cc * 2; return st * 1024 + (ob ^ (((ob >> 9) & 1) << 5)); }
__host__ __device__ __forceinline__ void stage_rc(int b, int& R, int& C) { const int st = b / 1024, sb = b % 1024, swz = sb ^ (((sb >> 9) & 1) << 5); R = (st >> 1) * 16 + swz / 64; C = (st & 1) * 32 + (swz % 64) / 2; }
__host__ __device__ __forceinline__ int perm32(int rho) { const int n = rho >> 4, i = rho & 15; return 8 * (i >> 2) + 4 * n + (i & 3); }

struct Unit { int pm, pn; };
struct Gemm { const bf16_t* A; const bf16_t* Bt; int lda, ldb, K, a_pn_col; };
struct StaticOrder {
    int nM, nN, nwg, G, c;
    __device__ void init(int nM_, int nN_, int G_, int c_) { nM = nM_; nN = nN_; nwg = nM * nN; G = G_; c = c_; }
    __device__ bool next(int i, Unit& u) const {
        const long L = (long)i * G + c; if (L >= nwg) return false;
        int wgid = (int)L; { const int q = nwg / NXCD, r = nwg % NXCD, xcd = wgid % NXCD, off = wgid / NXCD; wgid = (xcd < r ? xcd * (q + 1) : r * (q + 1) + (xcd - r) * q) + off; }
        const int nig = WGM * nN, gid = wgid / nig, fm = gid * WGM, gsz = (nM - fm) < WGM ? (nM - fm) : WGM;
        u.pm = fm + ((wgid % nig) % gsz); u.pn = (wgid % nig) / gsz; return true;
    }
};

template <class Epi>
__device__ __forceinline__ void gemm_phase(LAS unsigned char* lds, const Gemm g, const StaticOrder& S, const Epi& E) {
    const int tid = threadIdx.x, wid = __builtin_amdgcn_readfirstlane(tid >> 6), lane = tid & 63, wr = wid >> 2, wc = wid & 3, fr = lane & 15, fq = lane >> 4;
    const int nt = g.K / BK;
    unsigned voffA[2], voffB[2];
#pragma unroll
    for (int i = 0; i < 2; ++i) { int R, C; stage_rc(tid * 16 + i * 8192, R, C); const int Rb = (R & ~31) + perm32(R & 31);
        voffA[i] = (unsigned)(R * g.lda + C) * 2u; voffB[i] = (unsigned)(Rb * g.ldb + C) * 2u; }
    const size_t kstep = (size_t)(BK * 2);
    const size_t hstepA = (size_t)HALF * g.lda * 2, hstepB = (size_t)HALF * g.ldb * 2;
    const unsigned ldsw = (unsigned)wid * 1024u;
    const int aoff = lds_byte(wr * 64 + fr, fq * 8), boff = lds_byte(wc * 32 + fr, fq * 8);
#define PG8_UA(u) ((const char*)g.A + ((size_t)(u).pm * BM * g.lda + (size_t)(u).pn * g.a_pn_col) * 2)
#define PG8_UB(u) ((const char*)g.Bt + (size_t)(u).pn * BM * g.ldb * 2)
#define PG8_SA(b, h) (((b) * 2 + (h)) * HTB)
#define PG8_SB(b, h) ((4 + (b) * 2 + (h)) * HTB)
#define PG8_STAGE(bufoff, gbase, voff) do { _Pragma("unroll") for (int _i = 0; _i < 2; ++_i) \
        __builtin_amdgcn_global_load_lds((const unsigned*)((const char*)(gbase) + (voff)[_i]), (LAS unsigned*)(lds + (bufoff) + ldsw + _i * 8192), 16, 0, 0); } while (0)
#define PG8_LDA(dst, b, h) do { _Pragma("unroll") for (int m = 0; m < 4; ++m) _Pragma("unroll") for (int k = 0; k < 2; ++k) dst[m][k] = *(const LAS bf16x8*)(lds + PG8_SA(b, h) + aoff + m * 2048 + k * 1024); } while (0)
#define PG8_LDB(dst, b, h) do { _Pragma("unroll") for (int n = 0; n < 2; ++n) _Pragma("unroll") for (int k = 0; k < 2; ++k) dst[n][k] = *(const LAS bf16x8*)(lds + PG8_SB(b, h) + boff + n * 2048 + k * 1024); } while (0)
#define PG8_MMA(ai, bj, At, Bt) do { __builtin_amdgcn_s_setprio(1); _Pragma("unroll") for (int m = 0; m < 4; ++m) _Pragma("unroll") for (int n = 0; n < 2; ++n) _Pragma("unroll") for (int k = 0; k < 2; ++k) \
        acc[ai][bj][m][n] = __builtin_amdgcn_mfma_f32_16x16x32_bf16(Bt[n][k], At[m][k], acc[ai][bj][m][n], 0, 0, 0); __builtin_amdgcn_s_setprio(0); } while (0)
#define PG8_WAIT_V(n) asm volatile("s_waitcnt vmcnt(" #n ")" ::: "memory")
#define PG8_WAIT_L(n) asm volatile("s_waitcnt lgkmcnt(" #n ")" ::: "memory")
#define PG8_BAR __builtin_amdgcn_s_barrier()
#define PG8_SCHED __builtin_amdgcn_sched_barrier(0)
    Unit cur, nxt; int ui = 0;
    if (!S.next(0, cur)) return;
    f32x4 acc[2][2][4][2];
#pragma unroll
    for (int a = 0; a < 2; ++a)
#pragma unroll
        for (int b = 0; b < 2; ++b)
#pragma unroll
            for (int m = 0; m < 4; ++m)
#pragma unroll
                for (int n = 0; n < 2; ++n) acc[a][b][m][n] = (f32x4){0.f, 0.f, 0.f, 0.f};
    bf16x8 At[4][2], B0[2][2], B1[2][2];
    const char* cA = PG8_UA(cur); const char* cB = PG8_UB(cur);
    PG8_STAGE(PG8_SB(0, 0), cB, voffB); PG8_STAGE(PG8_SB(0, 1), cB + hstepB, voffB); PG8_STAGE(PG8_SA(0, 0), cA, voffA); PG8_STAGE(PG8_SA(0, 1), cA + hstepA, voffA);
    if (wr == 1) PG8_BAR;
    PG8_WAIT_V(2); PG8_BAR;
    PG8_STAGE(PG8_SB(1, 0), cB + kstep, voffB); PG8_STAGE(PG8_SA(1, 0), cA + kstep, voffA); PG8_STAGE(PG8_SB(1, 1), cB + hstepB + kstep, voffB);
    PG8_WAIT_V(6); PG8_BAR;
    for (;;) {
        const bool has_next = S.next(ui + 1, nxt);
        const char* nA = has_next ? PG8_UA(nxt) : cA; const char* nB = has_next ? PG8_UB(nxt) : cB;
        for (int t = 0; t < nt; t += 2) {
            const bool last = (t == nt - 2);
            const char* a1 = cA + (size_t)(t + 1) * kstep;
            const char* a2 = last ? nA : cA + (size_t)(t + 2) * kstep; const char* b2 = last ? nB : cB + (size_t)(t + 2) * kstep;
            const char* a3 = a2 + kstep; const char* b3 = b2 + kstep;
            PG8_LDB(B0, 0, 0); PG8_LDB(B1, 0, 1); PG8_SCHED; PG8_LDA(At, 0, 0); PG8_STAGE(PG8_SA(1, 1), a1 + hstepA, voffA);
            PG8_WAIT_V(8); PG8_WAIT_L(0); PG8_BAR; PG8_MMA(0, 0, At, B0); PG8_MMA(0, 1, At, B1); PG8_BAR; PG8_SCHED;
            PG8_LDA(At, 0, 1); PG8_STAGE(PG8_SB(0, 0), b2, voffB); PG8_STAGE(PG8_SB(0, 1), b2 + hstepB, voffB); PG8_STAGE(PG8_SA(0, 0), a2, voffA);
            PG8_WAIT_V(8); PG8_WAIT_L(0); PG8_BAR; PG8_MMA(1, 0, At, B0); PG8_MMA(1, 1, At, B1); PG8_BAR; PG8_SCHED;
            PG8_LDB(B0, 1, 0); PG8_LDB(B1, 1, 1); PG8_SCHED; PG8_LDA(At, 1, 0); PG8_STAGE(PG8_SA(0, 1), a2 + hstepA, voffA);
            PG8_WAIT_V(8); PG8_WAIT_L(0); PG8_BAR; PG8_MMA(0, 0, At, B0); PG8_MMA(0, 1, At, B1); PG8_BAR; PG8_SCHED;
            PG8_LDA(At, 1, 1); PG8_STAGE(PG8_SB(1, 0), b3, voffB); PG8_STAGE(PG8_SB(1, 1), b3 + hstepB, voffB); PG8_STAGE(PG8_SA(1, 0), a3, voffA);
            PG8_WAIT_V(8); PG8_WAIT_L(0); PG8_BAR; PG8_MMA(1, 0, At, B0); PG8_MMA(1, 1, At, B1); PG8_BAR; PG8_SCHED;
        }
        if (wr == 0) PG8_BAR;
        E(acc, cur, wr, wc, fr, fq);
        if (!has_next) break;
#pragma unroll
        for (int a = 0; a < 2; ++a)
#pragma unroll
            for (int b = 0; b < 2; ++b)
#pragma unroll
                for (int m = 0; m < 4; ++m)
#pragma unroll
                    for (int n = 0; n < 2; ++n) acc[a][b][m][n] = (f32x4){0.f, 0.f, 0.f, 0.f};
        cur = nxt; cA = nA; cB = nB; ++ui;
        if (wr == 1) PG8_BAR;
    }
    PG8_WAIT_V(0);
    PG8_BAR;
#undef PG8_UA
#undef PG8_UB
#undef PG8_SA
#undef PG8_SB
#undef PG8_STAGE
#undef PG8_LDA
#undef PG8_LDB
#undef PG8_MMA
#undef PG8_WAIT_V
#undef PG8_WAIT_L
#undef PG8_BAR
#undef PG8_SCHED
}

__device__ __forceinline__ void st8(bf16_t* p, const f32x4 v0, const f32x4 v1) {
    u32x4 w; w.x = cvt_pk_bf16(v0[0], v0[1]); w.y = cvt_pk_bf16(v0[2], v0[3]); w.z = cvt_pk_bf16(v1[0], v1[1]); w.w = cvt_pk_bf16(v1[2], v1[3]);
    *(u32x4*)p = w;
}
struct EpiProj {
    bf16_t* P; const float* cs;
    __device__ __forceinline__ void operator()(const f32x4 (&acc)[2][2][4][2], const Unit& u, int wr, int wc, int fr, int fq) const {
        const int row0 = u.pm * BM + wr * 64 + fr, type = u.pn >> 2, cl = wc * 32 + 8 * fq, col0 = u.pn * BM + cl;
        if (type <= 1) {
            const float sc = type == 1 ? 0.0625f : 1.0f;
#pragma unroll
            for (int ai = 0; ai < 2; ++ai)
#pragma unroll
                for (int m = 0; m < 4; ++m) {
                    const int row = row0 + ai * HALF + m * 16;
                    const int pidx = row < MP ? (row & (SEQ - 1)) : SEQ + ((row - MP) & 7);
                    const f32x4* t = (const f32x4*)(cs + ((size_t)pidx * 128 + cl) * 2);
                    const f32x4 t0 = t[0], t1 = t[1], t2 = t[2], t3 = t[3];
                    const f32x4 x1a = acc[ai][0][m][0], x1b = acc[ai][0][m][1], x2a = acc[ai][1][m][0], x2b = acc[ai][1][m][1];
                    f32x4 o1a, o1b, o2a, o2b;
                    o1a[0] = (x1a[0] * t0[0] - x2a[0] * t0[1]) * sc; o2a[0] = (x2a[0] * t0[0] + x1a[0] * t0[1]) * sc;
                    o1a[1] = (x1a[1] * t0[2] - x2a[1] * t0[3]) * sc; o2a[1] = (x2a[1] * t0[2] + x1a[1] * t0[3]) * sc;
                    o1a[2] = (x1a[2] * t1[0] - x2a[2] * t1[1]) * sc; o2a[2] = (x2a[2] * t1[0] + x1a[2] * t1[1]) * sc;
                    o1a[3] = (x1a[3] * t1[2] - x2a[3] * t1[3]) * sc; o2a[3] = (x2a[3] * t1[2] + x1a[3] * t1[3]) * sc;
                    o1b[0] = (x1b[0] * t2[0] - x2b[0] * t2[1]) * sc; o2b[0] = (x2b[0] * t2[0] + x1b[0] * t2[1]) * sc;
                    o1b[1] = (x1b[1] * t2[2] - x2b[1] * t2[3]) * sc; o2b[1] = (x2b[1] * t2[2] + x1b[1] * t2[3]) * sc;
                    o1b[2] = (x1b[2] * t3[0] - x2b[2] * t3[1]) * sc; o2b[2] = (x2b[2] * t3[0] + x1b[2] * t3[1]) * sc;
                    o1b[3] = (x1b[3] * t3[2] - x2b[3] * t3[3]) * sc; o2b[3] = (x2b[3] * t3[2] + x1b[3] * t3[3]) * sc;
                    bf16_t* rp = P + (size_t)row * INW + col0;
                    st8(rp, o1a, o1b); st8(rp + HALF, o2a, o2b);
                }
        } else {
            const bool act = type == 3;
#pragma unroll
            for (int ai = 0; ai < 2; ++ai)
#pragma unroll
                for (int m = 0; m < 4; ++m) {
                    bf16_t* rp = P + (size_t)(row0 + ai * HALF + m * 16) * INW + col0;
#pragma unroll
                    for (int bj = 0; bj < 2; ++bj) {
                        f32x4 v0 = acc[ai][bj][m][0], v1 = acc[ai][bj][m][1];
                        if (act) {
#pragma unroll
                            for (int i = 0; i < 4; ++i) { v0[i] = silu(v0[i]); v1[i] = silu(v1[i]); }
                        }
                        st8(rp + bj * HALF, v0, v1);
                    }
                }
        }
    }
};
struct EpiPlain {
    bf16_t* O; int ldc, coff; const float* scale;
    __device__ __forceinline__ void operator()(const f32x4 (&acc)[2][2][4][2], const Unit& u, int wr, int wc, int fr, int fq) const {
        const int row0 = u.pm * BM + wr * 64 + fr, cl = wc * 32 + 8 * fq, col0 = u.pn * BM + cl;
        f32x4 s[2][2];
#pragma unroll
        for (int bj = 0; bj < 2; ++bj)
#pragma unroll
            for (int n = 0; n < 2; ++n) s[bj][n] = scale ? *(const f32x4*)(scale + col0 + bj * HALF + 4 * n) : (f32x4){1.f, 1.f, 1.f, 1.f};
#pragma unroll
        for (int ai = 0; ai < 2; ++ai)
#pragma unroll
            for (int m = 0; m < 4; ++m) {
                bf16_t* rp = O + (size_t)(row0 + ai * HALF + m * 16) * ldc + coff + col0;
#pragma unroll
                for (int bj = 0; bj < 2; ++bj) st8(rp + bj * HALF, acc[ai][bj][m][0] * s[bj][0], acc[ai][bj][m][1] * s[bj][1]);
            }
    }
};
struct EpiGU {
    bf16_t* Hd;
    __device__ __forceinline__ void operator()(const f32x4 (&acc)[2][2][4][2], const Unit& u, int wr, int wc, int fr, int fq) const {
        const int row0 = u.pm * BM + wr * 64 + fr, cl = wc * 32 + 8 * fq, col0 = u.pn * HALF + cl;
#pragma unroll
        for (int ai = 0; ai < 2; ++ai)
#pragma unroll
            for (int m = 0; m < 4; ++m) {
                f32x4 v0, v1;
#pragma unroll
                for (int i = 0; i < 4; ++i) { v0[i] = silu(acc[ai][0][m][0][i]) * acc[ai][1][m][0][i]; v1[i] = silu(acc[ai][0][m][1][i]) * acc[ai][1][m][1][i]; }
                st8(Hd + (size_t)(row0 + ai * HALF + m * 16) * DFF + col0, v0, v1);
            }
    }
};
}

#define XB_TMO      128
#define XB_XCNT(j)  (256  + 64 * (j))
#define XB_XSUB(j)  (1280 + 64 * (j))
#define XB_XGEN(j)  (2304 + 64 * (j))
#define XB_TOP      3328
#define XB_TOPGEN   3392
#define XCD_BAR_WORDS 3456
#define XB_SPIN_CAP (1u << 18)
__device__ __forceinline__ unsigned xb_ld(unsigned* p)              { return __hip_atomic_load(p, __ATOMIC_RELAXED, __HIP_MEMORY_SCOPE_AGENT); }
__device__ __forceinline__ unsigned xb_add(unsigned* p, unsigned v) { return __hip_atomic_fetch_add(p, v, __ATOMIC_RELAXED, __HIP_MEMORY_SCOPE_AGENT); }
__device__ __forceinline__ unsigned xb_xcc_id() { return (unsigned)__builtin_amdgcn_s_getreg((3 << 11) | 20) & 0xFu; }
#define XB_SPIN(cond, bar) do { unsigned _sp = 0; while (cond) { __builtin_amdgcn_s_sleep(1); \
    if ((++_sp & 255u) == 0u) { if (xb_ld(&(bar)[XB_TMO])) break; if (_sp > XB_SPIN_CAP) { atomicAdd(&(bar)[XB_TMO], 1u); break; } } } } while (0)
struct XcdBarrier { unsigned* bar; unsigned x; volatile LAS unsigned* st; };
__device__ __forceinline__ XcdBarrier xcd_barrier_post(unsigned* bar, volatile LAS unsigned* st) {
    XcdBarrier b; b.bar = bar; b.x = xb_xcc_id(); b.st = st;
    if (threadIdx.x == 0) (void)xb_add(&bar[XB_XCNT(b.x)], 1u);
    return b;
}
__device__ __forceinline__ void xcd_barrier_complete(unsigned* bar, unsigned x, unsigned& nloc, unsigned& nx) {
    const unsigned G = gridDim.x * gridDim.y * gridDim.z;
    unsigned sum, cnt, mine, sp = 0u;
    for (;;) {
        sum = 0u; cnt = 0u; mine = 0u;
#pragma unroll
        for (unsigned j = 0; j < 16; ++j) { const unsigned c = xb_ld(&bar[XB_XCNT(j)]); sum += c; cnt += (c > 0u) ? 1u : 0u; mine = (j == x) ? c : mine; }
        if (sum == G) break;
        __builtin_amdgcn_s_sleep(1);
        if ((++sp & 255u) == 0u) { if (xb_ld(&bar[XB_TMO])) break; if (sp > XB_SPIN_CAP) { atomicAdd(&bar[XB_TMO], 1u); break; } }
    }
    nloc = mine > 0u ? mine : 1u; nx = cnt > 0u ? cnt : 1u;
}
__device__ __forceinline__ void xcd_barrier(const XcdBarrier& b) {
    asm volatile("s_waitcnt vmcnt(0)" ::: "memory");
    __syncthreads();
    if (threadIdx.x == 0) {
        unsigned* bar = b.bar;
        __builtin_amdgcn_s_waitcnt(0);
        unsigned nloc = b.st[0], nx = b.st[1];
        if (nloc == 0u) { xcd_barrier_complete(bar, b.x, nloc, nx); b.st[0] = nloc; b.st[1] = nx; }
        const unsigned old = xb_add(&bar[XB_XSUB(b.x)], 1u);
        const unsigned gen = old / nloc;
        if (old + 1u == (gen + 1u) * nloc) {
            __builtin_amdgcn_fence(__ATOMIC_RELEASE, "agent");
            asm volatile("s_waitcnt vmcnt(0)" ::: "memory");
            const unsigned og = xb_add(&bar[XB_TOP], 1u);
            const unsigned tg = og / nx;
            if (og + 1u == (tg + 1u) * nx) xb_add(&bar[XB_TOPGEN], 1u);
            else XB_SPIN(xb_ld(&bar[XB_TOPGEN]) == tg, bar);
            __builtin_amdgcn_fence(__ATOMIC_ACQUIRE, "agent");
            xb_add(&bar[XB_XGEN(b.x)], 1u);
            asm volatile("s_waitcnt vmcnt(0)" ::: "memory");
        } else {
            XB_SPIN(xb_ld(&bar[XB_XGEN(b.x)]) == gen, bar);
            __builtin_amdgcn_fence(__ATOMIC_ACQUIRE, "agent");
            asm volatile("s_waitcnt vmcnt(0)" ::: "memory");
        }
    }
    __syncthreads();
}

struct Args { const float* in[16]; float* out; unsigned char* ws; int ph_lo, ph_hi, use_cg, pad; };

struct Frame {
    LAS unsigned char* lds;
    int tid, lane, wave, vcu, G;
};

__device__ __forceinline__ void p0_transpose_item(const float* W, int K, int N, bf16_t* WT, int mode, LAS float* scr, int item, int lane) {
    const int nblk = N / 32, kb = item / nblk, nb = item % nblk, k0 = 64 * kb, n0 = 32 * nb;
#pragma unroll 8
    for (int i = 0; i < 32; ++i) { const int kk = 2 * i + (lane >> 5); scr[kk * 33 + (lane & 31)] = W[(size_t)(k0 + kk) * N + n0 + (lane & 31)]; }
    LDS_WAIT(); asm volatile("" ::: "memory");
    const int c = lane & 7;
    const int rbase = mode == 0 ? n0 : (256 * (n0 >> 7) + (n0 & 127) + (mode == 2 ? 128 : 0));
#pragma unroll
    for (int j = 0; j < 4; ++j) { const int n = (lane >> 3) + 8 * j; const LAS float* s = scr + (8 * c) * 33 + n;
        u32x4 o; o.x = pk2(s[0 * 33], s[1 * 33]); o.y = pk2(s[2 * 33], s[3 * 33]); o.z = pk2(s[4 * 33], s[5 * 33]); o.w = pk2(s[6 * 33], s[7 * 33]);
        *(GAS u32x4*)(WT + (size_t)(rbase + n) * K + k0 + 8 * c) = o; }
    LDS_WAIT(); asm volatile("" ::: "memory");
}
__device__ __forceinline__ void rms_row_to_bf16(const float* xrow, const float* w, bf16_t* orow, int lane) {
    const GAS f32x4* xr = (const GAS f32x4*)xrow + lane; const GAS f32x4* wr = (const GAS f32x4*)w + lane;
    f32x4 v[8]; float s = 0.f;
#pragma unroll
    for (int j = 0; j < 8; ++j) { v[j] = xr[64 * j]; s += (v[j].x * v[j].x + v[j].y * v[j].y) + (v[j].z * v[j].z + v[j].w * v[j].w); }
    const float rstd = 1.0f / sqrtf(wave_sum(s) * (1.f / D) + EPS);
    GAS u32x2* o8 = (GAS u32x2*)orow + lane;
#pragma unroll
    for (int j = 0; j < 8; ++j) { const f32x4 ww = wr[64 * j]; u32x2 o; o.x = pk2(v[j].x * rstd * ww.x, v[j].y * rstd * ww.y); o.y = pk2(v[j].z * rstd * ww.z, v[j].w * rstd * ww.w); o8[64 * j] = o; }
}
__device__ __forceinline__ const float* xrow_ptr(const float* xp, const float* xs, int m) { return m < MP ? xp + (size_t)m * D : xs + (size_t)(m - MP) * D; }

__device__ __forceinline__ void p0_prologue(Frame& F, const Args& a) {
    unsigned char* ws = a.ws;
    LAS float* scr = (LAS float*)(F.lds + F.wave * 16384);
    const int gw = F.vcu * NWAVES + F.wave, NGW = F.G * NWAVES;
    constexpr int I_IN = (D / 64) * (INW / 32), I_OUT = (D / 64) * (D / 32), I_G = (D / 64) * (DFF / 32), I_D = (DFF / 64) * (D / 32), I_P = 4 * 8;
    constexpr int NITEMS = I_IN + I_OUT + 2 * I_G + I_D + 4 * I_P;
    for (int it = gw; it < NITEMS; it += NGW) {
        int r = it;
        if (r < I_IN) { p0_transpose_item(a.in[6], D, INW, (bf16_t*)(ws + WS_WIN), 0, scr, r, F.lane); continue; } r -= I_IN;
        if (r < I_OUT) { p0_transpose_item(a.in[10], D, D, (bf16_t*)(ws + WS_WOUT), 0, scr, r, F.lane); continue; } r -= I_OUT;
        if (r < I_G) { p0_transpose_item(a.in[13], D, DFF, (bf16_t*)(ws + WS_WGU), 1, scr, r, F.lane); continue; } r -= I_G;
        if (r < I_G) { p0_transpose_item(a.in[14], D, DFF, (bf16_t*)(ws + WS_WGU), 2, scr, r, F.lane); continue; } r -= I_G;
        if (r < I_D) { p0_transpose_item(a.in[15], DFF, D, (bf16_t*)(ws + WS_WD), 0, scr, r, F.lane); continue; } r -= I_D;
        { const int g = r / I_P; p0_transpose_item(a.in[8] + (size_t)g * 65536, 256, 256, (bf16_t*)(ws + WS_WPOOL) + (size_t)g * 65536, 0, scr, r % I_P, F.lane); }
    }
    for (int m = gw; m < M; m += NGW) rms_row_to_bf16(xrow_ptr(a.in[0], a.in[1], m), a.in[4], (bf16_t*)(ws + WS_H) + (size_t)m * D, F.lane);
    float* cs = (float*)(ws + WS_CS);
    for (int idx = F.vcu * NTHR + F.tid; idx < NPOS * 128; idx += F.G * NTHR) {
        const int p = idx >> 7, j = idx & 127;
        double r = 0.930572040929699, inv = 1.0;
#pragma unroll
        for (int b = 0; b < 7; ++b) { if ((j >> b) & 1) inv *= r; r *= r; }
        const float invf = (float)inv;
        const float pos = (float)(p < SEQ ? p : 16384 + (p - SEQ));
        const float ang = pos * invf;
        double t = (double)ang * 0.15915494309189535; t -= __builtin_rint(t);
        const float tf = (float)t;
        f32x2 o; o.x = __builtin_amdgcn_cosf(tf); o.y = __builtin_amdgcn_sinf(tf);
        *(f32x2*)(cs + (size_t)idx * 2) = o;
    }
}

__device__ __forceinline__ unsigned toff(int r, int c16, int RB) { return (unsigned)(r * RB + ((((c16 & ~15) | ((c16 ^ r ^ (r >> 4)) & 15))) << 4)); }
#define MFMA32(a, b, c) __builtin_amdgcn_mfma_f32_32x32x16_bf16((a), (b), (c), 0, 0, 0)
__device__ __forceinline__ int crow(int reg, int h) { return (reg & 3) + 8 * (reg >> 2) + 4 * h; }
__device__ __forceinline__ bf16x8 frag(const LAS unsigned char* tile, int r, int c16, int RB) { return *(const LAS bf16x8*)(tile + toff(r, c16, RB)); }

__device__ __forceinline__ void load_nat128(LAS unsigned char* dst, const bf16_t* src, int ld, int tid) {
    tid = opaque(tid);
    u32x4 v[4];
#pragma unroll
    for (int it = 0; it < 4; ++it) { const int idx = tid + it * NTHR, r = idx >> 4, c = idx & 15; v[it] = *(const GAS u32x4*)(src + (size_t)r * ld + c * 8); }
#pragma unroll
    for (int it = 0; it < 4; ++it) { const int idx = tid + it * NTHR, r = idx >> 4, c = idx & 15; *(LAS u32x4*)(dst + toff(r, c, 256)) = v[it]; }
}
template <bool SCALE>
__device__ __forceinline__ void load_tr(LAS unsigned char* dst, const bf16_t* src, int ld, int tid, float sc_a, float sc_b) {
    tid = opaque(tid);
#pragma unroll
    for (int it = 0; it < 4; ++it) {
        const int T = it * NTHR + tid, ch_lo = T & 15, pp = (T >> 4) & 3, half = (T >> 6) & 1, quad = T >> 7;
        const int pair = 4 * quad + pp, chunk = 16 * half + ch_lo, j0 = 2 * pair, d0 = 8 * chunk;
        const u32x4 a = *(const GAS u32x4*)(src + (size_t)j0 * ld + d0), b = *(const GAS u32x4*)(src + (size_t)(j0 + 1) * ld + d0);
        float s0 = 1.f, s1 = 1.f;
        if (SCALE) { s0 = __builtin_amdgcn_exp2f(sc_a * (sc_b - (float)j0)); s1 = __builtin_amdgcn_exp2f(sc_a * (sc_b - (float)(j0 + 1))); }
#pragma unroll
        for (int i = 0; i < 8; ++i) {
            const unsigned wa = a[i >> 1], wb = b[i >> 1];
            unsigned w;
            if (SCALE) { const float fa = ((i & 1) ? bfhi(wa) : bflo(wa)) * s0, fb = ((i & 1) ? bfhi(wb) : bflo(wb)) * s1; w = pk2(fa, fb); }
            else w = (i & 1) ? ((wa >> 16) | (wb & 0xffff0000u)) : ((wa & 0xffffu) | (wb << 16));
            const int d = d0 + i;
            *(LAS unsigned*)(dst + toff(d, quad, 256) + pp * 4) = w;
        }
    }
}

__device__ __forceinline__ void u_item(Frame& F, const bf16_t* PROJ, bf16_t* UT, int item) {
    const int b = item >> 6, h = (item >> 4) & 3, c = item & 15, rows0 = b * SEQ + c * 128;
    const bf16_t* Ks = PROJ + (size_t)rows0 * INW + 1024 + h * 256; const bf16_t* Vs = Ks + 1024;
    LAS unsigned char* KT = F.lds; LAS unsigned char* VT = F.lds + 65536;
    const float lg = lg2gamma(h);
    load_tr<true>(KT, Ks, INW, F.tid, lg, 127.f);
    load_tr<false>(VT, Vs, INW, F.tid, 0.f, 0.f);
    __syncthreads();
    const int w = F.wave, r = opaque(F.lane) & 31, hh = opaque(F.lane) >> 5;
    f32x16 acc[8];
#pragma unroll
    for (int t = 0; t < 8; ++t)
#pragma unroll
        for (int i = 0; i < 16; ++i) acc[t][i] = 0.f;
#pragma unroll 2
    for (int ks = 0; ks < 8; ++ks) {
        const bf16x8 a = frag(KT, 32 * w + r, 2 * ks + hh, 256);
#pragma unroll
        for (int et = 0; et < 8; ++et) { const bf16x8 bb = frag(VT, 32 * et + r, 2 * ks + hh, 256); acc[et] = MFMA32(a, bb, acc[et]); }
    }
    bf16_t* Up = UT + ((size_t)((b * 4 + h) * 16 + c) * 256) * 256;
#pragma unroll
    for (int et = 0; et < 8; ++et)
#pragma unroll
        for (int g = 0; g < 4; ++g) {
            u32x2 o; o.x = cvt_pk_bf16(acc[et][4 * g], acc[et][4 * g + 1]); o.y = cvt_pk_bf16(acc[et][4 * g + 2], acc[et][4 * g + 3]);
            *(GAS u32x2*)(Up + (size_t)(32 * et + r) * 256 + 32 * w + 8 * g + 4 * hh) = o;
        }
    __syncthreads();
}

__device__ __forceinline__ void o_item(Frame& F, const bf16_t* PROJ, const bf16_t* SCT, const float* retw, bf16_t* MIX, int item) {
    const int b = item >> 6, h = (item >> 4) & 3, c = item & 15, rows0 = b * SEQ + c * 128;
    const bf16_t* Qs = PROJ + (size_t)rows0 * INW + h * 256; const bf16_t* Ks = Qs + 1024; const bf16_t* Vs = Qs + 2048; const bf16_t* Gs = Qs + 3072;
    LAS unsigned char* QH = F.lds; LAS unsigned char* KH = F.lds + 32768; LAS unsigned char* PB = F.lds + 65536; LAS unsigned char* VT = F.lds; LAS unsigned char* OB = F.lds;
    const float lg = lg2gamma(h);
    const int w = F.wave; int r = opaque(F.lane) & 31, hh = opaque(F.lane) >> 5;
    {
        const int ib = w >> 1, jb0 = 2 * (w & 1);
        f32x16 sc[2];
#pragma unroll
        for (int t = 0; t < 2; ++t)
#pragma unroll
            for (int i = 0; i < 16; ++i) sc[t][i] = 0.f;
        for (int dh = 0; dh < 2; ++dh) {
            load_nat128(QH, Qs + 128 * dh, INW, F.tid); load_nat128(KH, Ks + 128 * dh, INW, F.tid);
            __syncthreads();
            if (jb0 <= ib) {
#pragma unroll 1
                for (int ks = 0; ks < 8; ++ks) {
                    const bf16x8 a = frag(QH, 32 * ib + r, 2 * ks + hh, 256);
                    const bf16x8 b0 = frag(KH, 32 * jb0 + r, 2 * ks + hh, 256), b1 = frag(KH, 32 * (jb0 + 1) + r, 2 * ks + hh, 256);
                    sc[0] = MFMA32(a, b0, sc[0]); sc[1] = MFMA32(a, b1, sc[1]);
                }
            }
            __syncthreads();
        }
        r = opaque(r); hh = opaque(hh);
#pragma unroll
        for (int t = 0; t < 2; ++t) {
            const int j = 32 * (jb0 + t) + r;
#pragma unroll
            for (int reg = 0; reg < 16; ++reg) {
                const int i = 32 * ib + crow(reg, hh);
                const float v = (i >= j) ? sc[t][reg] * __builtin_amdgcn_exp2f(lg * (float)(i - j)) : 0.f;
                *(LAS bf16_t*)(PB + toff(i, j >> 3, 256) + (j & 7) * 2) = (bf16_t)f2bf(v);
            }
        }
    }
    f32x16 o[4];
#pragma unroll
    for (int t = 0; t < 4; ++t)
#pragma unroll
        for (int i = 0; i < 16; ++i) o[t][i] = 0.f;
    const bf16_t* Sp = SCT + ((size_t)((b * 4 + h) * 16 + c) * 256) * 256 + (size_t)(32 * w + r) * 256 + 8 * hh;
    for (int dh = 0; dh < 2; ++dh) {
        load_nat128(QH, Qs + 128 * dh, INW, F.tid);
        __syncthreads();
#pragma unroll 1
        for (int ks = 0; ks < 8; ++ks) {
            const bf16x8 bb = *(const GAS bf16x8*)(Sp + 128 * dh + 16 * ks);
#pragma unroll
            for (int ib = 0; ib < 4; ++ib) { const bf16x8 a = frag(QH, 32 * ib + r, 2 * ks + hh, 256); o[ib] = MFMA32(a, bb, o[ib]); }
        }
        __syncthreads();
    }
#pragma unroll
    for (int ib = 0; ib < 4; ++ib)
#pragma unroll
        for (int reg = 0; reg < 16; ++reg) o[ib][reg] *= __builtin_amdgcn_exp2f(lg * (float)(32 * ib + crow(reg, hh) + 1));
    load_tr<false>(VT, Vs, INW, F.tid, 0.f, 0.f);
    __syncthreads();
#pragma unroll 1
    for (int ks = 0; ks < 8; ++ks) {
        const bf16x8 bb = frag(VT, 32 * w + r, 2 * ks + hh, 256);
#pragma unroll
        for (int ib = 0; ib < 4; ++ib)
            if (ks < 2 * (ib + 1)) { const bf16x8 a = frag(PB, 32 * ib + r, 2 * ks + hh, 256); o[ib] = MFMA32(a, bb, o[ib]); }
    }
    __syncthreads();
    r = opaque(r); hh = opaque(hh);
#pragma unroll
    for (int ib = 0; ib < 4; ++ib)
#pragma unroll
        for (int reg = 0; reg < 16; ++reg) { const int i = 32 * ib + crow(reg, hh);
            *(LAS bf16_t*)(OB + i * 512 + (32 * w + r) * 2) = (bf16_t)f2bf(o[ib][reg]); }
    __syncthreads();
    {
        const int tid2 = opaque(F.tid), cc = tid2 & 31;
        const f32x4 wa = *(const GAS f32x4*)(retw + h * 256 + cc * 8), wb = *(const GAS f32x4*)(retw + h * 256 + cc * 8 + 4);
#pragma unroll 2
        for (int it = 0; it < 8; ++it) {
            const int i = (tid2 >> 5) + 16 * it;
            const u32x4 ov = *(const LAS u32x4*)(OB + i * 512 + cc * 16);
            const u32x4 gv = *(const GAS u32x4*)(Gs + (size_t)i * INW + cc * 8);
            float x[8];
#pragma unroll
            for (int k = 0; k < 4; ++k) { x[2 * k] = bflo(ov[k]); x[2 * k + 1] = bfhi(ov[k]); }
            float s = 0.f;
#pragma unroll
            for (int k = 0; k < 8; ++k) s += x[k] * x[k];
            s += __shfl_xor(s, 1); s += __shfl_xor(s, 2); s += __shfl_xor(s, 4); s += __shfl_xor(s, 8); s += __shfl_xor(s, 16);
            const float rstd = 1.0f / sqrtf(s * (1.f / 256.f) + EPS);
            u32x4 res;
            res[0] = pk2(x[0] * rstd * wa[0] * bflo(gv[0]), x[1] * rstd * wa[1] * bfhi(gv[0]));
            res[1] = pk2(x[2] * rstd * wa[2] * bflo(gv[1]), x[3] * rstd * wa[3] * bfhi(gv[1]));
            res[2] = pk2(x[4] * rstd * wb[0] * bflo(gv[2]), x[5] * rstd * wb[1] * bfhi(gv[2]));
            res[3] = pk2(x[6] * rstd * wb[2] * bflo(gv[3]), x[7] * rstd * wb[3] * bfhi(gv[3]));
            *(GAS u32x4*)(MIX + (size_t)(rows0 + i) * D + h * 256 + cc * 8) = res;
        }
    }
    __syncthreads();
}

__device__ __forceinline__ void s_item(Frame& F, const bf16_t* PROJ, const float* state, const float* retw, float* newstate, bf16_t* MIX, int item) {
    const int sb = item >> 2, h = item & 3, rows0 = MP + sb * 8;
    const float lg = lg2gamma(h);
    LAS float* QK = (LAS float*)F.lds;
    LAS float* QR = (LAS float*)(F.lds + 16384);
    LAS float* KR = (LAS float*)(F.lds + 16384 + 8224);
    LAS float* SCP = (LAS float*)(F.lds + 16384 + 2 * 8224);
    LAS float* SCO = (LAS float*)(F.lds + 16384 + 2 * 8224 + 2048);
    LAS float* RED = (LAS float*)(F.lds + 40960);
    const int w = F.wave, l = F.lane;
    for (int idx = F.tid; idx < 8 * 256; idx += NTHR) {
        const int i = idx >> 8, d = idx & 255;
        const float qv = bf2f(PROJ[(size_t)(rows0 + i) * INW + h * 256 + d]), kv = bf2f(PROJ[(size_t)(rows0 + i) * INW + 1024 + h * 256 + d]);
        QR[i * 257 + d] = qv; KR[i * 257 + d] = kv;
        QK[d * 16 + i] = qv * __builtin_amdgcn_exp2f(lg * (float)(i + 1)); QK[d * 16 + 8 + i] = kv * __builtin_amdgcn_exp2f(lg * (float)(7 - i));
    }
    float v[8][4];
#pragma unroll
    for (int j = 0; j < 8; ++j) { const u32x2 t = *(const GAS u32x2*)(PROJ + (size_t)(rows0 + j) * INW + 2048 + h * 256 + 4 * l); v[j][0] = bflo(t.x); v[j][1] = bfhi(t.x); v[j][2] = bflo(t.y); v[j][3] = bfhi(t.y); }
    __syncthreads();
    {
        const int i = l >> 3, j = l & 7; float s = 0.f;
#pragma unroll 8
        for (int d = 32 * w; d < 32 * w + 32; ++d) s += QR[i * 257 + d] * KR[j * 257 + d];
        SCP[w * 64 + l] = s;
    }
    float oacc[8][4];
#pragma unroll
    for (int i = 0; i < 8; ++i)
#pragma unroll
        for (int c = 0; c < 4; ++c) oacc[i][c] = 0.f;
    const float g8 = __builtin_amdgcn_exp2f(lg * 8.f);
    const GAS f32x4* Sp = (const GAS f32x4*)(state + ((size_t)(sb * 4 + h) * 256 + 32 * w) * 256) + l;
    GAS f32x4* Np = (GAS f32x4*)(newstate + ((size_t)(sb * 4 + h) * 256 + 32 * w) * 256) + l;
#pragma unroll 1
    for (int d0 = 0; d0 < 32; d0 += 4) {
        f32x4 s4[4];
#pragma unroll
        for (int k = 0; k < 4; ++k) s4[k] = Sp[(size_t)(d0 + k) * 64];
#pragma unroll
        for (int k = 0; k < 4; ++k) {
            const LAS f32x4* qk = (const LAS f32x4*)(QK + (32 * w + d0 + k) * 16);
            const f32x4 qa = qk[0], qb = qk[1], ka = qk[2], kb = qk[3];
            f32x4 n;
#pragma unroll
            for (int c = 0; c < 4; ++c) {
                const float sv = s4[k][c];
                oacc[0][c] += qa[0] * sv; oacc[1][c] += qa[1] * sv; oacc[2][c] += qa[2] * sv; oacc[3][c] += qa[3] * sv;
                oacc[4][c] += qb[0] * sv; oacc[5][c] += qb[1] * sv; oacc[6][c] += qb[2] * sv; oacc[7][c] += qb[3] * sv;
                float t = g8 * sv;
                t += ka[0] * v[0][c]; t += ka[1] * v[1][c]; t += ka[2] * v[2][c]; t += ka[3] * v[3][c];
                t += kb[0] * v[4][c]; t += kb[1] * v[5][c]; t += kb[2] * v[6][c]; t += kb[3] * v[7][c];
                n[c] = t;
            }
            Np[(size_t)(d0 + k) * 64] = n;
        }
    }
#pragma unroll
    for (int i = 0; i < 8; ++i) *(LAS f32x4*)(RED + (w * 8 + i) * 256 + 4 * l) = (f32x4){oacc[i][0], oacc[i][1], oacc[i][2], oacc[i][3]};
    __syncthreads();
    if (F.tid < 64) { const int i = l >> 3, j = l & 7; float s = 0.f;
#pragma unroll
        for (int ww = 0; ww < 8; ++ww) s += SCP[ww * 64 + l];
        SCO[l] = (i >= j) ? s * __builtin_amdgcn_exp2f(lg * (float)(i - j)) : 0.f; }
    __syncthreads();
    {
        const int i = w; f32x4 tot = (f32x4){0.f, 0.f, 0.f, 0.f};
#pragma unroll
        for (int ww = 0; ww < 8; ++ww) tot += *(const LAS f32x4*)(RED + (ww * 8 + i) * 256 + 4 * l);
#pragma unroll
        for (int j = 0; j < 8; ++j) { const float s = SCO[i * 8 + j];
#pragma unroll
            for (int c = 0; c < 4; ++c) tot[c] += s * v[j][c]; }
        const float ss = wave_sum((tot[0] * tot[0] + tot[1] * tot[1]) + (tot[2] * tot[2] + tot[3] * tot[3]));
        const float rstd = 1.0f / sqrtf(ss * (1.f / 256.f) + EPS);
        const f32x4 wn = *(const GAS f32x4*)(retw + h * 256 + 4 * l);
        const u32x2 gv = *(const GAS u32x2*)(PROJ + (size_t)(rows0 + i) * INW + 3072 + h * 256 + 4 * l);
        u32x2 res; res.x = pk2(tot[0] * rstd * wn[0] * bflo(gv.x), tot[1] * rstd * wn[1] * bfhi(gv.x)); res.y = pk2(tot[2] * rstd * wn[2] * bflo(gv.y), tot[3] * rstd * wn[3] * bfhi(gv.y));
        *(GAS u32x2*)(MIX + (size_t)(rows0 + i) * D + h * 256 + 4 * l) = res;
    }
    __syncthreads();
}

__device__ __forceinline__ void pool_prompt_task(const bf16_t* PROJ, bf16_t* POOLED, float* outp, int task) {
    const int blk = task >> 7, ch8 = task & 127, ch = ch8 * 8, wsz = 2 << (ch >> 8);
    const int m0 = blk * 32, t0 = m0 & (SEQ - 1), bseq = m0 >> 11;
    const bf16_t* U = PROJ + 4096 + ch;
    float sum[8];
#pragma unroll
    for (int k = 0; k < 8; ++k) sum[k] = 0.f;
    for (int i = 1; i < wsz; ++i) if (t0 - i >= 0) { const u32x4 a = *(const GAS u32x4*)(U + (size_t)(m0 - i) * INW);
#pragma unroll
        for (int k = 0; k < 4; ++k) { sum[2 * k] += bflo(a[k]); sum[2 * k + 1] += bfhi(a[k]); } }
    for (int k = 0; k < 32; ++k) {
        const int t = t0 + k, m = m0 + k;
        const u32x4 cu = *(const GAS u32x4*)(U + (size_t)m * INW);
        float cur[8];
#pragma unroll
        for (int q = 0; q < 4; ++q) { cur[2 * q] = bflo(cu[q]); cur[2 * q + 1] = bfhi(cu[q]); }
#pragma unroll
        for (int q = 0; q < 8; ++q) sum[q] += cur[q];
        const int cnt = (t + 1 < wsz) ? t + 1 : wsz; const float inv = 1.0f / (float)cnt;
        u32x4 o;
#pragma unroll
        for (int q = 0; q < 4; ++q) o[q] = pk2(sum[2 * q] * inv - cur[2 * q], sum[2 * q + 1] * inv - cur[2 * q + 1]);
        *(GAS u32x4*)(POOLED + (size_t)m * 1024 + ch) = o;
        if (t - wsz + 1 >= 0) { const u32x4 a = *(const GAS u32x4*)(U + (size_t)(m - wsz + 1) * INW);
#pragma unroll
            for (int q = 0; q < 4; ++q) { sum[2 * q] -= bflo(a[q]); sum[2 * q + 1] -= bfhi(a[q]); } }
        if (t >= SEQ - 15) { float* op = outp + ((size_t)bseq * 15 + (t - (SEQ - 15))) * 1024 + ch;
            *(GAS f32x4*)op = (f32x4){cur[0], cur[1], cur[2], cur[3]}; *(GAS f32x4*)(op + 4) = (f32x4){cur[4], cur[5], cur[6], cur[7]}; }
    }
}
__device__ __forceinline__ void pool_sample_task(const bf16_t* PROJ, const float* spool, bf16_t* POOLED, float* outs, int task) {
    const int sb = task >> 7, ch8 = task & 127, ch = ch8 * 8, wsz = 2 << (ch >> 8);
    const bf16_t* U = PROJ + (size_t)(MP + sb * 8) * INW + 4096 + ch;
    const float* B = spool + (size_t)sb * 15 * 1024 + ch;
    float sum[8];
#pragma unroll
    for (int k = 0; k < 8; ++k) sum[k] = 0.f;
    for (int i = 1; i < wsz; ++i) { const f32x4 a = *(const GAS f32x4*)(B + (size_t)(15 - i) * 1024), b2 = *(const GAS f32x4*)(B + (size_t)(15 - i) * 1024 + 4);
#pragma unroll
        for (int q = 0; q < 4; ++q) { sum[q] += a[q]; sum[4 + q] += b2[q]; } }
    const float inv = 1.0f / (float)wsz;
    for (int t = 0; t < 8; ++t) {
        const u32x4 cu = *(const GAS u32x4*)(U + (size_t)t * INW);
        float cur[8];
#pragma unroll
        for (int q = 0; q < 4; ++q) { cur[2 * q] = bflo(cu[q]); cur[2 * q + 1] = bfhi(cu[q]); }
#pragma unroll
        for (int q = 0; q < 8; ++q) sum[q] += cur[q];
        u32x4 o;
#pragma unroll
        for (int q = 0; q < 4; ++q) o[q] = pk2(sum[2 * q] * inv - cur[2 * q], sum[2 * q + 1] * inv - cur[2 * q + 1]);
        *(GAS u32x4*)(POOLED + (size_t)(MP + sb * 8 + t) * 1024 + ch) = o;
        const int xi = 15 + t - wsz + 1;
        if (xi < 15) { const f32x4 a = *(const GAS f32x4*)(B + (size_t)xi * 1024), b2 = *(const GAS f32x4*)(B + (size_t)xi * 1024 + 4);
#pragma unroll
            for (int q = 0; q < 4; ++q) { sum[q] -= a[q]; sum[4 + q] -= b2[q]; } }
        else { const u32x4 a = *(const GAS u32x4*)(U + (size_t)(xi - 15) * INW);
#pragma unroll
            for (int q = 0; q < 4; ++q) { sum[2 * q] -= bflo(a[q]); sum[2 * q + 1] -= bfhi(a[q]); } }
        float* op = outs + ((size_t)sb * 15 + 7 + t) * 1024 + ch;
        *(GAS f32x4*)op = (f32x4){cur[0], cur[1], cur[2], cur[3]}; *(GAS f32x4*)(op + 4) = (f32x4){cur[4], cur[5], cur[6], cur[7]};
    }
    for (int rr = 0; rr < 7; ++rr) { float* op = outs + ((size_t)sb * 15 + rr) * 1024 + ch; const float* ip = B + (size_t)(8 + rr) * 1024;
        *(GAS f32x4*)op = *(const GAS f32x4*)ip; *(GAS f32x4*)(op + 4) = *(const GAS f32x4*)(ip + 4); }
}

__device__ __forceinline__ void n1_row(const float* xrow, const bf16_t* mo, const float* wpost, const float* wpre, float* yrow, bf16_t* hrow, int lane) {
    f32x4 xa[4], xb[4]; u32x4 mv[4]; float s = 0.f;
#pragma unroll
    for (int j = 0; j < 4; ++j) { const int c = 8 * lane + 512 * j; xa[j] = *(const GAS f32x4*)(xrow + c); xb[j] = *(const GAS f32x4*)(xrow + c + 4); mv[j] = *(const GAS u32x4*)(mo + c); }
    float mf[4][8];
#pragma unroll
    for (int j = 0; j < 4; ++j)
#pragma unroll
        for (int q = 0; q < 4; ++q) { mf[j][2 * q] = bflo(mv[j][q]); mf[j][2 * q + 1] = bfhi(mv[j][q]); }
#pragma unroll
    for (int j = 0; j < 4; ++j)
#pragma unroll
        for (int q = 0; q < 8; ++q) s += mf[j][q] * mf[j][q];
    const float r1 = 1.0f / sqrtf(wave_sum(s) * (1.f / D) + EPS);
    float s2 = 0.f;
#pragma unroll
    for (int j = 0; j < 4; ++j) { const int c = 8 * lane + 512 * j; const f32x4 wa = *(const GAS f32x4*)(wpost + c), wb = *(const GAS f32x4*)(wpost + c + 4);
#pragma unroll
        for (int q = 0; q < 4; ++q) { xa[j][q] += mf[j][q] * r1 * wa[q]; xb[j][q] += mf[j][4 + q] * r1 * wb[q]; s2 += xa[j][q] * xa[j][q] + xb[j][q] * xb[j][q]; }
        *(GAS f32x4*)(yrow + c) = xa[j]; *(GAS f32x4*)(yrow + c + 4) = xb[j]; }
    const float r2 = 1.0f / sqrtf(wave_sum(s2) * (1.f / D) + EPS);
#pragma unroll
    for (int j = 0; j < 4; ++j) { const int c = 8 * lane + 512 * j; const f32x4 wa = *(const GAS f32x4*)(wpre + c), wb = *(const GAS f32x4*)(wpre + c + 4);
        u32x4 o; o.x = pk2(xa[j][0] * r2 * wa[0], xa[j][1] * r2 * wa[1]); o.y = pk2(xa[j][2] * r2 * wa[2], xa[j][3] * r2 * wa[3]);
        o.z = pk2(xb[j][0] * r2 * wb[0], xb[j][1] * r2 * wb[1]); o.w = pk2(xb[j][2] * r2 * wb[2], xb[j][3] * r2 * wb[3]);
        *(GAS u32x4*)(hrow + c) = o; }
}
__device__ __forceinline__ void n2_row(const bf16_t* ff, const float* wpost, float* yrow, int lane) {
    u32x4 fv[4]; float s = 0.f; float ffl[4][8];
#pragma unroll
    for (int j = 0; j < 4; ++j) fv[j] = *(const GAS u32x4*)(ff + 8 * lane + 512 * j);
#pragma unroll
    for (int j = 0; j < 4; ++j)
#pragma unroll
        for (int q = 0; q < 4; ++q) { ffl[j][2 * q] = bflo(fv[j][q]); ffl[j][2 * q + 1] = bfhi(fv[j][q]); }
#pragma unroll
    for (int j = 0; j < 4; ++j)
#pragma unroll
        for (int q = 0; q < 8; ++q) s += ffl[j][q] * ffl[j][q];
    const float r1 = 1.0f / sqrtf(wave_sum(s) * (1.f / D) + EPS);
#pragma unroll
    for (int j = 0; j < 4; ++j) { const int c = 8 * lane + 512 * j; const f32x4 wa = *(const GAS f32x4*)(wpost + c), wb = *(const GAS f32x4*)(wpost + c + 4);
        f32x4 ya = *(const GAS f32x4*)(yrow + c), yb = *(const GAS f32x4*)(yrow + c + 4);
#pragma unroll
        for (int q = 0; q < 4; ++q) { ya[q] += ffl[j][q] * r1 * wa[q]; yb[q] += ffl[j][4 + q] * r1 * wb[q]; }
        *(GAS f32x4*)(yrow + c) = ya; *(GAS f32x4*)(yrow + c + 4) = yb; }
}

constexpr int NPH = 10;
__global__ void __launch_bounds__(NTHR, 2) hyb_fwd(Args args) {
    extern __shared__ __attribute__((aligned(16))) unsigned char lds[];
    Frame F;
    F.lds = (LAS unsigned char*)lds;
    F.tid = threadIdx.x; F.lane = F.tid & 63; F.wave = __builtin_amdgcn_readfirstlane(F.tid >> 6);
    F.G = gridDim.x; { const int bx = blockIdx.x; F.vcu = (F.G % 8 == 0) ? (bx % 8) * (F.G / 8) + bx / 8 : bx; }
    unsigned char* ws = args.ws;
    const int lo = args.ph_lo, hi = args.ph_hi;
#ifndef PH_ENABLE
#define PH_ENABLE 0x3ff
#endif
#define IN(k) (((PH_ENABLE >> (k)) & 1) && lo <= (k) && (k) < hi)
#define BOTH(k) (IN(k) && IN((k) + 1))
#define GRID_BAR() do { cg::this_grid().sync(); } while (0)
    bf16_t* H = (bf16_t*)(ws + WS_H); bf16_t* PROJ = (bf16_t*)(ws + WS_PROJ); bf16_t* MIX = (bf16_t*)(ws + WS_MIX);
    bf16_t* UT = (bf16_t*)(ws + WS_UT); bf16_t* SCT = (bf16_t*)(ws + WS_SCT); bf16_t* POOLED = (bf16_t*)(ws + WS_POOLED);
    bf16_t* MO = (bf16_t*)(ws + WS_MO); bf16_t* HID = (bf16_t*)(ws + WS_HID); bf16_t* FFB = (bf16_t*)(ws + WS_FF);
    float* out = args.out;

    if (IN(0)) { p0_prologue(F, args); if (BOTH(0)) GRID_BAR(); }
    if (IN(1)) {
        pg8::Gemm g{H, (const bf16_t*)(ws + WS_WIN), D, D, D, 0}; pg8::StaticOrder S; S.init(M / 256, INW / 256, F.G, (int)blockIdx.x);
        pg8::EpiProj E{PROJ, (const float*)(ws + WS_CS)};
        pg8::gemm_phase(F.lds, g, S, E);
        if (BOTH(1)) GRID_BAR();
    }
    if (IN(2)) {
        for (int it = F.vcu; it < 256; it += F.G) u_item(F, PROJ, UT, it);
        for (int task = F.vcu * NTHR + F.tid; task < 256 * 128; task += F.G * NTHR) pool_prompt_task(PROJ, POOLED, out + O_POOLP, task);
        for (int task = F.vcu * NTHR + F.tid; task < 128 * 128; task += F.G * NTHR) pool_sample_task(PROJ, args.in[3], POOLED, out + O_POOLS, task);
        for (int it = F.vcu; it < 512; it += F.G) s_item(F, PROJ, args.in[2], args.in[7], out + O_RETS, MIX, it);
        if (BOTH(2)) GRID_BAR();
    }
    if (IN(3)) {
        for (int idx = F.vcu * NTHR + F.tid; idx < 16 * 256 * 32; idx += F.G * NTHR) {
            const int bh = idx >> 13, e = (idx >> 5) & 255, d8 = (idx & 31) * 8;
            const float g128 = __builtin_amdgcn_exp2f(lg2gamma(bh & 3) * 128.f);
            float s[8];
#pragma unroll
            for (int k = 0; k < 8; ++k) s[k] = 0.f;
            for (int c = 0; c < 16; ++c) {
                const size_t off = ((size_t)(bh * 16 + c) * 256 + e) * 256 + d8;
                u32x4 o; o.x = pk2(s[0], s[1]); o.y = pk2(s[2], s[3]); o.z = pk2(s[4], s[5]); o.w = pk2(s[6], s[7]);
                *(GAS u32x4*)(SCT + off) = o;
                const u32x4 uv = *(const GAS u32x4*)(UT + off);
#pragma unroll
                for (int k = 0; k < 4; ++k) { s[2 * k] = g128 * s[2 * k] + bflo(uv[k]); s[2 * k + 1] = g128 * s[2 * k + 1] + bfhi(uv[k]); }
            }
            float* op = out + O_RETP + (size_t)bh * 65536 + e;
#pragma unroll
            for (int k = 0; k < 8; ++k) op[(size_t)(d8 + k) * 256] = s[k];
        }
        {
            pg8::Gemm g{POOLED, (const bf16_t*)(ws + WS_WPOOL), 1024, 256, 256, 256}; pg8::StaticOrder S; S.init(M / 256, 4, F.G, (int)blockIdx.x);
            pg8::EpiPlain E{MIX, D, 1024, args.in[9]};
            pg8::gemm_phase(F.lds, g, S, E);
        }
        if (BOTH(3)) GRID_BAR();
    }
    if (IN(4)) {
        for (int it = F.vcu; it < 256; it += F.G) o_item(F, PROJ, SCT, args.in[7], MIX, it);
        if (BOTH(4)) GRID_BAR();
    }
    if (IN(5)) {
        pg8::Gemm g{MIX, (const bf16_t*)(ws + WS_WOUT), D, D, D, 0}; pg8::StaticOrder S; S.init(M / 256, D / 256, F.G, (int)blockIdx.x);
        pg8::EpiPlain E{MO, D, 0, nullptr};
        pg8::gemm_phase(F.lds, g, S, E);
        if (BOTH(5)) GRID_BAR();
    }
    if (IN(6)) {
        const int gw = F.vcu * NWAVES + F.wave, NGW = F.G * NWAVES;
        for (int m = gw; m < M; m += NGW) n1_row(xrow_ptr(args.in[0], args.in[1], m), MO + (size_t)m * D, args.in[5], args.in[11], out + O_Y + (size_t)m * D, H + (size_t)m * D, F.lane);
        if (BOTH(6)) GRID_BAR();
    }
    if (IN(7)) {
        pg8::Gemm g{H, (const bf16_t*)(ws + WS_WGU), D, D, D, 0}; pg8::StaticOrder S; S.init(M / 256, NGU / 256, F.G, (int)blockIdx.x);
        pg8::EpiGU E{HID};
        pg8::gemm_phase(F.lds, g, S, E);
        if (BOTH(7)) GRID_BAR();
    }
    if (IN(8)) {
        pg8::Gemm g{HID, (const bf16_t*)(ws + WS_WD), DFF, DFF, DFF, 0}; pg8::StaticOrder S; S.init(M / 256, D / 256, F.G, (int)blockIdx.x);
        pg8::EpiPlain E{FFB, D, 0, nullptr};
        pg8::gemm_phase(F.lds, g, S, E);
        if (BOTH(8)) GRID_BAR();
    }
    if (IN(9)) {
        const int gw = F.vcu * NWAVES + F.wave, NGW = F.G * NWAVES;
        for (int m = gw; m < M; m += NGW) n2_row(FFB + (size_t)m * D, args.in[12], out + O_Y + (size_t)m * D, F.lane);
    }
#undef IN
#undef BOTH
}

extern "C" void kernel_launch(void* const* d_in, const int* in_sizes, int n_in, void* d_out, int out_size, void* d_ws, size_t ws_size, hipStream_t stream) {
    static int grid = 0;
    if (grid == 0) {
        if (n_in != 16 || (size_t)out_size != O_END || ws_size < WS_END) { fprintf(stderr, "kernel_launch: unexpected shapes: n_in %d out %d ws %zu (need %zu)\n", n_in, out_size, ws_size, (size_t)WS_END); grid = -1; return; }
        int dev = 0, cus = 0, per_cu = 0;
        if (hipGetDevice(&dev) != hipSuccess || hipDeviceGetAttribute(&cus, hipDeviceAttributeMultiprocessorCount, dev) != hipSuccess) { grid = -1; return; }
        if (hipFuncSetAttribute((const void*)hyb_fwd, hipFuncAttributeMaxDynamicSharedMemorySize, LDS_BYTES) != hipSuccess) { fprintf(stderr, "kernel_launch: hipFuncSetAttribute failed\n"); grid = -1; return; }
        if (hipOccupancyMaxActiveBlocksPerMultiprocessor(&per_cu, (const void*)hyb_fwd, NTHR, LDS_BYTES) != hipSuccess || per_cu < 1) { fprintf(stderr, "kernel_launch: occupancy query says %d\n", per_cu); per_cu = 1; }
        (void)hipGetLastError();
        grid = cus * 1;
        fprintf(stderr, "kernel_launch: grid %d (occupancy query %d per CU)\n", grid, per_cu);
    }
    if (grid < 0) return;
    Args a{};
    for (int i = 0; i < 16; ++i) a.in[i] = (const float*)d_in[i];
    a.out = (float*)d_out; a.ws = (unsigned char*)d_ws;
    if (MK_N_LAUNCHES == 1) {
        a.ph_lo = 0; a.ph_hi = NPH; a.use_cg = 1;
        void* kargs[] = {&a};
        hipError_t e = hipLaunchCooperativeKernel((const void*)hyb_fwd, dim3(grid), dim3(NTHR), kargs, LDS_BYTES, stream);
        if (e != hipSuccess) fprintf(stderr, "kernel_launch: cooperative launch failed: %s (grid %d)\n", hipGetErrorString(e), grid);
    } else {
        for (int p = 0; p < NPH; ++p) {
            a.ph_lo = p; a.ph_hi = p + 1; a.use_cg = 0;
            hipLaunchKernelGGL(hyb_fwd, dim3(grid), dim3(NTHR), LDS_BYTES, stream, a);
        }
    }
}
```

```cpp
#include <hip/hip_runtime.h>
#include <hip/hip_cooperative_groups.h>
#include <cstdio>
#include <cstdint>
namespace cg = cooperative_groups;

#ifndef MK_N_LAUNCHES
#define MK_N_LAUNCHES 1
#endif

#define GAS __attribute__((address_space(1)))
#define LAS __attribute__((address_space(3)))
typedef unsigned short bf16_t;
typedef short bf16x8 __attribute__((ext_vector_type(8)));
typedef float f32x2 __attribute__((ext_vector_type(2)));
typedef float f32x4 __attribute__((ext_vector_type(4)));
typedef float f32x16 __attribute__((ext_vector_type(16)));
typedef unsigned u32x2 __attribute__((ext_vector_type(2)));
typedef unsigned u32x4 __attribute__((ext_vector_type(4)));

constexpr int D = 2048, MP = 8192, MS = 1024, M = MP + MS, SEQ = 2048;
constexpr int INW = 5120, DFF = 5632, NGU = 2 * DFF;
constexpr int NPOS = 2048 + 8;
constexpr float EPS = 1e-6f;
constexpr int NWAVES = 8, NTHR = 512;

constexpr size_t O_Y = 0, O_RETP = (size_t)M * D, O_POOLP = O_RETP + 4 * 4 * 65536, O_RETS = O_POOLP + 4 * 15 * 1024, O_POOLS = O_RETS + (size_t)128 * 4 * 65536, O_END = O_POOLS + 128 * 15 * 1024;

constexpr size_t MiB = 1u << 20;
constexpr size_t WS_CTL = 0, CTL_ZERO_BYTES = 1 * MiB;
constexpr size_t WS_CS = 1 * MiB;
constexpr size_t WS_WPOOL = 4 * MiB;
constexpr size_t WS_WIN = 8 * MiB;
constexpr size_t WS_WOUT = 28 * MiB;
constexpr size_t WS_WGU = 36 * MiB;
constexpr size_t WS_WD = 80 * MiB;
constexpr size_t WS_H = 102 * MiB;
constexpr size_t WS_PROJ = 138 * MiB;
constexpr size_t WS_MIX = 228 * MiB;
constexpr size_t WS_UT = 264 * MiB;
constexpr size_t WS_SCT = 296 * MiB;
constexpr size_t WS_POOLED = 328 * MiB;
constexpr size_t WS_MO = 346 * MiB;
constexpr size_t WS_HID = 138 * MiB;
constexpr size_t WS_FF = 382 * MiB;
constexpr size_t WS_END = 418 * MiB;
static_assert(WS_HID + (size_t)M * DFF * 2 <= WS_UT, "hid overlay");

constexpr int CW_BAR = 4096;
constexpr int LDS_BYTES = 147456;
constexpr int RING_BYTES = 131072, MISC_OFF = RING_BYTES + 320;

__device__ __forceinline__ unsigned f2bf(float f) { unsigned u = __builtin_bit_cast(unsigned, f); return (u + 0x7fffu + ((u >> 16) & 1u)) >> 16; }
__device__ __forceinline__ unsigned pk2(float lo, float hi) { return f2bf(lo) | (f2bf(hi) << 16); }
__device__ __forceinline__ unsigned cvt_pk_bf16(float lo, float hi) { unsigned r; asm volatile("v_cvt_pk_bf16_f32 %0, %1, %2" : "=v"(r) : "v"(lo), "v"(hi)); return r; }
__device__ __forceinline__ float bflo(unsigned w) { return __builtin_bit_cast(float, w << 16); }
__device__ __forceinline__ float bfhi(unsigned w) { return __builtin_bit_cast(float, w & 0xffff0000u); }
__device__ __forceinline__ float bf2f(bf16_t b) { return __builtin_bit_cast(float, (unsigned)b << 16); }
__device__ __forceinline__ float wave_sum(float v) {
#pragma unroll
    for (int o = 1; o < 64; o <<= 1) v += __shfl_xor(v, o);
    return v;
}
__device__ __forceinline__ float silu(float x) { return x * __builtin_amdgcn_rcpf(1.0f + __builtin_amdgcn_exp2f(-1.4426950408889634f * x)); }
__device__ __forceinline__ float lg2gamma(int h) { return h == 0 ? -0.04580368961312479f : h == 1 ? -0.02272007650008353f : h == 2 ? -0.011315313227834146f : -0.005646563141142063f; }
#define LDS_WAIT() asm volatile("s_waitcnt lgkmcnt(0)" ::: "memory")
__device__ __forceinline__ int opaque(int x) { asm volatile("" : "+v"(x)); return x; }

namespace pg8 {
constexpr int BM = 256, BK = 64, HALF = 128, HTB = HALF * BK * 2, STAGE_BYTES = 8 * HTB, NXCD = 8, WGM = 8;
__host__ __device__ __forceinline__ int lds_byte(int r, int c) { const int st = (r >> 4) * 2 + (c >> 5), rr = r & 15, cc = c & 31, ob = rr * 64 + cc * 2; return st * 1024 + (ob ^ (((ob >> 9) & 1) << 5)); }
__host__ __device__ __forceinline__ void stage_rc(int b, int& R, int& C) { const int st = b / 1024, sb = b % 1024, swz = sb ^ (((sb >> 9) & 1) << 5); R = (st >> 1) * 16 + swz / 64; C = (st & 1) * 32 + (swz % 64) / 2; }
__host__ __device__ __forceinline__ int perm32(int rho) { const int n = rho >> 4, i = rho & 15; return 8 * (i >> 2) + 4 * n + (i & 3); }

struct Unit { int pm, pn; };
struct Gemm { const bf16_t* A; const bf16_t* Bt; int lda, ldb, K, a_pn_col; };
struct StaticOrder {
    int nM, nN, nwg, G, c;
    __device__ void init(int nM_, int nN_, int G_, int c_) { nM = nM_; nN = nN_; nwg = nM * nN; G = G_; c = c_; }
    __device__ bool next(int i, Unit& u) const {
        const long L = (long)i * G + c; if (L >= nwg) return false;
        int wgid = (int)L; { const int q = nwg / NXCD, r = nwg % NXCD, xcd = wgid % NXCD, off = wgid / NXCD; wgid = (xcd < r ? xcd * (q + 1) : r * (q + 1) + (xcd - r) * q) + off; }
        const int nig = WGM * nN, gid = wgid / nig, fm = gid * WGM, gsz = (nM - fm) < WGM ? (nM - fm) : WGM;
        u.pm = fm + ((wgid % nig) % gsz); u.pn = (wgid % nig) / gsz; return true;
    }
};

template <class Epi>
__device__ __forceinline__ void gemm_phase(LAS unsigned char* lds, const Gemm g, const StaticOrder& S, const Epi& E) {
    const int tid = threadIdx.x, wid = __builtin_amdgcn_readfirstlane(tid >> 6), lane = tid & 63, wr = wid >> 2, wc = wid & 3, fr = lane & 15, fq = lane >> 4;
    const int nt = g.K / BK;
    unsigned voffA[2], voffB[2];
#pragma unroll
    for (int i = 0; i < 2; ++i) { int R, C; stage_rc(tid * 16 + i * 8192, R, C); const int Rb = (R & ~31) + perm32(R & 31);
        voffA[i] = (unsigned)(R * g.lda + C) * 2u; voffB[i] = (unsigned)(Rb * g.ldb + C) * 2u; }
    const size_t kstep = (size_t)(BK * 2);
    const size_t hstepA = (size_t)HALF * g.lda * 2, hstepB = (size_t)HALF * g.ldb * 2;
    const unsigned ldsw = (unsigned)wid * 1024u;
    const int aoff = lds_byte(wr * 64 + fr, fq * 8), boff = lds_byte(wc * 32 + fr, fq * 8);
#define PG8_UA(u) ((const char*)g.A + ((size_t)(u).pm * BM * g.lda + (size_t)(u).pn * g.a_pn_col) * 2)
#define PG8_UB(u) ((const char*)g.Bt + (size_t)(u).pn * BM * g.ldb * 2)
#define PG8_SA(b, h) (((b) * 2 + (h)) * HTB)
#define PG8_SB(b, h) ((4 + (b) * 2 + (h)) * HTB)
#define PG8_STAGE(bufoff, gbase, voff) do { _Pragma("unroll") for (int _i = 0; _i < 2; ++_i) \
        __builtin_amdgcn_global_load_lds((const unsigned*)((const char*)(gbase) + (voff)[_i]), (LAS unsigned*)(lds + (bufoff) + ldsw + _i * 8192), 16, 0, 0); } while (0)
#define PG8_LDA(dst, b, h) do { _Pragma("unroll") for (int m = 0; m < 4; ++m) _Pragma("unroll") for (int k = 0; k < 2; ++k) dst[m][k] = *(const LAS bf16x8*)(lds + PG8_SA(b, h) + aoff + m * 2048 + k * 1024); } while (0)
#define PG8_LDB(dst, b, h) do { _Pragma("unroll") for (int n = 0; n < 2; ++n) _Pragma("unroll") for (int k = 0; k < 2; ++k) dst[n][k] = *(const LAS bf16x8*)(lds + PG8_SB(b, h) + boff + n * 2048 + k * 1024); } while (0)
#define PG8_MMA(ai, bj, At, Bt) do { __builtin_amdgcn_s_setprio(1); _Pragma("unroll") for (int m = 0; m < 4; ++m) _Pragma("unroll") for (int n = 0; n < 2; ++n) _Pragma("unroll") for (int k = 0; k < 2; ++k) \
        acc[ai][bj][m][n] = __builtin_amdgcn_mfma_f32_16x16x32_bf16(Bt[n][k], At[m][k], acc[ai][bj][m][n], 0, 0, 0); __builtin_amdgcn_s_setprio(0); } while (0)
#define PG8_WAIT_V(n) asm volatile("s_waitcnt vmcnt(" #n ")" ::: "memory")
#define PG8_WAIT_L(n) asm volatile("s_waitcnt lgkmcnt(" #n ")" ::: "memory")
#define PG8_BAR __builtin_amdgcn_s_barrier()
#define PG8_SCHED __builtin_amdgcn_sched_barrier(0)
    Unit cur, nxt; int ui = 0;
    if (!S.next(0, cur)) return;
    f32x4 acc[2][2][4][2];
#pragma unroll
    for (int a = 0; a < 2; ++a)
#pragma unroll
        for (int b = 0; b < 2; ++b)
#pragma unroll
            for (int m = 0; m < 4; ++m)
#pragma unroll
                for (int n = 0; n < 2; ++n) acc[a][b][m][n] = (f32x4){0.f, 0.f, 0.f, 0.f};
    bf16x8 At[4][2], B0[2][2], B1[2][2];
    const char* cA = PG8_UA(cur); const char* cB = PG8_UB(cur);
    PG8_STAGE(PG8_SB(0, 0), cB, voffB); PG8_STAGE(PG8_SB(0, 1), cB + hstepB, voffB); PG8_STAGE(PG8_SA(0, 0), cA, voffA); PG8_STAGE(PG8_SA(0, 1), cA + hstepA, voffA);
    if (wr == 1) PG8_BAR;
    PG8_WAIT_V(2); PG8_BAR;
    PG8_STAGE(PG8_SB(1, 0), cB + kstep, voffB); PG8_STAGE(PG8_SA(1, 0), cA + kstep, voffA); PG8_STAGE(PG8_SB(1, 1), cB + hstepB + kstep, voffB);
    PG8_WAIT_V(6); PG8_BAR;
    for (;;) {
        const bool has_next = S.next(ui + 1, nxt);
        const char* nA = has_next ? PG8_UA(nxt) : cA; const char* nB = has_next ? PG8_UB(nxt) : cB;
        for (int t = 0; t < nt; t += 2) {
            const bool last = (t == nt - 2);
            const char* a1 = cA + (size_t)(t + 1) * kstep;
            const char* a2 = last ? nA : cA + (size_t)(t + 2) * kstep; const char* b2 = last ? nB : cB + (size_t)(t + 2) * kstep;
            const char* a3 = a2 + kstep; const char* b3 = b2 + kstep;
            PG8_LDB(B0, 0, 0); PG8_LDB(B1, 0, 1); PG8_SCHED; PG8_LDA(At, 0, 0); PG8_STAGE(PG8_SA(1, 1), a1 + hstepA, voffA);
            PG8_WAIT_V(8); PG8_WAIT_L(0); PG8_BAR; PG8_MMA(0, 0, At, B0); PG8_MMA(0, 1, At, B1); PG8_BAR; PG8_SCHED;
            PG8_LDA(At, 0, 1); PG8_STAGE(PG8_SB(0, 0), b2, voffB); PG8_STAGE(PG8_SB(0, 1), b2 + hstepB, voffB); PG8_STAGE(PG8_SA(0, 0), a2, voffA);
            PG8_WAIT_V(8); PG8_WAIT_L(0); PG8_BAR; PG8_MMA(1, 0, At, B0); PG8_MMA(1, 1, At, B1); PG8_BAR; PG8_SCHED;
            PG8_LDB(B0, 1, 0); PG8_LDB(B1, 1, 1); PG8_SCHED; PG8_LDA(At, 1, 0); PG8_STAGE(PG8_SA(0, 1), a2 + hstepA, voffA);
            PG8_WAIT_V(8); PG8_WAIT_L(0); PG8_BAR; PG8_MMA(0, 0, At, B0); PG8_MMA(0, 1, At, B1); PG8_BAR; PG8_SCHED;
            PG8_LDA(At, 1, 1); PG8_STAGE(PG8_SB(1, 0), b3, voffB); PG8_STAGE(PG8_SB(1, 1), b3 + hstepB, voffB); PG8_STAGE(PG8_SA(1, 0), a3, voffA);
            PG8_WAIT_V(8); PG8_WAIT_L(0); PG8_BAR; PG8_MMA(1, 0, At, B0); PG8_MMA(1, 1, At, B1); PG8_BAR; PG8_SCHED;
        }
        if (wr == 0) PG8_BAR;
        E(acc, cur, wr, wc, fr, fq);
        if (!has_next) break;
#pragma unroll
        for (int a = 0; a < 2; ++a)
#pragma unroll
            for (int b = 0; b < 2; ++b)
#pragma unroll
                for (int m = 0; m < 4; ++m)
#pragma unroll
                    for (int n = 0; n < 2; ++n) acc[a][b][m][n] = (f32x4){0.f, 0.f, 0.f, 0.f};
        cur = nxt; cA = nA; cB = nB; ++ui;
        if (wr == 1) PG8_BAR;
    }
    PG8_WAIT_V(0);
    PG8_BAR;
#undef PG8_UA
#undef PG8_UB
#undef PG8_SA
#undef PG8_SB
#undef PG8_STAGE
#undef PG8_LDA
#undef PG8_LDB
#undef PG8_MMA
#undef PG8_WAIT_V
#undef PG8_WAIT_L
#undef PG8_BAR
#undef PG8_SCHED
}

__device__ __forceinline__ void st8(bf16_t* p, const f32x4 v0, const f32x4 v1) {
    u32x4 w; w.x = cvt_pk_bf16(v0[0], v0[1]); w.y = cvt_pk_bf16(v0[2], v0[3]); w.z = cvt_pk_bf16(v1[0], v1[1]); w.w = cvt_pk_bf16(v1[2], v1[3]);
    *(u32x4*)p = w;
}
struct EpiProj {
    bf16_t* P; const float* cs;
    __device__ __forceinline__ void operator()(const f32x4 (&acc)[2][2][4][2], const Unit& u, int wr, int wc, int fr, int fq) const {
        const int row0 = u.pm * BM + wr * 64 + fr, type = u.pn >> 2, cl = wc * 32 + 8 * fq, col0 = u.pn * BM + cl;
        if (type <= 1) {
            const float sc = type == 1 ? 0.0625f : 1.0f;
#pragma unroll
            for (int ai = 0; ai < 2; ++ai)
#pragma unroll
                for (int m = 0; m < 4; ++m) {
                    const int row = row0 + ai * HALF + m * 16;
                    const int pidx = row < MP ? (row & (SEQ - 1)) : SEQ + ((row - MP) & 7);
                    const f32x4* t = (const f32x4*)(cs + ((size_t)pidx * 128 + cl) * 2);
                    const f32x4 t0 = t[0], t1 = t[1], t2 = t[2], t3 = t[3];
                    const f32x4 x1a = acc[ai][0][m][0], x1b = acc[ai][0][m][1], x2a = acc[ai][1][m][0], x2b = acc[ai][1][m][1];
                    f32x4 o1a, o1b, o2a, o2b;
                    o1a[0] = (x1a[0] * t0[0] - x2a[0] * t0[1]) * sc; o2a[0] = (x2a[0] * t0[0] + x1a[0] * t0[1]) * sc;
                    o1a[1] = (x1a[1] * t0[2] - x2a[1] * t0[3]) * sc; o2a[1] = (x2a[1] * t0[2] + x1a[1] * t0[3]) * sc;
                    o1a[2] = (x1a[2] * t1[0] - x2a[2] * t1[1]) * sc; o2a[2] = (x2a[2] * t1[0] + x1a[2] * t1[1]) * sc;
                    o1a[3] = (x1a[3] * t1[2] - x2a[3] * t1[3]) * sc; o2a[3] = (x2a[3] * t1[2] + x1a[3] * t1[3]) * sc;
                    o1b[0] = (x1b[0] * t2[0] - x2b[0] * t2[1]) * sc; o2b[0] = (x2b[0] * t2[0] + x1b[0] * t2[1]) * sc;
                    o1b[1] = (x1b[1] * t2[2] - x2b[1] * t2[3]) * sc; o2b[1] = (x2b[1] * t2[2] + x1b[1] * t2[3]) * sc;
                    o1b[2] = (x1b[2] * t3[0] - x2b[2] * t3[1]) * sc; o2b[2] = (x2b[2] * t3[0] + x1b[2] * t3[1]) * sc;
                    o1b[3] = (x1b[3] * t3[2] - x2b[3] * t3[3]) * sc; o2b[3] = (x2b[3] * t3[2] + x1b[3] * t3[3]) * sc;
                    bf16_t* rp = P + (size_t)row * INW + col0;
                    st8(rp, o1a, o1b); st8(rp + HALF, o2a, o2b);
                }
        } else {
            const bool act = type == 3;
#pragma unroll
            for (int ai = 0; ai < 2; ++ai)
#pragma unroll
                for (int m = 0; m < 4; ++m) {
                    bf16_t* rp = P + (size_t)(row0 + ai * HALF + m * 16) * INW + col0;
#pragma unroll
                    for (int bj = 0; bj < 2; ++bj) {
                        f32x4 v0 = acc[ai][bj][m][0], v1 = acc[ai][bj][m][1];
                        if (act) {
#pragma unroll
                            for (int i = 0; i < 4; ++i) { v0[i] = silu(v0[i]); v1[i] = silu(v1[i]); }
                        }
                        st8(rp + bj * HALF, v0, v1);
                    }
                }
        }
    }
};
struct EpiPlain {
    bf16_t* O; int ldc, coff; const float* scale;
    __device__ __forceinline__ void operator()(const f32x4 (&acc)[2][2][4][2], const Unit& u, int wr, int wc, int fr, int fq) const {
        const int row0 = u.pm * BM + wr * 64 + fr, cl = wc * 32 + 8 * fq, col0 = u.pn * BM + cl;
        f32x4 s[2][2];
#pragma unroll
        for (int bj = 0; bj < 2; ++bj)
#pragma unroll
            for (int n = 0; n < 2; ++n) s[bj][n] = scale ? *(const f32x4*)(scale + col0 + bj * HALF + 4 * n) : (f32x4){1.f, 1.f, 1.f, 1.f};
#pragma unroll
        for (int ai = 0; ai < 2; ++ai)
#pragma unroll
            for (int m = 0; m < 4; ++m) {
                bf16_t* rp = O + (size_t)(row0 + ai * HALF + m * 16) * ldc + coff + col0;
#pragma unroll
                for (int bj = 0; bj < 2; ++bj) st8(rp + bj * HALF, acc[ai][bj][m][0] * s[bj][0], acc[ai][bj][m][1] * s[bj][1]);
            }
    }
};
struct EpiGU {
    bf16_t* Hd;
    __device__ __forceinline__ void operator()(const f32x4 (&acc)[2][2][4][2], const Unit& u, int wr, int wc, int fr, int fq) const {
        const int row0 = u.pm * BM + wr * 64 + fr, cl = wc * 32 + 8 * fq, col0 = u.pn * HALF + cl;
#pragma unroll
        for (int ai = 0; ai < 2; ++ai)
#pragma unroll
            for (int m = 0; m < 4; ++m) {
                f32x4 v0, v1;
#pragma unroll
                for (int i = 0; i < 4; ++i) { v0[i] = silu(acc[ai][0][m][0][i]) * acc[ai][1][m][0][i]; v1[i] = silu(acc[ai][0][m][1][i]) * acc[ai][1][m][1][i]; }
                st8(Hd + (size_t)(row0 + ai * HALF + m * 16) * DFF + col0, v0, v1);
            }
    }
};
}

#define XB_TMO      128
#define XB_XCNT(j)  (256  + 64 * (j))
#define XB_XSUB(j)  (1280 + 64 * (j))
#define XB_XGEN(j)  (2304 + 64 * (j))
#define XB_TOP      3328
#define XB_TOPGEN   3392
#define XCD_BAR_WORDS 3456
#define XB_SPIN_CAP (1u << 18)
__device__ __forceinline__ unsigned xb_ld(unsigned* p)              { return __hip_atomic_load(p, __ATOMIC_RELAXED, __HIP_MEMORY_SCOPE_AGENT); }
__device__ __forceinline__ unsigned xb_add(unsigned* p, unsigned v) { return __hip_atomic_fetch_add(p, v, __ATOMIC_RELAXED, __HIP_MEMORY_SCOPE_AGENT); }
__device__ __forceinline__ unsigned xb_xcc_id() { return (unsigned)__builtin_amdgcn_s_getreg((3 << 11) | 20) & 0xFu; }
#define XB_SPIN(cond, bar) do { unsigned _sp = 0; while (cond) { __builtin_amdgcn_s_sleep(1); \
    if ((++_sp & 255u) == 0u) { if (xb_ld(&(bar)[XB_TMO])) break; if (_sp > XB_SPIN_CAP) { atomicAdd(&(bar)[XB_TMO], 1u); break; } } } } while (0)
__device__ __forceinline__ void xcd_barrier_post(unsigned* bar) {
    if (threadIdx.x == 0) (void)xb_add(&bar[XB_XCNT(xb_xcc_id())], 1u);
}
__device__ __forceinline__ void xcd_barrier_complete(unsigned* bar, unsigned x, unsigned& nloc, unsigned& nx) {
    const unsigned G = gridDim.x * gridDim.y * gridDim.z;
    unsigned sum, cnt, mine, sp = 0u;
    for (;;) {
        sum = 0u; cnt = 0u; mine = 0u;
#pragma unroll
        for (unsigned j = 0; j < 16; ++j) { const unsigned c = xb_ld(&bar[XB_XCNT(j)]); sum += c; cnt += (c > 0u) ? 1u : 0u; mine = (j == x) ? c : mine; }
        if (sum == G) break;
        __builtin_amdgcn_s_sleep(1);
        if ((++sp & 255u) == 0u) { if (xb_ld(&bar[XB_TMO])) break; if (sp > XB_SPIN_CAP) { atomicAdd(&bar[XB_TMO], 1u); break; } }
    }
    nloc = mine > 0u ? mine : 1u; nx = cnt > 0u ? cnt : 1u;
}
__device__ __forceinline__ void xcd_barrier(unsigned* bar, volatile LAS unsigned* st) {
    asm volatile("s_waitcnt vmcnt(0)" ::: "memory");
    __syncthreads();
    if (threadIdx.x == 0) {
        const unsigned x = xb_xcc_id();
        __builtin_amdgcn_s_waitcnt(0);
        unsigned nloc = st[0], nx = st[1];
        if (nloc == 0u) { xcd_barrier_complete(bar, x, nloc, nx); st[0] = nloc; st[1] = nx; }
        const unsigned old = xb_add(&bar[XB_XSUB(x)], 1u);
        const unsigned gen = old / nloc;
        if (old + 1u == (gen + 1u) * nloc) {
            __builtin_amdgcn_fence(__ATOMIC_RELEASE, "agent");
            asm volatile("s_waitcnt vmcnt(0)" ::: "memory");
            const unsigned og = xb_add(&bar[XB_TOP], 1u);
            const unsigned tg = og / nx;
            if (og + 1u == (tg + 1u) * nx) xb_add(&bar[XB_TOPGEN], 1u);
            else XB_SPIN(xb_ld(&bar[XB_TOPGEN]) == tg, bar);
            __builtin_amdgcn_fence(__ATOMIC_ACQUIRE, "agent");
            xb_add(&bar[XB_XGEN(x)], 1u);
            asm volatile("s_waitcnt vmcnt(0)" ::: "memory");
        } else {
            XB_SPIN(xb_ld(&bar[XB_XGEN(x)]) == gen, bar);
            __builtin_amdgcn_fence(__ATOMIC_ACQUIRE, "agent");
            asm volatile("s_waitcnt vmcnt(0)" ::: "memory");
        }
    }
    __syncthreads();
}

struct Args { const float* in[16]; float* out; unsigned char* ws; int ph_lo, ph_hi, use_cg, pad; };

struct Frame {
    LAS unsigned char* lds;
    int tid, lane, wave, vcu, G;
};

__device__ __forceinline__ void p0_transpose_item(const float* W, int K, int N, bf16_t* WT, int mode, LAS float* scr, int item, int lane) {
    const int nblk = N / 32, kb = item / nblk, nb = item % nblk, k0 = 64 * kb, n0 = 32 * nb;
#pragma unroll 8
    for (int i = 0; i < 32; ++i) { const int kk = 2 * i + (lane >> 5); scr[kk * 33 + (lane & 31)] = W[(size_t)(k0 + kk) * N + n0 + (lane & 31)]; }
    LDS_WAIT(); asm volatile("" ::: "memory");
    const int c = lane & 7;
    const int rbase = mode == 0 ? n0 : (256 * (n0 >> 7) + (n0 & 127) + (mode == 2 ? 128 : 0));
#pragma unroll
    for (int j = 0; j < 4; ++j) { const int n = (lane >> 3) + 8 * j; const LAS float* s = scr + (8 * c) * 33 + n;
        u32x4 o; o.x = pk2(s[0 * 33], s[1 * 33]); o.y = pk2(s[2 * 33], s[3 * 33]); o.z = pk2(s[4 * 33], s[5 * 33]); o.w = pk2(s[6 * 33], s[7 * 33]);
        *(GAS u32x4*)(WT + (size_t)(rbase + n) * K + k0 + 8 * c) = o; }
    LDS_WAIT(); asm volatile("" ::: "memory");
}
__device__ __forceinline__ void rms_row_to_bf16(const float* xrow, const float* w, bf16_t* orow, int lane) {
    const GAS f32x4* xr = (const GAS f32x4*)xrow + lane; const GAS f32x4* wr = (const GAS f32x4*)w + lane;
    f32x4 v[8]; float s = 0.f;
#pragma unroll
    for (int j = 0; j < 8; ++j) { v[j] = xr[64 * j]; s += (v[j].x * v[j].x + v[j].y * v[j].y) + (v[j].z * v[j].z + v[j].w * v[j].w); }
    const float rstd = 1.0f / sqrtf(wave_sum(s) * (1.f / D) + EPS);
    GAS u32x2* o8 = (GAS u32x2*)orow + lane;
#pragma unroll
    for (int j = 0; j < 8; ++j) { const f32x4 ww = wr[64 * j]; u32x2 o; o.x = pk2(v[j].x * rstd * ww.x, v[j].y * rstd * ww.y); o.y = pk2(v[j].z * rstd * ww.z, v[j].w * rstd * ww.w); o8[64 * j] = o; }
}
__device__ __forceinline__ const float* xrow_ptr(const float* xp, const float* xs, int m) { return m < MP ? xp + (size_t)m * D : xs + (size_t)(m - MP) * D; }

__device__ __forceinline__ void p0_prologue(Frame& F, const Args& a) {
    unsigned char* ws = a.ws;
    LAS float* scr = (LAS float*)(F.lds + F.wave * 16384);
    const int gw = F.vcu * NWAVES + F.wave, NGW = F.G * NWAVES;
    constexpr int I_IN = (D / 64) * (INW / 32), I_OUT = (D / 64) * (D / 32), I_G = (D / 64) * (DFF / 32), I_D = (DFF / 64) * (D / 32), I_P = 4 * 8;
    constexpr int NITEMS = I_IN + I_OUT + 2 * I_G + I_D + 4 * I_P;
    for (int it = gw; it < NITEMS; it += NGW) {
        int r = it;
        if (r < I_IN) { p0_transpose_item(a.in[6], D, INW, (bf16_t*)(ws + WS_WIN), 0, scr, r, F.lane); continue; } r -= I_IN;
        if (r < I_OUT) { p0_transpose_item(a.in[10], D, D, (bf16_t*)(ws + WS_WOUT), 0, scr, r, F.lane); continue; } r -= I_OUT;
        if (r < I_G) { p0_transpose_item(a.in[13], D, DFF, (bf16_t*)(ws + WS_WGU), 1, scr, r, F.lane); continue; } r -= I_G;
        if (r < I_G) { p0_transpose_item(a.in[14], D, DFF, (bf16_t*)(ws + WS_WGU), 2, scr, r, F.lane); continue; } r -= I_G;
        if (r < I_D) { p0_transpose_item(a.in[15], DFF, D, (bf16_t*)(ws + WS_WD), 0, scr, r, F.lane); continue; } r -= I_D;
        { const int g = r / I_P; p0_transpose_item(a.in[8] + (size_t)g * 65536, 256, 256, (bf16_t*)(ws + WS_WPOOL) + (size_t)g * 65536, 0, scr, r % I_P, F.lane); }
    }
    for (int m = gw; m < M; m += NGW) rms_row_to_bf16(xrow_ptr(a.in[0], a.in[1], m), a.in[4], (bf16_t*)(ws + WS_H) + (size_t)m * D, F.lane);
    float* cs = (float*)(ws + WS_CS);
    for (int idx = F.vcu * NTHR + F.tid; idx < NPOS * 128; idx += F.G * NTHR) {
        const int p = idx >> 7, j = idx & 127;
        double r = 0.930572040929699, inv = 1.0;
#pragma unroll
        for (int b = 0; b < 7; ++b) { if ((j >> b) & 1) inv *= r; r *= r; }
        const float invf = (float)inv;
        const float pos = (float)(p < SEQ ? p : 16384 + (p - SEQ));
        const float ang = pos * invf;
        double t = (double)ang * 0.15915494309189535; t -= __builtin_rint(t);
        const float tf = (float)t;
        f32x2 o; o.x = __builtin_amdgcn_cosf(tf); o.y = __builtin_amdgcn_sinf(tf);
        *(f32x2*)(cs + (size_t)idx * 2) = o;
    }
}

__device__ __forceinline__ unsigned toff(int r, int c16, int RB) { return (unsigned)(r * RB + ((((c16 & ~15) | ((c16 ^ r ^ (r >> 4)) & 15))) << 4)); }
#define MFMA32(a, b, c) __builtin_amdgcn_mfma_f32_32x32x16_bf16((a), (b), (c), 0, 0, 0)
__device__ __forceinline__ int crow(int reg, int h) { return (reg & 3) + 8 * (reg >> 2) + 4 * h; }
__device__ __forceinline__ bf16x8 frag(const LAS unsigned char* tile, int r, int c16, int RB) { return *(const LAS bf16x8*)(tile + toff(r, c16, RB)); }

__device__ __forceinline__ void load_nat128(LAS unsigned char* dst, const bf16_t* src, int ld, int tid) {
    tid = opaque(tid);
    u32x4 v[4];
#pragma unroll
    for (int it = 0; it < 4; ++it) { const int idx = tid + it * NTHR, r = idx >> 4, c = idx & 15; v[it] = *(const GAS u32x4*)(src + (size_t)r * ld + c * 8); }
#pragma unroll
    for (int it = 0; it < 4; ++it) { const int idx = tid + it * NTHR, r = idx >> 4, c = idx & 15; *(LAS u32x4*)(dst + toff(r, c, 256)) = v[it]; }
}
template <bool SCALE>
__device__ __forceinline__ void load_tr(LAS unsigned char* dst, const bf16_t* src, int ld, int tid, float sc_a, float sc_b) {
    tid = opaque(tid);
#pragma unroll
    for (int it = 0; it < 4; ++it) {
        const int T = it * NTHR + tid, ch_lo = T & 15, pp = (T >> 4) & 3, half = (T >> 6) & 1, quad = T >> 7;
        const int pair = 4 * quad + pp, chunk = 16 * half + ch_lo, j0 = 2 * pair, d0 = 8 * chunk;
        const u32x4 a = *(const GAS u32x4*)(src + (size_t)j0 * ld + d0), b = *(const GAS u32x4*)(src + (size_t)(j0 + 1) * ld + d0);
        float s0 = 1.f, s1 = 1.f;
        if (SCALE) { s0 = __builtin_amdgcn_exp2f(sc_a * (sc_b - (float)j0)); s1 = __builtin_amdgcn_exp2f(sc_a * (sc_b - (float)(j0 + 1))); }
#pragma unroll
        for (int i = 0; i < 8; ++i) {
            const unsigned wa = a[i >> 1], wb = b[i >> 1];
            unsigned w;
            if (SCALE) { const float fa = ((i & 1) ? bfhi(wa) : bflo(wa)) * s0, fb = ((i & 1) ? bfhi(wb) : bflo(wb)) * s1; w = pk2(fa, fb); }
            else w = (i & 1) ? ((wa >> 16) | (wb & 0xffff0000u)) : ((wa & 0xffffu) | (wb << 16));
            const int d = d0 + i;
            *(LAS unsigned*)(dst + toff(d, quad, 256) + pp * 4) = w;
        }
    }
}

__device__ __forceinline__ void u_item(Frame& F, const bf16_t* PROJ, bf16_t* UT, int item) {
    const int b = item >> 6, h = (item >> 4) & 3, c = item & 15, rows0 = b * SEQ + c * 128;
    const bf16_t* Ks = PROJ + (size_t)rows0 * INW + 1024 + h * 256; const bf16_t* Vs = Ks + 1024;
    LAS unsigned char* KT = F.lds; LAS unsigned char* VT = F.lds + 65536;
    const float lg = lg2gamma(h);
    load_tr<true>(KT, Ks, INW, F.tid, lg, 127.f);
    load_tr<false>(VT, Vs, INW, F.tid, 0.f, 0.f);
    __syncthreads();
    const int w = F.wave, r = opaque(F.lane) & 31, hh = opaque(F.lane) >> 5;
    f32x16 acc[8];
#pragma unroll
    for (int t = 0; t < 8; ++t)
#pragma unroll
        for (int i = 0; i < 16; ++i) acc[t][i] = 0.f;
#pragma unroll 1
    for (int ks = 0; ks < 8; ++ks) {
        const bf16x8 a = frag(KT, 32 * w + r, 2 * ks + hh, 256);
#pragma unroll
        for (int et = 0; et < 8; ++et) { const bf16x8 bb = frag(VT, 32 * et + r, 2 * ks + hh, 256); acc[et] = MFMA32(a, bb, acc[et]); }
    }
    bf16_t* Up = UT + ((size_t)((b * 4 + h) * 16 + c) * 256) * 256;
#pragma unroll
    for (int et = 0; et < 8; ++et)
#pragma unroll
        for (int g = 0; g < 4; ++g) {
            u32x2 o; o.x = cvt_pk_bf16(acc[et][4 * g], acc[et][4 * g + 1]); o.y = cvt_pk_bf16(acc[et][4 * g + 2], acc[et][4 * g + 3]);
            *(GAS u32x2*)(Up + (size_t)(32 * et + r) * 256 + 32 * w + 8 * g + 4 * hh) = o;
        }
    __syncthreads();
}

__device__ __forceinline__ void o_item(Frame& F, const bf16_t* PROJ, const bf16_t* SCT, const float* retw, bf16_t* MIX, int item) {
    const int b = item >> 6, h = (item >> 4) & 3, c = item & 15, rows0 = b * SEQ + c * 128;
    const bf16_t* Qs = PROJ + (size_t)rows0 * INW + h * 256; const bf16_t* Ks = Qs + 1024; const bf16_t* Vs = Qs + 2048; const bf16_t* Gs = Qs + 3072;
    LAS unsigned char* QH = F.lds; LAS unsigned char* KH = F.lds + 32768; LAS unsigned char* PB = F.lds + 65536; LAS unsigned char* VT = F.lds; LAS unsigned char* OB = F.lds;
    const float lg = lg2gamma(h);
    const int w = F.wave; int r = opaque(F.lane) & 31, hh = opaque(F.lane) >> 5;
    {
        const int ib = w >> 1, jb0 = 2 * (w & 1);
        f32x16 sc[2];
#pragma unroll
        for (int t = 0; t < 2; ++t)
#pragma unroll
            for (int i = 0; i < 16; ++i) sc[t][i] = 0.f;
        for (int dh = 0; dh < 2; ++dh) {
            load_nat128(QH, Qs + 128 * dh, INW, F.tid); load_nat128(KH, Ks + 128 * dh, INW, F.tid);
            __syncthreads();
            if (jb0 <= ib) {
#pragma unroll 1
                for (int ks = 0; ks < 8; ++ks) {
                    const bf16x8 a = frag(QH, 32 * ib + r, 2 * ks + hh, 256);
                    const bf16x8 b0 = frag(KH, 32 * jb0 + r, 2 * ks + hh, 256), b1 = frag(KH, 32 * (jb0 + 1) + r, 2 * ks + hh, 256);
                    sc[0] = MFMA32(a, b0, sc[0]); sc[1] = MFMA32(a, b1, sc[1]);
                }
            }
            __syncthreads();
        }
        r = opaque(r); hh = opaque(hh);
#pragma unroll
        for (int t = 0; t < 2; ++t) {
            const int j = 32 * (jb0 + t) + r;
#pragma unroll
            for (int reg = 0; reg < 16; ++reg) {
                const int i = 32 * ib + crow(reg, hh);
                const float v = (i >= j) ? sc[t][reg] * __builtin_amdgcn_exp2f(lg * (float)(i - j)) : 0.f;
                *(LAS bf16_t*)(PB + toff(i, j >> 3, 256) + (j & 7) * 2) = (bf16_t)f2bf(v);
            }
        }
    }
    f32x16 o[4];
#pragma unroll
    for (int t = 0; t < 4; ++t)
#pragma unroll
        for (int i = 0; i < 16; ++i) o[t][i] = 0.f;
    const bf16_t* Sp = SCT + ((size_t)((b * 4 + h) * 16 + c) * 256) * 256 + (size_t)(32 * w + r) * 256 + 8 * hh;
    for (int dh = 0; dh < 2; ++dh) {
        load_nat128(QH, Qs + 128 * dh, INW, F.tid);
        __syncthreads();
#pragma unroll 1
        for (int ks = 0; ks < 8; ++ks) {
            const bf16x8 bb = *(const GAS bf16x8*)(Sp + 128 * dh + 16 * ks);
#pragma unroll
            for (int ib = 0; ib < 4; ++ib) { const bf16x8 a = frag(QH, 32 * ib + r, 2 * ks + hh, 256); o[ib] = MFMA32(a, bb, o[ib]); }
        }
        __syncthreads();
    }
#pragma unroll
    for (int ib = 0; ib < 4; ++ib)
#pragma unroll
        for (int reg = 0; reg < 16; ++reg) o[ib][reg] *= __builtin_amdgcn_exp2f(lg * (float)(32 * ib + crow(reg, hh) + 1));
    load_tr<false>(VT, Vs, INW, F.tid, 0.f, 0.f);
    __syncthreads();
#pragma unroll 1
    for (int ks = 0; ks < 8; ++ks) {
        const bf16x8 bb = frag(VT, 32 * w + r, 2 * ks + hh, 256);
#pragma unroll
        for (int ib = 0; ib < 4; ++ib)
            if (ks < 2 * (ib + 1)) { const bf16x8 a = frag(PB, 32 * ib + r, 2 * ks + hh, 256); o[ib] = MFMA32(a, bb, o[ib]); }
    }
    __syncthreads();
    r = opaque(r); hh = opaque(hh);
#pragma unroll
    for (int ib = 0; ib < 4; ++ib)
#pragma unroll
        for (int reg = 0; reg < 16; ++reg) { const int i = 32 * ib + crow(reg, hh);
            *(LAS bf16_t*)(OB + i * 512 + (32 * w + r) * 2) = (bf16_t)f2bf(o[ib][reg]); }
    __syncthreads();
    {
        const int tid2 = opaque(F.tid), cc = tid2 & 31;
        const f32x4 wa = *(const GAS f32x4*)(retw + h * 256 + cc * 8), wb = *(const GAS f32x4*)(retw + h * 256 + cc * 8 + 4);
#pragma unroll 2
        for (int it = 0; it < 8; ++it) {
            const int i = (tid2 >> 5) + 16 * it;
            const u32x4 ov = *(const LAS u32x4*)(OB + i * 512 + cc * 16);
            const u32x4 gv = *(const GAS u32x4*)(Gs + (size_t)i * INW + cc * 8);
            float x[8];
#pragma unroll
            for (int k = 0; k < 4; ++k) { x[2 * k] = bflo(ov[k]); x[2 * k + 1] = bfhi(ov[k]); }
            float s = 0.f;
#pragma unroll
            for (int k = 0; k < 8; ++k) s += x[k] * x[k];
            s += __shfl_xor(s, 1); s += __shfl_xor(s, 2); s += __shfl_xor(s, 4); s += __shfl_xor(s, 8); s += __shfl_xor(s, 16);
            const float rstd = 1.0f / sqrtf(s * (1.f / 256.f) + EPS);
            u32x4 res;
            res[0] = pk2(x[0] * rstd * wa[0] * bflo(gv[0]), x[1] * rstd * wa[1] * bfhi(gv[0]));
            res[1] = pk2(x[2] * rstd * wa[2] * bflo(gv[1]), x[3] * rstd * wa[3] * bfhi(gv[1]));
            res[2] = pk2(x[4] * rstd * wb[0] * bflo(gv[2]), x[5] * rstd * wb[1] * bfhi(gv[2]));
            res[3] = pk2(x[6] * rstd * wb[2] * bflo(gv[3]), x[7] * rstd * wb[3] * bfhi(gv[3]));
            *(GAS u32x4*)(MIX + (size_t)(rows0 + i) * D + h * 256 + cc * 8) = res;
        }
    }
    __syncthreads();
}

__device__ __forceinline__ void s_item(Frame& F, const bf16_t* PROJ, const float* state, const float* retw, float* newstate, bf16_t* MIX, int item) {
    const int sb = item >> 2, h = item & 3, rows0 = MP + sb * 8;
    const float lg = lg2gamma(h);
    LAS float* QK = (LAS float*)F.lds;
    LAS float* QR = (LAS float*)(F.lds + 16384);
    LAS float* KR = (LAS float*)(F.lds + 16384 + 8224);
    LAS float* SCP = (LAS float*)(F.lds + 16384 + 2 * 8224);
    LAS float* SCO = (LAS float*)(F.lds + 16384 + 2 * 8224 + 2048);
    LAS float* RED = (LAS float*)(F.lds + 40960);
    const int w = F.wave, l = opaque(F.lane), tid_o = opaque(F.tid);
    for (int idx = tid_o; idx < 8 * 256; idx += NTHR) {
        const int i = idx >> 8, d = idx & 255;
        const float qv = bf2f(PROJ[(size_t)(rows0 + i) * INW + h * 256 + d]), kv = bf2f(PROJ[(size_t)(rows0 + i) * INW + 1024 + h * 256 + d]);
        QR[i * 257 + d] = qv; KR[i * 257 + d] = kv;
        QK[d * 16 + i] = qv * __builtin_amdgcn_exp2f(lg * (float)(i + 1)); QK[d * 16 + 8 + i] = kv * __builtin_amdgcn_exp2f(lg * (float)(7 - i));
    }
    float v[8][4];
#pragma unroll
    for (int j = 0; j < 8; ++j) { const u32x2 t = *(const GAS u32x2*)(PROJ + (size_t)(rows0 + j) * INW + 2048 + h * 256 + 4 * l); v[j][0] = bflo(t.x); v[j][1] = bfhi(t.x); v[j][2] = bflo(t.y); v[j][3] = bfhi(t.y); }
    __syncthreads();
    {
        const int i = l >> 3, j = l & 7; float s = 0.f;
#pragma unroll 8
        for (int d = 32 * w; d < 32 * w + 32; ++d) s += QR[i * 257 + d] * KR[j * 257 + d];
        SCP[w * 64 + l] = s;
    }
    float oacc[8][4];
#pragma unroll
    for (int i = 0; i < 8; ++i)
#pragma unroll
        for (int c = 0; c < 4; ++c) oacc[i][c] = 0.f;
    const float g8 = __builtin_amdgcn_exp2f(lg * 8.f);
    const GAS f32x4* Sp = (const GAS f32x4*)(state + ((size_t)(sb * 4 + h) * 256 + 32 * w) * 256) + l;
    GAS f32x4* Np = (GAS f32x4*)(newstate + ((size_t)(sb * 4 + h) * 256 + 32 * w) * 256) + l;
#pragma unroll 1
    for (int d0 = 0; d0 < 32; d0 += 4) {
        f32x4 s4[4];
#pragma unroll
        for (int k = 0; k < 4; ++k) s4[k] = Sp[(size_t)(d0 + k) * 64];
#pragma unroll
        for (int k = 0; k < 4; ++k) {
            const LAS f32x4* qk = (const LAS f32x4*)(QK + (32 * w + d0 + k) * 16);
            const f32x4 qa = qk[0], qb = qk[1], ka = qk[2], kb = qk[3];
            f32x4 n;
#pragma unroll
            for (int c = 0; c < 4; ++c) {
                const float sv = s4[k][c];
                oacc[0][c] += qa[0] * sv; oacc[1][c] += qa[1] * sv; oacc[2][c] += qa[2] * sv; oacc[3][c] += qa[3] * sv;
                oacc[4][c] += qb[0] * sv; oacc[5][c] += qb[1] * sv; oacc[6][c] += qb[2] * sv; oacc[7][c] += qb[3] * sv;
                float t = g8 * sv;
                t += ka[0] * v[0][c]; t += ka[1] * v[1][c]; t += ka[2] * v[2][c]; t += ka[3] * v[3][c];
                t += kb[0] * v[4][c]; t += kb[1] * v[5][c]; t += kb[2] * v[6][c]; t += kb[3] * v[7][c];
                n[c] = t;
            }
            Np[(size_t)(d0 + k) * 64] = n;
        }
    }
#pragma unroll
    for (int i = 0; i < 8; ++i) *(LAS f32x4*)(RED + (w * 8 + i) * 256 + 4 * l) = (f32x4){oacc[i][0], oacc[i][1], oacc[i][2], oacc[i][3]};
    __syncthreads();
    if (tid_o < 64) { const int i = l >> 3, j = l & 7; float s = 0.f;
#pragma unroll
        for (int ww = 0; ww < 8; ++ww) s += SCP[ww * 64 + l];
        SCO[l] = (i >= j) ? s * __builtin_amdgcn_exp2f(lg * (float)(i - j)) : 0.f; }
    __syncthreads();
    {
        const int i = w; f32x4 tot = (f32x4){0.f, 0.f, 0.f, 0.f};
#pragma unroll
        for (int ww = 0; ww < 8; ++ww) tot += *(const LAS f32x4*)(RED + (ww * 8 + i) * 256 + 4 * l);
#pragma unroll
        for (int j = 0; j < 8; ++j) { const float s = SCO[i * 8 + j];
#pragma unroll
            for (int c = 0; c < 4; ++c) tot[c] += s * v[j][c]; }
        const float ss = wave_sum((tot[0] * tot[0] + tot[1] * tot[1]) + (tot[2] * tot[2] + tot[3] * tot[3]));
        const float rstd = 1.0f / sqrtf(ss * (1.f / 256.f) + EPS);
        const f32x4 wn = *(const GAS f32x4*)(retw + h * 256 + 4 * l);
        const u32x2 gv = *(const GAS u32x2*)(PROJ + (size_t)(rows0 + i) * INW + 3072 + h * 256 + 4 * l);
        u32x2 res; res.x = pk2(tot[0] * rstd * wn[0] * bflo(gv.x), tot[1] * rstd * wn[1] * bfhi(gv.x)); res.y = pk2(tot[2] * rstd * wn[2] * bflo(gv.y), tot[3] * rstd * wn[3] * bfhi(gv.y));
        *(GAS u32x2*)(MIX + (size_t)(rows0 + i) * D + h * 256 + 4 * l) = res;
    }
    __syncthreads();
}

__device__ __forceinline__ void pool_prompt_task(const bf16_t* PROJ, bf16_t* POOLED, float* outp, int task) {
    const int blk = task >> 7, ch8 = task & 127, ch = ch8 * 8, wsz = 2 << (ch >> 8);
    const int m0 = blk * 32, t0 = m0 & (SEQ - 1), bseq = m0 >> 11;
    const bf16_t* U = PROJ + 4096 + ch;
    float sum[8];
#pragma unroll
    for (int k = 0; k < 8; ++k) sum[k] = 0.f;
    for (int i = 1; i < wsz; ++i) if (t0 - i >= 0) { const u32x4 a = *(const GAS u32x4*)(U + (size_t)(m0 - i) * INW);
#pragma unroll
        for (int k = 0; k < 4; ++k) { sum[2 * k] += bflo(a[k]); sum[2 * k + 1] += bfhi(a[k]); } }
    for (int k = 0; k < 32; ++k) {
        const int t = t0 + k, m = m0 + k;
        const u32x4 cu = *(const GAS u32x4*)(U + (size_t)m * INW);
        float cur[8];
#pragma unroll
        for (int q = 0; q < 4; ++q) { cur[2 * q] = bflo(cu[q]); cur[2 * q + 1] = bfhi(cu[q]); }
#pragma unroll
        for (int q = 0; q < 8; ++q) sum[q] += cur[q];
        const int cnt = (t + 1 < wsz) ? t + 1 : wsz; const float inv = 1.0f / (float)cnt;
        u32x4 o;
#pragma unroll
        for (int q = 0; q < 4; ++q) o[q] = pk2(sum[2 * q] * inv - cur[2 * q], sum[2 * q + 1] * inv - cur[2 * q + 1]);
        *(GAS u32x4*)(POOLED + (size_t)m * 1024 + ch) = o;
        if (t - wsz + 1 >= 0) { const u32x4 a = *(const GAS u32x4*)(U + (size_t)(m - wsz + 1) * INW);
#pragma unroll
            for (int q = 0; q < 4; ++q) { sum[2 * q] -= bflo(a[q]); sum[2 * q + 1] -= bfhi(a[q]); } }
        if (t >= SEQ - 15) { float* op = outp + ((size_t)bseq * 15 + (t - (SEQ - 15))) * 1024 + ch;
            *(GAS f32x4*)op = (f32x4){cur[0], cur[1], cur[2], cur[3]}; *(GAS f32x4*)(op + 4) = (f32x4){cur[4], cur[5], cur[6], cur[7]}; }
    }
}
__device__ __forceinline__ void pool_sample_task(const bf16_t* PROJ, const float* spool, bf16_t* POOLED, float* outs, int task) {
    const int sb = task >> 7, ch8 = task & 127, ch = ch8 * 8, wsz = 2 << (ch >> 8);
    const bf16_t* U = PROJ + (size_t)(MP + sb * 8) * INW + 4096 + ch;
    const float* B = spool + (size_t)sb * 15 * 1024 + ch;
    float sum[8];
#pragma unroll
    for (int k = 0; k < 8; ++k) sum[k] = 0.f;
    for (int i = 1; i < wsz; ++i) { const f32x4 a = *(const GAS f32x4*)(B + (size_t)(15 - i) * 1024), b2 = *(const GAS f32x4*)(B + (size_t)(15 - i) * 1024 + 4);
#pragma unroll
        for (int q = 0; q < 4; ++q) { sum[q] += a[q]; sum[4 + q] += b2[q]; } }
    const float inv = 1.0f / (float)wsz;
    for (int t = 0; t < 8; ++t) {
        const u32x4 cu = *(const GAS u32x4*)(U + (size_t)t * INW);
        float cur[8];
#pragma unroll
        for (int q = 0; q < 4; ++q) { cur[2 * q] = bflo(cu[q]); cur[2 * q + 1] = bfhi(cu[q]); }
#pragma unroll
        for (int q = 0; q < 8; ++q) sum[q] += cur[q];
        u32x4 o;
#pragma unroll
        for (int q = 0; q < 4; ++q) o[q] = pk2(sum[2 * q] * inv - cur[2 * q], sum[2 * q + 1] * inv - cur[2 * q + 1]);
        *(GAS u32x4*)(POOLED + (size_t)(MP + sb * 8 + t) * 1024 + ch) = o;
        const int xi = 15 + t - wsz + 1;
        if (xi < 15) { const f32x4 a = *(const GAS f32x4*)(B + (size_t)xi * 1024), b2 = *(const GAS f32x4*)(B + (size_t)xi * 1024 + 4);
#pragma unroll
            for (int q = 0; q < 4; ++q) { sum[q] -= a[q]; sum[4 + q] -= b2[q]; } }
        else { const u32x4 a = *(const GAS u32x4*)(U + (size_t)(xi - 15) * INW);
#pragma unroll
            for (int q = 0; q < 4; ++q) { sum[2 * q] -= bflo(a[q]); sum[2 * q + 1] -= bfhi(a[q]); } }
        float* op = outs + ((size_t)sb * 15 + 7 + t) * 1024 + ch;
        *(GAS f32x4*)op = (f32x4){cur[0], cur[1], cur[2], cur[3]}; *(GAS f32x4*)(op + 4) = (f32x4){cur[4], cur[5], cur[6], cur[7]};
    }
    for (int rr = 0; rr < 7; ++rr) { float* op = outs + ((size_t)sb * 15 + rr) * 1024 + ch; const float* ip = B + (size_t)(8 + rr) * 1024;
        *(GAS f32x4*)op = *(const GAS f32x4*)ip; *(GAS f32x4*)(op + 4) = *(const GAS f32x4*)(ip + 4); }
}

__device__ __forceinline__ void n1_row(const float* xrow, const bf16_t* mo, const float* wpost, const float* wpre, float* yrow, bf16_t* hrow, int lane) {
    f32x4 xa[4], xb[4]; u32x4 mv[4]; float s = 0.f;
#pragma unroll
    for (int j = 0; j < 4; ++j) { const int c = 8 * lane + 512 * j; xa[j] = *(const GAS f32x4*)(xrow + c); xb[j] = *(const GAS f32x4*)(xrow + c + 4); mv[j] = *(const GAS u32x4*)(mo + c); }
    float mf[4][8];
#pragma unroll
    for (int j = 0; j < 4; ++j)
#pragma unroll
        for (int q = 0; q < 4; ++q) { mf[j][2 * q] = bflo(mv[j][q]); mf[j][2 * q + 1] = bfhi(mv[j][q]); }
#pragma unroll
    for (int j = 0; j < 4; ++j)
#pragma unroll
        for (int q = 0; q < 8; ++q) s += mf[j][q] * mf[j][q];
    const float r1 = 1.0f / sqrtf(wave_sum(s) * (1.f / D) + EPS);
    float s2 = 0.f;
#pragma unroll
    for (int j = 0; j < 4; ++j) { const int c = 8 * lane + 512 * j; const f32x4 wa = *(const GAS f32x4*)(wpost + c), wb = *(const GAS f32x4*)(wpost + c + 4);
#pragma unroll
        for (int q = 0; q < 4; ++q) { xa[j][q] += mf[j][q] * r1 * wa[q]; xb[j][q] += mf[j][4 + q] * r1 * wb[q]; s2 += xa[j][q] * xa[j][q] + xb[j][q] * xb[j][q]; }
        *(GAS f32x4*)(yrow + c) = xa[j]; *(GAS f32x4*)(yrow + c + 4) = xb[j]; }
    const float r2 = 1.0f / sqrtf(wave_sum(s2) * (1.f / D) + EPS);
#pragma unroll
    for (int j = 0; j < 4; ++j) { const int c = 8 * lane + 512 * j; const f32x4 wa = *(const GAS f32x4*)(wpre + c), wb = *(const GAS f32x4*)(wpre + c + 4);
        u32x4 o; o.x = pk2(xa[j][0] * r2 * wa[0], xa[j][1] * r2 * wa[1]); o.y = pk2(xa[j][2] * r2 * wa[2], xa[j][3] * r2 * wa[3]);
        o.z = pk2(xb[j][0] * r2 * wb[0], xb[j][1] * r2 * wb[1]); o.w = pk2(xb[j][2] * r2 * wb[2], xb[j][3] * r2 * wb[3]);
        *(GAS u32x4*)(hrow + c) = o; }
}
__device__ __forceinline__ void n2_row(const bf16_t* ff, const float* wpost, float* yrow, int lane) {
    u32x4 fv[4]; float s = 0.f; float ffl[4][8];
#pragma unroll
    for (int j = 0; j < 4; ++j) fv[j] = *(const GAS u32x4*)(ff + 8 * lane + 512 * j);
#pragma unroll
    for (int j = 0; j < 4; ++j)
#pragma unroll
        for (int q = 0; q < 4; ++q) { ffl[j][2 * q] = bflo(fv[j][q]); ffl[j][2 * q + 1] = bfhi(fv[j][q]); }
#pragma unroll
    for (int j = 0; j < 4; ++j)
#pragma unroll
        for (int q = 0; q < 8; ++q) s += ffl[j][q] * ffl[j][q];
    const float r1 = 1.0f / sqrtf(wave_sum(s) * (1.f / D) + EPS);
#pragma unroll
    for (int j = 0; j < 4; ++j) { const int c = 8 * lane + 512 * j; const f32x4 wa = *(const GAS f32x4*)(wpost + c), wb = *(const GAS f32x4*)(wpost + c + 4);
        f32x4 ya = *(const GAS f32x4*)(yrow + c), yb = *(const GAS f32x4*)(yrow + c + 4);
#pragma unroll
        for (int q = 0; q < 4; ++q) { ya[q] += ffl[j][q] * r1 * wa[q]; yb[q] += ffl[j][4 + q] * r1 * wb[q]; }
        *(GAS f32x4*)(yrow + c) = ya; *(GAS f32x4*)(yrow + c + 4) = yb; }
}

constexpr int NPH = 10;
__global__ void __launch_bounds__(NTHR, 2) hyb_fwd(Args args) {
    extern __shared__ __attribute__((aligned(16))) unsigned char lds[];
    Frame F;
    F.lds = (LAS unsigned char*)lds;
    F.tid = threadIdx.x; F.lane = F.tid & 63; F.wave = __builtin_amdgcn_readfirstlane(F.tid >> 6);
    F.G = gridDim.x; { const int bx = blockIdx.x; F.vcu = (F.G % 8 == 0) ? (bx % 8) * (F.G / 8) + bx / 8 : bx; }
    unsigned char* ws = args.ws;
    const int lo = args.ph_lo, hi = args.ph_hi;
    if (F.tid < 32) ((volatile LAS unsigned*)(F.lds + MISC_OFF))[F.tid] = 0u;
    __syncthreads();
    if (args.use_cg) xcd_barrier_post((unsigned*)(ws + WS_CTL) + CW_BAR);
#ifndef PH_ENABLE
#define PH_ENABLE 0x3ff
#endif
#define IN(k) (((PH_ENABLE >> (k)) & 1) && lo <= (k) && (k) < hi)
#define BOTH(k) (IN(k) && IN((k) + 1))
#ifndef REP_MASK
#define REP_MASK 0
#endif
#define REPS(k) for (int rep_ = 0; rep_ <= ((REP_MASK >> (k)) & 1); ++rep_)
#define REP_MORE(k) (rep_ < ((REP_MASK >> (k)) & 1))
#ifndef CG_SEAMS
#define CG_SEAMS 0x001
#endif
#define GRID_BAR(k) do { if ((CG_SEAMS >> (k)) & 1) cg::this_grid().sync(); else xcd_barrier((unsigned*)(args.ws + WS_CTL) + CW_BAR, (volatile LAS unsigned*)(F.lds + MISC_OFF) + 8); } while (0)
    bf16_t* H = (bf16_t*)(ws + WS_H); bf16_t* PROJ = (bf16_t*)(ws + WS_PROJ); bf16_t* MIX = (bf16_t*)(ws + WS_MIX);
    bf16_t* UT = (bf16_t*)(ws + WS_UT); bf16_t* SCT = (bf16_t*)(ws + WS_SCT); bf16_t* POOLED = (bf16_t*)(ws + WS_POOLED);
    bf16_t* MO = (bf16_t*)(ws + WS_MO); bf16_t* HID = (bf16_t*)(ws + WS_HID); bf16_t* FFB = (bf16_t*)(ws + WS_FF);
    float* out = args.out;

    if (IN(0)) REPS(0) { p0_prologue(F, args); if (BOTH(0) || REP_MORE(0)) GRID_BAR(0); }
    if (IN(1)) REPS(1) {
        pg8::Gemm g{H, (const bf16_t*)(ws + WS_WIN), D, D, D, 0}; pg8::StaticOrder S; S.init(M / 256, INW / 256, F.G, (int)blockIdx.x);
        pg8::EpiProj E{PROJ, (const float*)(ws + WS_CS)};
        pg8::gemm_phase(F.lds, g, S, E);
        if (BOTH(1) || REP_MORE(1)) GRID_BAR(1);
    }
    if (IN(2)) REPS(2) {
        for (int it = F.vcu; it < 256; it += F.G) u_item(F, PROJ, UT, it);
        for (int task = F.vcu * NTHR + F.tid; task < 256 * 128; task += F.G * NTHR) pool_prompt_task(PROJ, POOLED, out + O_POOLP, task);
        for (int task = F.vcu * NTHR + F.tid; task < 128 * 128; task += F.G * NTHR) pool_sample_task(PROJ, args.in[3], POOLED, out + O_POOLS, task);
        for (int it = F.vcu; it < 512; it += F.G) s_item(F, PROJ, args.in[2], args.in[7], out + O_RETS, MIX, it);
        if (BOTH(2) || REP_MORE(2)) GRID_BAR(2);
    }
    if (IN(3)) REPS(3) {
        for (int idx = F.vcu * NTHR + F.tid; idx < 16 * 256 * 32; idx += F.G * NTHR) {
            const int bh = idx >> 13, e = (idx >> 5) & 255, d8 = (idx & 31) * 8;
            const float g128 = __builtin_amdgcn_exp2f(lg2gamma(bh & 3) * 128.f);
            float s[8];
#pragma unroll
            for (int k = 0; k < 8; ++k) s[k] = 0.f;
            for (int c = 0; c < 16; ++c) {
                const size_t off = ((size_t)(bh * 16 + c) * 256 + e) * 256 + d8;
                u32x4 o; o.x = pk2(s[0], s[1]); o.y = pk2(s[2], s[3]); o.z = pk2(s[4], s[5]); o.w = pk2(s[6], s[7]);
                *(GAS u32x4*)(SCT + off) = o;
                const u32x4 uv = *(const GAS u32x4*)(UT + off);
#pragma unroll
                for (int k = 0; k < 4; ++k) { s[2 * k] = g128 * s[2 * k] + bflo(uv[k]); s[2 * k + 1] = g128 * s[2 * k + 1] + bfhi(uv[k]); }
            }
            float* op = out + O_RETP + (size_t)bh * 65536 + e;
#pragma unroll
            for (int k = 0; k < 8; ++k) op[(size_t)(d8 + k) * 256] = s[k];
        }
        {
            pg8::Gemm g{POOLED, (const bf16_t*)(ws + WS_WPOOL), 1024, 256, 256, 256}; pg8::StaticOrder S; S.init(M / 256, 4, F.G, (int)blockIdx.x);
            pg8::EpiPlain E{MIX, D, 1024, args.in[9]};
            pg8::gemm_phase(F.lds, g, S, E);
        }
        if (BOTH(3) || REP_MORE(3)) GRID_BAR(3);
    }
    if (IN(4)) REPS(4) {
        for (int it = F.vcu; it < 256; it += F.G) o_item(F, PROJ, SCT, args.in[7], MIX, it);
        if (BOTH(4) || REP_MORE(4)) GRID_BAR(4);
    }
    if (IN(5)) REPS(5) {
        pg8::Gemm g{MIX, (const bf16_t*)(ws + WS_WOUT), D, D, D, 0}; pg8::StaticOrder S; S.init(M / 256, D / 256, F.G, (int)blockIdx.x);
        pg8::EpiPlain E{MO, D, 0, nullptr};
        pg8::gemm_phase(F.lds, g, S, E);
        if (BOTH(5) || REP_MORE(5)) GRID_BAR(5);
    }
    if (IN(6)) REPS(6) {
        const int gw = F.vcu * NWAVES + F.wave, NGW = F.G * NWAVES;
        for (int m = gw; m < M; m += NGW) n1_row(xrow_ptr(args.in[0], args.in[1], m), MO + (size_t)m * D, args.in[5], args.in[11], out + O_Y + (size_t)m * D, H + (size_t)m * D, F.lane);
        if (BOTH(6) || REP_MORE(6)) GRID_BAR(6);
    }
    if (IN(7)) REPS(7) {
        pg8::Gemm g{H, (const bf16_t*)(ws + WS_WGU), D, D, D, 0}; pg8::StaticOrder S; S.init(M / 256, NGU / 256, F.G, (int)blockIdx.x);
        pg8::EpiGU E{HID};
        pg8::gemm_phase(F.lds, g, S, E);
        if (BOTH(7) || REP_MORE(7)) GRID_BAR(7);
    }
    if (IN(8)) REPS(8) {
        pg8::Gemm g{HID, (const bf16_t*)(ws + WS_WD), DFF, DFF, DFF, 0}; pg8::StaticOrder S; S.init(M / 256, D / 256, F.G, (int)blockIdx.x);
        pg8::EpiPlain E{FFB, D, 0, nullptr};
        pg8::gemm_phase(F.lds, g, S, E);
        if (BOTH(8) || REP_MORE(8)) GRID_BAR(8);
    }
    if (IN(9)) {
        const int gw = F.vcu * NWAVES + F.wave, NGW = F.G * NWAVES;
        for (int m = gw; m < M; m += NGW) n2_row(FFB + (size_t)m * D, args.in[12], out + O_Y + (size_t)m * D, F.lane);
    }
#undef IN
#undef BOTH
}

extern "C" void kernel_launch(void* const* d_in, const int* in_sizes, int n_in, void* d_out, int out_size, void* d_ws, size_t ws_size, hipStream_t stream) {
    static int grid = 0;
    if (grid == 0) {
        if (n_in != 16 || (size_t)out_size != O_END || ws_size < WS_END) { fprintf(stderr, "kernel_launch: unexpected shapes: n_in %d out %d ws %zu (need %zu)\n", n_in, out_size, ws_size, (size_t)WS_END); grid = -1; return; }
        int dev = 0, cus = 0, per_cu = 0;
        if (hipGetDevice(&dev) != hipSuccess || hipDeviceGetAttribute(&cus, hipDeviceAttributeMultiprocessorCount, dev) != hipSuccess) { grid = -1; return; }
        if (hipFuncSetAttribute((const void*)hyb_fwd, hipFuncAttributeMaxDynamicSharedMemorySize, LDS_BYTES) != hipSuccess) { fprintf(stderr, "kernel_launch: hipFuncSetAttribute failed\n"); grid = -1; return; }
        if (hipOccupancyMaxActiveBlocksPerMultiprocessor(&per_cu, (const void*)hyb_fwd, NTHR, LDS_BYTES) != hipSuccess || per_cu < 1) { fprintf(stderr, "kernel_launch: occupancy query says %d\n", per_cu); per_cu = 1; }
        (void)hipGetLastError();
        grid = cus * 1;
        fprintf(stderr, "kernel_launch: grid %d (occupancy query %d per CU)\n", grid, per_cu);
    }
    if (grid < 0) return;
    Args a{};
    for (int i = 0; i < 16; ++i) a.in[i] = (const float*)d_in[i];
    a.out = (float*)d_out; a.ws = (unsigned char*)d_ws;
    if (hipMemsetAsync((char*)d_ws + WS_CTL, 0, CTL_ZERO_BYTES, stream) != hipSuccess) { fprintf(stderr, "kernel_launch: memset failed\n"); return; }
    if (MK_N_LAUNCHES == 1) {
        a.ph_lo = 0; a.ph_hi = NPH; a.use_cg = 1;
        void* kargs[] = {&a};
        hipError_t e = hipLaunchCooperativeKernel((const void*)hyb_fwd, dim3(grid), dim3(NTHR), kargs, LDS_BYTES, stream);
        if (e != hipSuccess) fprintf(stderr, "kernel_launch: cooperative launch failed: %s (grid %d)\n", hipGetErrorString(e), grid);
    } else {
        for (int p = 0; p < NPH; ++p) {
            a.ph_lo = p; a.ph_hi = p + 1; a.use_cg = 0;
            hipLaunchKernelGGL(hyb_fwd, dim3(grid), dim3(NTHR), LDS_BYTES, stream, a);
        }
    }
}
```

```cpp
#include <hip/hip_runtime.h>
#include <hip/hip_cooperative_groups.h>
#include <cstdio>
#include <cstdint>
namespace cg = cooperative_groups;

#ifndef MK_N_LAUNCHES
#define MK_N_LAUNCHES 1
#endif

#define GAS __attribute__((address_space(1)))
#define LAS __attribute__((address_space(3)))
typedef unsigned short bf16_t;
typedef short bf16x8 __attribute__((ext_vector_type(8)));
typedef float f32x2 __attribute__((ext_vector_type(2)));
typedef float f32x4 __attribute__((ext_vector_type(4)));
typedef float f32x16 __attribute__((ext_vector_type(16)));
typedef unsigned u32x2 __attribute__((ext_vector_type(2)));
typedef unsigned u32x4 __attribute__((ext_vector_type(4)));

constexpr int D = 2048, MP = 8192, MS = 1024, M = MP + MS, SEQ = 2048;
constexpr int INW = 5120, DFF = 5632, NGU = 2 * DFF;
constexpr int NPOS = 2048 + 8;
constexpr float EPS = 1e-6f;
constexpr int NWAVES = 8, NTHR = 512;

constexpr size_t O_Y = 0, O_RETP = (size_t)M * D, O_POOLP = O_RETP + 4 * 4 * 65536, O_RETS = O_POOLP + 4 * 15 * 1024, O_POOLS = O_RETS + (size_t)128 * 4 * 65536, O_END = O_POOLS + 128 * 15 * 1024;

constexpr size_t MiB = 1u << 20;
constexpr size_t WS_CTL = 0, CTL_ZERO_BYTES = 1 * MiB;
constexpr size_t WS_CS = 1 * MiB;
constexpr size_t WS_WPOOL = 4 * MiB;
constexpr size_t WS_WIN = 8 * MiB;
constexpr size_t WS_WOUT = 28 * MiB;
constexpr size_t WS_WGU = 36 * MiB;
constexpr size_t WS_WD = 80 * MiB;
constexpr size_t WS_H = 102 * MiB;
constexpr size_t WS_PROJ = 138 * MiB;
constexpr size_t WS_MIX = 228 * MiB;
constexpr size_t WS_UT = 264 * MiB;
constexpr size_t WS_SCT = 296 * MiB;
constexpr size_t WS_POOLED = 328 * MiB;
constexpr size_t WS_MO = 346 * MiB;
constexpr size_t WS_HID = 138 * MiB;
constexpr size_t WS_FF = 382 * MiB;
constexpr size_t WS_PART3 = 264 * MiB;
constexpr size_t WS_PART5 = 296 * MiB;
#ifndef SPLIT_MODE
#define SPLIT_MODE 1
#endif
constexpr size_t WS_END = 418 * MiB;
static_assert(WS_HID + (size_t)M * DFF * 2 <= WS_UT, "hid overlay");

constexpr int CW_SK = 16384;
#ifndef SK_RS_P3
#define SK_RS_P3 2
#endif
#ifndef SK_RS_P4
#define SK_RS_P4 7
#endif
#ifndef SK_RS_P5
#define SK_RS_P5 2
#endif
constexpr int CW_BAR = 4096;
constexpr int LDS_BYTES = 147456;
constexpr int RING_BYTES = 131072, MISC_OFF = RING_BYTES + 320, ARG_OFF = RING_BYTES + 512;

__device__ __forceinline__ unsigned f2bf(float f) { unsigned u = __builtin_bit_cast(unsigned, f); return (u + 0x7fffu + ((u >> 16) & 1u)) >> 16; }
__device__ __forceinline__ unsigned pk2(float lo, float hi) { return f2bf(lo) | (f2bf(hi) << 16); }
__device__ __forceinline__ unsigned cvt_pk_bf16(float lo, float hi) { unsigned r; asm volatile("v_cvt_pk_bf16_f32 %0, %1, %2" : "=v"(r) : "v"(lo), "v"(hi)); return r; }
__device__ __forceinline__ float bflo(unsigned w) { return __builtin_bit_cast(float, w << 16); }
__device__ __forceinline__ float bfhi(unsigned w) { return __builtin_bit_cast(float, w & 0xffff0000u); }
__device__ __forceinline__ float bf2f(bf16_t b) { return __builtin_bit_cast(float, (unsigned)b << 16); }
__device__ __forceinline__ float wave_sum(float v) {
#pragma unroll
    for (int o = 1; o < 64; o <<= 1) v += __shfl_xor(v, o);
    return v;
}
__device__ __forceinline__ float silu(float x) { return x * __builtin_amdgcn_rcpf(1.0f + __builtin_amdgcn_exp2f(-1.4426950408889634f * x)); }
__device__ __forceinline__ float lg2gamma(int h) { return h == 0 ? -0.04580368961312479f : h == 1 ? -0.02272007650008353f : h == 2 ? -0.011315313227834146f : -0.005646563141142063f; }
#define LDS_WAIT() asm volatile("s_waitcnt lgkmcnt(0)" ::: "memory")
__device__ __forceinline__ int opaque(int x) { asm volatile("" : "+v"(x)); return x; }

namespace pg8 {
constexpr int BM = 256, BK = 64, HALF = 128, HTB = HALF * BK * 2, STAGE_BYTES = 8 * HTB, NXCD = 8, WGM = 8;
__host__ __device__ __forceinline__ int lds_byte(int r, int c) { const int st = (r >> 4) * 2 + (c >> 5), rr = r & 15, cc = c & 31, ob = rr * 64 + cc * 2; return st * 1024 + (ob ^ (((ob >> 9) & 1) << 5)); }
__host__ __device__ __forceinline__ void stage_rc(int b, int& R, int& C) { const int st = b / 1024, sb = b % 1024, swz = sb ^ (((sb >> 9) & 1) << 5); R = (st >> 1) * 16 + swz / 64; C = (st & 1) * 32 + (swz % 64) / 2; }
__host__ __device__ __forceinline__ int perm32(int rho) { const int n = rho >> 4, i = rho & 15; return 8 * (i >> 2) + 4 * n + (i & 3); }

struct Unit { int pm, pn, kt0, nkt, role; };
struct Gemm { const bf16_t* A; const bf16_t* Bt; int lda, ldb, K, a_pn_col; };
struct HybridOrder {
    int nM, nN, nwg, G, c, Rs, P, n32, q, s, e, mode;
    __device__ void init(int nM_, int nN_, int K, int G_, int c_, int Rs_, int mode_ = 0) {
        mode = mode_; nM = nM_; nN = nN_; nwg = nM * nN; G = G_; c = c_; Rs = Rs_; P = K / (2 * BK); n32 = G / NXCD; q = nwg / NXCD;
        const int Ux = (q - Rs * n32) > 0 ? (q - Rs * n32) : 0, j = c / NXCD; const long T = (long)Ux * P;
        s = (int)((long)j * T / n32); e = (int)((long)(j + 1) * T / n32);
    }
    __device__ void tile(int wgid, Unit& u) const {
        const int nig = WGM * nN, gid = wgid / nig, fm = gid * WGM, gsz = (nM - fm) < WGM ? (nM - fm) : WGM;
        u.pm = fm + ((wgid % nig) % gsz); u.pn = (wgid % nig) / gsz;
    }
    __device__ bool next(int i, Unit& u) const {
        const int x = c % NXCD, j = c / NXCD;
        if (mode == 1) {
            if (i == 0) { u.pm = 8 * (x >> 1) + (j & 7); u.pn = 4 * (x & 1) + (j >> 3); u.kt0 = 0; u.nkt = 2 * P; u.role = 0; return true; }
            if (i == 1) { u.pm = 32 + (j >> 3); u.pn = j & 7; const int lo = x * P / 8, hi = (x + 1) * P / 8; u.kt0 = 2 * lo; u.nkt = 2 * (hi - lo); u.role = 3; return true; }
            return false;
        }
        if (i < Rs) { if (i * n32 + j >= q) return false; tile(x * q + i * n32 + j, u); u.kt0 = 0; u.nkt = 2 * P; u.role = 0; return true; }
        const int uidx = s / P + (i - Rs), lo = s > uidx * P ? s : uidx * P, hi = e < (uidx + 1) * P ? e : (uidx + 1) * P;
        if (lo >= hi) return false;
        tile(x * q + Rs * n32 + uidx, u);
        u.kt0 = 2 * (lo - uidx * P); u.nkt = 2 * (hi - lo); u.role = (lo > uidx * P) ? 1 : ((hi < (uidx + 1) * P) ? 2 : 0);
        return true;
    }
};
struct SkBuf { float* slab; unsigned* flags; bf16_t* part; };

template <class Epi>
__device__ __forceinline__ void gemm_phase(LAS unsigned char* lds, const Gemm g, const HybridOrder& S, const Epi& E, const SkBuf sk) {
    const int tid = threadIdx.x, wid = __builtin_amdgcn_readfirstlane(tid >> 6), lane = tid & 63, wr = wid >> 2, wc = wid & 3, fr = lane & 15, fq = lane >> 4;
    unsigned voffA[2], voffB[2];
#pragma unroll
    for (int i = 0; i < 2; ++i) { int R, C; stage_rc(tid * 16 + i * 8192, R, C); const int Rb = (R & ~31) + perm32(R & 31);
        voffA[i] = (unsigned)(R * g.lda + C) * 2u; voffB[i] = (unsigned)(Rb * g.ldb + C) * 2u; }
    const size_t kstep = (size_t)(BK * 2);
    const size_t hstepA = (size_t)HALF * g.lda * 2, hstepB = (size_t)HALF * g.ldb * 2;
    const unsigned ldsw = (unsigned)wid * 1024u;
    const int aoff = lds_byte(wr * 64 + fr, fq * 8), boff = lds_byte(wc * 32 + fr, fq * 8);
#define PG8_UA(u) ((const char*)g.A + ((size_t)(u).pm * BM * g.lda + (size_t)(u).pn * g.a_pn_col + (size_t)(u).kt0 * BK) * 2)
#define PG8_UB(u) ((const char*)g.Bt + ((size_t)(u).pn * BM * g.ldb + (size_t)(u).kt0 * BK) * 2)
#define PG8_SA(b, h) (((b) * 2 + (h)) * HTB)
#define PG8_SB(b, h) ((4 + (b) * 2 + (h)) * HTB)
#define PG8_STAGE(bufoff, gbase, voff) do { _Pragma("unroll") for (int _i = 0; _i < 2; ++_i) \
        __builtin_amdgcn_global_load_lds((const unsigned*)((const char*)(gbase) + (voff)[_i]), (LAS unsigned*)(lds + (bufoff) + ldsw + _i * 8192), 16, 0, 0); } while (0)
#define PG8_LDA(dst, b, h) do { _Pragma("unroll") for (int m = 0; m < 4; ++m) _Pragma("unroll") for (int k = 0; k < 2; ++k) dst[m][k] = *(const LAS bf16x8*)(lds + PG8_SA(b, h) + aoff + m * 2048 + k * 1024); } while (0)
#define PG8_LDB(dst, b, h) do { _Pragma("unroll") for (int n = 0; n < 2; ++n) _Pragma("unroll") for (int k = 0; k < 2; ++k) dst[n][k] = *(const LAS bf16x8*)(lds + PG8_SB(b, h) + boff + n * 2048 + k * 1024); } while (0)
#define PG8_MMA(ai, bj, At, Bt) do { __builtin_amdgcn_s_setprio(1); _Pragma("unroll") for (int m = 0; m < 4; ++m) _Pragma("unroll") for (int n = 0; n < 2; ++n) _Pragma("unroll") for (int k = 0; k < 2; ++k) \
        acc[ai][bj][m][n] = __builtin_amdgcn_mfma_f32_16x16x32_bf16(Bt[n][k], At[m][k], acc[ai][bj][m][n], 0, 0, 0); __builtin_amdgcn_s_setprio(0); } while (0)
#define PG8_WAIT_V(n) asm volatile("s_waitcnt vmcnt(" #n ")" ::: "memory")
#define PG8_WAIT_L(n) asm volatile("s_waitcnt lgkmcnt(" #n ")" ::: "memory")
#define PG8_BAR __builtin_amdgcn_s_barrier()
#define PG8_SCHED __builtin_amdgcn_sched_barrier(0)
    Unit cur, nxt; int ui = 0;
    if (!S.next(0, cur)) return;
    f32x4 acc[2][2][4][2];
#pragma unroll
    for (int a = 0; a < 2; ++a)
#pragma unroll
        for (int b = 0; b < 2; ++b)
#pragma unroll
            for (int m = 0; m < 4; ++m)
#pragma unroll
                for (int n = 0; n < 2; ++n) acc[a][b][m][n] = (f32x4){0.f, 0.f, 0.f, 0.f};
    bf16x8 At[4][2], B0[2][2], B1[2][2];
    const char* cA = PG8_UA(cur); const char* cB = PG8_UB(cur);
    PG8_STAGE(PG8_SB(0, 0), cB, voffB); PG8_STAGE(PG8_SB(0, 1), cB + hstepB, voffB); PG8_STAGE(PG8_SA(0, 0), cA, voffA); PG8_STAGE(PG8_SA(0, 1), cA + hstepA, voffA);
    if (wr == 1) PG8_BAR;
    PG8_WAIT_V(2); PG8_BAR;
    PG8_STAGE(PG8_SB(1, 0), cB + kstep, voffB); PG8_STAGE(PG8_SA(1, 0), cA + kstep, voffA); PG8_STAGE(PG8_SB(1, 1), cB + hstepB + kstep, voffB);
    PG8_WAIT_V(6); PG8_BAR;
    for (;;) {
        const bool has_next = S.next(ui + 1, nxt);
        const char* nA = has_next ? PG8_UA(nxt) : cA; const char* nB = has_next ? PG8_UB(nxt) : cB;
        const int nt = cur.nkt;
        for (int t = 0; t < nt; t += 2) {
            const bool last = (t == nt - 2);
            const char* a1 = cA + (size_t)(t + 1) * kstep;
            const char* a2 = last ? nA : cA + (size_t)(t + 2) * kstep; const char* b2 = last ? nB : cB + (size_t)(t + 2) * kstep;
            const char* a3 = a2 + kstep; const char* b3 = b2 + kstep;
            PG8_LDB(B0, 0, 0); PG8_LDB(B1, 0, 1); PG8_SCHED; PG8_LDA(At, 0, 0); PG8_STAGE(PG8_SA(1, 1), a1 + hstepA, voffA);
            PG8_WAIT_V(8); PG8_WAIT_L(0); PG8_BAR; PG8_MMA(0, 0, At, B0); PG8_MMA(0, 1, At, B1); PG8_BAR; PG8_SCHED;
            PG8_LDA(At, 0, 1); PG8_STAGE(PG8_SB(0, 0), b2, voffB); PG8_STAGE(PG8_SB(0, 1), b2 + hstepB, voffB); PG8_STAGE(PG8_SA(0, 0), a2, voffA);
            PG8_WAIT_V(8); PG8_WAIT_L(0); PG8_BAR; PG8_MMA(1, 0, At, B0); PG8_MMA(1, 1, At, B1); PG8_BAR; PG8_SCHED;
            PG8_LDB(B0, 1, 0); PG8_LDB(B1, 1, 1); PG8_SCHED; PG8_LDA(At, 1, 0); PG8_STAGE(PG8_SA(0, 1), a2 + hstepA, voffA);
            PG8_WAIT_V(8); PG8_WAIT_L(0); PG8_BAR; PG8_MMA(0, 0, At, B0); PG8_MMA(0, 1, At, B1); PG8_BAR; PG8_SCHED;
            PG8_LDA(At, 1, 1); PG8_STAGE(PG8_SB(1, 0), b3, voffB); PG8_STAGE(PG8_SB(1, 1), b3 + hstepB, voffB); PG8_STAGE(PG8_SA(1, 0), a3, voffA);
            PG8_WAIT_V(8); PG8_WAIT_L(0); PG8_BAR; PG8_MMA(1, 0, At, B0); PG8_MMA(1, 1, At, B1); PG8_BAR; PG8_SCHED;
        }
        if (wr == 0) PG8_BAR;
        if (cur.role == 1) {
            const __amdgpu_buffer_rsrc_t rs = __builtin_amdgcn_make_buffer_rsrc(sk.slab, 0, 0x7fffffff, 0x00020000);
            const unsigned base = ((unsigned)S.c * 16384u + (unsigned)opaque(tid)) * 16u;
#pragma unroll
            for (int a = 0; a < 2; ++a)
#pragma unroll
                for (int b = 0; b < 2; ++b)
#pragma unroll
                    for (int m = 0; m < 4; ++m)
#pragma unroll
                        for (int n = 0; n < 2; ++n)
                            __builtin_amdgcn_raw_buffer_store_b128(__builtin_bit_cast(u32x4, acc[a][b][m][n]), rs, base + (unsigned)(((a * 2 + b) * 4 + m) * 2 + n) * 8192u, 0, 16);
            PG8_WAIT_V(0); PG8_BAR;
            if (tid == 0) __hip_atomic_store(sk.flags + 64 * S.c, 1u, __ATOMIC_RELAXED, __HIP_MEMORY_SCOPE_AGENT);
        } else if (cur.role == 3) {
            bf16_t* O = sk.part + (size_t)(S.c % NXCD) * 1024 * 2048;
            const int row0 = (cur.pm - 32) * BM + wr * 64 + fr, col0 = cur.pn * BM + wc * 32 + 8 * fq;
#pragma unroll
            for (int ai = 0; ai < 2; ++ai)
#pragma unroll
                for (int m = 0; m < 4; ++m) {
                    bf16_t* rp = O + (size_t)(row0 + ai * HALF + m * 16) * 2048 + col0;
#pragma unroll
                    for (int bj = 0; bj < 2; ++bj) {
                        u32x4 wv; wv.x = cvt_pk_bf16(acc[ai][bj][m][0][0], acc[ai][bj][m][0][1]); wv.y = cvt_pk_bf16(acc[ai][bj][m][0][2], acc[ai][bj][m][0][3]);
                        wv.z = cvt_pk_bf16(acc[ai][bj][m][1][0], acc[ai][bj][m][1][1]); wv.w = cvt_pk_bf16(acc[ai][bj][m][1][2], acc[ai][bj][m][1][3]);
                        *(u32x4*)(rp + bj * HALF) = wv;
                    }
                }
        } else {
            E(acc, cur, wr, wc, fr, fq);
        }
        if (!has_next) break;
        if (nxt.role == 2) {
            const int pc = S.c + NXCD;
            if (wid == 0) {
                unsigned spins = 0;
                while (__builtin_amdgcn_readfirstlane(__hip_atomic_load(sk.flags + 64 * pc, __ATOMIC_RELAXED, __HIP_MEMORY_SCOPE_AGENT)) == 0u) { __builtin_amdgcn_s_sleep(2); if (++spins > (1u << 22)) break; }
                __builtin_amdgcn_fence(__ATOMIC_ACQUIRE, "agent");
                PG8_WAIT_V(0);
            }
            asm volatile("" ::: "memory"); PG8_BAR; asm volatile("" ::: "memory");
            const f32x4* sl = (const f32x4*)sk.slab + (size_t)pc * 16384 + opaque(tid);
#pragma unroll
            for (int a = 0; a < 2; ++a)
#pragma unroll
                for (int b = 0; b < 2; ++b)
#pragma unroll
                    for (int m = 0; m < 4; ++m)
#pragma unroll
                        for (int n = 0; n < 2; ++n) acc[a][b][m][n] = *(const GAS f32x4*)(sl + (((a * 2 + b) * 4 + m) * 2 + n) * 512);
#pragma unroll
            for (int a = 0; a < 2; ++a)
#pragma unroll
                for (int b = 0; b < 2; ++b)
#pragma unroll
                    for (int m = 0; m < 4; ++m)
#pragma unroll
                        for (int n = 0; n < 2; ++n) asm volatile("" : "+v"(acc[a][b][m][n]));
        } else {
#pragma unroll
        for (int a = 0; a < 2; ++a)
#pragma unroll
            for (int b = 0; b < 2; ++b)
#pragma unroll
                for (int m = 0; m < 4; ++m)
#pragma unroll
                    for (int n = 0; n < 2; ++n) acc[a][b][m][n] = (f32x4){0.f, 0.f, 0.f, 0.f};
        }
        cur = nxt; cA = nA; cB = nB; ++ui;
        if (wr == 1) PG8_BAR;
    }
    PG8_WAIT_V(0);
    PG8_BAR;
#undef PG8_UA
#undef PG8_UB
#undef PG8_SA
#undef PG8_SB
#undef PG8_STAGE
#undef PG8_LDA
#undef PG8_LDB
#undef PG8_MMA
#undef PG8_WAIT_V
#undef PG8_WAIT_L
#undef PG8_BAR
#undef PG8_SCHED
}

__device__ __forceinline__ void st8(bf16_t* p, const f32x4 v0, const f32x4 v1) {
    u32x4 w; w.x = cvt_pk_bf16(v0[0], v0[1]); w.y = cvt_pk_bf16(v0[2], v0[3]); w.z = cvt_pk_bf16(v1[0], v1[1]); w.w = cvt_pk_bf16(v1[2], v1[3]);
    *(u32x4*)p = w;
}
struct EpiProj {
    bf16_t* P; const float* cs;
    __device__ __forceinline__ void operator()(const f32x4 (&acc)[2][2][4][2], const Unit& u, int wr, int wc, int fr, int fq) const {
        const int row0 = u.pm * BM + wr * 64 + fr, type = u.pn >> 2, cl = wc * 32 + 8 * fq, col0 = u.pn * BM + cl;
        if (type <= 1) {
            const float sc = type == 1 ? 0.0625f : 1.0f;
#pragma unroll
            for (int ai = 0; ai < 2; ++ai)
#pragma unroll
                for (int m = 0; m < 4; ++m) {
                    const int row = row0 + ai * HALF + m * 16;
                    const int pidx = row < MP ? (row & (SEQ - 1)) : SEQ + ((row - MP) & 7);
                    const f32x4* t = (const f32x4*)(cs + ((size_t)pidx * 128 + cl) * 2);
                    const f32x4 t0 = t[0], t1 = t[1], t2 = t[2], t3 = t[3];
                    const f32x4 x1a = acc[ai][0][m][0], x1b = acc[ai][0][m][1], x2a = acc[ai][1][m][0], x2b = acc[ai][1][m][1];
                    f32x4 o1a, o1b, o2a, o2b;
                    o1a[0] = (x1a[0] * t0[0] - x2a[0] * t0[1]) * sc; o2a[0] = (x2a[0] * t0[0] + x1a[0] * t0[1]) * sc;
                    o1a[1] = (x1a[1] * t0[2] - x2a[1] * t0[3]) * sc; o2a[1] = (x2a[1] * t0[2] + x1a[1] * t0[3]) * sc;
                    o1a[2] = (x1a[2] * t1[0] - x2a[2] * t1[1]) * sc; o2a[2] = (x2a[2] * t1[0] + x1a[2] * t1[1]) * sc;
                    o1a[3] = (x1a[3] * t1[2] - x2a[3] * t1[3]) * sc; o2a[3] = (x2a[3] * t1[2] + x1a[3] * t1[3]) * sc;
                    o1b[0] = (x1b[0] * t2[0] - x2b[0] * t2[1]) * sc; o2b[0] = (x2b[0] * t2[0] + x1b[0] * t2[1]) * sc;
                    o1b[1] = (x1b[1] * t2[2] - x2b[1] * t2[3]) * sc; o2b[1] = (x2b[1] * t2[2] + x1b[1] * t2[3]) * sc;
                    o1b[2] = (x1b[2] * t3[0] - x2b[2] * t3[1]) * sc; o2b[2] = (x2b[2] * t3[0] + x1b[2] * t3[1]) * sc;
                    o1b[3] = (x1b[3] * t3[2] - x2b[3] * t3[3]) * sc; o2b[3] = (x2b[3] * t3[2] + x1b[3] * t3[3]) * sc;
                    bf16_t* rp = P + (size_t)row * INW + col0;
                    st8(rp, o1a, o1b); st8(rp + HALF, o2a, o2b);
                }
        } else {
            const bool act = type == 3;
#pragma unroll
            for (int ai = 0; ai < 2; ++ai)
#pragma unroll
                for (int m = 0; m < 4; ++m) {
                    bf16_t* rp = P + (size_t)(row0 + ai * HALF + m * 16) * INW + col0;
#pragma unroll
                    for (int bj = 0; bj < 2; ++bj) {
                        f32x4 v0 = acc[ai][bj][m][0], v1 = acc[ai][bj][m][1];
                        if (act) {
#pragma unroll
                            for (int i = 0; i < 4; ++i) { v0[i] = silu(v0[i]); v1[i] = silu(v1[i]); }
                        }
                        st8(rp + bj * HALF, v0, v1);
                    }
                }
        }
    }
};
struct EpiPlain {
    bf16_t* O; int ldc, coff; const float* scale;
    __device__ __forceinline__ void operator()(const f32x4 (&acc)[2][2][4][2], const Unit& u, int wr, int wc, int fr, int fq) const {
        const int row0 = u.pm * BM + wr * 64 + fr, cl = wc * 32 + 8 * fq, col0 = u.pn * BM + cl;
        f32x4 s[2][2];
#pragma unroll
        for (int bj = 0; bj < 2; ++bj)
#pragma unroll
            for (int n = 0; n < 2; ++n) s[bj][n] = scale ? *(const f32x4*)(scale + col0 + bj * HALF + 4 * n) : (f32x4){1.f, 1.f, 1.f, 1.f};
#pragma unroll
        for (int ai = 0; ai < 2; ++ai)
#pragma unroll
            for (int m = 0; m < 4; ++m) {
                bf16_t* rp = O + (size_t)(row0 + ai * HALF + m * 16) * ldc + coff + col0;
#pragma unroll
                for (int bj = 0; bj < 2; ++bj) st8(rp + bj * HALF, acc[ai][bj][m][0] * s[bj][0], acc[ai][bj][m][1] * s[bj][1]);
            }
    }
};
struct EpiGU {
    bf16_t* Hd;
    __device__ __forceinline__ void operator()(const f32x4 (&acc)[2][2][4][2], const Unit& u, int wr, int wc, int fr, int fq) const {
        const int row0 = u.pm * BM + wr * 64 + fr, cl = wc * 32 + 8 * fq, col0 = u.pn * HALF + cl;
#pragma unroll
        for (int ai = 0; ai < 2; ++ai)
#pragma unroll
            for (int m = 0; m < 4; ++m) {
                f32x4 v0, v1;
#pragma unroll
                for (int i = 0; i < 4; ++i) { v0[i] = silu(acc[ai][0][m][0][i]) * acc[ai][1][m][0][i]; v1[i] = silu(acc[ai][0][m][1][i]) * acc[ai][1][m][1][i]; }
                st8(Hd + (size_t)(row0 + ai * HALF + m * 16) * DFF + col0, v0, v1);
            }
    }
};
}

#define XB_TMO      128
#define XB_XCNT(j)  (256  + 64 * (j))
#define XB_XSUB(j)  (1280 + 64 * (j))
#define XB_XGEN(j)  (2304 + 64 * (j))
#define XB_TOP      3328
#define XB_TOPGEN   3392
#define XCD_BAR_WORDS 3456
#define XB_SPIN_CAP (1u << 18)
__device__ __forceinline__ unsigned xb_ld(unsigned* p)              { return __hip_atomic_load(p, __ATOMIC_RELAXED, __HIP_MEMORY_SCOPE_AGENT); }
__device__ __forceinline__ unsigned xb_add(unsigned* p, unsigned v) { return __hip_atomic_fetch_add(p, v, __ATOMIC_RELAXED, __HIP_MEMORY_SCOPE_AGENT); }
__device__ __forceinline__ unsigned xb_xcc_id() { return (unsigned)__builtin_amdgcn_s_getreg((3 << 11) | 20) & 0xFu; }
#define XB_SPIN(cond, bar) do { unsigned _sp = 0; while (cond) { __builtin_amdgcn_s_sleep(1); \
    if ((++_sp & 255u) == 0u) { if (xb_ld(&(bar)[XB_TMO])) break; if (_sp > XB_SPIN_CAP) { atomicAdd(&(bar)[XB_TMO], 1u); break; } } } } while (0)
__device__ __forceinline__ void xcd_barrier_post(unsigned* bar) {
    if (threadIdx.x == 0) (void)xb_add(&bar[XB_XCNT(xb_xcc_id())], 1u);
}
__device__ __forceinline__ void xcd_barrier_complete(unsigned* bar, unsigned x, unsigned& nloc, unsigned& nx) {
    const unsigned G = gridDim.x * gridDim.y * gridDim.z;
    unsigned sum, cnt, mine, sp = 0u;
    for (;;) {
        sum = 0u; cnt = 0u; mine = 0u;
#pragma unroll
        for (unsigned j = 0; j < 16; ++j) { const unsigned c = xb_ld(&bar[XB_XCNT(j)]); sum += c; cnt += (c > 0u) ? 1u : 0u; mine = (j == x) ? c : mine; }
        if (sum == G) break;
        __builtin_amdgcn_s_sleep(1);
        if ((++sp & 255u) == 0u) { if (xb_ld(&bar[XB_TMO])) break; if (sp > XB_SPIN_CAP) { atomicAdd(&bar[XB_TMO], 1u); break; } }
    }
    nloc = mine > 0u ? mine : 1u; nx = cnt > 0u ? cnt : 1u;
}
__device__ __forceinline__ void xcd_barrier(unsigned* bar, volatile LAS unsigned* st) {
    asm volatile("s_waitcnt vmcnt(0)" ::: "memory");
    __syncthreads();
    if (threadIdx.x == 0) {
        const unsigned x = xb_xcc_id();
        __builtin_amdgcn_s_waitcnt(0);
        unsigned nloc = st[0], nx = st[1];
        if (nloc == 0u) { xcd_barrier_complete(bar, x, nloc, nx); st[0] = nloc; st[1] = nx; }
        const unsigned old = xb_add(&bar[XB_XSUB(x)], 1u);
        const unsigned gen = old / nloc;
        if (old + 1u == (gen + 1u) * nloc) {
            __builtin_amdgcn_fence(__ATOMIC_RELEASE, "agent");
            asm volatile("s_waitcnt vmcnt(0)" ::: "memory");
            const unsigned og = xb_add(&bar[XB_TOP], 1u);
            const unsigned tg = og / nx;
            if (og + 1u == (tg + 1u) * nx) xb_add(&bar[XB_TOPGEN], 1u);
            else XB_SPIN(xb_ld(&bar[XB_TOPGEN]) == tg, bar);
            __builtin_amdgcn_fence(__ATOMIC_ACQUIRE, "agent");
            xb_add(&bar[XB_XGEN(x)], 1u);
            asm volatile("s_waitcnt vmcnt(0)" ::: "memory");
        } else {
            XB_SPIN(xb_ld(&bar[XB_XGEN(x)]) == gen, bar);
            __builtin_amdgcn_fence(__ATOMIC_ACQUIRE, "agent");
            asm volatile("s_waitcnt vmcnt(0)" ::: "memory");
        }
    }
    __syncthreads();
}

struct Args { const float* in[16]; float* out; unsigned char* ws; int ph_lo, ph_hi, use_cg, pad; };

struct Frame {
    LAS unsigned char* lds;
    int tid, lane, wave, vcu, G;
};
__device__ __forceinline__ const float* ldarg(const Frame& F, int k) {
    const volatile LAS unsigned* p = (const volatile LAS unsigned*)(F.lds + ARG_OFF) + 2 * k;
    const unsigned lo = __builtin_amdgcn_readfirstlane(p[0]), hi = __builtin_amdgcn_readfirstlane(p[1]);
    return (const float*)(((unsigned long long)hi << 32) | lo);
}
#define AIN(k) ldarg(F, (k))
#define AOUT ((float*)ldarg(F, 16))
#define AWS ((unsigned char*)ldarg(F, 17))

struct TrItem { const float* W; bf16_t* WT; int K, N, mode, k0, n0; };
struct P0Ptrs { const float *w_in, *w_out, *w_gate, *w_up, *w_down, *w_pool; unsigned char* ws; };
__device__ __forceinline__ TrItem p0_decode(const P0Ptrs& a, unsigned char* ws, int it) {
    constexpr int I_IN = (D / 64) * (INW / 256), I_OUT = (D / 64) * (D / 256), I_G = (D / 64) * (DFF / 256), I_D = (DFF / 64) * (D / 256);
    TrItem t; int r = it, nblk;
    if (r < I_IN) { t.W = a.w_in; t.WT = (bf16_t*)(ws + WS_WIN); t.K = D; t.N = INW; t.mode = 0; }
    else if ((r -= I_IN) < I_OUT) { t.W = a.w_out; t.WT = (bf16_t*)(ws + WS_WOUT); t.K = D; t.N = D; t.mode = 0; }
    else if ((r -= I_OUT) < I_G) { t.W = a.w_gate; t.WT = (bf16_t*)(ws + WS_WGU); t.K = D; t.N = DFF; t.mode = 1; }
    else if ((r -= I_G) < I_G) { t.W = a.w_up; t.WT = (bf16_t*)(ws + WS_WGU); t.K = D; t.N = DFF; t.mode = 2; }
    else if ((r -= I_G) < I_D) { t.W = a.w_down; t.WT = (bf16_t*)(ws + WS_WD); t.K = DFF; t.N = D; t.mode = 0; }
    else { r -= I_D; const int g = r >> 2; r &= 3; t.W = a.w_pool + (size_t)g * 65536; t.WT = (bf16_t*)(ws + WS_WPOOL) + (size_t)g * 65536; t.K = 256; t.N = 256; t.mode = 0; }
    nblk = t.N >> 8; t.k0 = 64 * (r / nblk); t.n0 = 256 * (r % nblk);
    return t;
}
constexpr int P0_NITEMS = (D / 64) * (INW / 256) + (D / 64) * (D / 256) + 2 * (D / 64) * (DFF / 256) + (DFF / 64) * (D / 256) + 16;
__device__ __forceinline__ void p0_transposes(Frame& F) {
    P0Ptrs a; a.w_in = AIN(6); a.w_out = AIN(10); a.w_gate = AIN(13); a.w_up = AIN(14); a.w_down = AIN(15); a.w_pool = AIN(8); a.ws = AWS;
    unsigned char* ws = a.ws;
    LAS float* buf = (LAS float*)F.lds;
    const int w = F.wave, l = opaque(F.lane);
    int it = F.vcu;
    if (it >= P0_NITEMS) return;
    TrItem t = p0_decode(a, ws, it);
    f32x4 v[8];
#pragma unroll
    for (int i = 0; i < 8; ++i) v[i] = *(const GAS f32x4*)(t.W + (size_t)(t.k0 + 8 * w + i) * t.N + t.n0 + 4 * l);
    for (;;) {
#pragma unroll
        for (int i = 0; i < 8; ++i) *(LAS f32x4*)(buf + (8 * w + i) * 260 + ((4 * l) ^ (4 * (w & 7)))) = v[i];
        __syncthreads();
        const TrItem cur = t;
        const int nit = it + F.G; const bool has_next = nit < P0_NITEMS;
        if (has_next) { t = p0_decode(a, ws, nit);
#pragma unroll
            for (int i = 0; i < 8; ++i) v[i] = *(const GAS f32x4*)(t.W + (size_t)(t.k0 + 8 * w + i) * t.N + t.n0 + 4 * l); }
        const int ko = l & 7;
#pragma unroll
        for (int sidx = 0; sidx < 4; ++sidx) {
            const int nl = 32 * w + 8 * sidx + (l >> 3), n = cur.n0 + nl;
            const LAS float* p = buf + (8 * ko) * 260 + (nl ^ (4 * ko));
            u32x4 o; o.x = pk2(p[0], p[260]); o.y = pk2(p[2 * 260], p[3 * 260]); o.z = pk2(p[4 * 260], p[5 * 260]); o.w = pk2(p[6 * 260], p[7 * 260]);
            const int row = cur.mode == 0 ? n : (256 * (n >> 7) + (n & 127) + (cur.mode == 2 ? 128 : 0));
            *(GAS u32x4*)(cur.WT + (size_t)row * cur.K + cur.k0 + 8 * ko) = o;
        }
        __syncthreads();
        if (!has_next) break;
        it = nit;
    }
}
__device__ __forceinline__ void rms_row_to_bf16(const float* xrow, const float* w, bf16_t* orow, int lane) {
    const GAS f32x4* xr = (const GAS f32x4*)xrow + lane; const GAS f32x4* wr = (const GAS f32x4*)w + lane;
    f32x4 v[8]; float s = 0.f;
#pragma unroll
    for (int j = 0; j < 8; ++j) { v[j] = xr[64 * j]; s += (v[j].x * v[j].x + v[j].y * v[j].y) + (v[j].z * v[j].z + v[j].w * v[j].w); }
    const float rstd = 1.0f / sqrtf(wave_sum(s) * (1.f / D) + EPS);
    GAS u32x2* o8 = (GAS u32x2*)orow + lane;
#pragma unroll
    for (int j = 0; j < 8; ++j) { const f32x4 ww = wr[64 * j]; u32x2 o; o.x = pk2(v[j].x * rstd * ww.x, v[j].y * rstd * ww.y); o.y = pk2(v[j].z * rstd * ww.z, v[j].w * rstd * ww.w); o8[64 * j] = o; }
}
__device__ __forceinline__ const float* xrow_ptr(const float* xp, const float* xs, int m) { return m < MP ? xp + (size_t)m * D : xs + (size_t)(m - MP) * D; }

__device__ __forceinline__ void p0_prologue(Frame& F) {
    p0_transposes(F);
    unsigned char* ws = AWS;
    const int gw = F.vcu * NWAVES + F.wave, NGW = F.G * NWAVES;
    const float* xp_ = AIN(0); const float* xs_ = AIN(1); const float* nw_ = AIN(4);
    for (int m = gw; m < M; m += NGW) rms_row_to_bf16(xrow_ptr(xp_, xs_, m), nw_, (bf16_t*)(ws + WS_H) + (size_t)m * D, F.lane);
    float* cs = (float*)(ws + WS_CS);
    for (int idx = F.vcu * NTHR + F.tid; idx < NPOS * 128; idx += F.G * NTHR) {
        const int p = idx >> 7, j = idx & 127;
        double r = 0.930572040929699, inv = 1.0;
#pragma unroll
        for (int b = 0; b < 7; ++b) { if ((j >> b) & 1) inv *= r; r *= r; }
        const float invf = (float)inv;
        const float pos = (float)(p < SEQ ? p : 16384 + (p - SEQ));
        const float ang = pos * invf;
        double t = (double)ang * 0.15915494309189535; t -= __builtin_rint(t);
        const float tf = (float)t;
        f32x2 o; o.x = __builtin_amdgcn_cosf(tf); o.y = __builtin_amdgcn_sinf(tf);
        *(f32x2*)(cs + (size_t)idx * 2) = o;
    }
}

__device__ __forceinline__ unsigned toff(int r, int c16, int RB) { return (unsigned)(r * RB + ((((c16 & ~15) | ((c16 ^ r ^ (r >> 4)) & 15))) << 4)); }
#define MFMA32(a, b, c) __builtin_amdgcn_mfma_f32_32x32x16_bf16((a), (b), (c), 0, 0, 0)
__device__ __forceinline__ int crow(int reg, int h) { return (reg & 3) + 8 * (reg >> 2) + 4 * h; }
__device__ __forceinline__ bf16x8 frag(const LAS unsigned char* tile, int r, int c16, int RB) { return *(const LAS bf16x8*)(tile + toff(r, c16, RB)); }

__device__ __forceinline__ void load_nat128(LAS unsigned char* dst, const bf16_t* src, int ld, int tid) {
    tid = opaque(tid);
    u32x4 v[4];
#pragma unroll
    for (int it = 0; it < 4; ++it) { const int idx = tid + it * NTHR, r = idx >> 4, c = idx & 15; v[it] = *(const GAS u32x4*)(src + (size_t)r * ld + c * 8); }
#pragma unroll
    for (int it = 0; it < 4; ++it) { const int idx = tid + it * NTHR, r = idx >> 4, c = idx & 15; *(LAS u32x4*)(dst + toff(r, c, 256)) = v[it]; }
}
template <bool SCALE>
__device__ __forceinline__ void load_tr(LAS unsigned char* dst, const bf16_t* src, int ld, int tid, float sc_a, float sc_b) {
    tid = opaque(tid);
#pragma unroll
    for (int it = 0; it < 4; ++it) {
        const int T = it * NTHR + tid, ch_lo = T & 15, pp = (T >> 4) & 3, half = (T >> 6) & 1, quad = T >> 7;
        const int pair = 4 * quad + pp, chunk = 16 * half + ch_lo, j0 = 2 * pair, d0 = 8 * chunk;
        const u32x4 a = *(const GAS u32x4*)(src + (size_t)j0 * ld + d0), b = *(const GAS u32x4*)(src + (size_t)(j0 + 1) * ld + d0);
        float s0 = 1.f, s1 = 1.f;
        if (SCALE) { s0 = __builtin_amdgcn_exp2f(sc_a * (sc_b - (float)j0)); s1 = __builtin_amdgcn_exp2f(sc_a * (sc_b - (float)(j0 + 1))); }
#pragma unroll
        for (int i = 0; i < 8; ++i) {
            const unsigned wa = a[i >> 1], wb = b[i >> 1];
            unsigned w;
            if (SCALE) { const float fa = ((i & 1) ? bfhi(wa) : bflo(wa)) * s0, fb = ((i & 1) ? bfhi(wb) : bflo(wb)) * s1; w = pk2(fa, fb); }
            else w = (i & 1) ? ((wa >> 16) | (wb & 0xffff0000u)) : ((wa & 0xffffu) | (wb << 16));
            const int d = d0 + i;
            *(LAS unsigned*)(dst + toff(d, quad, 256) + pp * 4) = w;
        }
    }
}

__device__ __forceinline__ void u_item(Frame& F, const bf16_t* PROJ, bf16_t* UT, int item) {
    const int b = item >> 6, h = (item >> 4) & 3, c = item & 15, rows0 = b * SEQ + c * 128;
    const bf16_t* Ks = PROJ + (size_t)rows0 * INW + 1024 + h * 256; const bf16_t* Vs = Ks + 1024;
    LAS unsigned char* KT = F.lds; LAS unsigned char* VT = F.lds + 65536;
    const float lg = lg2gamma(h);
    load_tr<true>(KT, Ks, INW, F.tid, lg, 127.f);
    load_tr<false>(VT, Vs, INW, F.tid, 0.f, 0.f);
    __syncthreads();
    const int w = F.wave, r = opaque(F.lane) & 31, hh = opaque(F.lane) >> 5;
    bf16_t* Up = UT + ((size_t)((b * 4 + h) * 16 + c) * 256) * 256;
#pragma unroll 1
    for (int eh = 0; eh < 2; ++eh) {
        f32x16 acc[4];
#pragma unroll
        for (int t = 0; t < 4; ++t)
#pragma unroll
            for (int i = 0; i < 16; ++i) acc[t][i] = 0.f;
#pragma unroll 1
        for (int ks = 0; ks < 8; ++ks) {
            const bf16x8 a = frag(KT, 32 * w + r, 2 * ks + hh, 256);
#pragma unroll
            for (int et = 0; et < 4; ++et) { const bf16x8 bb = frag(VT, 32 * (4 * eh + et) + r, 2 * ks + hh, 256); acc[et] = MFMA32(a, bb, acc[et]); }
        }
#pragma unroll
        for (int et = 0; et < 4; ++et)
#pragma unroll
            for (int g = 0; g < 4; ++g) {
                u32x2 o; o.x = cvt_pk_bf16(acc[et][4 * g], acc[et][4 * g + 1]); o.y = cvt_pk_bf16(acc[et][4 * g + 2], acc[et][4 * g + 3]);
                *(GAS u32x2*)(Up + (size_t)(32 * (4 * eh + et) + r) * 256 + 32 * w + 8 * g + 4 * hh) = o;
            }
    }
    __syncthreads();
}

__device__ __forceinline__ void o_item(Frame& F, const bf16_t* PROJ, const bf16_t* SCT, const float* retw, bf16_t* MIX, int item) {
    const int b = item >> 6, h = (item >> 4) & 3, c = item & 15, rows0 = b * SEQ + c * 128;
    const bf16_t* Qs = PROJ + (size_t)rows0 * INW + h * 256; const bf16_t* Ks = Qs + 1024; const bf16_t* Vs = Qs + 2048; const bf16_t* Gs = Qs + 3072;
    LAS unsigned char* QF = F.lds; LAS unsigned char* KH = F.lds + 65536; LAS unsigned char* PB = F.lds + 98304; LAS unsigned char* VT = F.lds; LAS unsigned char* OB = F.lds;
    const float lg = lg2gamma(h);
    const int w = F.wave; int r = opaque(F.lane) & 31, hh = opaque(F.lane) >> 5; const int tid = opaque(F.tid);
    u32x4 qv[8], kv[4]; bf16x8 sfr[16];
#pragma unroll
    for (int it = 0; it < 8; ++it) { const int idx = tid + it * NTHR, rr = idx >> 5, cc = idx & 31; qv[it] = *(const GAS u32x4*)(Qs + (size_t)rr * INW + cc * 8); }
#pragma unroll
    for (int it = 0; it < 4; ++it) { const int idx = tid + it * NTHR, rr = idx >> 4, cc = idx & 15; kv[it] = *(const GAS u32x4*)(Ks + (size_t)rr * INW + cc * 8); }
    {
        const bf16_t* Sp = SCT + ((size_t)((b * 4 + h) * 16 + c) * 256) * 256 + (size_t)(32 * w + r) * 256 + 8 * hh;
#pragma unroll
        for (int ks = 0; ks < 16; ++ks) sfr[ks] = *(const GAS bf16x8*)(Sp + 16 * ks);
    }
#pragma unroll
    for (int it = 0; it < 8; ++it) { const int idx = tid + it * NTHR, rr = idx >> 5, cc = idx & 31; *(LAS u32x4*)(QF + toff(rr, cc, 512)) = qv[it]; }
#pragma unroll
    for (int it = 0; it < 4; ++it) { const int idx = tid + it * NTHR, rr = idx >> 4, cc = idx & 15; *(LAS u32x4*)(KH + toff(rr, cc, 256)) = kv[it]; }
    __syncthreads();
#pragma unroll
    for (int it = 0; it < 4; ++it) { const int idx = tid + it * NTHR, rr = idx >> 4, cc = idx & 15; kv[it] = *(const GAS u32x4*)(Ks + 128 + (size_t)rr * INW + cc * 8); }
    const int ib_s = w >> 1, jb0 = 2 * (w & 1);
    f32x16 sc[2];
#pragma unroll
    for (int t = 0; t < 2; ++t)
#pragma unroll
        for (int i = 0; i < 16; ++i) sc[t][i] = 0.f;
    if (jb0 <= ib_s) {
#pragma unroll 1
        for (int ks = 0; ks < 8; ++ks) {
            const bf16x8 a = frag(QF, 32 * ib_s + r, 2 * ks + hh, 512);
            const bf16x8 b0 = frag(KH, 32 * jb0 + r, 2 * ks + hh, 256), b1 = frag(KH, 32 * (jb0 + 1) + r, 2 * ks + hh, 256);
            sc[0] = MFMA32(a, b0, sc[0]); sc[1] = MFMA32(a, b1, sc[1]);
        }
    }
    __syncthreads();
#pragma unroll
    for (int it = 0; it < 4; ++it) { const int idx = tid + it * NTHR, rr = idx >> 4, cc = idx & 15; *(LAS u32x4*)(KH + toff(rr, cc, 256)) = kv[it]; }
    __syncthreads();
    u32x4 va[4], vb[4];
#pragma unroll
    for (int it = 0; it < 4; ++it) {
        const int T = it * NTHR + tid, ch_lo = T & 15, pp = (T >> 4) & 3, half = (T >> 6) & 1, quad = T >> 7;
        const int pair = 4 * quad + pp, chunk = 16 * half + ch_lo, j0 = 2 * pair, d0 = 8 * chunk;
        va[it] = *(const GAS u32x4*)(Vs + (size_t)j0 * INW + d0); vb[it] = *(const GAS u32x4*)(Vs + (size_t)(j0 + 1) * INW + d0);
    }
    if (jb0 <= ib_s) {
#pragma unroll 1
        for (int ks = 0; ks < 8; ++ks) {
            const bf16x8 a = frag(QF, 32 * ib_s + r, 16 + 2 * ks + hh, 512);
            const bf16x8 b0 = frag(KH, 32 * jb0 + r, 2 * ks + hh, 256), b1 = frag(KH, 32 * (jb0 + 1) + r, 2 * ks + hh, 256);
            sc[0] = MFMA32(a, b0, sc[0]); sc[1] = MFMA32(a, b1, sc[1]);
        }
    }
    r = opaque(r); hh = opaque(hh);
#pragma unroll
    for (int t = 0; t < 2; ++t) {
        const int j = 32 * (jb0 + t) + r;
#pragma unroll
        for (int reg = 0; reg < 16; ++reg) {
            const int i = 32 * ib_s + crow(reg, hh);
            const float v = (i >= j) ? sc[t][reg] * __builtin_amdgcn_exp2f(lg * (float)(i - j)) : 0.f;
            *(LAS bf16_t*)(PB + toff(i, j >> 3, 256) + (j & 7) * 2) = (bf16_t)f2bf(v);
        }
    }
    f32x16 o[4];
#pragma unroll
    for (int t = 0; t < 4; ++t)
#pragma unroll
        for (int i = 0; i < 16; ++i) o[t][i] = 0.f;
    r = opaque(r); hh = opaque(hh);
#pragma unroll
    for (int ks = 0; ks < 16; ++ks) {
#pragma unroll
        for (int ib = 0; ib < 4; ++ib) { const bf16x8 a = frag(QF, 32 * ib + r, 2 * ks + hh, 512); o[ib] = MFMA32(a, sfr[ks], o[ib]); }
    }
#pragma unroll
    for (int ib = 0; ib < 4; ++ib)
#pragma unroll
        for (int reg = 0; reg < 16; ++reg) o[ib][reg] *= __builtin_amdgcn_exp2f(lg * (float)(32 * ib + crow(reg, hh) + 1));
    __syncthreads();
#pragma unroll
    for (int it = 0; it < 4; ++it) {
        const int T = it * NTHR + tid, ch_lo = T & 15, pp = (T >> 4) & 3, half = (T >> 6) & 1, quad = T >> 7;
        const int chunk = 16 * half + ch_lo, d0 = 8 * chunk;
#pragma unroll
        for (int i = 0; i < 8; ++i) {
            const unsigned wa = va[it][i >> 1], wb = vb[it][i >> 1];
            const unsigned wv = (i & 1) ? ((wa >> 16) | (wb & 0xffff0000u)) : ((wa & 0xffffu) | (wb << 16));
            *(LAS unsigned*)(VT + toff(d0 + i, quad, 256) + pp * 4) = wv;
        }
    }
    __syncthreads();
    r = opaque(r); hh = opaque(hh);
#pragma unroll 1
    for (int ks = 0; ks < 8; ++ks) {
        const bf16x8 bb = frag(VT, 32 * w + r, 2 * ks + hh, 256);
#pragma unroll
        for (int ib = 0; ib < 4; ++ib)
            if (ks < 2 * (ib + 1)) { const bf16x8 a = frag(PB, 32 * ib + r, 2 * ks + hh, 256); o[ib] = MFMA32(a, bb, o[ib]); }
    }
    __syncthreads();
    r = opaque(r); hh = opaque(hh);
#pragma unroll
    for (int ib = 0; ib < 4; ++ib)
#pragma unroll
        for (int reg = 0; reg < 16; ++reg) { const int i = 32 * ib + crow(reg, hh);
            *(LAS bf16_t*)(OB + i * 512 + (32 * w + r) * 2) = (bf16_t)f2bf(o[ib][reg]); }
    __syncthreads();
    {
        const int tid2 = opaque(F.tid), cc = tid2 & 31;
        const f32x4 wa = *(const GAS f32x4*)(retw + h * 256 + cc * 8), wb = *(const GAS f32x4*)(retw + h * 256 + cc * 8 + 4);
        u32x4 gv[8];
#pragma unroll
        for (int it = 0; it < 8; ++it) gv[it] = *(const GAS u32x4*)(Gs + (size_t)((tid2 >> 5) + 16 * it) * INW + cc * 8);
#pragma unroll
        for (int it = 0; it < 8; ++it) {
            const int i = (tid2 >> 5) + 16 * it;
            const u32x4 ov = *(const LAS u32x4*)(OB + i * 512 + cc * 16);
            float x[8];
#pragma unroll
            for (int k = 0; k < 4; ++k) { x[2 * k] = bflo(ov[k]); x[2 * k + 1] = bfhi(ov[k]); }
            float sq = 0.f;
#pragma unroll
            for (int k = 0; k < 8; ++k) sq += x[k] * x[k];
            sq += __shfl_xor(sq, 1); sq += __shfl_xor(sq, 2); sq += __shfl_xor(sq, 4); sq += __shfl_xor(sq, 8); sq += __shfl_xor(sq, 16);
            const float rstd = 1.0f / sqrtf(sq * (1.f / 256.f) + EPS);
            u32x4 res;
            res[0] = pk2(x[0] * rstd * wa[0] * bflo(gv[it][0]), x[1] * rstd * wa[1] * bfhi(gv[it][0]));
            res[1] = pk2(x[2] * rstd * wa[2] * bflo(gv[it][1]), x[3] * rstd * wa[3] * bfhi(gv[it][1]));
            res[2] = pk2(x[4] * rstd * wb[0] * bflo(gv[it][2]), x[5] * rstd * wb[1] * bfhi(gv[it][2]));
            res[3] = pk2(x[6] * rstd * wb[2] * bflo(gv[it][3]), x[7] * rstd * wb[3] * bfhi(gv[it][3]));
            *(GAS u32x4*)(MIX + (size_t)(rows0 + i) * D + h * 256 + cc * 8) = res;
        }
    }
    __syncthreads();
}

__device__ __forceinline__ void s_item(Frame& F, const bf16_t* PROJ, const float* state, const float* retw, float* newstate, bf16_t* MIX, int item) {
    const int sb = item >> 2, h = item & 3, rows0 = MP + sb * 8;
    const float lg = lg2gamma(h);
    LAS float* QK = (LAS float*)F.lds;
    LAS float* QR = (LAS float*)(F.lds + 16384);
    LAS float* KR = (LAS float*)(F.lds + 16384 + 8224);
    LAS float* SCP = (LAS float*)(F.lds + 16384 + 2 * 8224);
    LAS float* SCO = (LAS float*)(F.lds + 16384 + 2 * 8224 + 2048);
    LAS float* RED = (LAS float*)(F.lds + 40960);
    const int w = opaque(F.wave), l = opaque(F.lane), tid_o = opaque(F.tid);
    {
        const int isk = tid_o >> 8, i = (tid_o >> 5) & 7, d8 = (tid_o & 31) * 8;
        const u32x4 raw = *(const GAS u32x4*)(PROJ + (size_t)(rows0 + i) * INW + isk * 1024 + h * 256 + d8);
        float f[8];
#pragma unroll
        for (int q = 0; q < 4; ++q) { f[2 * q] = bflo(raw[q]); f[2 * q + 1] = bfhi(raw[q]); }
        const float sc = __builtin_amdgcn_exp2f(lg * (float)(isk ? 7 - i : i + 1));
        LAS float* R = isk ? KR : QR;
#pragma unroll
        for (int k = 0; k < 8; ++k) { R[i * 257 + d8 + k] = f[k]; QK[(d8 + k) * 16 + isk * 8 + i] = f[k] * sc; }
    }
    float v[8][4];
#pragma unroll
    for (int j = 0; j < 8; ++j) { const u32x2 t = *(const GAS u32x2*)(PROJ + (size_t)(rows0 + j) * INW + 2048 + h * 256 + 4 * l); v[j][0] = bflo(t.x); v[j][1] = bfhi(t.x); v[j][2] = bflo(t.y); v[j][3] = bfhi(t.y); }
    __syncthreads();
    {
        const int i = l >> 3, j = l & 7; float s = 0.f;
#pragma unroll 8
        for (int d = 32 * w; d < 32 * w + 32; ++d) s += QR[i * 257 + d] * KR[j * 257 + d];
        SCP[w * 64 + l] = s;
    }
    float oacc[8][4];
#pragma unroll
    for (int i = 0; i < 8; ++i)
#pragma unroll
        for (int c = 0; c < 4; ++c) oacc[i][c] = 0.f;
    const float g8 = __builtin_amdgcn_exp2f(lg * 8.f);
    const GAS f32x4* Sp = (const GAS f32x4*)(state + ((size_t)(sb * 4 + h) * 256 + 32 * w) * 256) + l;
    GAS f32x4* Np = (GAS f32x4*)(newstate + ((size_t)(sb * 4 + h) * 256 + 32 * w) * 256) + l;
    f32x4 sA[4], sB[4];
#define S_LOAD4(dst, row0) do { const GAS f32x4* p0_ = Sp + (size_t)(row0) * 64; asm volatile("" : "+v"(p0_)); \
        _Pragma("unroll") for (int k = 0; k < 4; ++k) dst[k] = p0_[k * 64]; } while (0)
#define S_COMP4(src, row0) do { GAS f32x4* n0_ = Np + (size_t)(row0) * 64; asm volatile("" : "+v"(n0_)); \
        _Pragma("unroll") for (int k = 0; k < 4; ++k) { \
            const LAS f32x4* qk = (const LAS f32x4*)(QK + (32 * w + (row0) + k) * 16); \
            const f32x4 qa = qk[0], qb = qk[1], ka = qk[2], kb = qk[3]; f32x4 n; \
            _Pragma("unroll") for (int c = 0; c < 4; ++c) { const float sv = src[k][c]; \
                oacc[0][c] += qa[0] * sv; oacc[1][c] += qa[1] * sv; oacc[2][c] += qa[2] * sv; oacc[3][c] += qa[3] * sv; \
                oacc[4][c] += qb[0] * sv; oacc[5][c] += qb[1] * sv; oacc[6][c] += qb[2] * sv; oacc[7][c] += qb[3] * sv; \
                float t = g8 * sv; \
                t += ka[0] * v[0][c]; t += ka[1] * v[1][c]; t += ka[2] * v[2][c]; t += ka[3] * v[3][c]; \
                t += kb[0] * v[4][c]; t += kb[1] * v[5][c]; t += kb[2] * v[6][c]; t += kb[3] * v[7][c]; n[c] = t; } \
            n0_[k * 64] = n; \
            if (k & 1) asm volatile("" ::: "memory"); } } while (0)
    S_LOAD4(sA, 0);
#pragma unroll 1
    for (int h2 = 0; h2 < 4; ++h2) {
        S_LOAD4(sB, 8 * h2 + 4);
        S_COMP4(sA, 8 * h2);
        if (h2 < 3) S_LOAD4(sA, 8 * h2 + 8);
        S_COMP4(sB, 8 * h2 + 4);
    }
#undef S_LOAD4
#undef S_COMP4
#pragma unroll
    for (int i = 0; i < 8; ++i) *(LAS f32x4*)(RED + (w * 8 + i) * 256 + 4 * l) = (f32x4){oacc[i][0], oacc[i][1], oacc[i][2], oacc[i][3]};
    __syncthreads();
    if (tid_o < 64) { const int i = l >> 3, j = l & 7; float s = 0.f;
#pragma unroll
        for (int ww = 0; ww < 8; ++ww) s += SCP[ww * 64 + l];
        SCO[l] = (i >= j) ? s * __builtin_amdgcn_exp2f(lg * (float)(i - j)) : 0.f; }
    __syncthreads();
    {
        const int i = w; f32x4 tot = (f32x4){0.f, 0.f, 0.f, 0.f};
#pragma unroll
        for (int ww = 0; ww < 8; ++ww) tot += *(const LAS f32x4*)(RED + (ww * 8 + i) * 256 + 4 * l);
#pragma unroll
        for (int j = 0; j < 8; ++j) { const float s = SCO[i * 8 + j];
#pragma unroll
            for (int c = 0; c < 4; ++c) tot[c] += s * v[j][c]; }
        const float ss = wave_sum((tot[0] * tot[0] + tot[1] * tot[1]) + (tot[2] * tot[2] + tot[3] * tot[3]));
        const float rstd = 1.0f / sqrtf(ss * (1.f / 256.f) + EPS);
        const f32x4 wn = *(const GAS f32x4*)(retw + h * 256 + 4 * l);
        const u32x2 gv = *(const GAS u32x2*)(PROJ + (size_t)(rows0 + i) * INW + 3072 + h * 256 + 4 * l);
        u32x2 res; res.x = pk2(tot[0] * rstd * wn[0] * bflo(gv.x), tot[1] * rstd * wn[1] * bfhi(gv.x)); res.y = pk2(tot[2] * rstd * wn[2] * bflo(gv.y), tot[3] * rstd * wn[3] * bfhi(gv.y));
        *(GAS u32x2*)(MIX + (size_t)(rows0 + i) * D + h * 256 + 4 * l) = res;
    }
    __syncthreads();
}

__device__ __forceinline__ void unpk8(const u32x4 v, float (&f)[8]) {
#pragma unroll
    for (int q = 0; q < 4; ++q) { f[2 * q] = bflo(v[q]); f[2 * q + 1] = bfhi(v[q]); }
}
template <int W>
__device__ __forceinline__ void pool_prompt_blk(const bf16_t* PROJ, bf16_t* POOLED, float* outp, int rb, int ch) {
    const int m0 = rb * 8, t0 = m0 & (SEQ - 1), bseq = m0 >> 11;
    const bf16_t* U = PROJ + 4096 + ch;
    u32x4 x[W + 7];
#pragma unroll
    for (int i = 0; i < W + 7; ++i) { const int t = t0 - (W - 1) + i; const int mi = (t >= 0) ? m0 - (W - 1) + i : m0; x[i] = *(const GAS u32x4*)(U + (size_t)mi * INW); }
#pragma unroll
    for (int i = 0; i < W - 1; ++i) { const int t = t0 - (W - 1) + i; if (t < 0) x[i] = (u32x4){0u, 0u, 0u, 0u}; }
    float sum[8];
#pragma unroll
    for (int k = 0; k < 8; ++k) sum[k] = 0.f;
#pragma unroll
    for (int i = 0; i < W - 1; ++i) { float f[8]; unpk8(x[i], f);
#pragma unroll
        for (int k = 0; k < 8; ++k) sum[k] += f[k]; }
#pragma unroll
    for (int r = 0; r < 8; ++r) {
        float cur[8]; unpk8(x[W - 1 + r], cur);
#pragma unroll
        for (int k = 0; k < 8; ++k) sum[k] += cur[k];
        const int t = t0 + r; const int cnt = (t + 1 < W) ? t + 1 : W; const float inv = 1.0f / (float)cnt;
        u32x4 o;
#pragma unroll
        for (int q = 0; q < 4; ++q) o[q] = pk2(sum[2 * q] * inv - cur[2 * q], sum[2 * q + 1] * inv - cur[2 * q + 1]);
        *(GAS u32x4*)(POOLED + (size_t)(m0 + r) * 1024 + ch) = o;
        float sub[8]; unpk8(x[r], sub);
#pragma unroll
        for (int k = 0; k < 8; ++k) sum[k] -= sub[k];
        if (t >= SEQ - 15) { float* op = outp + ((size_t)bseq * 15 + (t - (SEQ - 15))) * 1024 + ch;
            *(GAS f32x4*)op = (f32x4){cur[0], cur[1], cur[2], cur[3]}; *(GAS f32x4*)(op + 4) = (f32x4){cur[4], cur[5], cur[6], cur[7]}; }
    }
}
template <int W>
__device__ __forceinline__ void pool_sample_blk(const bf16_t* PROJ, const float* spool, bf16_t* POOLED, float* outs, int sb, int ch) {
    const bf16_t* U = PROJ + (size_t)(MP + sb * 8) * INW + 4096 + ch;
    const float* B = spool + (size_t)sb * 15 * 1024 + ch;
    f32x4 ba[W - 1], bb[W - 1]; u32x4 xn[8]; f32x4 ca[7], cb[7];
#pragma unroll
    for (int i = 0; i < W - 1; ++i) { ba[i] = *(const GAS f32x4*)(B + (size_t)(15 - (W - 1) + i) * 1024); bb[i] = *(const GAS f32x4*)(B + (size_t)(15 - (W - 1) + i) * 1024 + 4); }
#pragma unroll
    for (int r = 0; r < 8; ++r) xn[r] = *(const GAS u32x4*)(U + (size_t)r * INW);
#pragma unroll
    for (int rr = 0; rr < 7; ++rr) { ca[rr] = *(const GAS f32x4*)(B + (size_t)(8 + rr) * 1024); cb[rr] = *(const GAS f32x4*)(B + (size_t)(8 + rr) * 1024 + 4); }
    float sum[8];
#pragma unroll
    for (int k = 0; k < 8; ++k) sum[k] = 0.f;
#pragma unroll
    for (int i = 0; i < W - 1; ++i)
#pragma unroll
        for (int q = 0; q < 4; ++q) { sum[q] += ba[i][q]; sum[4 + q] += bb[i][q]; }
    const float inv = 1.0f / (float)W;
#pragma unroll
    for (int r = 0; r < 8; ++r) {
        float cur[8]; unpk8(xn[r], cur);
#pragma unroll
        for (int k = 0; k < 8; ++k) sum[k] += cur[k];
        u32x4 o;
#pragma unroll
        for (int q = 0; q < 4; ++q) o[q] = pk2(sum[2 * q] * inv - cur[2 * q], sum[2 * q + 1] * inv - cur[2 * q + 1]);
        *(GAS u32x4*)(POOLED + (size_t)(MP + sb * 8 + r) * 1024 + ch) = o;
        if (r < W - 1) {
#pragma unroll
            for (int q = 0; q < 4; ++q) { sum[q] -= ba[r < W - 1 ? r : 0][q]; sum[4 + q] -= bb[r < W - 1 ? r : 0][q]; }
        } else { float sub[8]; unpk8(xn[r >= W - 1 ? r - (W - 1) : 0], sub);
#pragma unroll
            for (int k = 0; k < 8; ++k) sum[k] -= sub[k]; }
        float* op = outs + ((size_t)sb * 15 + 7 + r) * 1024 + ch;
        *(GAS f32x4*)op = (f32x4){cur[0], cur[1], cur[2], cur[3]}; *(GAS f32x4*)(op + 4) = (f32x4){cur[4], cur[5], cur[6], cur[7]};
    }
#pragma unroll
    for (int rr = 0; rr < 7; ++rr) { float* op = outs + ((size_t)sb * 15 + rr) * 1024 + ch; *(GAS f32x4*)op = ca[rr]; *(GAS f32x4*)(op + 4) = cb[rr]; }
}
__device__ __forceinline__ void pool_tasks(Frame& F, const bf16_t* PROJ, const float* spool, bf16_t* POOLED, float* outp, float* outs) {
    for (int gt = F.vcu * NTHR + opaque(F.tid); gt < 1024 * 128; gt += F.G * NTHR) {
        const int cgp = gt & 31, rbl = (gt >> 5) & 1, grp = (gt >> 6) & 3, rb = (gt >> 8) * 2 + rbl, ch = grp * 256 + cgp * 8;
        if (grp == 0) pool_prompt_blk<2>(PROJ, POOLED, outp, rb, ch); else if (grp == 1) pool_prompt_blk<4>(PROJ, POOLED, outp, rb, ch);
        else if (grp == 2) pool_prompt_blk<8>(PROJ, POOLED, outp, rb, ch); else pool_prompt_blk<16>(PROJ, POOLED, outp, rb, ch);
    }
    for (int gt = F.vcu * NTHR + opaque(F.tid); gt < 128 * 128; gt += F.G * NTHR) {
        const int cgp = gt & 31, sbl = (gt >> 5) & 1, grp = (gt >> 6) & 3, sb = (gt >> 8) * 2 + sbl, ch = grp * 256 + cgp * 8;
        if (grp == 0) pool_sample_blk<2>(PROJ, spool, POOLED, outs, sb, ch); else if (grp == 1) pool_sample_blk<4>(PROJ, spool, POOLED, outs, sb, ch);
        else if (grp == 2) pool_sample_blk<8>(PROJ, spool, POOLED, outs, sb, ch); else pool_sample_blk<16>(PROJ, spool, POOLED, outs, sb, ch);
    }
}

__device__ __forceinline__ void load_row_bf16(const bf16_t* row, int nparts, size_t pstride, int lane, float (&f)[4][8]) {
#pragma unroll
    for (int j = 0; j < 4; ++j)
#pragma unroll
        for (int q = 0; q < 8; ++q) f[j][q] = 0.f;
    for (int p = 0; p < nparts; ++p) {
        u32x4 v[4];
#pragma unroll
        for (int j = 0; j < 4; ++j) v[j] = *(const GAS u32x4*)(row + (size_t)p * pstride + 8 * lane + 512 * j);
#pragma unroll
        for (int j = 0; j < 4; ++j)
#pragma unroll
            for (int q = 0; q < 4; ++q) { f[j][2 * q] += bflo(v[j][q]); f[j][2 * q + 1] += bfhi(v[j][q]); }
    }
}
__device__ __forceinline__ void n1_row(const float* xrow, const bf16_t* mo, int nparts, size_t pstride, const float* wpost, const float* wpre, float* yrow, bf16_t* hrow, int lane) {
    f32x4 xa[4], xb[4]; float s = 0.f;
#pragma unroll
    for (int j = 0; j < 4; ++j) { const int c = 8 * lane + 512 * j; xa[j] = *(const GAS f32x4*)(xrow + c); xb[j] = *(const GAS f32x4*)(xrow + c + 4); }
    float mf[4][8];
    load_row_bf16(mo, nparts, pstride, lane, mf);
#pragma unroll
    for (int j = 0; j < 4; ++j)
#pragma unroll
        for (int q = 0; q < 8; ++q) s += mf[j][q] * mf[j][q];
    const float r1 = 1.0f / sqrtf(wave_sum(s) * (1.f / D) + EPS);
    float s2 = 0.f;
#pragma unroll
    for (int j = 0; j < 4; ++j) { const int c = 8 * lane + 512 * j; const f32x4 wa = *(const GAS f32x4*)(wpost + c), wb = *(const GAS f32x4*)(wpost + c + 4);
#pragma unroll
        for (int q = 0; q < 4; ++q) { xa[j][q] += mf[j][q] * r1 * wa[q]; xb[j][q] += mf[j][4 + q] * r1 * wb[q]; s2 += xa[j][q] * xa[j][q] + xb[j][q] * xb[j][q]; }
        *(GAS f32x4*)(yrow + c) = xa[j]; *(GAS f32x4*)(yrow + c + 4) = xb[j]; }
    const float r2 = 1.0f / sqrtf(wave_sum(s2) * (1.f / D) + EPS);
#pragma unroll
    for (int j = 0; j < 4; ++j) { const int c = 8 * lane + 512 * j; const f32x4 wa = *(const GAS f32x4*)(wpre + c), wb = *(const GAS f32x4*)(wpre + c + 4);
        u32x4 o; o.x = pk2(xa[j][0] * r2 * wa[0], xa[j][1] * r2 * wa[1]); o.y = pk2(xa[j][2] * r2 * wa[2], xa[j][3] * r2 * wa[3]);
        o.z = pk2(xb[j][0] * r2 * wb[0], xb[j][1] * r2 * wb[1]); o.w = pk2(xb[j][2] * r2 * wb[2], xb[j][3] * r2 * wb[3]);
        *(GAS u32x4*)(hrow + c) = o; }
}
__device__ __forceinline__ void n2_row(const bf16_t* ff, int nparts, size_t pstride, const float* wpost, float* yrow, int lane) {
    float s = 0.f; float ffl[4][8];
    load_row_bf16(ff, nparts, pstride, lane, ffl);
#pragma unroll
    for (int j = 0; j < 4; ++j)
#pragma unroll
        for (int q = 0; q < 8; ++q) s += ffl[j][q] * ffl[j][q];
    const float r1 = 1.0f / sqrtf(wave_sum(s) * (1.f / D) + EPS);
#pragma unroll
    for (int j = 0; j < 4; ++j) { const int c = 8 * lane + 512 * j; const f32x4 wa = *(const GAS f32x4*)(wpost + c), wb = *(const GAS f32x4*)(wpost + c + 4);
        f32x4 ya = *(const GAS f32x4*)(yrow + c), yb = *(const GAS f32x4*)(yrow + c + 4);
#pragma unroll
        for (int q = 0; q < 4; ++q) { ya[q] += ffl[j][q] * r1 * wa[q]; yb[q] += ffl[j][4 + q] * r1 * wb[q]; }
        *(GAS f32x4*)(yrow + c) = ya; *(GAS f32x4*)(yrow + c + 4) = yb; }
}

constexpr int NPH = 10;
__global__ void __launch_bounds__(NTHR, 2) hyb_fwd(Args args) {
    extern __shared__ __attribute__((aligned(16))) unsigned char lds[];
    Frame F;
    F.lds = (LAS unsigned char*)lds;
    F.tid = threadIdx.x; F.lane = F.tid & 63; F.wave = __builtin_amdgcn_readfirstlane(F.tid >> 6);
    F.G = gridDim.x; { const int bx = blockIdx.x; F.vcu = (F.G % 8 == 0) ? (bx % 8) * (F.G / 8) + bx / 8 : bx; }
    if (F.tid == 0) {
        volatile LAS unsigned long long* at = (volatile LAS unsigned long long*)(F.lds + ARG_OFF);
#pragma unroll
        for (int i = 0; i < 16; ++i) at[i] = (unsigned long long)args.in[i];
        at[16] = (unsigned long long)args.out; at[17] = (unsigned long long)args.ws;
    }
    const int lo = args.ph_lo, hi = args.ph_hi;
    if (F.tid < 32) ((volatile LAS unsigned*)(F.lds + MISC_OFF))[F.tid] = 0u;
    __syncthreads();
    if (args.use_cg) xcd_barrier_post((unsigned*)(AWS + WS_CTL) + CW_BAR);
    if (args.pad == 0x5a5a5a5a) cg::this_grid().sync();
#ifndef PH_ENABLE
#define PH_ENABLE 0x3ff
#endif
#define IN(k) (((PH_ENABLE >> (k)) & 1) && lo <= (k) && (k) < hi)
#define BOTH(k) (IN(k) && IN((k) + 1))
#ifndef REP_MASK
#define REP_MASK 0
#endif
#define REPS(k) for (int rep_ = 0; rep_ <= ((REP_MASK >> (k)) & 1); ++rep_)
#define REP_MORE(k) (rep_ < ((REP_MASK >> (k)) & 1))
#ifndef CG_SEAMS
#define CG_SEAMS 0x000
#endif
#define GRID_BAR(k) do { if ((CG_SEAMS >> (k)) & 1) cg::this_grid().sync(); else xcd_barrier((unsigned*)(AWS + WS_CTL) + CW_BAR, (volatile LAS unsigned*)(F.lds + MISC_OFF) + 8); } while (0)
#define WSP(off) ((bf16_t*)(ws + (off)))
#ifndef SUBREP_MASK
#define SUBREP_MASK 0
#endif
#define SUBREP(k) for (int sr_ = 0; sr_ <= ((SUBREP_MASK >> (k)) & 1); ++sr_)
    if (IN(0)) REPS(0) { p0_prologue(F); if (BOTH(0) || REP_MORE(0)) GRID_BAR(0); }
    if (IN(1)) REPS(1) {
        unsigned char* ws = AWS;
        pg8::Gemm g{WSP(WS_H), WSP(WS_WIN), D, D, D, 0}; pg8::HybridOrder S; S.init(M / 256, INW / 256, D, F.G, (int)blockIdx.x, 3);
        pg8::EpiProj E{WSP(WS_PROJ), (const float*)(ws + WS_CS)};
        pg8::gemm_phase(F.lds, g, S, E, pg8::SkBuf{nullptr, nullptr, nullptr});
        if (BOTH(1) || REP_MORE(1)) GRID_BAR(1);
    }
    if (IN(2)) REPS(2) {
        unsigned char* ws = AWS; float* out = AOUT;
        SUBREP(0) for (int it = F.vcu; it < 256; it += F.G) u_item(F, WSP(WS_PROJ), WSP(WS_UT), it);
        SUBREP(1) pool_tasks(F, WSP(WS_PROJ), AIN(3), WSP(WS_POOLED), out + O_POOLP, out + O_POOLS);
        { const float* st = AIN(2); const float* rw = AIN(7);
          SUBREP(2) for (int it = F.vcu; it < 512; it += F.G) s_item(F, WSP(WS_PROJ), st, rw, out + O_RETS, WSP(WS_MIX), it); }
        if (BOTH(2) || REP_MORE(2)) GRID_BAR(2);
    }
    if (IN(3)) REPS(3) {
        unsigned char* ws = AWS;
#ifdef POOL_TWICE
        { float* out2 = AOUT; pool_tasks(F, WSP(WS_PROJ), AIN(3), WSP(WS_POOLED), out2 + O_POOLP, out2 + O_POOLS); asm volatile("s_waitcnt vmcnt(0)" ::: "memory"); __syncthreads(); }
#endif
        {
        float* out = AOUT; const bf16_t* UT = WSP(WS_UT); bf16_t* SCT = WSP(WS_SCT);
        for (int idx = F.vcu * NTHR + F.tid; idx < 16 * 256 * 32; idx += F.G * NTHR) {
            const int bh = idx >> 13, e = (idx >> 5) & 255, d8 = (idx & 31) * 8;
            const float g128 = __builtin_amdgcn_exp2f(lg2gamma(bh & 3) * 128.f);
            float s[8];
#pragma unroll
            for (int k = 0; k < 8; ++k) s[k] = 0.f;
            u32x4 uv[16];
#pragma unroll
            for (int c = 0; c < 16; ++c) uv[c] = *(const GAS u32x4*)(UT + ((size_t)(bh * 16 + c) * 256 + e) * 256 + d8);
#pragma unroll
            for (int c = 0; c < 16; ++c) {
                u32x4 o; o.x = pk2(s[0], s[1]); o.y = pk2(s[2], s[3]); o.z = pk2(s[4], s[5]); o.w = pk2(s[6], s[7]);
                *(GAS u32x4*)(SCT + ((size_t)(bh * 16 + c) * 256 + e) * 256 + d8) = o;
#pragma unroll
                for (int k = 0; k < 4; ++k) { s[2 * k] = g128 * s[2 * k] + bflo(uv[c][k]); s[2 * k + 1] = g128 * s[2 * k + 1] + bfhi(uv[c][k]); }
            }
            float* op = out + O_RETP + (size_t)bh * 65536 + e;
#pragma unroll
            for (int k = 0; k < 8; ++k) op[(size_t)(d8 + k) * 256] = s[k];
        }
        }
        {
            pg8::Gemm g{WSP(WS_POOLED), WSP(WS_WPOOL), 1024, 256, 256, 256}; pg8::HybridOrder S; S.init(M / 256, 4, 256, F.G, (int)blockIdx.x, 1);
            pg8::EpiPlain E{WSP(WS_MIX), D, 1024, AIN(9)};
            pg8::gemm_phase(F.lds, g, S, E, pg8::SkBuf{nullptr, nullptr, nullptr});
        }
        if (BOTH(3) || REP_MORE(3)) GRID_BAR(3);
    }
    if (IN(4)) REPS(4) {
        unsigned char* ws = AWS; const float* rw = AIN(7);
        for (int it = F.vcu; it < 256; it += F.G) o_item(F, WSP(WS_PROJ), WSP(WS_SCT), rw, WSP(WS_MIX), it);
        if (BOTH(4) || REP_MORE(4)) GRID_BAR(4);
    }
    if (IN(5)) REPS(5) {
        unsigned char* ws = AWS;
        pg8::Gemm g{WSP(WS_MIX), WSP(WS_WOUT), D, D, D, 0}; pg8::HybridOrder S; S.init(M / 256, D / 256, D, F.G, (int)blockIdx.x, SK_RS_P3, SPLIT_MODE);
        pg8::EpiPlain E{WSP(WS_MO), D, 0, nullptr};
        pg8::gemm_phase(F.lds, g, S, E, pg8::SkBuf{(float*)(ws + WS_POOLED), (unsigned*)(ws + WS_CTL) + CW_SK, WSP(WS_PART3)});
        if (BOTH(5) || REP_MORE(5)) GRID_BAR(5);
    }
    if (IN(6)) REPS(6) {
        unsigned char* ws = AWS; float* out = AOUT;
        const float* xp_ = AIN(0); const float* xs_ = AIN(1); const float* w5 = AIN(5); const float* w11 = AIN(11);
        const int gw = F.vcu * NWAVES + F.wave, NGW = F.G * NWAVES;
        for (int m = gw; m < M; m += NGW) { const bool sp = SPLIT_MODE && m >= MP;
            n1_row(xrow_ptr(xp_, xs_, m), sp ? WSP(WS_PART3) + (size_t)(m - MP) * D : WSP(WS_MO) + (size_t)m * D, sp ? 8 : 1, (size_t)1024 * 2048, w5, w11, out + O_Y + (size_t)m * D, WSP(WS_H) + (size_t)m * D, F.lane); }
        if (BOTH(6) || REP_MORE(6)) GRID_BAR(6);
    }
    if (IN(7)) REPS(7) {
        unsigned char* ws = AWS;
        pg8::Gemm g{WSP(WS_H), WSP(WS_WGU), D, D, D, 0}; pg8::HybridOrder S; S.init(M / 256, NGU / 256, D, F.G, (int)blockIdx.x, SK_RS_P4);
        pg8::EpiGU E{WSP(WS_HID)};
        pg8::gemm_phase(F.lds, g, S, E, pg8::SkBuf{(float*)(ws + WS_MO), (unsigned*)(ws + WS_CTL) + CW_SK + 16384, nullptr});
        if (BOTH(7) || REP_MORE(7)) GRID_BAR(7);
    }
    if (IN(8)) REPS(8) {
        unsigned char* ws = AWS;
        pg8::Gemm g{WSP(WS_HID), WSP(WS_WD), DFF, DFF, DFF, 0}; pg8::HybridOrder S; S.init(M / 256, D / 256, DFF, F.G, (int)blockIdx.x, SK_RS_P5, SPLIT_MODE);
        pg8::EpiPlain E{WSP(WS_FF), D, 0, nullptr};
        pg8::gemm_phase(F.lds, g, S, E, pg8::SkBuf{(float*)(ws + WS_POOLED), (unsigned*)(ws + WS_CTL) + CW_SK + 32768, WSP(WS_PART5)});
        if (BOTH(8) || REP_MORE(8)) GRID_BAR(8);
    }
    if (IN(9)) {
        unsigned char* ws = AWS; float* out = AOUT; const float* w12 = AIN(12);
        const int gw = F.vcu * NWAVES + F.wave, NGW = F.G * NWAVES;
        for (int m = gw; m < M; m += NGW) { const bool sp = SPLIT_MODE && m >= MP;
            n2_row(sp ? WSP(WS_PART5) + (size_t)(m - MP) * D : WSP(WS_FF) + (size_t)m * D, sp ? 8 : 1, (size_t)1024 * 2048, w12, out + O_Y + (size_t)m * D, F.lane); }
    }
#undef IN
#undef BOTH
}

extern "C" void kernel_launch(void* const* d_in, const int* in_sizes, int n_in, void* d_out, int out_size, void* d_ws, size_t ws_size, hipStream_t stream) {
    static int grid = 0;
    if (grid == 0) {
        if (n_in != 16 || (size_t)out_size != O_END || ws_size < WS_END) { fprintf(stderr, "kernel_launch: unexpected shapes: n_in %d out %d ws %zu (need %zu)\n", n_in, out_size, ws_size, (size_t)WS_END); grid = -1; return; }
        int dev = 0, cus = 0, per_cu = 0;
        if (hipGetDevice(&dev) != hipSuccess || hipDeviceGetAttribute(&cus, hipDeviceAttributeMultiprocessorCount, dev) != hipSuccess) { grid = -1; return; }
        if (hipFuncSetAttribute((const void*)hyb_fwd, hipFuncAttributeMaxDynamicSharedMemorySize, LDS_BYTES) != hipSuccess) { fprintf(stderr, "kernel_launch: hipFuncSetAttribute failed\n"); grid = -1; return; }
        if (hipOccupancyMaxActiveBlocksPerMultiprocessor(&per_cu, (const void*)hyb_fwd, NTHR, LDS_BYTES) != hipSuccess || per_cu < 1) { fprintf(stderr, "kernel_launch: occupancy query says %d\n", per_cu); per_cu = 1; }
        (void)hipGetLastError();
        grid = cus * 1;
        if (SPLIT_MODE && grid != 256) { fprintf(stderr, "kernel_launch: this build's unit schedule needs exactly 256 workgroups (got %d CUs); nothing launched\n", cus); grid = -1; return; }
        fprintf(stderr, "kernel_launch: grid %d (occupancy query %d per CU)\n", grid, per_cu);
    }
    if (grid < 0) return;
    Args a{};
    for (int i = 0; i < 16; ++i) a.in[i] = (const float*)d_in[i];
    a.out = (float*)d_out; a.ws = (unsigned char*)d_ws;
    if (hipMemsetAsync((char*)d_ws + WS_CTL, 0, CTL_ZERO_BYTES, stream) != hipSuccess) { fprintf(stderr, "kernel_launch: memset failed\n"); return; }
    if (MK_N_LAUNCHES == 1) {
        a.ph_lo = 0; a.ph_hi = NPH; a.use_cg = 1;
        void* kargs[] = {&a};
        hipError_t e = hipLaunchCooperativeKernel((const void*)hyb_fwd, dim3(grid), dim3(NTHR), kargs, LDS_BYTES, stream);
        if (e != hipSuccess) fprintf(stderr, "kernel_launch: cooperative launch failed: %s (grid %d)\n", hipGetErrorString(e), grid);
    } else {
        for (int p = 0; p < NPH; ++p) {
            a.ph_lo = p; a.ph_hi = p + 1; a.use_cg = 0;
            hipLaunchKernelGGL(hyb_fwd, dim3(grid), dim3(NTHR), LDS_BYTES, stream, a);
        }
    }
}
```

```cpp
#include <hip/hip_runtime.h>
#include <hip/hip_cooperative_groups.h>
#include <cstdio>
#include <cstdint>
namespace cg = cooperative_groups;

#ifndef MK_N_LAUNCHES
#define MK_N_LAUNCHES 1
#endif

#define GAS __attribute__((address_space(1)))
#define LAS __attribute__((address_space(3)))
typedef unsigned short bf16_t;
typedef short bf16x8 __attribute__((ext_vector_type(8)));
typedef float f32x2 __attribute__((ext_vector_type(2)));
typedef float f32x4 __attribute__((ext_vector_type(4)));
typedef float f32x16 __attribute__((ext_vector_type(16)));
typedef unsigned u32x2 __attribute__((ext_vector_type(2)));
typedef unsigned u32x4 __attribute__((ext_vector_type(4)));

constexpr int D = 2048, MP = 8192, MS = 1024, M = MP + MS, SEQ = 2048;
constexpr int INW = 5120, DFF = 5632, NGU = 2 * DFF;
constexpr int NPOS = 2048 + 8;
constexpr float EPS = 1e-6f;
constexpr int NWAVES = 8, NTHR = 512;

constexpr size_t O_Y = 0, O_RETP = (size_t)M * D, O_POOLP = O_RETP + 4 * 4 * 65536, O_RETS = O_POOLP + 4 * 15 * 1024, O_POOLS = O_RETS + (size_t)128 * 4 * 65536, O_END = O_POOLS + 128 * 15 * 1024;

constexpr size_t MiB = 1u << 20;
constexpr size_t WS_CTL = 0, CTL_ZERO_BYTES = 1 * MiB;
constexpr size_t WS_CS = 1 * MiB;
constexpr size_t WS_WPOOL = 4 * MiB;
constexpr size_t WS_WIN = 8 * MiB;
constexpr size_t WS_WOUT = 28 * MiB;
constexpr size_t WS_WGU = 36 * MiB;
constexpr size_t WS_WD = 80 * MiB;
constexpr size_t WS_H = 102 * MiB;
constexpr size_t WS_PROJ = 138 * MiB;
constexpr size_t WS_MIX = 228 * MiB;
constexpr size_t WS_UT = 264 * MiB;
constexpr size_t WS_SCT = 296 * MiB;
constexpr size_t WS_POOLED = 328 * MiB;
constexpr size_t WS_MO = 346 * MiB;
constexpr size_t WS_HID = 138 * MiB;
constexpr size_t WS_FF = 382 * MiB;
constexpr size_t WS_PART3 = 264 * MiB;
constexpr size_t WS_PART5 = 296 * MiB;
#ifndef SPLIT_MODE
#define SPLIT_MODE 1
#endif
constexpr size_t WS_END = 418 * MiB;
static_assert(WS_HID + (size_t)M * DFF * 2 <= WS_UT, "hid overlay");

constexpr int CW_SK = 16384;
#ifndef SK_RS_P3
#define SK_RS_P3 2
#endif
#ifndef SK_RS_P4
#define SK_RS_P4 7
#endif
#ifndef SK_RS_P5
#define SK_RS_P5 2
#endif
constexpr int CW_BAR = 4096;
constexpr int LDS_BYTES = 147456;
constexpr int RING_BYTES = 131072, MISC_OFF = RING_BYTES + 320, ARG_OFF = RING_BYTES + 512;

__device__ __forceinline__ unsigned f2bf(float f) { unsigned u = __builtin_bit_cast(unsigned, f); return (u + 0x7fffu + ((u >> 16) & 1u)) >> 16; }
__device__ __forceinline__ unsigned pk2(float lo, float hi) { return f2bf(lo) | (f2bf(hi) << 16); }
__device__ __forceinline__ unsigned cvt_pk_bf16(float lo, float hi) { unsigned r; asm volatile("v_cvt_pk_bf16_f32 %0, %1, %2" : "=v"(r) : "v"(lo), "v"(hi)); return r; }
__device__ __forceinline__ float bflo(unsigned w) { return __builtin_bit_cast(float, w << 16); }
__device__ __forceinline__ float bfhi(unsigned w) { return __builtin_bit_cast(float, w & 0xffff0000u); }
__device__ __forceinline__ float bf2f(bf16_t b) { return __builtin_bit_cast(float, (unsigned)b << 16); }
__device__ __forceinline__ float wave_sum(float v) {
#pragma unroll
    for (int o = 1; o < 64; o <<= 1) v += __shfl_xor(v, o);
    return v;
}
__device__ __forceinline__ float silu(float x) { return x * __builtin_amdgcn_rcpf(1.0f + __builtin_amdgcn_exp2f(-1.4426950408889634f * x)); }
__device__ __forceinline__ float lg2gamma(int h) { return h == 0 ? -0.04580368961312479f : h == 1 ? -0.02272007650008353f : h == 2 ? -0.011315313227834146f : -0.005646563141142063f; }
#define LDS_WAIT() asm volatile("s_waitcnt lgkmcnt(0)" ::: "memory")
__device__ __forceinline__ int opaque(int x) { asm volatile("" : "+v"(x)); return x; }

namespace pg8 {
constexpr int BM = 256, BK = 64, HALF = 128, HTB = HALF * BK * 2, STAGE_BYTES = 8 * HTB, NXCD = 8, WGM = 8;
__host__ __device__ __forceinline__ int lds_byte(int r, int c) { const int st = (r >> 4) * 2 + (c >> 5), rr = r & 15, cc = c & 31, ob = rr * 64 + cc * 2; return st * 1024 + (ob ^ (((ob >> 9) & 1) << 5)); }
__host__ __device__ __forceinline__ void stage_rc(int b, int& R, int& C) { const int st = b / 1024, sb = b % 1024, swz = sb ^ (((sb >> 9) & 1) << 5); R = (st >> 1) * 16 + swz / 64; C = (st & 1) * 32 + (swz % 64) / 2; }
__host__ __device__ __forceinline__ int perm32(int rho) { const int n = rho >> 4, i = rho & 15; return 8 * (i >> 2) + 4 * n + (i & 3); }

struct Unit { int pm, pn, kt0, nkt, role; };
struct Gemm { const bf16_t* A; const bf16_t* Bt; int lda, ldb, K, a_pn_col; };
struct HybridOrder {
    int nM, nN, nwg, G, c, Rs, P, n32, q, s, e, mode;
    __device__ void init(int nM_, int nN_, int K, int G_, int c_, int Rs_, int mode_ = 0) {
        mode = mode_; nM = nM_; nN = nN_; nwg = nM * nN; G = G_; c = c_; Rs = Rs_; P = K / (2 * BK); n32 = G / NXCD; q = nwg / NXCD;
        const int Ux = (q - Rs * n32) > 0 ? (q - Rs * n32) : 0, j = c / NXCD; const long T = (long)Ux * P;
        s = (int)((long)j * T / n32); e = (int)((long)(j + 1) * T / n32);
    }
    __device__ void tile(int wgid, Unit& u) const {
        const int nig = WGM * nN, gid = wgid / nig, fm = gid * WGM, gsz = (nM - fm) < WGM ? (nM - fm) : WGM;
        u.pm = fm + ((wgid % nig) % gsz); u.pn = (wgid % nig) / gsz;
    }
    __device__ bool next(int i, Unit& u) const {
        const int x = c % NXCD, j = c / NXCD;
        if (mode == 1) {
            if (i == 0) { u.pm = 8 * (x >> 1) + (j & 7); u.pn = 4 * (x & 1) + (j >> 3); u.kt0 = 0; u.nkt = 2 * P; u.role = 0; return true; }
            if (i == 1) { u.pm = 32 + (j >> 3); u.pn = j & 7; const int lo = x * P / 8, hi = (x + 1) * P / 8; u.kt0 = 2 * lo; u.nkt = 2 * (hi - lo); u.role = 3; return true; }
            return false;
        }
        if (i < Rs) { if (i * n32 + j >= q) return false; tile(x * q + i * n32 + j, u); u.kt0 = 0; u.nkt = 2 * P; u.role = 0; return true; }
        const int uidx = s / P + (i - Rs), lo = s > uidx * P ? s : uidx * P, hi = e < (uidx + 1) * P ? e : (uidx + 1) * P;
        if (lo >= hi) return false;
        tile(x * q + Rs * n32 + uidx, u);
        u.kt0 = 2 * (lo - uidx * P); u.nkt = 2 * (hi - lo); u.role = (lo > uidx * P) ? 1 : ((hi < (uidx + 1) * P) ? 2 : 0);
        return true;
    }
};
struct SkBuf { float* slab; unsigned* flags; bf16_t* part; };

template <class Epi>
__device__ __forceinline__ void gemm_phase(LAS unsigned char* lds, const Gemm g, const HybridOrder& S, const Epi& E, const SkBuf sk) {
    const int tid = threadIdx.x, wid = __builtin_amdgcn_readfirstlane(tid >> 6), lane = tid & 63, wr = wid >> 2, wc = wid & 3, fr = lane & 15, fq = lane >> 4;
    unsigned voffA[2], voffB[2];
#pragma unroll
    for (int i = 0; i < 2; ++i) { int R, C; stage_rc(tid * 16 + i * 8192, R, C); const int Rb = (R & ~31) + perm32(R & 31);
        voffA[i] = (unsigned)(R * g.lda + C) * 2u; voffB[i] = (unsigned)(Rb * g.ldb + C) * 2u; }
    const size_t kstep = (size_t)(BK * 2);
    const size_t hstepA = (size_t)HALF * g.lda * 2, hstepB = (size_t)HALF * g.ldb * 2;
    const unsigned ldsw = (unsigned)wid * 1024u;
    const int aoff = lds_byte(wr * 64 + fr, fq * 8), boff = lds_byte(wc * 32 + fr, fq * 8);
#define PG8_UA(u) ((const char*)g.A + ((size_t)(u).pm * BM * g.lda + (size_t)(u).pn * g.a_pn_col + (size_t)(u).kt0 * BK) * 2)
#define PG8_UB(u) ((const char*)g.Bt + ((size_t)(u).pn * BM * g.ldb + (size_t)(u).kt0 * BK) * 2)
#define PG8_SA(b, h) (((b) * 2 + (h)) * HTB)
#define PG8_SB(b, h) ((4 + (b) * 2 + (h)) * HTB)
#define PG8_STAGE(bufoff, gbase, voff) do { _Pragma("unroll") for (int _i = 0; _i < 2; ++_i) \
        __builtin_amdgcn_global_load_lds((const unsigned*)((const char*)(gbase) + (voff)[_i]), (LAS unsigned*)(lds + (bufoff) + ldsw + _i * 8192), 16, 0, 0); } while (0)
#define PG8_LDA(dst, b, h) do { _Pragma("unroll") for (int m = 0; m < 4; ++m) _Pragma("unroll") for (int k = 0; k < 2; ++k) dst[m][k] = *(const LAS bf16x8*)(lds + PG8_SA(b, h) + aoff + m * 2048 + k * 1024); } while (0)
#define PG8_LDB(dst, b, h) do { _Pragma("unroll") for (int n = 0; n < 2; ++n) _Pragma("unroll") for (int k = 0; k < 2; ++k) dst[n][k] = *(const LAS bf16x8*)(lds + PG8_SB(b, h) + boff + n * 2048 + k * 1024); } while (0)
#define PG8_MMA(ai, bj, At, Bt) do { __builtin_amdgcn_s_setprio(1); _Pragma("unroll") for (int m = 0; m < 4; ++m) _Pragma("unroll") for (int n = 0; n < 2; ++n) _Pragma("unroll") for (int k = 0; k < 2; ++k) \
        acc[ai][bj][m][n] = __builtin_amdgcn_mfma_f32_16x16x32_bf16(Bt[n][k], At[m][k], acc[ai][bj][m][n], 0, 0, 0); __builtin_amdgcn_s_setprio(0); } while (0)
#define PG8_WAIT_V(n) asm volatile("s_waitcnt vmcnt(" #n ")" ::: "memory")
#define PG8_WAIT_L(n) asm volatile("s_waitcnt lgkmcnt(" #n ")" ::: "memory")
#define PG8_BAR __builtin_amdgcn_s_barrier()
#define PG8_SCHED __builtin_amdgcn_sched_barrier(0)
    Unit cur, nxt; int ui = 0;
    if (!S.next(0, cur)) return;
    f32x4 acc[2][2][4][2];
#pragma unroll
    for (int a = 0; a < 2; ++a)
#pragma unroll
        for (int b = 0; b < 2; ++b)
#pragma unroll
            for (int m = 0; m < 4; ++m)
#pragma unroll
                for (int n = 0; n < 2; ++n) acc[a][b][m][n] = (f32x4){0.f, 0.f, 0.f, 0.f};
    bf16x8 At[4][2], B0[2][2], B1[2][2];
    const char* cA = PG8_UA(cur); const char* cB = PG8_UB(cur);
    PG8_STAGE(PG8_SB(0, 0), cB, voffB); PG8_STAGE(PG8_SB(0, 1), cB + hstepB, voffB); PG8_STAGE(PG8_SA(0, 0), cA, voffA); PG8_STAGE(PG8_SA(0, 1), cA + hstepA, voffA);
    if (wr == 1) PG8_BAR;
    PG8_WAIT_V(2); PG8_BAR;
    PG8_STAGE(PG8_SB(1, 0), cB + kstep, voffB); PG8_STAGE(PG8_SA(1, 0), cA + kstep, voffA); PG8_STAGE(PG8_SB(1, 1), cB + hstepB + kstep, voffB);
    PG8_WAIT_V(6); PG8_BAR;
    for (;;) {
        const bool has_next = S.next(ui + 1, nxt);
        const char* nA = has_next ? PG8_UA(nxt) : cA; const char* nB = has_next ? PG8_UB(nxt) : cB;
        const int nt = cur.nkt;
        for (int t = 0; t < nt; t += 2) {
            const bool last = (t == nt - 2);
            const char* a1 = cA + (size_t)(t + 1) * kstep;
            const char* a2 = last ? nA : cA + (size_t)(t + 2) * kstep; const char* b2 = last ? nB : cB + (size_t)(t + 2) * kstep;
            const char* a3 = a2 + kstep; const char* b3 = b2 + kstep;
            PG8_LDB(B0, 0, 0); PG8_LDB(B1, 0, 1); PG8_SCHED; PG8_LDA(At, 0, 0); PG8_STAGE(PG8_SA(1, 1), a1 + hstepA, voffA);
            PG8_WAIT_V(8); PG8_WAIT_L(0); PG8_BAR; PG8_MMA(0, 0, At, B0); PG8_MMA(0, 1, At, B1); PG8_BAR; PG8_SCHED;
            PG8_LDA(At, 0, 1); PG8_STAGE(PG8_SB(0, 0), b2, voffB); PG8_STAGE(PG8_SB(0, 1), b2 + hstepB, voffB); PG8_STAGE(PG8_SA(0, 0), a2, voffA);
            PG8_WAIT_V(8); PG8_WAIT_L(0); PG8_BAR; PG8_MMA(1, 0, At, B0); PG8_MMA(1, 1, At, B1); PG8_BAR; PG8_SCHED;
            PG8_LDB(B0, 1, 0); PG8_LDB(B1, 1, 1); PG8_SCHED; PG8_LDA(At, 1, 0); PG8_STAGE(PG8_SA(0, 1), a2 + hstepA, voffA);
            PG8_WAIT_V(8); PG8_WAIT_L(0); PG8_BAR; PG8_MMA(0, 0, At, B0); PG8_MMA(0, 1, At, B1); PG8_BAR; PG8_SCHED;
            PG8_LDA(At, 1, 1); PG8_STAGE(PG8_SB(1, 0), b3, voffB); PG8_STAGE(PG8_SB(1, 1), b3 + hstepB, voffB); PG8_STAGE(PG8_SA(1, 0), a3, voffA);
            PG8_WAIT_V(8); PG8_WAIT_L(0); PG8_BAR; PG8_MMA(1, 0, At, B0); PG8_MMA(1, 1, At, B1); PG8_BAR; PG8_SCHED;
        }
        if (wr == 0) PG8_BAR;
        if (cur.role == 1) {
            const __amdgpu_buffer_rsrc_t rs = __builtin_amdgcn_make_buffer_rsrc(sk.slab, 0, 0x7fffffff, 0x00020000);
            const unsigned base = ((unsigned)S.c * 16384u + (unsigned)opaque(tid)) * 16u;
#pragma unroll
            for (int a = 0; a < 2; ++a)
#pragma unroll
                for (int b = 0; b < 2; ++b)
#pragma unroll
                    for (int m = 0; m < 4; ++m)
#pragma unroll
                        for (int n = 0; n < 2; ++n)
                            __builtin_amdgcn_raw_buffer_store_b128(__builtin_bit_cast(u32x4, acc[a][b][m][n]), rs, base + (unsigned)(((a * 2 + b) * 4 + m) * 2 + n) * 8192u, 0, 16);
            PG8_WAIT_V(0); PG8_BAR;
            if (tid == 0) __hip_atomic_store(sk.flags + 64 * S.c, 1u, __ATOMIC_RELAXED, __HIP_MEMORY_SCOPE_AGENT);
        } else if (cur.role == 3) {
            bf16_t* O = sk.part + (size_t)(S.c % NXCD) * 1024 * 2048;
            const int row0 = (cur.pm - 32) * BM + wr * 64 + fr, col0 = cur.pn * BM + wc * 32 + 8 * fq;
#pragma unroll
            for (int ai = 0; ai < 2; ++ai)
#pragma unroll
                for (int m = 0; m < 4; ++m) {
                    bf16_t* rp = O + (size_t)(row0 + ai * HALF + m * 16) * 2048 + col0;
#pragma unroll
                    for (int bj = 0; bj < 2; ++bj) {
                        u32x4 wv; wv.x = cvt_pk_bf16(acc[ai][bj][m][0][0], acc[ai][bj][m][0][1]); wv.y = cvt_pk_bf16(acc[ai][bj][m][0][2], acc[ai][bj][m][0][3]);
                        wv.z = cvt_pk_bf16(acc[ai][bj][m][1][0], acc[ai][bj][m][1][1]); wv.w = cvt_pk_bf16(acc[ai][bj][m][1][2], acc[ai][bj][m][1][3]);
                        *(u32x4*)(rp + bj * HALF) = wv;
                    }
                }
        } else {
            E(acc, cur, wr, wc, fr, fq);
        }
        if (!has_next) break;
        if (nxt.role == 2) {
            const int pc = S.c + NXCD;
            if (wid == 0) {
                unsigned spins = 0;
                while (__builtin_amdgcn_readfirstlane(__hip_atomic_load(sk.flags + 64 * pc, __ATOMIC_RELAXED, __HIP_MEMORY_SCOPE_AGENT)) == 0u) { __builtin_amdgcn_s_sleep(2); if (++spins > (1u << 22)) break; }
                __builtin_amdgcn_fence(__ATOMIC_ACQUIRE, "agent");
                PG8_WAIT_V(0);
            }
            asm volatile("" ::: "memory"); PG8_BAR; asm volatile("" ::: "memory");
            const f32x4* sl = (const f32x4*)sk.slab + (size_t)pc * 16384 + opaque(tid);
#pragma unroll
            for (int a = 0; a < 2; ++a)
#pragma unroll
                for (int b = 0; b < 2; ++b)
#pragma unroll
                    for (int m = 0; m < 4; ++m)
#pragma unroll
                        for (int n = 0; n < 2; ++n) acc[a][b][m][n] = *(const GAS f32x4*)(sl + (((a * 2 + b) * 4 + m) * 2 + n) * 512);
#pragma unroll
            for (int a = 0; a < 2; ++a)
#pragma unroll
                for (int b = 0; b < 2; ++b)
#pragma unroll
                    for (int m = 0; m < 4; ++m)
#pragma unroll
                        for (int n = 0; n < 2; ++n) asm volatile("" : "+v"(acc[a][b][m][n]));
        } else {
#pragma unroll
        for (int a = 0; a < 2; ++a)
#pragma unroll
            for (int b = 0; b < 2; ++b)
#pragma unroll
                for (int m = 0; m < 4; ++m)
#pragma unroll
                    for (int n = 0; n < 2; ++n) acc[a][b][m][n] = (f32x4){0.f, 0.f, 0.f, 0.f};
        }
        cur = nxt; cA = nA; cB = nB; ++ui;
        if (wr == 1) PG8_BAR;
    }
    PG8_WAIT_V(0);
    PG8_BAR;
#undef PG8_UA
#undef PG8_UB
#undef PG8_SA
#undef PG8_SB
#undef PG8_STAGE
#undef PG8_LDA
#undef PG8_LDB
#undef PG8_MMA
#undef PG8_WAIT_V
#undef PG8_WAIT_L
#undef PG8_BAR
#undef PG8_SCHED
}

__device__ __forceinline__ void st8(bf16_t* p, const f32x4 v0, const f32x4 v1) {
    u32x4 w; w.x = cvt_pk_bf16(v0[0], v0[1]); w.y = cvt_pk_bf16(v0[2], v0[3]); w.z = cvt_pk_bf16(v1[0], v1[1]); w.w = cvt_pk_bf16(v1[2], v1[3]);
    *(u32x4*)p = w;
}
struct EpiProj {
    bf16_t* P; const float* cs;
    __device__ __forceinline__ void operator()(const f32x4 (&acc)[2][2][4][2], const Unit& u, int wr, int wc, int fr, int fq) const {
        const int row0 = u.pm * BM + wr * 64 + fr, type = u.pn >> 2, cl = wc * 32 + 8 * fq, col0 = u.pn * BM + cl;
        if (type <= 1) {
            const float sc = type == 1 ? 0.0625f : 1.0f;
#pragma unroll
            for (int ai = 0; ai < 2; ++ai)
#pragma unroll
                for (int m = 0; m < 4; ++m) {
                    const int row = row0 + ai * HALF + m * 16;
                    const int pidx = row < MP ? (row & (SEQ - 1)) : SEQ + ((row - MP) & 7);
                    const f32x4* t = (const f32x4*)(cs + ((size_t)pidx * 128 + cl) * 2);
                    const f32x4 t0 = t[0], t1 = t[1], t2 = t[2], t3 = t[3];
                    const f32x4 x1a = acc[ai][0][m][0], x1b = acc[ai][0][m][1], x2a = acc[ai][1][m][0], x2b = acc[ai][1][m][1];
                    f32x4 o1a, o1b, o2a, o2b;
                    o1a[0] = (x1a[0] * t0[0] - x2a[0] * t0[1]) * sc; o2a[0] = (x2a[0] * t0[0] + x1a[0] * t0[1]) * sc;
                    o1a[1] = (x1a[1] * t0[2] - x2a[1] * t0[3]) * sc; o2a[1] = (x2a[1] * t0[2] + x1a[1] * t0[3]) * sc;
                    o1a[2] = (x1a[2] * t1[0] - x2a[2] * t1[1]) * sc; o2a[2] = (x2a[2] * t1[0] + x1a[2] * t1[1]) * sc;
                    o1a[3] = (x1a[3] * t1[2] - x2a[3] * t1[3]) * sc; o2a[3] = (x2a[3] * t1[2] + x1a[3] * t1[3]) * sc;
                    o1b[0] = (x1b[0] * t2[0] - x2b[0] * t2[1]) * sc; o2b[0] = (x2b[0] * t2[0] + x1b[0] * t2[1]) * sc;
                    o1b[1] = (x1b[1] * t2[2] - x2b[1] * t2[3]) * sc; o2b[1] = (x2b[1] * t2[2] + x1b[1] * t2[3]) * sc;
                    o1b[2] = (x1b[2] * t3[0] - x2b[2] * t3[1]) * sc; o2b[2] = (x2b[2] * t3[0] + x1b[2] * t3[1]) * sc;
                    o1b[3] = (x1b[3] * t3[2] - x2b[3] * t3[3]) * sc; o2b[3] = (x2b[3] * t3[2] + x1b[3] * t3[3]) * sc;
                    bf16_t* rp = P + (size_t)row * INW + col0;
                    st8(rp, o1a, o1b); st8(rp + HALF, o2a, o2b);
                }
        } else {
            const bool act = type == 3;
#pragma unroll
            for (int ai = 0; ai < 2; ++ai)
#pragma unroll
                for (int m = 0; m < 4; ++m) {
                    bf16_t* rp = P + (size_t)(row0 + ai * HALF + m * 16) * INW + col0;
#pragma unroll
                    for (int bj = 0; bj < 2; ++bj) {
                        f32x4 v0 = acc[ai][bj][m][0], v1 = acc[ai][bj][m][1];
                        if (act) {
#pragma unroll
                            for (int i = 0; i < 4; ++i) { v0[i] = silu(v0[i]); v1[i] = silu(v1[i]); }
                        }
                        st8(rp + bj * HALF, v0, v1);
                    }
                }
        }
    }
};
struct EpiPlain {
    bf16_t* O; int ldc, coff; const float* scale;
    __device__ __forceinline__ void operator()(const f32x4 (&acc)[2][2][4][2], const Unit& u, int wr, int wc, int fr, int fq) const {
        const int row0 = u.pm * BM + wr * 64 + fr, cl = wc * 32 + 8 * fq, col0 = u.pn * BM + cl;
        f32x4 s[2][2];
#pragma unroll
        for (int bj = 0; bj < 2; ++bj)
#pragma unroll
            for (int n = 0; n < 2; ++n) s[bj][n] = scale ? *(const f32x4*)(scale + col0 + bj * HALF + 4 * n) : (f32x4){1.f, 1.f, 1.f, 1.f};
#pragma unroll
        for (int ai = 0; ai < 2; ++ai)
#pragma unroll
            for (int m = 0; m < 4; ++m) {
                bf16_t* rp = O + (size_t)(row0 + ai * HALF + m * 16) * ldc + coff + col0;
#pragma unroll
                for (int bj = 0; bj < 2; ++bj) st8(rp + bj * HALF, acc[ai][bj][m][0] * s[bj][0], acc[ai][bj][m][1] * s[bj][1]);
            }
    }
};
struct EpiGU {
    bf16_t* Hd;
    __device__ __forceinline__ void operator()(const f32x4 (&acc)[2][2][4][2], const Unit& u, int wr, int wc, int fr, int fq) const {
        const int row0 = u.pm * BM + wr * 64 + fr, cl = wc * 32 + 8 * fq, col0 = u.pn * HALF + cl;
#pragma unroll
        for (int ai = 0; ai < 2; ++ai)
#pragma unroll
            for (int m = 0; m < 4; ++m) {
                f32x4 v0, v1;
#pragma unroll
                for (int i = 0; i < 4; ++i) { v0[i] = silu(acc[ai][0][m][0][i]) * acc[ai][1][m][0][i]; v1[i] = silu(acc[ai][0][m][1][i]) * acc[ai][1][m][1][i]; }
                st8(Hd + (size_t)(row0 + ai * HALF + m * 16) * DFF + col0, v0, v1);
            }
    }
};
}

#define XB_TMO      128
#define XB_XCNT(j)  (256  + 64 * (j))
#define XB_XSUB(j)  (1280 + 64 * (j))
#define XB_XGEN(j)  (2304 + 64 * (j))
#define XB_TOP      3328
#define XB_TOPGEN   3392
#define XCD_BAR_WORDS 3456
#define XB_SPIN_CAP (1u << 18)
__device__ __forceinline__ unsigned xb_ld(unsigned* p)              { return __hip_atomic_load(p, __ATOMIC_RELAXED, __HIP_MEMORY_SCOPE_AGENT); }
__device__ __forceinline__ unsigned xb_add(unsigned* p, unsigned v) { return __hip_atomic_fetch_add(p, v, __ATOMIC_RELAXED, __HIP_MEMORY_SCOPE_AGENT); }
__device__ __forceinline__ unsigned xb_xcc_id() { return (unsigned)__builtin_amdgcn_s_getreg((3 << 11) | 20) & 0xFu; }
#define XB_SPIN(cond, bar) do { unsigned _sp = 0; while (cond) { __builtin_amdgcn_s_sleep(1); \
    if ((++_sp & 255u) == 0u) { if (xb_ld(&(bar)[XB_TMO])) break; if (_sp > XB_SPIN_CAP) { atomicAdd(&(bar)[XB_TMO], 1u); break; } } } } while (0)
__device__ __forceinline__ void xcd_barrier_post(unsigned* bar) {
    if (threadIdx.x == 0) (void)xb_add(&bar[XB_XCNT(xb_xcc_id())], 1u);
}
__device__ __forceinline__ void xcd_barrier_complete(unsigned* bar, unsigned x, unsigned& nloc, unsigned& nx) {
    const unsigned G = gridDim.x * gridDim.y * gridDim.z;
    unsigned sum, cnt, mine, sp = 0u;
    for (;;) {
        sum = 0u; cnt = 0u; mine = 0u;
#pragma unroll
        for (unsigned j = 0; j < 16; ++j) { const unsigned c = xb_ld(&bar[XB_XCNT(j)]); sum += c; cnt += (c > 0u) ? 1u : 0u; mine = (j == x) ? c : mine; }
        if (sum == G) break;
        __builtin_amdgcn_s_sleep(1);
        if ((++sp & 255u) == 0u) { if (xb_ld(&bar[XB_TMO])) break; if (sp > XB_SPIN_CAP) { atomicAdd(&bar[XB_TMO], 1u); break; } }
    }
    nloc = mine > 0u ? mine : 1u; nx = cnt > 0u ? cnt : 1u;
}
__device__ __forceinline__ void xcd_barrier(unsigned* bar, volatile LAS unsigned* st) {
    asm volatile("s_waitcnt vmcnt(0)" ::: "memory");
    __syncthreads();
    if (threadIdx.x == 0) {
        const unsigned x = xb_xcc_id();
        __builtin_amdgcn_s_waitcnt(0);
        unsigned nloc = st[0], nx = st[1];
        if (nloc == 0u) { xcd_barrier_complete(bar, x, nloc, nx); st[0] = nloc; st[1] = nx; }
        const unsigned old = xb_add(&bar[XB_XSUB(x)], 1u);
        const unsigned gen = old / nloc;
        if (old + 1u == (gen + 1u) * nloc) {
            __builtin_amdgcn_fence(__ATOMIC_RELEASE, "agent");
            asm volatile("s_waitcnt vmcnt(0)" ::: "memory");
            const unsigned og = xb_add(&bar[XB_TOP], 1u);
            const unsigned tg = og / nx;
            if (og + 1u == (tg + 1u) * nx) xb_add(&bar[XB_TOPGEN], 1u);
            else XB_SPIN(xb_ld(&bar[XB_TOPGEN]) == tg, bar);
            __builtin_amdgcn_fence(__ATOMIC_ACQUIRE, "agent");
            xb_add(&bar[XB_XGEN(x)], 1u);
            asm volatile("s_waitcnt vmcnt(0)" ::: "memory");
        } else {
            XB_SPIN(xb_ld(&bar[XB_XGEN(x)]) == gen, bar);
            __builtin_amdgcn_fence(__ATOMIC_ACQUIRE, "agent");
            asm volatile("s_waitcnt vmcnt(0)" ::: "memory");
        }
    }
    __syncthreads();
}

struct Args { const float* in[16]; float* out; unsigned char* ws; int ph_lo, ph_hi, use_cg, pad; };

struct Frame {
    LAS unsigned char* lds;
    int tid, lane, wave, vcu, G;
};
__device__ __forceinline__ const float* ldarg(const Frame& F, int k) {
    const volatile LAS unsigned* p = (const volatile LAS unsigned*)(F.lds + ARG_OFF) + 2 * k;
    const unsigned lo = __builtin_amdgcn_readfirstlane(p[0]), hi = __builtin_amdgcn_readfirstlane(p[1]);
    return (const float*)(((unsigned long long)hi << 32) | lo);
}
#define AIN(k) ldarg(F, (k))
#define AOUT ((float*)ldarg(F, 16))
#define AWS ((unsigned char*)ldarg(F, 17))

struct TrItem { const float* W; bf16_t* WT; int K, N, mode, k0, n0; };
constexpr int TR_IN = (D / 64) * (INW / 256), TR_OUT = (D / 64) * (D / 256), TR_G = (D / 64) * (DFF / 256), TR_D = (DFF / 64) * (D / 256);
struct P0Ptrs { const float *w_in, *w_out, *w_gate, *w_up, *w_down, *w_pool; unsigned char* ws; };
__device__ __forceinline__ TrItem p0_decode(const P0Ptrs& a, unsigned char* ws, int it) {
    TrItem t; int r = it, nblk;
    if (r < TR_IN) { t.W = a.w_in; t.WT = (bf16_t*)(ws + WS_WIN); t.K = D; t.N = INW; t.mode = 0; }
    else if ((r -= TR_IN) < TR_OUT) { t.W = a.w_out; t.WT = (bf16_t*)(ws + WS_WOUT); t.K = D; t.N = D; t.mode = 0; }
    else if ((r -= TR_OUT) < 16) { const int g = r >> 2; r &= 3; t.W = a.w_pool + (size_t)g * 65536; t.WT = (bf16_t*)(ws + WS_WPOOL) + (size_t)g * 65536; t.K = 256; t.N = 256; t.mode = 0; }
    else if ((r -= 16) < TR_G) { t.W = a.w_gate; t.WT = (bf16_t*)(ws + WS_WGU); t.K = D; t.N = DFF; t.mode = 1; }
    else if ((r -= TR_G) < TR_G) { t.W = a.w_up; t.WT = (bf16_t*)(ws + WS_WGU); t.K = D; t.N = DFF; t.mode = 2; }
    else { r -= TR_G; t.W = a.w_down; t.WT = (bf16_t*)(ws + WS_WD); t.K = DFF; t.N = D; t.mode = 0; }
    nblk = t.N >> 8; t.k0 = 64 * (r / nblk); t.n0 = 256 * (r % nblk);
    return t;
}
constexpr int P0_NITEMS = TR_IN + TR_OUT + 16 + 2 * TR_G + TR_D;
constexpr int TR_B = TR_IN + TR_OUT + 16 + 2 * TR_G, TR_C = P0_NITEMS;
#ifndef TR_P1_ITEMS
#define TR_P1_ITEMS 800
#endif
constexpr int TR_A = TR_B - TR_P1_ITEMS;
__device__ __forceinline__ void p0_transposes(Frame& F, int it_begin, int it_end, int worker, int nworkers) {
    P0Ptrs a; a.w_in = AIN(6); a.w_out = AIN(10); a.w_gate = AIN(13); a.w_up = AIN(14); a.w_down = AIN(15); a.w_pool = AIN(8); a.ws = AWS;
    unsigned char* ws = a.ws;
    LAS float* buf = (LAS float*)F.lds;
    const int w = F.wave, l = opaque(F.lane);
    int it = it_begin + worker;
    if (it >= it_end) return;
    TrItem t = p0_decode(a, ws, it);
    f32x4 v[8];
#pragma unroll
    for (int i = 0; i < 8; ++i) v[i] = *(const GAS f32x4*)(t.W + (size_t)(t.k0 + 8 * w + i) * t.N + t.n0 + 4 * l);
    for (;;) {
#pragma unroll
        for (int i = 0; i < 8; ++i) *(LAS f32x4*)(buf + (8 * w + i) * 260 + ((4 * l) ^ (4 * (w & 7)))) = v[i];
        __syncthreads();
        const TrItem cur = t;
        const int nit = it + nworkers; const bool has_next = nit < it_end;
        if (has_next) { t = p0_decode(a, ws, nit);
#pragma unroll
            for (int i = 0; i < 8; ++i) v[i] = *(const GAS f32x4*)(t.W + (size_t)(t.k0 + 8 * w + i) * t.N + t.n0 + 4 * l); }
        const int ko = l & 7;
#pragma unroll
        for (int sidx = 0; sidx < 4; ++sidx) {
            const int nl = 32 * w + 8 * sidx + (l >> 3), n = cur.n0 + nl;
            const LAS float* p = buf + (8 * ko) * 260 + (nl ^ (4 * ko));
            u32x4 o; o.x = pk2(p[0], p[260]); o.y = pk2(p[2 * 260], p[3 * 260]); o.z = pk2(p[4 * 260], p[5 * 260]); o.w = pk2(p[6 * 260], p[7 * 260]);
            const int row = cur.mode == 0 ? n : (256 * (n >> 7) + (n & 127) + (cur.mode == 2 ? 128 : 0));
            *(GAS u32x4*)(cur.WT + (size_t)row * cur.K + cur.k0 + 8 * ko) = o;
        }
        __syncthreads();
        if (!has_next) break;
        it = nit;
    }
}
__device__ __forceinline__ void rms_row_to_bf16(const float* xrow, const float* w, bf16_t* orow, int lane) {
    const GAS f32x4* xr = (const GAS f32x4*)xrow + lane; const GAS f32x4* wr = (const GAS f32x4*)w + lane;
    f32x4 v[8]; float s = 0.f;
#pragma unroll
    for (int j = 0; j < 8; ++j) { v[j] = xr[64 * j]; s += (v[j].x * v[j].x + v[j].y * v[j].y) + (v[j].z * v[j].z + v[j].w * v[j].w); }
    const float rstd = 1.0f / sqrtf(wave_sum(s) * (1.f / D) + EPS);
    GAS u32x2* o8 = (GAS u32x2*)orow + lane;
#pragma unroll
    for (int j = 0; j < 8; ++j) { const f32x4 ww = wr[64 * j]; u32x2 o; o.x = pk2(v[j].x * rstd * ww.x, v[j].y * rstd * ww.y); o.y = pk2(v[j].z * rstd * ww.z, v[j].w * rstd * ww.w); o8[64 * j] = o; }
}
__device__ __forceinline__ const float* xrow_ptr(const float* xp, const float* xs, int m) { return m < MP ? xp + (size_t)m * D : xs + (size_t)(m - MP) * D; }

__device__ __forceinline__ void p0_prologue(Frame& F) {
    p0_transposes(F, 0, TR_A, F.vcu, F.G);
    unsigned char* ws = AWS;
    const int gw = F.vcu * NWAVES + F.wave, NGW = F.G * NWAVES;
    const float* xp_ = AIN(0); const float* xs_ = AIN(1); const float* nw_ = AIN(4);
    for (int m = gw; m < M; m += NGW) rms_row_to_bf16(xrow_ptr(xp_, xs_, m), nw_, (bf16_t*)(ws + WS_H) + (size_t)m * D, F.lane);
    float* cs = (float*)(ws + WS_CS);
    for (int idx = F.vcu * NTHR + F.tid; idx < NPOS * 128; idx += F.G * NTHR) {
        const int p = idx >> 7, j = idx & 127;
        double r = 0.930572040929699, inv = 1.0;
#pragma unroll
        for (int b = 0; b < 7; ++b) { if ((j >> b) & 1) inv *= r; r *= r; }
        const float invf = (float)inv;
        const float pos = (float)(p < SEQ ? p : 16384 + (p - SEQ));
        const float ang = pos * invf;
        double t = (double)ang * 0.15915494309189535; t -= __builtin_rint(t);
        const float tf = (float)t;
        f32x2 o; o.x = __builtin_amdgcn_cosf(tf); o.y = __builtin_amdgcn_sinf(tf);
        *(f32x2*)(cs + (size_t)idx * 2) = o;
    }
}

__device__ __forceinline__ unsigned toff(int r, int c16, int RB) { return (unsigned)(r * RB + ((((c16 & ~15) | ((c16 ^ r ^ (r >> 4)) & 15))) << 4)); }
#define MFMA32(a, b, c) __builtin_amdgcn_mfma_f32_32x32x16_bf16((a), (b), (c), 0, 0, 0)
__device__ __forceinline__ int crow(int reg, int h) { return (reg & 3) + 8 * (reg >> 2) + 4 * h; }
__device__ __forceinline__ bf16x8 frag(const LAS unsigned char* tile, int r, int c16, int RB) { return *(const LAS bf16x8*)(tile + toff(r, c16, RB)); }

__device__ __forceinline__ void load_nat128(LAS unsigned char* dst, const bf16_t* src, int ld, int tid) {
    tid = opaque(tid);
    u32x4 v[4];
#pragma unroll
    for (int it = 0; it < 4; ++it) { const int idx = tid + it * NTHR, r = idx >> 4, c = idx & 15; v[it] = *(const GAS u32x4*)(src + (size_t)r * ld + c * 8); }
#pragma unroll
    for (int it = 0; it < 4; ++it) { const int idx = tid + it * NTHR, r = idx >> 4, c = idx & 15; *(LAS u32x4*)(dst + toff(r, c, 256)) = v[it]; }
}
template <bool SCALE>
__device__ __forceinline__ void load_tr(LAS unsigned char* dst, const bf16_t* src, int ld, int tid, float sc_a, float sc_b) {
    tid = opaque(tid);
#pragma unroll
    for (int it = 0; it < 4; ++it) {
        const int T = it * NTHR + tid, ch_lo = T & 15, pp = (T >> 4) & 3, half = (T >> 6) & 1, quad = T >> 7;
        const int pair = 4 * quad + pp, chunk = 16 * half + ch_lo, j0 = 2 * pair, d0 = 8 * chunk;
        const u32x4 a = *(const GAS u32x4*)(src + (size_t)j0 * ld + d0), b = *(const GAS u32x4*)(src + (size_t)(j0 + 1) * ld + d0);
        float s0 = 1.f, s1 = 1.f;
        if (SCALE) { s0 = __builtin_amdgcn_exp2f(sc_a * (sc_b - (float)j0)); s1 = __builtin_amdgcn_exp2f(sc_a * (sc_b - (float)(j0 + 1))); }
#pragma unroll
        for (int i = 0; i < 8; ++i) {
            const unsigned wa = a[i >> 1], wb = b[i >> 1];
            unsigned w;
            if (SCALE) { const float fa = ((i & 1) ? bfhi(wa) : bflo(wa)) * s0, fb = ((i & 1) ? bfhi(wb) : bflo(wb)) * s1; w = pk2(fa, fb); }
            else w = (i & 1) ? ((wa >> 16) | (wb & 0xffff0000u)) : ((wa & 0xffffu) | (wb << 16));
            const int d = d0 + i;
            *(LAS unsigned*)(dst + toff(d, quad, 256) + pp * 4) = w;
        }
    }
}

__device__ __forceinline__ void u_item(Frame& F, const bf16_t* PROJ, bf16_t* UT, int item) {
    const int b = item >> 6, h = (item >> 4) & 3, c = item & 15, rows0 = b * SEQ + c * 128;
    const bf16_t* Ks = PROJ + (size_t)rows0 * INW + 1024 + h * 256; const bf16_t* Vs = Ks + 1024;
    LAS unsigned char* KT = F.lds; LAS unsigned char* VT = F.lds + 65536;
    const float lg = lg2gamma(h);
    load_tr<true>(KT, Ks, INW, F.tid, lg, 127.f);
    load_tr<false>(VT, Vs, INW, F.tid, 0.f, 0.f);
    __syncthreads();
    const int w = F.wave, r = opaque(F.lane) & 31, hh = opaque(F.lane) >> 5;
    bf16_t* Up = UT + ((size_t)((b * 4 + h) * 16 + c) * 256) * 256;
#pragma unroll 1
    for (int eh = 0; eh < 2; ++eh) {
        f32x16 acc[4];
#pragma unroll
        for (int t = 0; t < 4; ++t)
#pragma unroll
            for (int i = 0; i < 16; ++i) acc[t][i] = 0.f;
#pragma unroll 1
        for (int ks = 0; ks < 8; ++ks) {
            const bf16x8 a = frag(KT, 32 * w + r, 2 * ks + hh, 256);
#pragma unroll
            for (int et = 0; et < 4; ++et) { const bf16x8 bb = frag(VT, 32 * (4 * eh + et) + r, 2 * ks + hh, 256); acc[et] = MFMA32(a, bb, acc[et]); }
        }
#pragma unroll
        for (int et = 0; et < 4; ++et)
#pragma unroll
            for (int g = 0; g < 4; ++g) {
                u32x2 o; o.x = cvt_pk_bf16(acc[et][4 * g], acc[et][4 * g + 1]); o.y = cvt_pk_bf16(acc[et][4 * g + 2], acc[et][4 * g + 3]);
                *(GAS u32x2*)(Up + (size_t)(32 * (4 * eh + et) + r) * 256 + 32 * w + 8 * g + 4 * hh) = o;
            }
    }
    __syncthreads();
}

__device__ __forceinline__ void o_item(Frame& F, const bf16_t* PROJ, const bf16_t* SCT, const float* retw, bf16_t* MIX, int item) {
    const int b = item >> 6, h = (item >> 4) & 3, c = item & 15, rows0 = b * SEQ + c * 128;
    const bf16_t* Qs = PROJ + (size_t)rows0 * INW + h * 256; const bf16_t* Ks = Qs + 1024; const bf16_t* Vs = Qs + 2048; const bf16_t* Gs = Qs + 3072;
    LAS unsigned char* QF = F.lds; LAS unsigned char* KH = F.lds + 65536; LAS unsigned char* PB = F.lds + 98304; LAS unsigned char* VT = F.lds; LAS unsigned char* OB = F.lds;
    const float lg = lg2gamma(h);
    const int w = F.wave; int r = opaque(F.lane) & 31, hh = opaque(F.lane) >> 5; const int tid = opaque(F.tid);
    u32x4 qv[8], kv[4]; bf16x8 sfr[16];
#pragma unroll
    for (int it = 0; it < 8; ++it) { const int idx = tid + it * NTHR, rr = idx >> 5, cc = idx & 31; qv[it] = *(const GAS u32x4*)(Qs + (size_t)rr * INW + cc * 8); }
#pragma unroll
    for (int it = 0; it < 4; ++it) { const int idx = tid + it * NTHR, rr = idx >> 4, cc = idx & 15; kv[it] = *(const GAS u32x4*)(Ks + (size_t)rr * INW + cc * 8); }
    {
        const bf16_t* Sp = SCT + ((size_t)((b * 4 + h) * 16 + c) * 256) * 256 + (size_t)(32 * w + r) * 256 + 8 * hh;
#pragma unroll
        for (int ks = 0; ks < 16; ++ks) sfr[ks] = *(const GAS bf16x8*)(Sp + 16 * ks);
    }
#pragma unroll
    for (int it = 0; it < 8; ++it) { const int idx = tid + it * NTHR, rr = idx >> 5, cc = idx & 31; *(LAS u32x4*)(QF + toff(rr, cc, 512)) = qv[it]; }
#pragma unroll
    for (int it = 0; it < 4; ++it) { const int idx = tid + it * NTHR, rr = idx >> 4, cc = idx & 15; *(LAS u32x4*)(KH + toff(rr, cc, 256)) = kv[it]; }
    __syncthreads();
#pragma unroll
    for (int it = 0; it < 4; ++it) { const int idx = tid + it * NTHR, rr = idx >> 4, cc = idx & 15; kv[it] = *(const GAS u32x4*)(Ks + 128 + (size_t)rr * INW + cc * 8); }
    const int ib_s = w >> 1, jb0 = 2 * (w & 1);
    f32x16 sc[2];
#pragma unroll
    for (int t = 0; t < 2; ++t)
#pragma unroll
        for (int i = 0; i < 16; ++i) sc[t][i] = 0.f;
    if (jb0 <= ib_s) {
#pragma unroll 1
        for (int ks = 0; ks < 8; ++ks) {
            const bf16x8 a = frag(QF, 32 * ib_s + r, 2 * ks + hh, 512);
            const bf16x8 b0 = frag(KH, 32 * jb0 + r, 2 * ks + hh, 256), b1 = frag(KH, 32 * (jb0 + 1) + r, 2 * ks + hh, 256);
            sc[0] = MFMA32(a, b0, sc[0]); sc[1] = MFMA32(a, b1, sc[1]);
        }
    }
    __syncthreads();
#pragma unroll
    for (int it = 0; it < 4; ++it) { const int idx = tid + it * NTHR, rr = idx >> 4, cc = idx & 15; *(LAS u32x4*)(KH + toff(rr, cc, 256)) = kv[it]; }
    __syncthreads();
    u32x4 va[4], vb[4];
#pragma unroll
    for (int it = 0; it < 4; ++it) {
        const int T = it * NTHR + tid, ch_lo = T & 15, pp = (T >> 4) & 3, half = (T >> 6) & 1, quad = T >> 7;
        const int pair = 4 * quad + pp, chunk = 16 * half + ch_lo, j0 = 2 * pair, d0 = 8 * chunk;
        va[it] = *(const GAS u32x4*)(Vs + (size_t)j0 * INW + d0); vb[it] = *(const GAS u32x4*)(Vs + (size_t)(j0 + 1) * INW + d0);
    }
    if (jb0 <= ib_s) {
#pragma unroll 1
        for (int ks = 0; ks < 8; ++ks) {
            const bf16x8 a = frag(QF, 32 * ib_s + r, 16 + 2 * ks + hh, 512);
            const bf16x8 b0 = frag(KH, 32 * jb0 + r, 2 * ks + hh, 256), b1 = frag(KH, 32 * (jb0 + 1) + r, 2 * ks + hh, 256);
            sc[0] = MFMA32(a, b0, sc[0]); sc[1] = MFMA32(a, b1, sc[1]);
        }
    }
    r = opaque(r); hh = opaque(hh);
#pragma unroll
    for (int t = 0; t < 2; ++t) {
        const int j = 32 * (jb0 + t) + r;
#pragma unroll
        for (int reg = 0; reg < 16; ++reg) {
            const int i = 32 * ib_s + crow(reg, hh);
            const float v = (i >= j) ? sc[t][reg] * __builtin_amdgcn_exp2f(lg * (float)(i - j)) : 0.f;
            *(LAS bf16_t*)(PB + toff(i, j >> 3, 256) + (j & 7) * 2) = (bf16_t)f2bf(v);
        }
    }
    f32x16 o[4];
#pragma unroll
    for (int t = 0; t < 4; ++t)
#pragma unroll
        for (int i = 0; i < 16; ++i) o[t][i] = 0.f;
    r = opaque(r); hh = opaque(hh);
#pragma unroll
    for (int ks = 0; ks < 16; ++ks) {
#pragma unroll
        for (int ib = 0; ib < 4; ++ib) { const bf16x8 a = frag(QF, 32 * ib + r, 2 * ks + hh, 512); o[ib] = MFMA32(a, sfr[ks], o[ib]); }
    }
#pragma unroll
    for (int ib = 0; ib < 4; ++ib)
#pragma unroll
        for (int reg = 0; reg < 16; ++reg) o[ib][reg] *= __builtin_amdgcn_exp2f(lg * (float)(32 * ib + crow(reg, hh) + 1));
    __syncthreads();
#pragma unroll
    for (int it = 0; it < 4; ++it) {
        const int T = it * NTHR + tid, ch_lo = T & 15, pp = (T >> 4) & 3, half = (T >> 6) & 1, quad = T >> 7;
        const int chunk = 16 * half + ch_lo, d0 = 8 * chunk;
#pragma unroll
        for (int i = 0; i < 8; ++i) {
            const unsigned wa = va[it][i >> 1], wb = vb[it][i >> 1];
            const unsigned wv = (i & 1) ? ((wa >> 16) | (wb & 0xffff0000u)) : ((wa & 0xffffu) | (wb << 16));
            *(LAS unsigned*)(VT + toff(d0 + i, quad, 256) + pp * 4) = wv;
        }
    }
    __syncthreads();
    r = opaque(r); hh = opaque(hh);
#pragma unroll 1
    for (int ks = 0; ks < 8; ++ks) {
        const bf16x8 bb = frag(VT, 32 * w + r, 2 * ks + hh, 256);
#pragma unroll
        for (int ib = 0; ib < 4; ++ib)
            if (ks < 2 * (ib + 1)) { const bf16x8 a = frag(PB, 32 * ib + r, 2 * ks + hh, 256); o[ib] = MFMA32(a, bb, o[ib]); }
    }
    __syncthreads();
    r = opaque(r); hh = opaque(hh);
#pragma unroll
    for (int ib = 0; ib < 4; ++ib)
#pragma unroll
        for (int reg = 0; reg < 16; ++reg) { const int i = 32 * ib + crow(reg, hh);
            *(LAS bf16_t*)(OB + i * 512 + (32 * w + r) * 2) = (bf16_t)f2bf(o[ib][reg]); }
    __syncthreads();
    {
        const int tid2 = opaque(F.tid), cc = tid2 & 31;
        const f32x4 wa = *(const GAS f32x4*)(retw + h * 256 + cc * 8), wb = *(const GAS f32x4*)(retw + h * 256 + cc * 8 + 4);
        u32x4 gv[8];
#pragma unroll
        for (int it = 0; it < 8; ++it) gv[it] = *(const GAS u32x4*)(Gs + (size_t)((tid2 >> 5) + 16 * it) * INW + cc * 8);
#pragma unroll
        for (int it = 0; it < 8; ++it) {
            const int i = (tid2 >> 5) + 16 * it;
            const u32x4 ov = *(const LAS u32x4*)(OB + i * 512 + cc * 16);
            float x[8];
#pragma unroll
            for (int k = 0; k < 4; ++k) { x[2 * k] = bflo(ov[k]); x[2 * k + 1] = bfhi(ov[k]); }
            float sq = 0.f;
#pragma unroll
            for (int k = 0; k < 8; ++k) sq += x[k] * x[k];
            sq += __shfl_xor(sq, 1); sq += __shfl_xor(sq, 2); sq += __shfl_xor(sq, 4); sq += __shfl_xor(sq, 8); sq += __shfl_xor(sq, 16);
            const float rstd = 1.0f / sqrtf(sq * (1.f / 256.f) + EPS);
            u32x4 res;
            res[0] = pk2(x[0] * rstd * wa[0] * bflo(gv[it][0]), x[1] * rstd * wa[1] * bfhi(gv[it][0]));
            res[1] = pk2(x[2] * rstd * wa[2] * bflo(gv[it][1]), x[3] * rstd * wa[3] * bfhi(gv[it][1]));
            res[2] = pk2(x[4] * rstd * wb[0] * bflo(gv[it][2]), x[5] * rstd * wb[1] * bfhi(gv[it][2]));
            res[3] = pk2(x[6] * rstd * wb[2] * bflo(gv[it][3]), x[7] * rstd * wb[3] * bfhi(gv[it][3]));
            *(GAS u32x4*)(MIX + (size_t)(rows0 + i) * D + h * 256 + cc * 8) = res;
        }
    }
    __syncthreads();
}

__device__ __forceinline__ void s_item(Frame& F, const bf16_t* PROJ, const float* state, const float* retw, float* newstate, bf16_t* MIX, int item) {
    const int sb = item >> 2, h = item & 3, rows0 = MP + sb * 8;
    const float lg = lg2gamma(h);
    LAS float* QK = (LAS float*)F.lds;
    LAS float* QR = (LAS float*)(F.lds + 16384);
    LAS float* KR = (LAS float*)(F.lds + 16384 + 8224);
    LAS float* SCP = (LAS float*)(F.lds + 16384 + 2 * 8224);
    LAS float* SCO = (LAS float*)(F.lds + 16384 + 2 * 8224 + 2048);
    LAS float* RED = (LAS float*)(F.lds + 40960);
    const int w = opaque(F.wave), l = opaque(F.lane), tid_o = opaque(F.tid);
    {
        const int isk = tid_o >> 8, i = (tid_o >> 5) & 7, d8 = (tid_o & 31) * 8;
        const u32x4 raw = *(const GAS u32x4*)(PROJ + (size_t)(rows0 + i) * INW + isk * 1024 + h * 256 + d8);
        float f[8];
#pragma unroll
        for (int q = 0; q < 4; ++q) { f[2 * q] = bflo(raw[q]); f[2 * q + 1] = bfhi(raw[q]); }
        const float sc = __builtin_amdgcn_exp2f(lg * (float)(isk ? 7 - i : i + 1));
        LAS float* R = isk ? KR : QR;
#pragma unroll
        for (int k = 0; k < 8; ++k) { R[i * 257 + d8 + k] = f[k]; QK[(d8 + k) * 16 + isk * 8 + i] = f[k] * sc; }
    }
    float v[8][4];
#pragma unroll
    for (int j = 0; j < 8; ++j) { const u32x2 t = *(const GAS u32x2*)(PROJ + (size_t)(rows0 + j) * INW + 2048 + h * 256 + 4 * l); v[j][0] = bflo(t.x); v[j][1] = bfhi(t.x); v[j][2] = bflo(t.y); v[j][3] = bfhi(t.y); }
    __syncthreads();
    {
        const int i = l >> 3, j = l & 7; float s = 0.f;
#pragma unroll 8
        for (int d = 32 * w; d < 32 * w + 32; ++d) s += QR[i * 257 + d] * KR[j * 257 + d];
        SCP[w * 64 + l] = s;
    }
    float oacc[8][4];
#pragma unroll
    for (int i = 0; i < 8; ++i)
#pragma unroll
        for (int c = 0; c < 4; ++c) oacc[i][c] = 0.f;
    const float g8 = __builtin_amdgcn_exp2f(lg * 8.f);
    const GAS f32x4* Sp = (const GAS f32x4*)(state + ((size_t)(sb * 4 + h) * 256 + 32 * w) * 256) + l;
    GAS f32x4* Np = (GAS f32x4*)(newstate + ((size_t)(sb * 4 + h) * 256 + 32 * w) * 256) + l;
    f32x4 sA[4], sB[4];
#define S_LOAD4(dst, row0) do { const GAS f32x4* p0_ = Sp + (size_t)(row0) * 64; asm volatile("" : "+v"(p0_)); \
        _Pragma("unroll") for (int k = 0; k < 4; ++k) dst[k] = p0_[k * 64]; } while (0)
#define S_COMP4(src, row0) do { GAS f32x4* n0_ = Np + (size_t)(row0) * 64; asm volatile("" : "+v"(n0_)); \
        _Pragma("unroll") for (int k = 0; k < 4; ++k) { \
            const LAS f32x4* qk = (const LAS f32x4*)(QK + (32 * w + (row0) + k) * 16); \
            const f32x4 qa = qk[0], qb = qk[1], ka = qk[2], kb = qk[3]; f32x4 n; \
            _Pragma("unroll") for (int c = 0; c < 4; ++c) { const float sv = src[k][c]; \
                oacc[0][c] += qa[0] * sv; oacc[1][c] += qa[1] * sv; oacc[2][c] += qa[2] * sv; oacc[3][c] += qa[3] * sv; \
                oacc[4][c] += qb[0] * sv; oacc[5][c] += qb[1] * sv; oacc[6][c] += qb[2] * sv; oacc[7][c] += qb[3] * sv; \
                float t = g8 * sv; \
                t += ka[0] * v[0][c]; t += ka[1] * v[1][c]; t += ka[2] * v[2][c]; t += ka[3] * v[3][c]; \
                t += kb[0] * v[4][c]; t += kb[1] * v[5][c]; t += kb[2] * v[6][c]; t += kb[3] * v[7][c]; n[c] = t; } \
            n0_[k * 64] = n; \
            if (k & 1) asm volatile("" ::: "memory"); } } while (0)
    S_LOAD4(sA, 0);
#pragma unroll 1
    for (int h2 = 0; h2 < 4; ++h2) {
        S_LOAD4(sB, 8 * h2 + 4);
        S_COMP4(sA, 8 * h2);
        if (h2 < 3) S_LOAD4(sA, 8 * h2 + 8);
        S_COMP4(sB, 8 * h2 + 4);
    }
#undef S_LOAD4
#undef S_COMP4
#pragma unroll
    for (int i = 0; i < 8; ++i) *(LAS f32x4*)(RED + (w * 8 + i) * 256 + 4 * l) = (f32x4){oacc[i][0], oacc[i][1], oacc[i][2], oacc[i][3]};
    __syncthreads();
    if (tid_o < 64) { const int i = l >> 3, j = l & 7; float s = 0.f;
#pragma unroll
        for (int ww = 0; ww < 8; ++ww) s += SCP[ww * 64 + l];
        SCO[l] = (i >= j) ? s * __builtin_amdgcn_exp2f(lg * (float)(i - j)) : 0.f; }
    __syncthreads();
    {
        const int i = w; f32x4 tot = (f32x4){0.f, 0.f, 0.f, 0.f};
#pragma unroll
        for (int ww = 0; ww < 8; ++ww) tot += *(const LAS f32x4*)(RED + (ww * 8 + i) * 256 + 4 * l);
#pragma unroll
        for (int j = 0; j < 8; ++j) { const float s = SCO[i * 8 + j];
#pragma unroll
            for (int c = 0; c < 4; ++c) tot[c] += s * v[j][c]; }
        const float ss = wave_sum((tot[0] * tot[0] + tot[1] * tot[1]) + (tot[2] * tot[2] + tot[3] * tot[3]));
        const float rstd = 1.0f / sqrtf(ss * (1.f / 256.f) + EPS);
        const f32x4 wn = *(const GAS f32x4*)(retw + h * 256 + 4 * l);
        const u32x2 gv = *(const GAS u32x2*)(PROJ + (size_t)(rows0 + i) * INW + 3072 + h * 256 + 4 * l);
        u32x2 res; res.x = pk2(tot[0] * rstd * wn[0] * bflo(gv.x), tot[1] * rstd * wn[1] * bfhi(gv.x)); res.y = pk2(tot[2] * rstd * wn[2] * bflo(gv.y), tot[3] * rstd * wn[3] * bfhi(gv.y));
        *(GAS u32x2*)(MIX + (size_t)(rows0 + i) * D + h * 256 + 4 * l) = res;
    }
    __syncthreads();
}

__device__ __forceinline__ void unpk8(const u32x4 v, float (&f)[8]) {
#pragma unroll
    for (int q = 0; q < 4; ++q) { f[2 * q] = bflo(v[q]); f[2 * q + 1] = bfhi(v[q]); }
}
template <int W>
__device__ __forceinline__ void pool_prompt_blk(const bf16_t* PROJ, bf16_t* POOLED, float* outp, int rb, int ch) {
    const int m0 = rb * 8, t0 = m0 & (SEQ - 1), bseq = m0 >> 11;
    const bf16_t* U = PROJ + 4096 + ch;
    u32x4 x[W + 7];
#pragma unroll
    for (int i = 0; i < W + 7; ++i) { const int t = t0 - (W - 1) + i; const int mi = (t >= 0) ? m0 - (W - 1) + i : m0; x[i] = *(const GAS u32x4*)(U + (size_t)mi * INW); }
#pragma unroll
    for (int i = 0; i < W - 1; ++i) { const int t = t0 - (W - 1) + i; if (t < 0) x[i] = (u32x4){0u, 0u, 0u, 0u}; }
    float sum[8];
#pragma unroll
    for (int k = 0; k < 8; ++k) sum[k] = 0.f;
#pragma unroll
    for (int i = 0; i < W - 1; ++i) { float f[8]; unpk8(x[i], f);
#pragma unroll
        for (int k = 0; k < 8; ++k) sum[k] += f[k]; }
#pragma unroll
    for (int r = 0; r < 8; ++r) {
        float cur[8]; unpk8(x[W - 1 + r], cur);
#pragma unroll
        for (int k = 0; k < 8; ++k) sum[k] += cur[k];
        const int t = t0 + r; const int cnt = (t + 1 < W) ? t + 1 : W; const float inv = 1.0f / (float)cnt;
        u32x4 o;
#pragma unroll
        for (int q = 0; q < 4; ++q) o[q] = pk2(sum[2 * q] * inv - cur[2 * q], sum[2 * q + 1] * inv - cur[2 * q + 1]);
        *(GAS u32x4*)(POOLED + (size_t)(m0 + r) * 1024 + ch) = o;
        float sub[8]; unpk8(x[r], sub);
#pragma unroll
        for (int k = 0; k < 8; ++k) sum[k] -= sub[k];
        if (t >= SEQ - 15) { float* op = outp + ((size_t)bseq * 15 + (t - (SEQ - 15))) * 1024 + ch;
            *(GAS f32x4*)op = (f32x4){cur[0], cur[1], cur[2], cur[3]}; *(GAS f32x4*)(op + 4) = (f32x4){cur[4], cur[5], cur[6], cur[7]}; }
    }
}
template <int W>
__device__ __forceinline__ void pool_sample_blk(const bf16_t* PROJ, const float* spool, bf16_t* POOLED, float* outs, int sb, int ch) {
    const bf16_t* U = PROJ + (size_t)(MP + sb * 8) * INW + 4096 + ch;
    const float* B = spool + (size_t)sb * 15 * 1024 + ch;
    f32x4 ba[W - 1], bb[W - 1]; u32x4 xn[8]; f32x4 ca[7], cb[7];
#pragma unroll
    for (int i = 0; i < W - 1; ++i) { ba[i] = *(const GAS f32x4*)(B + (size_t)(15 - (W - 1) + i) * 1024); bb[i] = *(const GAS f32x4*)(B + (size_t)(15 - (W - 1) + i) * 1024 + 4); }
#pragma unroll
    for (int r = 0; r < 8; ++r) xn[r] = *(const GAS u32x4*)(U + (size_t)r * INW);
#pragma unroll
    for (int rr = 0; rr < 7; ++rr) { ca[rr] = *(const GAS f32x4*)(B + (size_t)(8 + rr) * 1024); cb[rr] = *(const GAS f32x4*)(B + (size_t)(8 + rr) * 1024 + 4); }
    float sum[8];
#pragma unroll
    for (int k = 0; k < 8; ++k) sum[k] = 0.f;
#pragma unroll
    for (int i = 0; i < W - 1; ++i)
#pragma unroll
        for (int q = 0; q < 4; ++q) { sum[q] += ba[i][q]; sum[4 + q] += bb[i][q]; }
    const float inv = 1.0f / (float)W;
#pragma unroll
    for (int r = 0; r < 8; ++r) {
        float cur[8]; unpk8(xn[r], cur);
#pragma unroll
        for (int k = 0; k < 8; ++k) sum[k] += cur[k];
        u32x4 o;
#pragma unroll
        for (int q = 0; q < 4; ++q) o[q] = pk2(sum[2 * q] * inv - cur[2 * q], sum[2 * q + 1] * inv - cur[2 * q + 1]);
        *(GAS u32x4*)(POOLED + (size_t)(MP + sb * 8 + r) * 1024 + ch) = o;
        if (r < W - 1) {
#pragma unroll
            for (int q = 0; q < 4; ++q) { sum[q] -= ba[r < W - 1 ? r : 0][q]; sum[4 + q] -= bb[r < W - 1 ? r : 0][q]; }
        } else { float sub[8]; unpk8(xn[r >= W - 1 ? r - (W - 1) : 0], sub);
#pragma unroll
            for (int k = 0; k < 8; ++k) sum[k] -= sub[k]; }
        float* op = outs + ((size_t)sb * 15 + 7 + r) * 1024 + ch;
        *(GAS f32x4*)op = (f32x4){cur[0], cur[1], cur[2], cur[3]}; *(GAS f32x4*)(op + 4) = (f32x4){cur[4], cur[5], cur[6], cur[7]};
    }
#pragma unroll
    for (int rr = 0; rr < 7; ++rr) { float* op = outs + ((size_t)sb * 15 + rr) * 1024 + ch; *(GAS f32x4*)op = ca[rr]; *(GAS f32x4*)(op + 4) = cb[rr]; }
}
__device__ __forceinline__ void pool_tasks(Frame& F, const bf16_t* PROJ, const float* spool, bf16_t* POOLED, float* outp, float* outs) {
    for (int gt = F.vcu * NTHR + opaque(F.tid); gt < 1024 * 128; gt += F.G * NTHR) {
        const int cgp = gt & 31, rbl = (gt >> 5) & 1, grp = (gt >> 6) & 3, rb = (gt >> 8) * 2 + rbl, ch = grp * 256 + cgp * 8;
        if (grp == 0) pool_prompt_blk<2>(PROJ, POOLED, outp, rb, ch); else if (grp == 1) pool_prompt_blk<4>(PROJ, POOLED, outp, rb, ch);
        else if (grp == 2) pool_prompt_blk<8>(PROJ, POOLED, outp, rb, ch); else pool_prompt_blk<16>(PROJ, POOLED, outp, rb, ch);
    }
    for (int gt = F.vcu * NTHR + opaque(F.tid); gt < 128 * 128; gt += F.G * NTHR) {
        const int cgp = gt & 31, sbl = (gt >> 5) & 1, grp = (gt >> 6) & 3, sb = (gt >> 8) * 2 + sbl, ch = grp * 256 + cgp * 8;
        if (grp == 0) pool_sample_blk<2>(PROJ, spool, POOLED, outs, sb, ch); else if (grp == 1) pool_sample_blk<4>(PROJ, spool, POOLED, outs, sb, ch);
        else if (grp == 2) pool_sample_blk<8>(PROJ, spool, POOLED, outs, sb, ch); else pool_sample_blk<16>(PROJ, spool, POOLED, outs, sb, ch);
    }
}

__device__ __forceinline__ void load_row_bf16(const bf16_t* row, int nparts, size_t pstride, int lane, float (&f)[4][8]) {
#pragma unroll
    for (int j = 0; j < 4; ++j)
#pragma unroll
        for (int q = 0; q < 8; ++q) f[j][q] = 0.f;
    for (int p = 0; p < nparts; ++p) {
        u32x4 v[4];
#pragma unroll
        for (int j = 0; j < 4; ++j) v[j] = *(const GAS u32x4*)(row + (size_t)p * pstride + 8 * lane + 512 * j);
#pragma unroll
        for (int j = 0; j < 4; ++j)
#pragma unroll
            for (int q = 0; q < 4; ++q) { f[j][2 * q] += bflo(v[j][q]); f[j][2 * q + 1] += bfhi(v[j][q]); }
    }
}
__device__ __forceinline__ void n1_row(const float* xrow, const bf16_t* mo, int nparts, size_t pstride, const float* wpost, const float* wpre, float* yrow, bf16_t* hrow, int lane) {
    f32x4 xa[4], xb[4]; float s = 0.f;
#pragma unroll
    for (int j = 0; j < 4; ++j) { const int c = 8 * lane + 512 * j; xa[j] = *(const GAS f32x4*)(xrow + c); xb[j] = *(const GAS f32x4*)(xrow + c + 4); }
    float mf[4][8];
    load_row_bf16(mo, nparts, pstride, lane, mf);
#pragma unroll
    for (int j = 0; j < 4; ++j)
#pragma unroll
        for (int q = 0; q < 8; ++q) s += mf[j][q] * mf[j][q];
    const float r1 = 1.0f / sqrtf(wave_sum(s) * (1.f / D) + EPS);
    float s2 = 0.f;
#pragma unroll
    for (int j = 0; j < 4; ++j) { const int c = 8 * lane + 512 * j; const f32x4 wa = *(const GAS f32x4*)(wpost + c), wb = *(const GAS f32x4*)(wpost + c + 4);
#pragma unroll
        for (int q = 0; q < 4; ++q) { xa[j][q] += mf[j][q] * r1 * wa[q]; xb[j][q] += mf[j][4 + q] * r1 * wb[q]; s2 += xa[j][q] * xa[j][q] + xb[j][q] * xb[j][q]; }
        *(GAS f32x4*)(yrow + c) = xa[j]; *(GAS f32x4*)(yrow + c + 4) = xb[j]; }
    const float r2 = 1.0f / sqrtf(wave_sum(s2) * (1.f / D) + EPS);
#pragma unroll
    for (int j = 0; j < 4; ++j) { const int c = 8 * lane + 512 * j; const f32x4 wa = *(const GAS f32x4*)(wpre + c), wb = *(const GAS f32x4*)(wpre + c + 4);
        u32x4 o; o.x = pk2(xa[j][0] * r2 * wa[0], xa[j][1] * r2 * wa[1]); o.y = pk2(xa[j][2] * r2 * wa[2], xa[j][3] * r2 * wa[3]);
        o.z = pk2(xb[j][0] * r2 * wb[0], xb[j][1] * r2 * wb[1]); o.w = pk2(xb[j][2] * r2 * wb[2], xb[j][3] * r2 * wb[3]);
        *(GAS u32x4*)(hrow + c) = o; }
}
__device__ __forceinline__ void n2_row(const bf16_t* ff, int nparts, size_t pstride, const float* wpost, float* yrow, int lane) {
    float s = 0.f; float ffl[4][8];
    load_row_bf16(ff, nparts, pstride, lane, ffl);
#pragma unroll
    for (int j = 0; j < 4; ++j)
#pragma unroll
        for (int q = 0; q < 8; ++q) s += ffl[j][q] * ffl[j][q];
    const float r1 = 1.0f / sqrtf(wave_sum(s) * (1.f / D) + EPS);
#pragma unroll
    for (int j = 0; j < 4; ++j) { const int c = 8 * lane + 512 * j; const f32x4 wa = *(const GAS f32x4*)(wpost + c), wb = *(const GAS f32x4*)(wpost + c + 4);
        f32x4 ya = *(const GAS f32x4*)(yrow + c), yb = *(const GAS f32x4*)(yrow + c + 4);
#pragma unroll
        for (int q = 0; q < 4; ++q) { ya[q] += ffl[j][q] * r1 * wa[q]; yb[q] += ffl[j][4 + q] * r1 * wb[q]; }
        *(GAS f32x4*)(yrow + c) = ya; *(GAS f32x4*)(yrow + c + 4) = yb; }
}

constexpr int NPH = 10;
__global__ void __launch_bounds__(NTHR, 2) hyb_fwd(Args args) {
    extern __shared__ __attribute__((aligned(16))) unsigned char lds[];
    Frame F;
    F.lds = (LAS unsigned char*)lds;
    F.tid = threadIdx.x; F.lane = F.tid & 63; F.wave = __builtin_amdgcn_readfirstlane(F.tid >> 6);
    F.G = gridDim.x; { const int bx = blockIdx.x; F.vcu = (F.G % 8 == 0) ? (bx % 8) * (F.G / 8) + bx / 8 : bx; }
    if (F.tid == 0) {
        volatile LAS unsigned long long* at = (volatile LAS unsigned long long*)(F.lds + ARG_OFF);
#pragma unroll
        for (int i = 0; i < 16; ++i) at[i] = (unsigned long long)args.in[i];
        at[16] = (unsigned long long)args.out; at[17] = (unsigned long long)args.ws;
    }
    const int lo = args.ph_lo, hi = args.ph_hi;
    if (F.tid < 32) ((volatile LAS unsigned*)(F.lds + MISC_OFF))[F.tid] = 0u;
    __syncthreads();
    if (args.use_cg) xcd_barrier_post((unsigned*)(AWS + WS_CTL) + CW_BAR);
    if (args.pad == 0x5a5a5a5a) cg::this_grid().sync();
#ifndef PH_ENABLE
#define PH_ENABLE 0x3ff
#endif
#define IN(k) (((PH_ENABLE >> (k)) & 1) && lo <= (k) && (k) < hi)
#define BOTH(k) (IN(k) && IN((k) + 1))
#ifndef REP_MASK
#define REP_MASK 0
#endif
#define REPS(k) for (int rep_ = 0; rep_ <= ((REP_MASK >> (k)) & 1); ++rep_)
#define REP_MORE(k) (rep_ < ((REP_MASK >> (k)) & 1))
#ifndef CG_SEAMS
#define CG_SEAMS 0x000
#endif
#define GRID_BAR(k) do { if ((CG_SEAMS >> (k)) & 1) cg::this_grid().sync(); else xcd_barrier((unsigned*)(AWS + WS_CTL) + CW_BAR, (volatile LAS unsigned*)(F.lds + MISC_OFF) + 8); } while (0)
#define WSP(off) ((bf16_t*)(ws + (off)))
#ifndef SUBREP_MASK
#define SUBREP_MASK 0
#endif
#define SUBREP(k) for (int sr_ = 0; sr_ <= ((SUBREP_MASK >> (k)) & 1); ++sr_)
    if (IN(0)) REPS(0) { p0_prologue(F); if (BOTH(0) || REP_MORE(0)) GRID_BAR(0); }
    if (IN(1)) REPS(1) {
        unsigned char* ws = AWS;
        const int jx = (int)blockIdx.x / 8, spare = F.G / 8 - 30;
        if (F.G != 256 || jx < 30) {
            const int GG = F.G == 256 ? 240 : F.G;
            pg8::Gemm g{WSP(WS_H), WSP(WS_WIN), D, D, D, 0}; pg8::HybridOrder S; S.init(M / 256, INW / 256, D, GG, (int)blockIdx.x, 3);
            pg8::EpiProj E{WSP(WS_PROJ), (const float*)(ws + WS_CS)};
            pg8::gemm_phase(F.lds, g, S, E, pg8::SkBuf{nullptr, nullptr, nullptr});
        } else p0_transposes(F, TR_A, TR_B, (jx - 30) * 8 + (int)blockIdx.x % 8, spare * 8);
        if (BOTH(1) || REP_MORE(1)) GRID_BAR(1);
    }
    if (IN(2)) REPS(2) {
        unsigned char* ws = AWS; float* out = AOUT;
        SUBREP(0) for (int it = F.vcu; it < 256; it += F.G) u_item(F, WSP(WS_PROJ), WSP(WS_UT), it);
        SUBREP(1) pool_tasks(F, WSP(WS_PROJ), AIN(3), WSP(WS_POOLED), out + O_POOLP, out + O_POOLS);
        { const float* st = AIN(2); const float* rw = AIN(7);
          SUBREP(2) for (int it = F.vcu; it < 512; it += F.G) s_item(F, WSP(WS_PROJ), st, rw, out + O_RETS, WSP(WS_MIX), it); }
        if (BOTH(2) || REP_MORE(2)) GRID_BAR(2);
    }
    if (IN(3)) REPS(3) {
        unsigned char* ws = AWS;
#ifdef POOL_TWICE
        { float* out2 = AOUT; pool_tasks(F, WSP(WS_PROJ), AIN(3), WSP(WS_POOLED), out2 + O_POOLP, out2 + O_POOLS); asm volatile("s_waitcnt vmcnt(0)" ::: "memory"); __syncthreads(); }
#endif
        {
        float* out = AOUT; const bf16_t* UT = WSP(WS_UT); bf16_t* SCT = WSP(WS_SCT);
        for (int idx = F.vcu * NTHR + F.tid; idx < 16 * 256 * 32; idx += F.G * NTHR) {
            const int bh = idx >> 13, e = (idx >> 5) & 255, d8 = (idx & 31) * 8;
            const float g128 = __builtin_amdgcn_exp2f(lg2gamma(bh & 3) * 128.f);
            float s[8];
#pragma unroll
            for (int k = 0; k < 8; ++k) s[k] = 0.f;
            u32x4 uv[16];
#pragma unroll
            for (int c = 0; c < 16; ++c) uv[c] = *(const GAS u32x4*)(UT + ((size_t)(bh * 16 + c) * 256 + e) * 256 + d8);
#pragma unroll
            for (int c = 0; c < 16; ++c) {
                u32x4 o; o.x = pk2(s[0], s[1]); o.y = pk2(s[2], s[3]); o.z = pk2(s[4], s[5]); o.w = pk2(s[6], s[7]);
                *(GAS u32x4*)(SCT + ((size_t)(bh * 16 + c) * 256 + e) * 256 + d8) = o;
#pragma unroll
                for (int k = 0; k < 4; ++k) { s[2 * k] = g128 * s[2 * k] + bflo(uv[c][k]); s[2 * k + 1] = g128 * s[2 * k + 1] + bfhi(uv[c][k]); }
            }
            float* op = out + O_RETP + (size_t)bh * 65536 + e;
#pragma unroll
            for (int k = 0; k < 8; ++k) op[(size_t)(d8 + k) * 256] = s[k];
        }
        }
        {
            pg8::Gemm g{WSP(WS_POOLED), WSP(WS_WPOOL), 1024, 256, 256, 256}; pg8::HybridOrder S; S.init(M / 256, 4, 256, F.G, (int)blockIdx.x, 1);
            pg8::EpiPlain E{WSP(WS_MIX), D, 1024, AIN(9)};
            pg8::gemm_phase(F.lds, g, S, E, pg8::SkBuf{nullptr, nullptr, nullptr});
        }
        if (BOTH(3) || REP_MORE(3)) GRID_BAR(3);
    }
    if (IN(4)) REPS(4) {
        unsigned char* ws = AWS; const float* rw = AIN(7);
        for (int it = F.vcu; it < 256; it += F.G) o_item(F, WSP(WS_PROJ), WSP(WS_SCT), rw, WSP(WS_MIX), it);
        if (BOTH(4) || REP_MORE(4)) GRID_BAR(4);
    }
    if (IN(5)) REPS(5) {
        unsigned char* ws = AWS;
        pg8::Gemm g{WSP(WS_MIX), WSP(WS_WOUT), D, D, D, 0}; pg8::HybridOrder S; S.init(M / 256, D / 256, D, F.G, (int)blockIdx.x, SK_RS_P3, SPLIT_MODE);
        pg8::EpiPlain E{WSP(WS_MO), D, 0, nullptr};
        pg8::gemm_phase(F.lds, g, S, E, pg8::SkBuf{(float*)(ws + WS_POOLED), (unsigned*)(ws + WS_CTL) + CW_SK, WSP(WS_PART3)});
        if (BOTH(5) || REP_MORE(5)) GRID_BAR(5);
    }
    if (IN(6)) REPS(6) {
        unsigned char* ws = AWS; float* out = AOUT;
        const float* xp_ = AIN(0); const float* xs_ = AIN(1); const float* w5 = AIN(5); const float* w11 = AIN(11);
        const int gw = F.vcu * NWAVES + F.wave, NGW = F.G * NWAVES;
        for (int m = gw; m < M; m += NGW) { const bool sp = SPLIT_MODE && m >= MP;
            n1_row(xrow_ptr(xp_, xs_, m), sp ? WSP(WS_PART3) + (size_t)(m - MP) * D : WSP(WS_MO) + (size_t)m * D, sp ? 8 : 1, (size_t)1024 * 2048, w5, w11, out + O_Y + (size_t)m * D, WSP(WS_H) + (size_t)m * D, F.lane); }
        if (BOTH(6) || REP_MORE(6)) GRID_BAR(6);
    }
    if (IN(7)) REPS(7) {
        unsigned char* ws = AWS;
        const int jx = (int)blockIdx.x / 8;
        if (jx < 29) {
            pg8::Gemm g{WSP(WS_H), WSP(WS_WGU), D, D, D, 0}; pg8::HybridOrder S; S.init(M / 256, NGU / 256, D, 232, (int)blockIdx.x, SK_RS_P4);
            pg8::EpiGU E{WSP(WS_HID)};
            pg8::gemm_phase(F.lds, g, S, E, pg8::SkBuf{(float*)(ws + WS_MO), (unsigned*)(ws + WS_CTL) + CW_SK + 16384, nullptr});
        } else p0_transposes(F, TR_B, TR_C, (jx - 29) * 8 + (int)blockIdx.x % 8, 24);
        if (BOTH(7) || REP_MORE(7)) GRID_BAR(7);
    }
    if (IN(8)) REPS(8) {
        unsigned char* ws = AWS;
        pg8::Gemm g{WSP(WS_HID), WSP(WS_WD), DFF, DFF, DFF, 0}; pg8::HybridOrder S; S.init(M / 256, D / 256, DFF, F.G, (int)blockIdx.x, SK_RS_P5, SPLIT_MODE);
        pg8::EpiPlain E{WSP(WS_FF), D, 0, nullptr};
        pg8::gemm_phase(F.lds, g, S, E, pg8::SkBuf{(float*)(ws + WS_POOLED), (unsigned*)(ws + WS_CTL) + CW_SK + 32768, WSP(WS_PART5)});
        if (BOTH(8) || REP_MORE(8)) GRID_BAR(8);
    }
    if (IN(9)) {
        unsigned char* ws = AWS; float* out = AOUT; const float* w12 = AIN(12);
        const int gw = F.vcu * NWAVES + F.wave, NGW = F.G * NWAVES;
        for (int m = gw; m < M; m += NGW) { const bool sp = SPLIT_MODE && m >= MP;
            n2_row(sp ? WSP(WS_PART5) + (size_t)(m - MP) * D : WSP(WS_FF) + (size_t)m * D, sp ? 8 : 1, (size_t)1024 * 2048, w12, out + O_Y + (size_t)m * D, F.lane); }
    }
#undef IN
#undef BOTH
}

extern "C" void kernel_launch(void* const* d_in, const int* in_sizes, int n_in, void* d_out, int out_size, void* d_ws, size_t ws_size, hipStream_t stream) {
    static int grid = 0;
    if (grid == 0) {
        if (n_in != 16 || (size_t)out_size != O_END || ws_size < WS_END) { fprintf(stderr, "kernel_launch: unexpected shapes: n_in %d out %d ws %zu (need %zu)\n", n_in, out_size, ws_size, (size_t)WS_END); grid = -1; return; }
        int dev = 0, cus = 0, per_cu = 0;
        if (hipGetDevice(&dev) != hipSuccess || hipDeviceGetAttribute(&cus, hipDeviceAttributeMultiprocessorCount, dev) != hipSuccess) { grid = -1; return; }
        if (hipFuncSetAttribute((const void*)hyb_fwd, hipFuncAttributeMaxDynamicSharedMemorySize, LDS_BYTES) != hipSuccess) { fprintf(stderr, "kernel_launch: hipFuncSetAttribute failed\n"); grid = -1; return; }
        if (hipOccupancyMaxActiveBlocksPerMultiprocessor(&per_cu, (const void*)hyb_fwd, NTHR, LDS_BYTES) != hipSuccess || per_cu < 1) { fprintf(stderr, "kernel_launch: occupancy query says %d\n", per_cu); per_cu = 1; }
        (void)hipGetLastError();
        grid = cus * 1;
        if (SPLIT_MODE && grid != 256) { fprintf(stderr, "kernel_launch: this build's unit schedule needs exactly 256 workgroups (got %d CUs); nothing launched\n", cus); grid = -1; return; }
        fprintf(stderr, "kernel_launch: grid %d (occupancy query %d per CU)\n", grid, per_cu);
    }
    if (grid < 0) return;
    Args a{};
    for (int i = 0; i < 16; ++i) a.in[i] = (const float*)d_in[i];
    a.out = (float*)d_out; a.ws = (unsigned char*)d_ws;
    if (hipMemsetAsync((char*)d_ws + WS_CTL, 0, CTL_ZERO_BYTES, stream) != hipSuccess) { fprintf(stderr, "kernel_launch: memset failed\n"); return; }
    if (MK_N_LAUNCHES == 1) {
        a.ph_lo = 0; a.ph_hi = NPH; a.use_cg = 1;
        void* kargs[] = {&a};
        hipError_t e = hipLaunchCooperativeKernel((const void*)hyb_fwd, dim3(grid), dim3(NTHR), kargs, LDS_BYTES, stream);
        if (e != hipSuccess) fprintf(stderr, "kernel_launch: cooperative launch failed: %s (grid %d)\n", hipGetErrorString(e), grid);
    } else {
        for (int p = 0; p < NPH; ++p) {
            a.ph_lo = p; a.ph_hi = p + 1; a.use_cg = 0;
            hipLaunchKernelGGL(hyb_fwd, dim3(grid), dim3(NTHR), LDS_BYTES, stream, a);
        }
    }
}
```

```cpp
#include <hip/hip_runtime.h>
#include <hip/hip_cooperative_groups.h>
#include <cstdio>
#include <cstdint>
namespace cg = cooperative_groups;

#ifndef MK_N_LAUNCHES
#define MK_N_LAUNCHES 1
#endif

#define GAS __attribute__((address_space(1)))
#define LAS __attribute__((address_space(3)))
typedef unsigned short bf16_t;
typedef short bf16x8 __attribute__((ext_vector_type(8)));
typedef float f32x2 __attribute__((ext_vector_type(2)));
typedef float f32x4 __attribute__((ext_vector_type(4)));
typedef float f32x16 __attribute__((ext_vector_type(16)));
typedef unsigned u32x2 __attribute__((ext_vector_type(2)));
typedef unsigned u32x4 __attribute__((ext_vector_type(4)));

constexpr int D = 2048, MP = 8192, MS = 1024, M = MP + MS, SEQ = 2048;
constexpr int INW = 5120, DFF = 5632, NGU = 2 * DFF;
constexpr int NPOS = 2048 + 8;
constexpr float EPS = 1e-6f;
constexpr int NWAVES = 8, NTHR = 512;

constexpr size_t O_Y = 0, O_RETP = (size_t)M * D, O_POOLP = O_RETP + 4 * 4 * 65536, O_RETS = O_POOLP + 4 * 15 * 1024, O_POOLS = O_RETS + (size_t)128 * 4 * 65536, O_END = O_POOLS + 128 * 15 * 1024;

constexpr size_t MiB = 1u << 20;
constexpr size_t WS_CTL = 0, CTL_ZERO_BYTES = 1 * MiB;
constexpr size_t CTL_MS_OFF = 16384, CTL_MS_BYTES = 16384;
constexpr size_t WS_CS = 1 * MiB;
constexpr size_t WS_WPOOL = 4 * MiB;
constexpr size_t WS_WIN = 8 * MiB;
constexpr size_t WS_WOUT = 28 * MiB;
constexpr size_t WS_WGU = 36 * MiB;
constexpr size_t WS_WD = 80 * MiB;
constexpr size_t WS_H = 102 * MiB;
constexpr size_t WS_PROJ = 138 * MiB;
constexpr size_t WS_MIX = 228 * MiB;
constexpr size_t WS_UT = 264 * MiB;
constexpr size_t WS_SCT = 296 * MiB;
constexpr size_t WS_POOLED = 328 * MiB;
constexpr size_t WS_MO = 346 * MiB;
constexpr size_t WS_HID = 138 * MiB;
constexpr size_t WS_FF = 382 * MiB;
constexpr size_t WS_PART3 = 264 * MiB;
constexpr size_t WS_PART5 = 296 * MiB;
#ifndef SPLIT_MODE
#define SPLIT_MODE 1
#endif
constexpr size_t WS_END = 418 * MiB;
static_assert(WS_HID + (size_t)M * DFF * 2 <= WS_UT, "hid overlay");

constexpr int CW_SK = 16384;
#ifndef SK_RS_P3
#define SK_RS_P3 2
#endif
#ifndef SK_RS_P4
#define SK_RS_P4 7
#endif
#ifndef SK_RS_P5
#define SK_RS_P5 2
#endif
constexpr int CW_BAR = 4096;
constexpr int LDS_BYTES = 147456;
constexpr int RING_BYTES = 131072, MISC_OFF = RING_BYTES + 320, ARG_OFF = RING_BYTES + 512;

__device__ __forceinline__ unsigned f2bf(float f) { unsigned u = __builtin_bit_cast(unsigned, f); return (u + 0x7fffu + ((u >> 16) & 1u)) >> 16; }
__device__ __forceinline__ unsigned cvt_pk_bf16(float lo, float hi) { unsigned r; asm volatile("v_cvt_pk_bf16_f32 %0, %1, %2" : "=v"(r) : "v"(lo), "v"(hi)); return r; }
__device__ __forceinline__ unsigned pk2(float lo, float hi) { unsigned r; asm("v_cvt_pk_bf16_f32 %0, %1, %2" : "=v"(r) : "v"(lo), "v"(hi)); return r; }
__device__ __forceinline__ float bflo(unsigned w) { return __builtin_bit_cast(float, w << 16); }
__device__ __forceinline__ float bfhi(unsigned w) { return __builtin_bit_cast(float, w & 0xffff0000u); }
__device__ __forceinline__ float bf2f(bf16_t b) { return __builtin_bit_cast(float, (unsigned)b << 16); }
__device__ __forceinline__ float wave_sum(float v) {
#pragma unroll
    for (int o = 1; o < 64; o <<= 1) v += __shfl_xor(v, o);
    return v;
}
__device__ __forceinline__ float silu(float x) { return x * __builtin_amdgcn_rcpf(1.0f + __builtin_amdgcn_exp2f(-1.4426950408889634f * x)); }
__device__ __forceinline__ float lg2gamma(int h) { return h == 0 ? -0.04580368961312479f : h == 1 ? -0.02272007650008353f : h == 2 ? -0.011315313227834146f : -0.005646563141142063f; }
#define LDS_WAIT() asm volatile("s_waitcnt lgkmcnt(0)" ::: "memory")
__device__ __forceinline__ int opaque(int x) { asm volatile("" : "+v"(x)); return x; }

namespace pg8 {
constexpr int BM = 256, BK = 64, HALF = 128, HTB = HALF * BK * 2, STAGE_BYTES = 8 * HTB, NXCD = 8, WGM = 8;
__host__ __device__ __forceinline__ int lds_byte(int r, int c) { const int st = (r >> 4) * 2 + (c >> 5), rr = r & 15, cc = c & 31, ob = rr * 64 + cc * 2; return st * 1024 + (ob ^ (((ob >> 9) & 1) << 5)); }
__host__ __device__ __forceinline__ void stage_rc(int b, int& R, int& C) { const int st = b / 1024, sb = b % 1024, swz = sb ^ (((sb >> 9) & 1) << 5); R = (st >> 1) * 16 + swz / 64; C = (st & 1) * 32 + (swz % 64) / 2; }
__host__ __device__ __forceinline__ int perm32(int rho) { const int n = rho >> 4, i = rho & 15; return 8 * (i >> 2) + 4 * n + (i & 3); }

struct Unit { int pm, pn, kt0, nkt, role; };
struct Gemm { const bf16_t* A; const bf16_t* Bt; int lda, ldb, K, a_pn_col; };
struct HybridOrder {
    int nM, nN, nwg, G, c, Rs, P, n32, q, s, e, mode;
    __device__ void init(int nM_, int nN_, int K, int G_, int c_, int Rs_, int mode_ = 0) {
        mode = mode_; nM = nM_; nN = nN_; nwg = nM * nN; G = G_; c = c_; Rs = Rs_; P = K / (2 * BK); n32 = G / NXCD; q = nwg / NXCD;
        const int Ux = (q - Rs * n32) > 0 ? (q - Rs * n32) : 0, j = c / NXCD; const long T = (long)Ux * P;
        s = (int)((long)j * T / n32); e = (int)((long)(j + 1) * T / n32);
    }
    __device__ void tile(int wgid, Unit& u) const {
        const int nig = WGM * nN, gid = wgid / nig, fm = gid * WGM, gsz = (nM - fm) < WGM ? (nM - fm) : WGM;
        u.pm = fm + ((wgid % nig) % gsz); u.pn = (wgid % nig) / gsz;
    }
    __device__ bool next(int i, Unit& u) const {
        const int x = c % NXCD, j = c / NXCD;
        if (mode == 1) {
            if (i == 0) { u.pm = 8 * (x >> 1) + (j & 7); u.pn = 4 * (x & 1) + (j >> 3); u.kt0 = 0; u.nkt = 2 * P; u.role = 0; return true; }
            if (i == 1) { u.pm = 32 + (j >> 3); u.pn = j & 7; const int lo = x * P / 8, hi = (x + 1) * P / 8; u.kt0 = 2 * lo; u.nkt = 2 * (hi - lo); u.role = 3; return true; }
            return false;
        }
        if (i < Rs) { if (i * n32 + j >= q) return false; tile(x * q + i * n32 + j, u); u.kt0 = 0; u.nkt = 2 * P; u.role = 0; return true; }
        const int uidx = s / P + (i - Rs), lo = s > uidx * P ? s : uidx * P, hi = e < (uidx + 1) * P ? e : (uidx + 1) * P;
        if (lo >= hi) return false;
        tile(x * q + Rs * n32 + uidx, u);
        u.kt0 = 2 * (lo - uidx * P); u.nkt = 2 * (hi - lo); u.role = (lo > uidx * P) ? 1 : ((hi < (uidx + 1) * P) ? 2 : 0);
        return true;
    }
};
struct SkBuf { float* slab; unsigned* flags; bf16_t* part; };

template <class Epi>
__device__ __forceinline__ void gemm_phase(LAS unsigned char* lds, const Gemm g, const HybridOrder& S, const Epi& E, const SkBuf sk) {
    const int tid = threadIdx.x, wid = __builtin_amdgcn_readfirstlane(tid >> 6), lane = tid & 63, wr = wid >> 2, wc = wid & 3, fr = lane & 15, fq = lane >> 4;
    unsigned voffA[2], voffB[2];
#pragma unroll
    for (int i = 0; i < 2; ++i) { int R, C; stage_rc(tid * 16 + i * 8192, R, C); const int Rb = (R & ~31) + perm32(R & 31);
        voffA[i] = (unsigned)(R * g.lda + C) * 2u; voffB[i] = (unsigned)(Rb * g.ldb + C) * 2u; }
    const size_t kstep = (size_t)(BK * 2);
    const size_t hstepA = (size_t)HALF * g.lda * 2, hstepB = (size_t)HALF * g.ldb * 2;
    const unsigned ldsw = (unsigned)wid * 1024u;
    const int aoff = lds_byte(wr * 64 + fr, fq * 8), boff = lds_byte(wc * 32 + fr, fq * 8);
#define PG8_UA(u) ((const char*)g.A + ((size_t)(u).pm * BM * g.lda + (size_t)(u).pn * g.a_pn_col + (size_t)(u).kt0 * BK) * 2)
#define PG8_UB(u) ((const char*)g.Bt + ((size_t)(u).pn * BM * g.ldb + (size_t)(u).kt0 * BK) * 2)
#define PG8_SA(b, h) (((b) * 2 + (h)) * HTB)
#define PG8_SB(b, h) ((4 + (b) * 2 + (h)) * HTB)
#define PG8_STAGE(bufoff, gbase, voff) do { _Pragma("unroll") for (int _i = 0; _i < 2; ++_i) \
        __builtin_amdgcn_global_load_lds((const unsigned*)((const char*)(gbase) + (voff)[_i]), (LAS unsigned*)(lds + (bufoff) + ldsw + _i * 8192), 16, 0, 0); } while (0)
#define PG8_LDA(dst, b, h) do { _Pragma("unroll") for (int m = 0; m < 4; ++m) _Pragma("unroll") for (int k = 0; k < 2; ++k) dst[m][k] = *(const LAS bf16x8*)(lds + PG8_SA(b, h) + aoff + m * 2048 + k * 1024); } while (0)
#define PG8_LDB(dst, b, h) do { _Pragma("unroll") for (int n = 0; n < 2; ++n) _Pragma("unroll") for (int k = 0; k < 2; ++k) dst[n][k] = *(const LAS bf16x8*)(lds + PG8_SB(b, h) + boff + n * 2048 + k * 1024); } while (0)
#define PG8_MMA(ai, bj, At, Bt) do { __builtin_amdgcn_s_setprio(1); _Pragma("unroll") for (int m = 0; m < 4; ++m) _Pragma("unroll") for (int n = 0; n < 2; ++n) _Pragma("unroll") for (int k = 0; k < 2; ++k) \
        acc[ai][bj][m][n] = __builtin_amdgcn_mfma_f32_16x16x32_bf16(Bt[n][k], At[m][k], acc[ai][bj][m][n], 0, 0, 0); __builtin_amdgcn_s_setprio(0); } while (0)
#define PG8_WAIT_V(n) asm volatile("s_waitcnt vmcnt(" #n ")" ::: "memory")
#define PG8_WAIT_L(n) asm volatile("s_waitcnt lgkmcnt(" #n ")" ::: "memory")
#define PG8_BAR __builtin_amdgcn_s_barrier()
#define PG8_SCHED __builtin_amdgcn_sched_barrier(0)
    Unit cur, nxt; int ui = 0;
    if (!S.next(0, cur)) return;
    f32x4 acc[2][2][4][2];
#pragma unroll
    for (int a = 0; a < 2; ++a)
#pragma unroll
        for (int b = 0; b < 2; ++b)
#pragma unroll
            for (int m = 0; m < 4; ++m)
#pragma unroll
                for (int n = 0; n < 2; ++n) acc[a][b][m][n] = (f32x4){0.f, 0.f, 0.f, 0.f};
    bf16x8 At[4][2], B0[2][2], B1[2][2];
    const char* cA = PG8_UA(cur); const char* cB = PG8_UB(cur);
    PG8_STAGE(PG8_SB(0, 0), cB, voffB); PG8_STAGE(PG8_SB(0, 1), cB + hstepB, voffB); PG8_STAGE(PG8_SA(0, 0), cA, voffA); PG8_STAGE(PG8_SA(0, 1), cA + hstepA, voffA);
    if (wr == 1) PG8_BAR;
    PG8_WAIT_V(2); PG8_BAR;
    PG8_STAGE(PG8_SB(1, 0), cB + kstep, voffB); PG8_STAGE(PG8_SA(1, 0), cA + kstep, voffA); PG8_STAGE(PG8_SB(1, 1), cB + hstepB + kstep, voffB);
    PG8_WAIT_V(6); PG8_BAR;
    for (;;) {
        const bool has_next = S.next(ui + 1, nxt);
        const char* nA = has_next ? PG8_UA(nxt) : cA; const char* nB = has_next ? PG8_UB(nxt) : cB;
        const int nt = cur.nkt;
        for (int t = 0; t < nt; t += 2) {
            const bool last = (t == nt - 2);
            const char* a1 = cA + (size_t)(t + 1) * kstep;
            const char* a2 = last ? nA : cA + (size_t)(t + 2) * kstep; const char* b2 = last ? nB : cB + (size_t)(t + 2) * kstep;
            const char* a3 = a2 + kstep; const char* b3 = b2 + kstep;
            PG8_LDB(B0, 0, 0); PG8_LDB(B1, 0, 1); PG8_SCHED; PG8_LDA(At, 0, 0); PG8_STAGE(PG8_SA(1, 1), a1 + hstepA, voffA);
            PG8_WAIT_V(8); PG8_WAIT_L(0); PG8_BAR; PG8_MMA(0, 0, At, B0); PG8_MMA(0, 1, At, B1); PG8_BAR; PG8_SCHED;
            PG8_LDA(At, 0, 1); PG8_STAGE(PG8_SB(0, 0), b2, voffB); PG8_STAGE(PG8_SB(0, 1), b2 + hstepB, voffB); PG8_STAGE(PG8_SA(0, 0), a2, voffA);
            PG8_WAIT_V(8); PG8_WAIT_L(0); PG8_BAR; PG8_MMA(1, 0, At, B0); PG8_MMA(1, 1, At, B1); PG8_BAR; PG8_SCHED;
            PG8_LDB(B0, 1, 0); PG8_LDB(B1, 1, 1); PG8_SCHED; PG8_LDA(At, 1, 0); PG8_STAGE(PG8_SA(0, 1), a2 + hstepA, voffA);
            PG8_WAIT_V(8); PG8_WAIT_L(0); PG8_BAR; PG8_MMA(0, 0, At, B0); PG8_MMA(0, 1, At, B1); PG8_BAR; PG8_SCHED;
            PG8_LDA(At, 1, 1); PG8_STAGE(PG8_SB(1, 0), b3, voffB); PG8_STAGE(PG8_SB(1, 1), b3 + hstepB, voffB); PG8_STAGE(PG8_SA(1, 0), a3, voffA);
            PG8_WAIT_V(8); PG8_WAIT_L(0); PG8_BAR; PG8_MMA(1, 0, At, B0); PG8_MMA(1, 1, At, B1); PG8_BAR; PG8_SCHED;
        }
        if (wr == 0) PG8_BAR;
        if (cur.role == 1) {
            const __amdgpu_buffer_rsrc_t rs = __builtin_amdgcn_make_buffer_rsrc(sk.slab, 0, 0x7fffffff, 0x00020000);
            const unsigned base = ((unsigned)S.c * 16384u + (unsigned)opaque(tid)) * 16u;
#pragma unroll
            for (int a = 0; a < 2; ++a)
#pragma unroll
                for (int b = 0; b < 2; ++b)
#pragma unroll
                    for (int m = 0; m < 4; ++m)
#pragma unroll
                        for (int n = 0; n < 2; ++n)
                            __builtin_amdgcn_raw_buffer_store_b128(__builtin_bit_cast(u32x4, acc[a][b][m][n]), rs, base + (unsigned)(((a * 2 + b) * 4 + m) * 2 + n) * 8192u, 0, 16);
            PG8_WAIT_V(0); PG8_BAR;
            if (tid == 0) __hip_atomic_store(sk.flags + 64 * S.c, 1u, __ATOMIC_RELAXED, __HIP_MEMORY_SCOPE_AGENT);
        } else if (cur.role == 3) {
            bf16_t* O = sk.part + (size_t)(S.c % NXCD) * 1024 * 2048;
            const int row0 = (cur.pm - 32) * BM + wr * 64 + fr, col0 = cur.pn * BM + wc * 32 + 8 * fq;
#pragma unroll
            for (int ai = 0; ai < 2; ++ai)
#pragma unroll
                for (int m = 0; m < 4; ++m) {
                    bf16_t* rp = O + (size_t)(row0 + ai * HALF + m * 16) * 2048 + col0;
#pragma unroll
                    for (int bj = 0; bj < 2; ++bj) {
                        u32x4 wv; wv.x = cvt_pk_bf16(acc[ai][bj][m][0][0], acc[ai][bj][m][0][1]); wv.y = cvt_pk_bf16(acc[ai][bj][m][0][2], acc[ai][bj][m][0][3]);
                        wv.z = cvt_pk_bf16(acc[ai][bj][m][1][0], acc[ai][bj][m][1][1]); wv.w = cvt_pk_bf16(acc[ai][bj][m][1][2], acc[ai][bj][m][1][3]);
                        *(u32x4*)(rp + bj * HALF) = wv;
                    }
                }
        } else {
            E(acc, cur, wr, wc, fr, fq);
        }
        if (!has_next) break;
        if (nxt.role == 2) {
            const int pc = S.c + NXCD;
            if (wid == 0) {
                unsigned spins = 0;
                while (__builtin_amdgcn_readfirstlane(__hip_atomic_load(sk.flags + 64 * pc, __ATOMIC_RELAXED, __HIP_MEMORY_SCOPE_AGENT)) == 0u) { __builtin_amdgcn_s_sleep(2); if (++spins > (1u << 22)) break; }
                __builtin_amdgcn_fence(__ATOMIC_ACQUIRE, "agent");
                PG8_WAIT_V(0);
            }
            asm volatile("" ::: "memory"); PG8_BAR; asm volatile("" ::: "memory");
            const f32x4* sl = (const f32x4*)sk.slab + (size_t)pc * 16384 + opaque(tid);
#pragma unroll
            for (int a = 0; a < 2; ++a)
#pragma unroll
                for (int b = 0; b < 2; ++b)
#pragma unroll
                    for (int m = 0; m < 4; ++m)
#pragma unroll
                        for (int n = 0; n < 2; ++n) acc[a][b][m][n] = *(const GAS f32x4*)(sl + (((a * 2 + b) * 4 + m) * 2 + n) * 512);
#pragma unroll
            for (int a = 0; a < 2; ++a)
#pragma unroll
                for (int b = 0; b < 2; ++b)
#pragma unroll
                    for (int m = 0; m < 4; ++m)
#pragma unroll
                        for (int n = 0; n < 2; ++n) asm volatile("" : "+v"(acc[a][b][m][n]));
        } else {
#pragma unroll
        for (int a = 0; a < 2; ++a)
#pragma unroll
            for (int b = 0; b < 2; ++b)
#pragma unroll
                for (int m = 0; m < 4; ++m)
#pragma unroll
                    for (int n = 0; n < 2; ++n) acc[a][b][m][n] = (f32x4){0.f, 0.f, 0.f, 0.f};
        }
        cur = nxt; cA = nA; cB = nB; ++ui;
        if (wr == 1) PG8_BAR;
    }
    PG8_WAIT_V(0);
    PG8_BAR;
#undef PG8_UA
#undef PG8_UB
#undef PG8_SA
#undef PG8_SB
#undef PG8_STAGE
#undef PG8_LDA
#undef PG8_LDB
#undef PG8_MMA
#undef PG8_WAIT_V
#undef PG8_WAIT_L
#undef PG8_BAR
#undef PG8_SCHED
}

__device__ __forceinline__ void st8(bf16_t* p, const f32x4 v0, const f32x4 v1) {
    u32x4 w; w.x = cvt_pk_bf16(v0[0], v0[1]); w.y = cvt_pk_bf16(v0[2], v0[3]); w.z = cvt_pk_bf16(v1[0], v1[1]); w.w = cvt_pk_bf16(v1[2], v1[3]);
    *(u32x4*)p = w;
}
struct EpiProj {
    bf16_t* P; const float* cs;
    __device__ __forceinline__ void operator()(const f32x4 (&acc)[2][2][4][2], const Unit& u, int wr, int wc, int fr, int fq) const {
        const int row0 = u.pm * BM + wr * 64 + fr, type = u.pn >> 2, cl = wc * 32 + 8 * fq, col0 = u.pn * BM + cl;
        if (type <= 1) {
            const float sc = type == 1 ? 0.0625f : 1.0f;
#pragma unroll
            for (int ai = 0; ai < 2; ++ai)
#pragma unroll
                for (int m = 0; m < 4; ++m) {
                    const int row = row0 + ai * HALF + m * 16;
                    const int pidx = row < MP ? (row & (SEQ - 1)) : SEQ + ((row - MP) & 7);
                    const f32x4* t = (const f32x4*)cs + (size_t)(cl >> 3) * 4 * NPOS + pidx;
                    const f32x4 t0 = t[0], t1 = t[NPOS], t2 = t[2 * NPOS], t3 = t[3 * NPOS];
                    const f32x4 x1a = acc[ai][0][m][0], x1b = acc[ai][0][m][1], x2a = acc[ai][1][m][0], x2b = acc[ai][1][m][1];
                    f32x4 o1a, o1b, o2a, o2b;
                    o1a[0] = (x1a[0] * t0[0] - x2a[0] * t0[1]) * sc; o2a[0] = (x2a[0] * t0[0] + x1a[0] * t0[1]) * sc;
                    o1a[1] = (x1a[1] * t0[2] - x2a[1] * t0[3]) * sc; o2a[1] = (x2a[1] * t0[2] + x1a[1] * t0[3]) * sc;
                    o1a[2] = (x1a[2] * t1[0] - x2a[2] * t1[1]) * sc; o2a[2] = (x2a[2] * t1[0] + x1a[2] * t1[1]) * sc;
                    o1a[3] = (x1a[3] * t1[2] - x2a[3] * t1[3]) * sc; o2a[3] = (x2a[3] * t1[2] + x1a[3] * t1[3]) * sc;
                    o1b[0] = (x1b[0] * t2[0] - x2b[0] * t2[1]) * sc; o2b[0] = (x2b[0] * t2[0] + x1b[0] * t2[1]) * sc;
                    o1b[1] = (x1b[1] * t2[2] - x2b[1] * t2[3]) * sc; o2b[1] = (x2b[1] * t2[2] + x1b[1] * t2[3]) * sc;
                    o1b[2] = (x1b[2] * t3[0] - x2b[2] * t3[1]) * sc; o2b[2] = (x2b[2] * t3[0] + x1b[2] * t3[1]) * sc;
                    o1b[3] = (x1b[3] * t3[2] - x2b[3] * t3[3]) * sc; o2b[3] = (x2b[3] * t3[2] + x1b[3] * t3[3]) * sc;
                    bf16_t* rp = P + (size_t)row * INW + col0;
                    st8(rp, o1a, o1b); st8(rp + HALF, o2a, o2b);
                }
        } else {
            const bool act = type == 3;
#pragma unroll
            for (int ai = 0; ai < 2; ++ai)
#pragma unroll
                for (int m = 0; m < 4; ++m) {
                    bf16_t* rp = P + (size_t)(row0 + ai * HALF + m * 16) * INW + col0;
#pragma unroll
                    for (int bj = 0; bj < 2; ++bj) {
                        f32x4 v0 = acc[ai][bj][m][0], v1 = acc[ai][bj][m][1];
                        if (act) {
#pragma unroll
                            for (int i = 0; i < 4; ++i) { v0[i] = silu(v0[i]); v1[i] = silu(v1[i]); }
                        }
                        st8(rp + bj * HALF, v0, v1);
                    }
                }
        }
    }
};
struct EpiPlain {
    bf16_t* O; int ldc, coff; const float* scale;
    __device__ __forceinline__ void operator()(const f32x4 (&acc)[2][2][4][2], const Unit& u, int wr, int wc, int fr, int fq) const {
        const int row0 = u.pm * BM + wr * 64 + fr, cl = wc * 32 + 8 * fq, col0 = u.pn * BM + cl;
        f32x4 s[2][2];
#pragma unroll
        for (int bj = 0; bj < 2; ++bj)
#pragma unroll
            for (int n = 0; n < 2; ++n) s[bj][n] = scale ? *(const f32x4*)(scale + col0 + bj * HALF + 4 * n) : (f32x4){1.f, 1.f, 1.f, 1.f};
#pragma unroll
        for (int ai = 0; ai < 2; ++ai)
#pragma unroll
            for (int m = 0; m < 4; ++m) {
                bf16_t* rp = O + (size_t)(row0 + ai * HALF + m * 16) * ldc + coff + col0;
#pragma unroll
                for (int bj = 0; bj < 2; ++bj) st8(rp + bj * HALF, acc[ai][bj][m][0] * s[bj][0], acc[ai][bj][m][1] * s[bj][1]);
            }
    }
};
struct EpiGU {
    bf16_t* Hd;
    __device__ __forceinline__ void operator()(const f32x4 (&acc)[2][2][4][2], const Unit& u, int wr, int wc, int fr, int fq) const {
        const int row0 = u.pm * BM + wr * 64 + fr, cl = wc * 32 + 8 * fq, col0 = u.pn * HALF + cl;
#pragma unroll
        for (int ai = 0; ai < 2; ++ai)
#pragma unroll
            for (int m = 0; m < 4; ++m) {
                f32x4 v0, v1;
#pragma unroll
                for (int i = 0; i < 4; ++i) { v0[i] = silu(acc[ai][0][m][0][i]) * acc[ai][1][m][0][i]; v1[i] = silu(acc[ai][0][m][1][i]) * acc[ai][1][m][1][i]; }
                st8(Hd + (size_t)(row0 + ai * HALF + m * 16) * DFF + col0, v0, v1);
            }
    }
};
}

#define XB_TMO      128
#define XB_XCNT(j)  (256  + 64 * (j))
#define XB_XSUB(j)  (1280 + 64 * (j))
#define XB_XGEN(j)  (2304 + 64 * (j))
#define XB_TOP      3328
#define XB_TOPGEN   3392
#define XCD_BAR_WORDS 3456
#define XB_SPIN_CAP (1u << 18)
__device__ __forceinline__ unsigned xb_ld(unsigned* p)              { return __hip_atomic_load(p, __ATOMIC_RELAXED, __HIP_MEMORY_SCOPE_AGENT); }
__device__ __forceinline__ unsigned xb_add(unsigned* p, unsigned v) { return __hip_atomic_fetch_add(p, v, __ATOMIC_RELAXED, __HIP_MEMORY_SCOPE_AGENT); }
__device__ __forceinline__ unsigned xb_xcc_id() { return (unsigned)__builtin_amdgcn_s_getreg((3 << 11) | 20) & 0xFu; }
#define XB_SPIN(cond, bar) do { unsigned _sp = 0; while (cond) { __builtin_amdgcn_s_sleep(1); \
    if ((++_sp & 255u) == 0u) { if (xb_ld(&(bar)[XB_TMO])) break; if (_sp > XB_SPIN_CAP) { atomicAdd(&(bar)[XB_TMO], 1u); break; } } } } while (0)
__device__ __forceinline__ void xcd_barrier_post(unsigned* bar) {
    if (threadIdx.x == 0) (void)xb_add(&bar[XB_XCNT(xb_xcc_id())], 1u);
}
__device__ __forceinline__ void xcd_barrier_complete(unsigned* bar, unsigned x, unsigned& nloc, unsigned& nx) {
    const unsigned G = gridDim.x * gridDim.y * gridDim.z;
    unsigned sum, cnt, mine, sp = 0u;
    for (;;) {
        sum = 0u; cnt = 0u; mine = 0u;
#pragma unroll
        for (unsigned j = 0; j < 16; ++j) { const unsigned c = xb_ld(&bar[XB_XCNT(j)]); sum += c; cnt += (c > 0u) ? 1u : 0u; mine = (j == x) ? c : mine; }
        if (sum == G) break;
        __builtin_amdgcn_s_sleep(1);
        if ((++sp & 255u) == 0u) { if (xb_ld(&bar[XB_TMO])) break; if (sp > XB_SPIN_CAP) { atomicAdd(&bar[XB_TMO], 1u); break; } }
    }
    nloc = mine > 0u ? mine : 1u; nx = cnt > 0u ? cnt : 1u;
}
__device__ __forceinline__ void xcd_barrier(unsigned* bar, volatile LAS unsigned* st) {
    asm volatile("s_waitcnt vmcnt(0)" ::: "memory");
    __syncthreads();
    if (threadIdx.x == 0) {
        const unsigned x = xb_xcc_id();
        __builtin_amdgcn_s_waitcnt(0);
        unsigned nloc = st[0], nx = st[1];
        if (nloc == 0u) { xcd_barrier_complete(bar, x, nloc, nx); st[0] = nloc; st[1] = nx; }
        const unsigned old = xb_add(&bar[XB_XSUB(x)], 1u);
        const unsigned gen = old / nloc;
        if (old + 1u == (gen + 1u) * nloc) {
            __builtin_amdgcn_fence(__ATOMIC_RELEASE, "agent");
            asm volatile("s_waitcnt vmcnt(0)" ::: "memory");
            const unsigned og = xb_add(&bar[XB_TOP], 1u);
            const unsigned tg = og / nx;
            if (og + 1u == (tg + 1u) * nx) xb_add(&bar[XB_TOPGEN], 1u);
            else XB_SPIN(xb_ld(&bar[XB_TOPGEN]) == tg, bar);
            __builtin_amdgcn_fence(__ATOMIC_ACQUIRE, "agent");
            xb_add(&bar[XB_XGEN(x)], 1u);
            asm volatile("s_waitcnt vmcnt(0)" ::: "memory");
        } else {
            XB_SPIN(xb_ld(&bar[XB_XGEN(x)]) == gen, bar);
            __builtin_amdgcn_fence(__ATOMIC_ACQUIRE, "agent");
            asm volatile("s_waitcnt vmcnt(0)" ::: "memory");
        }
    }
    __syncthreads();
}

struct Args { const float* in[16]; float* out; unsigned char* ws; int ph_lo, ph_hi, use_cg, pad; };

struct Frame {
    LAS unsigned char* lds;
    int tid, lane, wave, vcu, G;
};
__device__ __forceinline__ const float* ldarg(const Frame& F, int k) {
    const volatile LAS unsigned* p = (const volatile LAS unsigned*)(F.lds + ARG_OFF) + 2 * k;
    const unsigned lo = __builtin_amdgcn_readfirstlane(p[0]), hi = __builtin_amdgcn_readfirstlane(p[1]);
    return (const float*)(((unsigned long long)hi << 32) | lo);
}
#define AIN(k) ldarg(F, (k))
#define AOUT ((float*)ldarg(F, 16))
#define AWS ((unsigned char*)ldarg(F, 17))

struct TrItem { const float* W; bf16_t* WT; int K, N, mode, k0, n0; };
constexpr int TR_IN = (D / 64) * (INW / 256), TR_OUT = (D / 64) * (D / 256), TR_G = (D / 64) * (DFF / 256), TR_D = (DFF / 64) * (D / 256);
struct P0Ptrs { const float *w_in, *w_out, *w_gate, *w_up, *w_down, *w_pool; unsigned char* ws; };
__device__ __forceinline__ TrItem p0_decode(const P0Ptrs& a, unsigned char* ws, int it) {
    TrItem t; int r = it, nblk;
    if (r < TR_IN) { t.W = a.w_in; t.WT = (bf16_t*)(ws + WS_WIN); t.K = D; t.N = INW; t.mode = 0; }
    else if ((r -= TR_IN) < TR_OUT) { t.W = a.w_out; t.WT = (bf16_t*)(ws + WS_WOUT); t.K = D; t.N = D; t.mode = 0; }
    else if ((r -= TR_OUT) < 16) { const int g = r >> 2; r &= 3; t.W = a.w_pool + (size_t)g * 65536; t.WT = (bf16_t*)(ws + WS_WPOOL) + (size_t)g * 65536; t.K = 256; t.N = 256; t.mode = 0; }
    else if ((r -= 16) < TR_G) { t.W = a.w_gate; t.WT = (bf16_t*)(ws + WS_WGU); t.K = D; t.N = DFF; t.mode = 1; }
    else if ((r -= TR_G) < TR_G) { t.W = a.w_up; t.WT = (bf16_t*)(ws + WS_WGU); t.K = D; t.N = DFF; t.mode = 2; }
    else { r -= TR_G; t.W = a.w_down; t.WT = (bf16_t*)(ws + WS_WD); t.K = DFF; t.N = D; t.mode = 0; }
    nblk = t.N >> 8; t.k0 = 64 * (r / nblk); t.n0 = 256 * (r % nblk);
    return t;
}
constexpr int P0_NITEMS = TR_IN + TR_OUT + 16 + 2 * TR_G + TR_D;
constexpr int TR_B = TR_IN + TR_OUT + 16 + 2 * TR_G, TR_C = P0_NITEMS;
#ifndef TR_P1_ITEMS
#define TR_P1_ITEMS 800
#endif
constexpr int TR_A = TR_B - TR_P1_ITEMS;
__device__ __forceinline__ void p0_transposes(Frame& F, int it_begin, int it_end, int worker, int nworkers) {
    P0Ptrs a; a.w_in = AIN(6); a.w_out = AIN(10); a.w_gate = AIN(13); a.w_up = AIN(14); a.w_down = AIN(15); a.w_pool = AIN(8); a.ws = AWS;
    unsigned char* ws = a.ws;
    LAS float* buf = (LAS float*)F.lds;
    const int w = F.wave, l = opaque(F.lane);
#define TR_LOAD(V, T) do { _Pragma("unroll") for (int i = 0; i < 8; ++i) V[i] = *(const GAS f32x4*)((T).W + (size_t)((T).k0 + 8 * w + i) * (T).N + (T).n0 + 4 * l); } while (0)
#define TR_STEP(V, CUR) do { \
        _Pragma("unroll") for (int i = 0; i < 8; ++i) *(LAS f32x4*)(buf + (8 * w + i) * 260 + ((4 * l) ^ (4 * (w & 7)))) = V[i]; \
        __syncthreads(); \
        const TrItem cur_ = (CUR); \
        const int nit_ = it + 2 * nworkers; \
        if (nit_ < it_end) { (CUR) = p0_decode(a, ws, nit_); TR_LOAD(V, (CUR)); } \
        const int ko = l & 7; \
        _Pragma("unroll") for (int sidx = 0; sidx < 4; ++sidx) { \
            const int nl = 32 * w + 8 * sidx + (l >> 3), n = cur_.n0 + nl; \
            const LAS float* p = buf + (8 * ko) * 260 + (nl ^ (4 * ko)); \
            u32x4 o; o.x = pk2(p[0], p[260]); o.y = pk2(p[2 * 260], p[3 * 260]); o.z = pk2(p[4 * 260], p[5 * 260]); o.w = pk2(p[6 * 260], p[7 * 260]); \
            const int row = cur_.mode == 0 ? n : (256 * (n >> 7) + (n & 127) + (cur_.mode == 2 ? 128 : 0)); \
            *(GAS u32x4*)(cur_.WT + (size_t)row * cur_.K + cur_.k0 + 8 * ko) = o; } \
        __syncthreads(); } while (0)
    int it = it_begin + worker;
    if (it >= it_end) return;
    TrItem tA = p0_decode(a, ws, it), tB = tA;
    f32x4 vA[8], vB[8];
    TR_LOAD(vA, tA);
    if (it + nworkers < it_end) { tB = p0_decode(a, ws, it + nworkers); TR_LOAD(vB, tB); }
    for (;;) {
        TR_STEP(vA, tA);
        it += nworkers; if (it >= it_end) break;
        TR_STEP(vB, tB);
        it += nworkers; if (it >= it_end) break;
    }
#undef TR_LOAD
#undef TR_STEP
}
__device__ __forceinline__ void rms_row_to_bf16(const float* xrow, const float* w, bf16_t* orow, int lane) {
    const GAS f32x4* xr = (const GAS f32x4*)xrow + lane; const GAS f32x4* wr = (const GAS f32x4*)w + lane;
    f32x4 v[8]; float s = 0.f;
#pragma unroll
    for (int j = 0; j < 8; ++j) { v[j] = xr[64 * j]; s += (v[j].x * v[j].x + v[j].y * v[j].y) + (v[j].z * v[j].z + v[j].w * v[j].w); }
    const float rstd = 1.0f / sqrtf(wave_sum(s) * (1.f / D) + EPS);
    GAS u32x2* o8 = (GAS u32x2*)orow + lane;
#pragma unroll
    for (int j = 0; j < 8; ++j) { const f32x4 ww = wr[64 * j]; u32x2 o; o.x = pk2(v[j].x * rstd * ww.x, v[j].y * rstd * ww.y); o.y = pk2(v[j].z * rstd * ww.z, v[j].w * rstd * ww.w); o8[64 * j] = o; }
}
__device__ __forceinline__ const float* xrow_ptr(const float* xp, const float* xs, int m) { return m < MP ? xp + (size_t)m * D : xs + (size_t)(m - MP) * D; }

__device__ __forceinline__ void p0_prologue(Frame& F) {
    p0_transposes(F, 0, TR_A, F.vcu, F.G);
    unsigned char* ws = AWS;
    const int gw = F.vcu * NWAVES + F.wave, NGW = F.G * NWAVES;
    const float* xp_ = AIN(0); const float* xs_ = AIN(1); const float* nw_ = AIN(4);
    for (int m = gw; m < M; m += NGW) rms_row_to_bf16(xrow_ptr(xp_, xs_, m), nw_, (bf16_t*)(ws + WS_H) + (size_t)m * D, F.lane);
    float* cs = (float*)(ws + WS_CS);
    for (int idx = F.vcu * NTHR + F.tid; idx < NPOS * 128; idx += F.G * NTHR) {
        const int p = idx >> 7, j = idx & 127;
        double r = 0.930572040929699, inv = 1.0;
#pragma unroll
        for (int b = 0; b < 7; ++b) { if ((j >> b) & 1) inv *= r; r *= r; }
        const float invf = (float)inv;
        const float pos = (float)(p < SEQ ? p : 16384 + (p - SEQ));
        const float ang = pos * invf;
        double t = (double)ang * 0.15915494309189535; t -= __builtin_rint(t);
        const float tf = (float)t;
        f32x2 o; o.x = __builtin_amdgcn_cosf(tf); o.y = __builtin_amdgcn_sinf(tf);
        *(f32x2*)(cs + ((size_t)(((j >> 3) * 4 + ((j & 7) >> 1)) * NPOS + p)) * 4 + (j & 1) * 2) = o;
    }
}

__device__ __forceinline__ unsigned toff(int r, int c16, int RB) { return (unsigned)(r * RB + ((((c16 & ~15) | ((c16 ^ r ^ (r >> 4)) & 15))) << 4)); }
#define MFMA32(a, b, c) __builtin_amdgcn_mfma_f32_32x32x16_bf16((a), (b), (c), 0, 0, 0)
__device__ __forceinline__ int crow(int reg, int h) { return (reg & 3) + 8 * (reg >> 2) + 4 * h; }
__device__ __forceinline__ bf16x8 frag(const LAS unsigned char* tile, int r, int c16, int RB) { return *(const LAS bf16x8*)(tile + toff(r, c16, RB)); }

__device__ __forceinline__ void load_nat128(LAS unsigned char* dst, const bf16_t* src, int ld, int tid) {
    tid = opaque(tid);
    u32x4 v[4];
#pragma unroll
    for (int it = 0; it < 4; ++it) { const int idx = tid + it * NTHR, r = idx >> 4, c = idx & 15; v[it] = *(const GAS u32x4*)(src + (size_t)r * ld + c * 8); }
#pragma unroll
    for (int it = 0; it < 4; ++it) { const int idx = tid + it * NTHR, r = idx >> 4, c = idx & 15; *(LAS u32x4*)(dst + toff(r, c, 256)) = v[it]; }
}
template <bool SCALE>
__device__ __forceinline__ void load_tr(LAS unsigned char* dst, const bf16_t* src, int ld, int tid, float sc_a, float sc_b) {
    tid = opaque(tid);
#pragma unroll
    for (int it = 0; it < 4; ++it) {
        const int T = it * NTHR + tid, ch_lo = T & 15, pp = (T >> 4) & 3, half = (T >> 6) & 1, quad = T >> 7;
        const int pair = 4 * quad + pp, chunk = 16 * half + ch_lo, j0 = 2 * pair, d0 = 8 * chunk;
        const u32x4 a = *(const GAS u32x4*)(src + (size_t)j0 * ld + d0), b = *(const GAS u32x4*)(src + (size_t)(j0 + 1) * ld + d0);
        float s0 = 1.f, s1 = 1.f;
        if (SCALE) { s0 = __builtin_amdgcn_exp2f(sc_a * (sc_b - (float)j0)); s1 = __builtin_amdgcn_exp2f(sc_a * (sc_b - (float)(j0 + 1))); }
#pragma unroll
        for (int i = 0; i < 8; ++i) {
            const unsigned wa = a[i >> 1], wb = b[i >> 1];
            unsigned w;
            if (SCALE) { const float fa = ((i & 1) ? bfhi(wa) : bflo(wa)) * s0, fb = ((i & 1) ? bfhi(wb) : bflo(wb)) * s1; w = pk2(fa, fb); }
            else w = (i & 1) ? ((wa >> 16) | (wb & 0xffff0000u)) : ((wa & 0xffffu) | (wb << 16));
            const int d = d0 + i;
            *(LAS unsigned*)(dst + toff(d, quad, 256) + pp * 4) = w;
        }
    }
}

__device__ __forceinline__ void u_item(Frame& F, const bf16_t* PROJ, bf16_t* UT, int item) {
    const int b = item >> 6, h = (item >> 4) & 3, c = item & 15, rows0 = b * SEQ + c * 128;
    const bf16_t* Ks = PROJ + (size_t)rows0 * INW + 1024 + h * 256; const bf16_t* Vs = Ks + 1024;
    LAS unsigned char* KT = F.lds; LAS unsigned char* VT = F.lds + 65536;
    const float lg = lg2gamma(h);
    load_tr<true>(KT, Ks, INW, F.tid, lg, 127.f);
    load_tr<false>(VT, Vs, INW, F.tid, 0.f, 0.f);
    __syncthreads();
    const int w = F.wave, r = opaque(F.lane) & 31, hh = opaque(F.lane) >> 5;
    bf16_t* Up = UT + ((size_t)((b * 4 + h) * 16 + c) * 256) * 256;
#pragma unroll 1
    for (int eh = 0; eh < 2; ++eh) {
        f32x16 acc[4];
#pragma unroll
        for (int t = 0; t < 4; ++t)
#pragma unroll
            for (int i = 0; i < 16; ++i) acc[t][i] = 0.f;
#pragma unroll 1
        for (int ks = 0; ks < 8; ++ks) {
            const bf16x8 a = frag(KT, 32 * w + r, 2 * ks + hh, 256);
#pragma unroll
            for (int et = 0; et < 4; ++et) { const bf16x8 bb = frag(VT, 32 * (4 * eh + et) + r, 2 * ks + hh, 256); acc[et] = MFMA32(a, bb, acc[et]); }
        }
#pragma unroll
        for (int et = 0; et < 4; ++et)
#pragma unroll
            for (int g = 0; g < 4; ++g) {
                u32x2 o; o.x = cvt_pk_bf16(acc[et][4 * g], acc[et][4 * g + 1]); o.y = cvt_pk_bf16(acc[et][4 * g + 2], acc[et][4 * g + 3]);
                *(GAS u32x2*)(Up + (size_t)(32 * (4 * eh + et) + r) * 256 + 32 * w + 8 * g + 4 * hh) = o;
            }
    }
    __syncthreads();
}

__device__ __forceinline__ void o_item(Frame& F, const bf16_t* PROJ, const bf16_t* SCT, const float* retw, bf16_t* MIX, int item) {
    const int b = item >> 6, h = (item >> 4) & 3, c = item & 15, rows0 = b * SEQ + c * 128;
    const bf16_t* Qs = PROJ + (size_t)rows0 * INW + h * 256; const bf16_t* Ks = Qs + 1024; const bf16_t* Vs = Qs + 2048; const bf16_t* Gs = Qs + 3072;
    LAS unsigned char* QF = F.lds; LAS unsigned char* KH = F.lds + 65536; LAS unsigned char* PB = F.lds + 98304; LAS unsigned char* VT = F.lds; LAS unsigned char* OB = F.lds;
    const float lg = lg2gamma(h);
    const int w = F.wave; int r = opaque(F.lane) & 31, hh = opaque(F.lane) >> 5; const int tid = opaque(F.tid);
    u32x4 qv[8], kv[4]; bf16x8 sfr[16];
#pragma unroll
    for (int it = 0; it < 8; ++it) { const int idx = tid + it * NTHR, rr = idx >> 5, cc = idx & 31; qv[it] = *(const GAS u32x4*)(Qs + (size_t)rr * INW + cc * 8); }
#pragma unroll
    for (int it = 0; it < 4; ++it) { const int idx = tid + it * NTHR, rr = idx >> 4, cc = idx & 15; kv[it] = *(const GAS u32x4*)(Ks + (size_t)rr * INW + cc * 8); }
    {
        const bf16_t* Sp = SCT + ((size_t)((b * 4 + h) * 16 + c) * 256) * 256 + (size_t)(32 * w + r) * 256 + 8 * hh;
#pragma unroll
        for (int ks = 0; ks < 16; ++ks) sfr[ks] = *(const GAS bf16x8*)(Sp + 16 * ks);
    }
#pragma unroll
    for (int it = 0; it < 8; ++it) { const int idx = tid + it * NTHR, rr = idx >> 5, cc = idx & 31; *(LAS u32x4*)(QF + toff(rr, cc, 512)) = qv[it]; }
#pragma unroll
    for (int it = 0; it < 4; ++it) { const int idx = tid + it * NTHR, rr = idx >> 4, cc = idx & 15; *(LAS u32x4*)(KH + toff(rr, cc, 256)) = kv[it]; }
    __syncthreads();
#pragma unroll
    for (int it = 0; it < 4; ++it) { const int idx = tid + it * NTHR, rr = idx >> 4, cc = idx & 15; kv[it] = *(const GAS u32x4*)(Ks + 128 + (size_t)rr * INW + cc * 8); }
    const int ib_s = w >> 1, jb0 = 2 * (w & 1);
    f32x16 sc[2];
#pragma unroll
    for (int t = 0; t < 2; ++t)
#pragma unroll
        for (int i = 0; i < 16; ++i) sc[t][i] = 0.f;
    if (jb0 <= ib_s) {
#pragma unroll 1
        for (int ks = 0; ks < 8; ++ks) {
            const bf16x8 a = frag(QF, 32 * ib_s + r, 2 * ks + hh, 512);
            const bf16x8 b0 = frag(KH, 32 * jb0 + r, 2 * ks + hh, 256), b1 = frag(KH, 32 * (jb0 + 1) + r, 2 * ks + hh, 256);
            sc[0] = MFMA32(a, b0, sc[0]); sc[1] = MFMA32(a, b1, sc[1]);
        }
    }
    __syncthreads();
#pragma unroll
    for (int it = 0; it < 4; ++it) { const int idx = tid + it * NTHR, rr = idx >> 4, cc = idx & 15; *(LAS u32x4*)(KH + toff(rr, cc, 256)) = kv[it]; }
    __syncthreads();
    u32x4 va[4], vb[4];
#pragma unroll
    for (int it = 0; it < 4; ++it) {
        const int T = it * NTHR + tid, ch_lo = T & 15, pp = (T >> 4) & 3, half = (T >> 6) & 1, quad = T >> 7;
        const int pair = 4 * quad + pp, chunk = 16 * half + ch_lo, j0 = 2 * pair, d0 = 8 * chunk;
        va[it] = *(const GAS u32x4*)(Vs + (size_t)j0 * INW + d0); vb[it] = *(const GAS u32x4*)(Vs + (size_t)(j0 + 1) * INW + d0);
    }
    if (jb0 <= ib_s) {
#pragma unroll 1
        for (int ks = 0; ks < 8; ++ks) {
            const bf16x8 a = frag(QF, 32 * ib_s + r, 16 + 2 * ks + hh, 512);
            const bf16x8 b0 = frag(KH, 32 * jb0 + r, 2 * ks + hh, 256), b1 = frag(KH, 32 * (jb0 + 1) + r, 2 * ks + hh, 256);
            sc[0] = MFMA32(a, b0, sc[0]); sc[1] = MFMA32(a, b1, sc[1]);
        }
    }
    r = opaque(r); hh = opaque(hh);
#pragma unroll
    for (int t = 0; t < 2; ++t) {
        const int j = 32 * (jb0 + t) + r;
#pragma unroll
        for (int reg = 0; reg < 16; ++reg) {
            const int i = 32 * ib_s + crow(reg, hh);
            const float v = (i >= j) ? sc[t][reg] * __builtin_amdgcn_exp2f(lg * (float)(i - j)) : 0.f;
            *(LAS bf16_t*)(PB + toff(i, j >> 3, 256) + (j & 7) * 2) = (bf16_t)f2bf(v);
        }
    }
    f32x16 o[4];
#pragma unroll
    for (int t = 0; t < 4; ++t)
#pragma unroll
        for (int i = 0; i < 16; ++i) o[t][i] = 0.f;
    r = opaque(r); hh = opaque(hh);
#pragma unroll
    for (int ks = 0; ks < 16; ++ks) {
#pragma unroll
        for (int ib = 0; ib < 4; ++ib) { const bf16x8 a = frag(QF, 32 * ib + r, 2 * ks + hh, 512); o[ib] = MFMA32(a, sfr[ks], o[ib]); }
    }
#pragma unroll
    for (int ib = 0; ib < 4; ++ib)
#pragma unroll
        for (int reg = 0; reg < 16; ++reg) o[ib][reg] *= __builtin_amdgcn_exp2f(lg * (float)(32 * ib + crow(reg, hh) + 1));
    __syncthreads();
#pragma unroll
    for (int it = 0; it < 4; ++it) {
        const int T = it * NTHR + tid, ch_lo = T & 15, pp = (T >> 4) & 3, half = (T >> 6) & 1, quad = T >> 7;
        const int chunk = 16 * half + ch_lo, d0 = 8 * chunk;
#pragma unroll
        for (int i = 0; i < 8; ++i) {
            const unsigned wa = va[it][i >> 1], wb = vb[it][i >> 1];
            const unsigned wv = (i & 1) ? ((wa >> 16) | (wb & 0xffff0000u)) : ((wa & 0xffffu) | (wb << 16));
            *(LAS unsigned*)(VT + toff(d0 + i, quad, 256) + pp * 4) = wv;
        }
    }
    __syncthreads();
    r = opaque(r); hh = opaque(hh);
#pragma unroll 1
    for (int ks = 0; ks < 8; ++ks) {
        const bf16x8 bb = frag(VT, 32 * w + r, 2 * ks + hh, 256);
#pragma unroll
        for (int ib = 0; ib < 4; ++ib)
            if (ks < 2 * (ib + 1)) { const bf16x8 a = frag(PB, 32 * ib + r, 2 * ks + hh, 256); o[ib] = MFMA32(a, bb, o[ib]); }
    }
    __syncthreads();
    r = opaque(r); hh = opaque(hh);
#pragma unroll
    for (int ib = 0; ib < 4; ++ib)
#pragma unroll
        for (int reg = 0; reg < 16; ++reg) { const int i = 32 * ib + crow(reg, hh);
            *(LAS bf16_t*)(OB + i * 512 + (32 * w + r) * 2) = (bf16_t)f2bf(o[ib][reg]); }
    __syncthreads();
    {
        const int tid2 = opaque(F.tid), cc = tid2 & 31;
        const f32x4 wa = *(const GAS f32x4*)(retw + h * 256 + cc * 8), wb = *(const GAS f32x4*)(retw + h * 256 + cc * 8 + 4);
        u32x4 gv[8];
#pragma unroll
        for (int it = 0; it < 8; ++it) gv[it] = *(const GAS u32x4*)(Gs + (size_t)((tid2 >> 5) + 16 * it) * INW + cc * 8);
#pragma unroll
        for (int it = 0; it < 8; ++it) {
            const int i = (tid2 >> 5) + 16 * it;
            const u32x4 ov = *(const LAS u32x4*)(OB + i * 512 + cc * 16);
            float x[8];
#pragma unroll
            for (int k = 0; k < 4; ++k) { x[2 * k] = bflo(ov[k]); x[2 * k + 1] = bfhi(ov[k]); }
            float sq = 0.f;
#pragma unroll
            for (int k = 0; k < 8; ++k) sq += x[k] * x[k];
            sq += __shfl_xor(sq, 1); sq += __shfl_xor(sq, 2); sq += __shfl_xor(sq, 4); sq += __shfl_xor(sq, 8); sq += __shfl_xor(sq, 16);
            const float rstd = 1.0f / sqrtf(sq * (1.f / 256.f) + EPS);
            u32x4 res;
            res[0] = pk2(x[0] * rstd * wa[0] * bflo(gv[it][0]), x[1] * rstd * wa[1] * bfhi(gv[it][0]));
            res[1] = pk2(x[2] * rstd * wa[2] * bflo(gv[it][1]), x[3] * rstd * wa[3] * bfhi(gv[it][1]));
            res[2] = pk2(x[4] * rstd * wb[0] * bflo(gv[it][2]), x[5] * rstd * wb[1] * bfhi(gv[it][2]));
            res[3] = pk2(x[6] * rstd * wb[2] * bflo(gv[it][3]), x[7] * rstd * wb[3] * bfhi(gv[it][3]));
            *(GAS u32x4*)(MIX + (size_t)(rows0 + i) * D + h * 256 + cc * 8) = res;
        }
    }
    __syncthreads();
}

__device__ __forceinline__ void s_item(Frame& F, const bf16_t* PROJ, const float* state, const float* retw, float* newstate, bf16_t* MIX, int item) {
    const int sb = item >> 2, h = item & 3, rows0 = MP + sb * 8;
    const float lg = lg2gamma(h);
    LAS float* QK = (LAS float*)F.lds;
    LAS float* QR = (LAS float*)(F.lds + 16384);
    LAS float* KR = (LAS float*)(F.lds + 16384 + 8224);
    LAS float* SCP = (LAS float*)(F.lds + 16384 + 2 * 8224);
    LAS float* SCO = (LAS float*)(F.lds + 16384 + 2 * 8224 + 2048);
    LAS float* RED = (LAS float*)(F.lds + 40960);
    const int w = opaque(F.wave), l = opaque(F.lane), tid_o = opaque(F.tid);
    {
        const int isk = tid_o >> 8, i = (tid_o >> 5) & 7, d8 = (tid_o & 31) * 8;
        const u32x4 raw = *(const GAS u32x4*)(PROJ + (size_t)(rows0 + i) * INW + isk * 1024 + h * 256 + d8);
        float f[8];
#pragma unroll
        for (int q = 0; q < 4; ++q) { f[2 * q] = bflo(raw[q]); f[2 * q + 1] = bfhi(raw[q]); }
        const float sc = __builtin_amdgcn_exp2f(lg * (float)(isk ? 7 - i : i + 1));
        LAS float* R = isk ? KR : QR;
#pragma unroll
        for (int k = 0; k < 8; ++k) { R[i * 257 + d8 + k] = f[k]; QK[(d8 + k) * 16 + isk * 8 + i] = f[k] * sc; }
    }
    float v[8][4];
#pragma unroll
    for (int j = 0; j < 8; ++j) { const u32x2 t = *(const GAS u32x2*)(PROJ + (size_t)(rows0 + j) * INW + 2048 + h * 256 + 4 * l); v[j][0] = bflo(t.x); v[j][1] = bfhi(t.x); v[j][2] = bflo(t.y); v[j][3] = bfhi(t.y); }
    __syncthreads();
    {
        const int i = l >> 3, j = l & 7; float s = 0.f;
#pragma unroll 8
        for (int d = 32 * w; d < 32 * w + 32; ++d) s += QR[i * 257 + d] * KR[j * 257 + d];
        SCP[w * 64 + l] = s;
    }
    float oacc[8][4];
#pragma unroll
    for (int i = 0; i < 8; ++i)
#pragma unroll
        for (int c = 0; c < 4; ++c) oacc[i][c] = 0.f;
    const float g8 = __builtin_amdgcn_exp2f(lg * 8.f);
    const GAS f32x4* Sp = (const GAS f32x4*)(state + ((size_t)(sb * 4 + h) * 256 + 32 * w) * 256) + l;
    GAS f32x4* Np = (GAS f32x4*)(newstate + ((size_t)(sb * 4 + h) * 256 + 32 * w) * 256) + l;
    f32x4 sA[4], sB[4];
#define S_LOAD4(dst, row0) do { const GAS f32x4* p0_ = Sp + (size_t)(row0) * 64; asm volatile("" : "+v"(p0_)); \
        _Pragma("unroll") for (int k = 0; k < 4; ++k) dst[k] = p0_[k * 64]; } while (0)
#define S_COMP4(src, row0) do { GAS f32x4* n0_ = Np + (size_t)(row0) * 64; asm volatile("" : "+v"(n0_)); \
        _Pragma("unroll") for (int k = 0; k < 4; ++k) { \
            const LAS f32x4* qk = (const LAS f32x4*)(QK + (32 * w + (row0) + k) * 16); \
            const f32x4 qa = qk[0], qb = qk[1], ka = qk[2], kb = qk[3]; f32x4 n; \
            _Pragma("unroll") for (int c = 0; c < 4; ++c) { const float sv = src[k][c]; \
                oacc[0][c] += qa[0] * sv; oacc[1][c] += qa[1] * sv; oacc[2][c] += qa[2] * sv; oacc[3][c] += qa[3] * sv; \
                oacc[4][c] += qb[0] * sv; oacc[5][c] += qb[1] * sv; oacc[6][c] += qb[2] * sv; oacc[7][c] += qb[3] * sv; \
                float t = g8 * sv; \
                t += ka[0] * v[0][c]; t += ka[1] * v[1][c]; t += ka[2] * v[2][c]; t += ka[3] * v[3][c]; \
                t += kb[0] * v[4][c]; t += kb[1] * v[5][c]; t += kb[2] * v[6][c]; t += kb[3] * v[7][c]; n[c] = t; } \
            n0_[k * 64] = n; \
            if (k & 1) asm volatile("" ::: "memory"); } } while (0)
    S_LOAD4(sA, 0);
#pragma unroll 1
    for (int h2 = 0; h2 < 4; ++h2) {
        S_LOAD4(sB, 8 * h2 + 4);
        S_COMP4(sA, 8 * h2);
        if (h2 < 3) S_LOAD4(sA, 8 * h2 + 8);
        S_COMP4(sB, 8 * h2 + 4);
    }
#undef S_LOAD4
#undef S_COMP4
#pragma unroll
    for (int i = 0; i < 8; ++i) *(LAS f32x4*)(RED + (w * 8 + i) * 256 + 4 * l) = (f32x4){oacc[i][0], oacc[i][1], oacc[i][2], oacc[i][3]};
    __syncthreads();
    if (tid_o < 64) { const int i = l >> 3, j = l & 7; float s = 0.f;
#pragma unroll
        for (int ww = 0; ww < 8; ++ww) s += SCP[ww * 64 + l];
        SCO[l] = (i >= j) ? s * __builtin_amdgcn_exp2f(lg * (float)(i - j)) : 0.f; }
    __syncthreads();
    {
        const int i = w; f32x4 tot = (f32x4){0.f, 0.f, 0.f, 0.f};
#pragma unroll
        for (int ww = 0; ww < 8; ++ww) tot += *(const LAS f32x4*)(RED + (ww * 8 + i) * 256 + 4 * l);
#pragma unroll
        for (int j = 0; j < 8; ++j) { const float s = SCO[i * 8 + j];
#pragma unroll
            for (int c = 0; c < 4; ++c) tot[c] += s * v[j][c]; }
        const float ss = wave_sum((tot[0] * tot[0] + tot[1] * tot[1]) + (tot[2] * tot[2] + tot[3] * tot[3]));
        const float rstd = 1.0f / sqrtf(ss * (1.f / 256.f) + EPS);
        const f32x4 wn = *(const GAS f32x4*)(retw + h * 256 + 4 * l);
        const u32x2 gv = *(const GAS u32x2*)(PROJ + (size_t)(rows0 + i) * INW + 3072 + h * 256 + 4 * l);
        u32x2 res; res.x = pk2(tot[0] * rstd * wn[0] * bflo(gv.x), tot[1] * rstd * wn[1] * bfhi(gv.x)); res.y = pk2(tot[2] * rstd * wn[2] * bflo(gv.y), tot[3] * rstd * wn[3] * bfhi(gv.y));
        *(GAS u32x2*)(MIX + (size_t)(rows0 + i) * D + h * 256 + 4 * l) = res;
    }
    __syncthreads();
}

__device__ __forceinline__ void unpk8(const u32x4 v, float (&f)[8]) {
#pragma unroll
    for (int q = 0; q < 4; ++q) { f[2 * q] = bflo(v[q]); f[2 * q + 1] = bfhi(v[q]); }
}
template <int W>
__device__ __forceinline__ void pool_prompt_blk(const bf16_t* PROJ, bf16_t* POOLED, float* outp, int rb, int ch) {
    const int m0 = rb * 8, t0 = m0 & (SEQ - 1), bseq = m0 >> 11;
    const bf16_t* U = PROJ + 4096 + ch;
    u32x4 x[W + 7];
#pragma unroll
    for (int i = 0; i < W + 7; ++i) { const int t = t0 - (W - 1) + i; const int mi = (t >= 0) ? m0 - (W - 1) + i : m0; x[i] = *(const GAS u32x4*)(U + (size_t)mi * INW); }
#pragma unroll
    for (int i = 0; i < W - 1; ++i) { const int t = t0 - (W - 1) + i; if (t < 0) x[i] = (u32x4){0u, 0u, 0u, 0u}; }
    float sum[8];
#pragma unroll
    for (int k = 0; k < 8; ++k) sum[k] = 0.f;
#pragma unroll
    for (int i = 0; i < W - 1; ++i) { float f[8]; unpk8(x[i], f);
#pragma unroll
        for (int k = 0; k < 8; ++k) sum[k] += f[k]; }
#pragma unroll
    for (int r = 0; r < 8; ++r) {
        float cur[8]; unpk8(x[W - 1 + r], cur);
#pragma unroll
        for (int k = 0; k < 8; ++k) sum[k] += cur[k];
        const int t = t0 + r; const int cnt = (t + 1 < W) ? t + 1 : W; const float inv = 1.0f / (float)cnt;
        u32x4 o;
#pragma unroll
        for (int q = 0; q < 4; ++q) o[q] = pk2(sum[2 * q] * inv - cur[2 * q], sum[2 * q + 1] * inv - cur[2 * q + 1]);
        *(GAS u32x4*)(POOLED + (size_t)(m0 + r) * 1024 + ch) = o;
        float sub[8]; unpk8(x[r], sub);
#pragma unroll
        for (int k = 0; k < 8; ++k) sum[k] -= sub[k];
        if (t >= SEQ - 15) { float* op = outp + ((size_t)bseq * 15 + (t - (SEQ - 15))) * 1024 + ch;
            *(GAS f32x4*)op = (f32x4){cur[0], cur[1], cur[2], cur[3]}; *(GAS f32x4*)(op + 4) = (f32x4){cur[4], cur[5], cur[6], cur[7]}; }
    }
}
template <int W>
__device__ __forceinline__ void pool_sample_blk(const bf16_t* PROJ, const float* spool, bf16_t* POOLED, float* outs, int sb, int ch) {
    const bf16_t* U = PROJ + (size_t)(MP + sb * 8) * INW + 4096 + ch;
    const float* B = spool + (size_t)sb * 15 * 1024 + ch;
    f32x4 ba[W - 1], bb[W - 1]; u32x4 xn[8]; f32x4 ca[7], cb[7];
#pragma unroll
    for (int i = 0; i < W - 1; ++i) { ba[i] = *(const GAS f32x4*)(B + (size_t)(15 - (W - 1) + i) * 1024); bb[i] = *(const GAS f32x4*)(B + (size_t)(15 - (W - 1) + i) * 1024 + 4); }
#pragma unroll
    for (int r = 0; r < 8; ++r) xn[r] = *(const GAS u32x4*)(U + (size_t)r * INW);
#pragma unroll
    for (int rr = 0; rr < 7; ++rr) { ca[rr] = *(const GAS f32x4*)(B + (size_t)(8 + rr) * 1024); cb[rr] = *(const GAS f32x4*)(B + (size_t)(8 + rr) * 1024 + 4); }
    float sum[8];
#pragma unroll
    for (int k = 0; k < 8; ++k) sum[k] = 0.f;
#pragma unroll
    for (int i = 0; i < W - 1; ++i)
#pragma unroll
        for (int q = 0; q < 4; ++q) { sum[q] += ba[i][q]; sum[4 + q] += bb[i][q]; }
    const float inv = 1.0f / (float)W;
#pragma unroll
    for (int r = 0; r < 8; ++r) {
        float cur[8]; unpk8(xn[r], cur);
#pragma unroll
        for (int k = 0; k < 8; ++k) sum[k] += cur[k];
        u32x4 o;
#pragma unroll
        for (int q = 0; q < 4; ++q) o[q] = pk2(sum[2 * q] * inv - cur[2 * q], sum[2 * q + 1] * inv - cur[2 * q + 1]);
        *(GAS u32x4*)(POOLED + (size_t)(MP + sb * 8 + r) * 1024 + ch) = o;
        if (r < W - 1) {
#pragma unroll
            for (int q = 0; q < 4; ++q) { sum[q] -= ba[r < W - 1 ? r : 0][q]; sum[4 + q] -= bb[r < W - 1 ? r : 0][q]; }
        } else { float sub[8]; unpk8(xn[r >= W - 1 ? r - (W - 1) : 0], sub);
#pragma unroll
            for (int k = 0; k < 8; ++k) sum[k] -= sub[k]; }
        float* op = outs + ((size_t)sb * 15 + 7 + r) * 1024 + ch;
        *(GAS f32x4*)op = (f32x4){cur[0], cur[1], cur[2], cur[3]}; *(GAS f32x4*)(op + 4) = (f32x4){cur[4], cur[5], cur[6], cur[7]};
    }
#pragma unroll
    for (int rr = 0; rr < 7; ++rr) { float* op = outs + ((size_t)sb * 15 + rr) * 1024 + ch; *(GAS f32x4*)op = ca[rr]; *(GAS f32x4*)(op + 4) = cb[rr]; }
}
__device__ __forceinline__ void pool_tasks(Frame& F, const bf16_t* PROJ, const float* spool, bf16_t* POOLED, float* outp, float* outs) {
    for (int gt = F.vcu * NTHR + opaque(F.tid); gt < 1024 * 128; gt += F.G * NTHR) {
        const int cgp = gt & 31, rbl = (gt >> 5) & 1, grp = (gt >> 6) & 3, rb = (gt >> 8) * 2 + rbl, ch = grp * 256 + cgp * 8;
        if (grp == 0) pool_prompt_blk<2>(PROJ, POOLED, outp, rb, ch); else if (grp == 1) pool_prompt_blk<4>(PROJ, POOLED, outp, rb, ch);
        else if (grp == 2) pool_prompt_blk<8>(PROJ, POOLED, outp, rb, ch); else pool_prompt_blk<16>(PROJ, POOLED, outp, rb, ch);
    }
    for (int gt = F.vcu * NTHR + opaque(F.tid); gt < 128 * 128; gt += F.G * NTHR) {
        const int cgp = gt & 31, sbl = (gt >> 5) & 1, grp = (gt >> 6) & 3, sb = (gt >> 8) * 2 + sbl, ch = grp * 256 + cgp * 8;
        if (grp == 0) pool_sample_blk<2>(PROJ, spool, POOLED, outs, sb, ch); else if (grp == 1) pool_sample_blk<4>(PROJ, spool, POOLED, outs, sb, ch);
        else if (grp == 2) pool_sample_blk<8>(PROJ, spool, POOLED, outs, sb, ch); else pool_sample_blk<16>(PROJ, spool, POOLED, outs, sb, ch);
    }
}

__device__ __forceinline__ void load_row_bf16(const bf16_t* row, int nparts, size_t pstride, int lane, float (&f)[4][8]) {
#pragma unroll
    for (int j = 0; j < 4; ++j)
#pragma unroll
        for (int q = 0; q < 8; ++q) f[j][q] = 0.f;
    for (int p = 0; p < nparts; ++p) {
        u32x4 v[4];
#pragma unroll
        for (int j = 0; j < 4; ++j) v[j] = *(const GAS u32x4*)(row + (size_t)p * pstride + 8 * lane + 512 * j);
#pragma unroll
        for (int j = 0; j < 4; ++j)
#pragma unroll
            for (int q = 0; q < 4; ++q) { f[j][2 * q] += bflo(v[j][q]); f[j][2 * q + 1] += bfhi(v[j][q]); }
    }
}
__device__ __forceinline__ void n1_row(const float* xrow, const bf16_t* mo, int nparts, size_t pstride, const float* wpost, const float* wpre, bf16_t* x1row, bf16_t* hrow, int lane) {
    f32x4 xa[4], xb[4]; float s = 0.f;
#pragma unroll
    for (int j = 0; j < 4; ++j) { const int c = 8 * lane + 512 * j; xa[j] = *(const GAS f32x4*)(xrow + c); xb[j] = *(const GAS f32x4*)(xrow + c + 4); }
    float mf[4][8];
    load_row_bf16(mo, nparts, pstride, lane, mf);
#pragma unroll
    for (int j = 0; j < 4; ++j)
#pragma unroll
        for (int q = 0; q < 8; ++q) s += mf[j][q] * mf[j][q];
    const float r1 = 1.0f / sqrtf(wave_sum(s) * (1.f / D) + EPS);
    float s2 = 0.f;
#pragma unroll
    for (int j = 0; j < 4; ++j) { const int c = 8 * lane + 512 * j; const f32x4 wa = *(const GAS f32x4*)(wpost + c), wb = *(const GAS f32x4*)(wpost + c + 4);
#pragma unroll
        for (int q = 0; q < 4; ++q) { xa[j][q] += mf[j][q] * r1 * wa[q]; xb[j][q] += mf[j][4 + q] * r1 * wb[q]; s2 += xa[j][q] * xa[j][q] + xb[j][q] * xb[j][q]; }
        { u32x4 o1; o1.x = pk2(xa[j][0], xa[j][1]); o1.y = pk2(xa[j][2], xa[j][3]); o1.z = pk2(xb[j][0], xb[j][1]); o1.w = pk2(xb[j][2], xb[j][3]); *(GAS u32x4*)(x1row + c) = o1; } }
    const float r2 = 1.0f / sqrtf(wave_sum(s2) * (1.f / D) + EPS);
#pragma unroll
    for (int j = 0; j < 4; ++j) { const int c = 8 * lane + 512 * j; const f32x4 wa = *(const GAS f32x4*)(wpre + c), wb = *(const GAS f32x4*)(wpre + c + 4);
        u32x4 o; o.x = pk2(xa[j][0] * r2 * wa[0], xa[j][1] * r2 * wa[1]); o.y = pk2(xa[j][2] * r2 * wa[2], xa[j][3] * r2 * wa[3]);
        o.z = pk2(xb[j][0] * r2 * wb[0], xb[j][1] * r2 * wb[1]); o.w = pk2(xb[j][2] * r2 * wb[2], xb[j][3] * r2 * wb[3]);
        *(GAS u32x4*)(hrow + c) = o; }
}
__device__ __forceinline__ void n2_row(const bf16_t* ff, int nparts, size_t pstride, const float* wpost, const bf16_t* x1row, float* yrow, int lane) {
    float s = 0.f; float ffl[4][8];
    load_row_bf16(ff, nparts, pstride, lane, ffl);
#pragma unroll
    for (int j = 0; j < 4; ++j)
#pragma unroll
        for (int q = 0; q < 8; ++q) s += ffl[j][q] * ffl[j][q];
    const float r1 = 1.0f / sqrtf(wave_sum(s) * (1.f / D) + EPS);
#pragma unroll
    for (int j = 0; j < 4; ++j) { const int c = 8 * lane + 512 * j; const f32x4 wa = *(const GAS f32x4*)(wpost + c), wb = *(const GAS f32x4*)(wpost + c + 4);
        const u32x4 xv = *(const GAS u32x4*)(x1row + c);
        f32x4 ya = (f32x4){bflo(xv.x), bfhi(xv.x), bflo(xv.y), bfhi(xv.y)}, yb = (f32x4){bflo(xv.z), bfhi(xv.z), bflo(xv.w), bfhi(xv.w)};
#pragma unroll
        for (int q = 0; q < 4; ++q) { ya[q] += ffl[j][q] * r1 * wa[q]; yb[q] += ffl[j][4 + q] * r1 * wb[q]; }
        *(GAS f32x4*)(yrow + c) = ya; *(GAS f32x4*)(yrow + c + 4) = yb; }
}

constexpr int NPH = 10;
__global__ void __launch_bounds__(NTHR, 2) hyb_fwd(Args args) {
    extern __shared__ __attribute__((aligned(16))) unsigned char lds[];
    Frame F;
    F.lds = (LAS unsigned char*)lds;
    F.tid = threadIdx.x; F.lane = F.tid & 63; F.wave = __builtin_amdgcn_readfirstlane(F.tid >> 6);
    F.G = gridDim.x; { const int bx = blockIdx.x; F.vcu = (F.G % 8 == 0) ? (bx % 8) * (F.G / 8) + bx / 8 : bx; }
    if (F.tid == 0) {
        volatile LAS unsigned long long* at = (volatile LAS unsigned long long*)(F.lds + ARG_OFF);
#pragma unroll
        for (int i = 0; i < 16; ++i) at[i] = (unsigned long long)args.in[i];
        at[16] = (unsigned long long)args.out; at[17] = (unsigned long long)args.ws;
    }
    const int lo = args.ph_lo, hi = args.ph_hi;
    if (F.tid < 32) ((volatile LAS unsigned*)(F.lds + MISC_OFF))[F.tid] = 0u;
    __syncthreads();
    if (args.use_cg) xcd_barrier_post((unsigned*)(AWS + WS_CTL) + CW_BAR);
    if (args.pad == 0x5a5a5a5a) cg::this_grid().sync();
#ifndef PH_ENABLE
#define PH_ENABLE 0x3ff
#endif
#define IN(k) (((PH_ENABLE >> (k)) & 1) && lo <= (k) && (k) < hi)
#define BOTH(k) (IN(k) && IN((k) + 1))
#ifndef REP_MASK
#define REP_MASK 0
#endif
#define REPS(k) for (int rep_ = 0; rep_ <= ((REP_MASK >> (k)) & 1); ++rep_)
#define REP_MORE(k) (rep_ < ((REP_MASK >> (k)) & 1))
#ifndef CG_SEAMS
#define CG_SEAMS 0x000
#endif
#define GRID_BAR(k) do { if ((CG_SEAMS >> (k)) & 1) cg::this_grid().sync(); else xcd_barrier((unsigned*)(AWS + WS_CTL) + CW_BAR, (volatile LAS unsigned*)(F.lds + MISC_OFF) + 8); } while (0)
#define WSP(off) ((bf16_t*)(ws + (off)))
#ifndef SUBREP_MASK
#define SUBREP_MASK 0
#endif
#define SUBREP(k) for (int sr_ = 0; sr_ <= ((SUBREP_MASK >> (k)) & 1); ++sr_)
    if (IN(0)) REPS(0) { p0_prologue(F); if (BOTH(0) || REP_MORE(0)) GRID_BAR(0); }
    if (IN(1)) REPS(1) {
        unsigned char* ws = AWS;
        const int jx = (int)blockIdx.x / 8, spare = F.G / 8 - 30;
        if (F.G != 256 || jx < 30) {
            const int GG = F.G == 256 ? 240 : F.G;
            pg8::Gemm g{WSP(WS_H), WSP(WS_WIN), D, D, D, 0}; pg8::HybridOrder S; S.init(M / 256, INW / 256, D, GG, (int)blockIdx.x, 3);
            pg8::EpiProj E{WSP(WS_PROJ), (const float*)(ws + WS_CS)};
            pg8::gemm_phase(F.lds, g, S, E, pg8::SkBuf{nullptr, nullptr, nullptr});
        } else p0_transposes(F, TR_A, TR_B, (jx - 30) * 8 + (int)blockIdx.x % 8, spare * 8);
        if (BOTH(1) || REP_MORE(1)) GRID_BAR(1);
    }
    if (IN(2)) REPS(2) {
        unsigned char* ws = AWS; float* out = AOUT;
        SUBREP(0) for (int it = F.vcu; it < 256; it += F.G) u_item(F, WSP(WS_PROJ), WSP(WS_UT), it);
        SUBREP(1) pool_tasks(F, WSP(WS_PROJ), AIN(3), WSP(WS_POOLED), out + O_POOLP, out + O_POOLS);
        { const float* st = AIN(2); const float* rw = AIN(7);
          SUBREP(2) for (int it = F.vcu; it < 512; it += F.G) s_item(F, WSP(WS_PROJ), st, rw, out + O_RETS, WSP(WS_MIX), it); }
        if (BOTH(2) || REP_MORE(2)) GRID_BAR(2);
    }
    if (IN(3)) REPS(3) {
        unsigned char* ws = AWS;
#ifdef POOL_TWICE
        { float* out2 = AOUT; pool_tasks(F, WSP(WS_PROJ), AIN(3), WSP(WS_POOLED), out2 + O_POOLP, out2 + O_POOLS); asm volatile("s_waitcnt vmcnt(0)" ::: "memory"); __syncthreads(); }
#endif
        {
        float* out = AOUT; const bf16_t* UT = WSP(WS_UT); bf16_t* SCT = WSP(WS_SCT);
        for (int idx = F.vcu * NTHR + F.tid; idx < 16 * 256 * 32; idx += F.G * NTHR) {
            const int bh = idx >> 13, e = (idx >> 5) & 255, d8 = (idx & 31) * 8;
            const float g128 = __builtin_amdgcn_exp2f(lg2gamma(bh & 3) * 128.f);
            float s[8];
#pragma unroll
            for (int k = 0; k < 8; ++k) s[k] = 0.f;
            u32x4 uv[16];
#pragma unroll
            for (int c = 0; c < 16; ++c) uv[c] = *(const GAS u32x4*)(UT + ((size_t)(bh * 16 + c) * 256 + e) * 256 + d8);
#pragma unroll
            for (int c = 0; c < 16; ++c) {
                u32x4 o; o.x = pk2(s[0], s[1]); o.y = pk2(s[2], s[3]); o.z = pk2(s[4], s[5]); o.w = pk2(s[6], s[7]);
                *(GAS u32x4*)(SCT + ((size_t)(bh * 16 + c) * 256 + e) * 256 + d8) = o;
#pragma unroll
                for (int k = 0; k < 4; ++k) { s[2 * k] = g128 * s[2 * k] + bflo(uv[c][k]); s[2 * k + 1] = g128 * s[2 * k + 1] + bfhi(uv[c][k]); }
            }
            float* op = out + O_RETP + (size_t)bh * 65536 + e;
#pragma unroll
            for (int k = 0; k < 8; ++k) op[(size_t)(d8 + k) * 256] = s[k];
        }
        }
        {
            pg8::Gemm g{WSP(WS_POOLED), WSP(WS_WPOOL), 1024, 256, 256, 256}; pg8::HybridOrder S; S.init(M / 256, 4, 256, F.G, (int)blockIdx.x, 1);
            pg8::EpiPlain E{WSP(WS_MIX), D, 1024, AIN(9)};
            pg8::gemm_phase(F.lds, g, S, E, pg8::SkBuf{nullptr, nullptr, nullptr});
        }
        if (BOTH(3) || REP_MORE(3)) GRID_BAR(3);
    }
    if (IN(4)) REPS(4) {
        unsigned char* ws = AWS; const float* rw = AIN(7);
        for (int it = F.vcu; it < 256; it += F.G) o_item(F, WSP(WS_PROJ), WSP(WS_SCT), rw, WSP(WS_MIX), it);
        if (BOTH(4) || REP_MORE(4)) GRID_BAR(4);
    }
    if (IN(5)) REPS(5) {
        unsigned char* ws = AWS;
        pg8::Gemm g{WSP(WS_MIX), WSP(WS_WOUT), D, D, D, 0}; pg8::HybridOrder S; S.init(M / 256, D / 256, D, F.G, (int)blockIdx.x, SK_RS_P3, SPLIT_MODE);
        pg8::EpiPlain E{WSP(WS_MO), D, 0, nullptr};
        pg8::gemm_phase(F.lds, g, S, E, pg8::SkBuf{(float*)(ws + WS_POOLED), (unsigned*)(ws + WS_CTL) + CW_SK, WSP(WS_PART3)});
        if (BOTH(5) || REP_MORE(5)) GRID_BAR(5);
    }
    if (IN(6)) REPS(6) {
        unsigned char* ws = AWS; float* out = AOUT;
        const float* xp_ = AIN(0); const float* xs_ = AIN(1); const float* w5 = AIN(5); const float* w11 = AIN(11);
        const int gw = F.vcu * NWAVES + F.wave, NGW = F.G * NWAVES;
        for (int m = gw; m < M; m += NGW) { const bool sp = SPLIT_MODE && m >= MP;
            n1_row(xrow_ptr(xp_, xs_, m), sp ? WSP(WS_PART3) + (size_t)(m - MP) * D : WSP(WS_MO) + (size_t)m * D, sp ? 8 : 1, (size_t)1024 * 2048, w5, w11, WSP(WS_MO) + (size_t)m * D, WSP(WS_H) + (size_t)m * D, F.lane); }
        if (BOTH(6) || REP_MORE(6)) GRID_BAR(6);
    }
    if (IN(7)) REPS(7) {
        unsigned char* ws = AWS;
        const int jx = (int)blockIdx.x / 8;
        if (jx < 29) {
            pg8::Gemm g{WSP(WS_H), WSP(WS_WGU), D, D, D, 0}; pg8::HybridOrder S; S.init(M / 256, NGU / 256, D, 232, (int)blockIdx.x, SK_RS_P4);
            pg8::EpiGU E{WSP(WS_HID)};
            pg8::gemm_phase(F.lds, g, S, E, pg8::SkBuf{(float*)(ws + WS_MO), (unsigned*)(ws + WS_CTL) + CW_SK + 16384, nullptr});
        } else p0_transposes(F, TR_B, TR_C, (jx - 29) * 8 + (int)blockIdx.x % 8, 24);
        if (BOTH(7) || REP_MORE(7)) GRID_BAR(7);
    }
    if (IN(8)) REPS(8) {
        unsigned char* ws = AWS;
        pg8::Gemm g{WSP(WS_HID), WSP(WS_WD), DFF, DFF, DFF, 0}; pg8::HybridOrder S; S.init(M / 256, D / 256, DFF, F.G, (int)blockIdx.x, SK_RS_P5, SPLIT_MODE);
        pg8::EpiPlain E{WSP(WS_FF), D, 0, nullptr};
        pg8::gemm_phase(F.lds, g, S, E, pg8::SkBuf{(float*)(ws + WS_POOLED), (unsigned*)(ws + WS_CTL) + CW_SK + 32768, WSP(WS_PART5)});
        if (BOTH(8) || REP_MORE(8)) GRID_BAR(8);
    }
    if (IN(9)) {
        unsigned char* ws = AWS; float* out = AOUT; const float* w12 = AIN(12);
        const int gw = F.vcu * NWAVES + F.wave, NGW = F.G * NWAVES;
        for (int m = gw; m < M; m += NGW) { const bool sp = SPLIT_MODE && m >= MP;
            n2_row(sp ? WSP(WS_PART5) + (size_t)(m - MP) * D : WSP(WS_FF) + (size_t)m * D, sp ? 8 : 1, (size_t)1024 * 2048, w12, WSP(WS_MO) + (size_t)m * D, out + O_Y + (size_t)m * D, F.lane); }
    }
#undef IN
#undef BOTH
}

extern "C" void kernel_launch(void* const* d_in, const int* in_sizes, int n_in, void* d_out, int out_size, void* d_ws, size_t ws_size, hipStream_t stream) {
    static int grid = 0;
    if (grid == 0) {
        if (n_in != 16 || (size_t)out_size != O_END || ws_size < WS_END) { fprintf(stderr, "kernel_launch: unexpected shapes: n_in %d out %d ws %zu (need %zu)\n", n_in, out_size, ws_size, (size_t)WS_END); grid = -1; return; }
        int dev = 0, cus = 0, per_cu = 0;
        if (hipGetDevice(&dev) != hipSuccess || hipDeviceGetAttribute(&cus, hipDeviceAttributeMultiprocessorCount, dev) != hipSuccess) { grid = -1; return; }
        if (hipFuncSetAttribute((const void*)hyb_fwd, hipFuncAttributeMaxDynamicSharedMemorySize, LDS_BYTES) != hipSuccess) { fprintf(stderr, "kernel_launch: hipFuncSetAttribute failed\n"); grid = -1; return; }
        if (hipOccupancyMaxActiveBlocksPerMultiprocessor(&per_cu, (const void*)hyb_fwd, NTHR, LDS_BYTES) != hipSuccess || per_cu < 1) { fprintf(stderr, "kernel_launch: occupancy query says %d\n", per_cu); per_cu = 1; }
        (void)hipGetLastError();
        grid = cus * 1;
        if (SPLIT_MODE && grid != 256) { fprintf(stderr, "kernel_launch: this build's unit schedule needs exactly 256 workgroups (got %d CUs); nothing launched\n", cus); grid = -1; return; }
        fprintf(stderr, "kernel_launch: grid %d (occupancy query %d per CU)\n", grid, per_cu);
    }
    if (grid < 0) return;
    Args a{};
    for (int i = 0; i < 16; ++i) a.in[i] = (const float*)d_in[i];
    a.out = (float*)d_out; a.ws = (unsigned char*)d_ws;
    if (hipMemsetAsync((char*)d_ws + WS_CTL + CTL_MS_OFF, 0, CTL_MS_BYTES, stream) != hipSuccess) { fprintf(stderr, "kernel_launch: memset failed\n"); return; }
    if (MK_N_LAUNCHES == 1) {
        a.ph_lo = 0; a.ph_hi = NPH; a.use_cg = 1;
        void* kargs[] = {&a};
        hipError_t e = hipLaunchCooperativeKernel((const void*)hyb_fwd, dim3(grid), dim3(NTHR), kargs, LDS_BYTES, stream);
        if (e != hipSuccess) fprintf(stderr, "kernel_launch: cooperative launch failed: %s (grid %d)\n", hipGetErrorString(e), grid);
    } else {
        for (int p = 0; p < NPH; ++p) {
            a.ph_lo = p; a.ph_hi = p + 1; a.use_cg = 0;
            hipLaunchKernelGGL(hyb_fwd, dim3(grid), dim3(NTHR), LDS_BYTES, stream, a);
        }
    }
}
```

```cpp
#include <hip/hip_runtime.h>
#include <hip/hip_cooperative_groups.h>
#include <cstdio>
#include <cstdint>
namespace cg = cooperative_groups;

#ifndef NO_MEMSET_NODE
#define NO_MEMSET_NODE 0
#endif
#ifndef TS_SCALE
#define TS_SCALE 1.0f
#endif
#ifndef MK_N_LAUNCHES
#define MK_N_LAUNCHES 1
#endif

#define GAS __attribute__((address_space(1)))
#define LAS __attribute__((address_space(3)))
typedef unsigned short bf16_t;
typedef short bf16x8 __attribute__((ext_vector_type(8)));
typedef float f32x2 __attribute__((ext_vector_type(2)));
typedef float f32x4 __attribute__((ext_vector_type(4)));
typedef float f32x16 __attribute__((ext_vector_type(16)));
typedef unsigned u32x2 __attribute__((ext_vector_type(2)));
typedef unsigned u32x4 __attribute__((ext_vector_type(4)));

constexpr int D = 2048, MP = 8192, MS = 1024, M = MP + MS, SEQ = 2048;
constexpr int INW = 5120, DFF = 5632, NGU = 2 * DFF;
constexpr int PLD = 256;
constexpr size_t PTILE = (size_t)9216 * 256;
constexpr int NPOS = 2048 + 8;
constexpr float EPS = 1e-6f;
constexpr int NWAVES = 8, NTHR = 512;

constexpr size_t O_Y = 0, O_RETP = (size_t)M * D, O_POOLP = O_RETP + 4 * 4 * 65536, O_RETS = O_POOLP + 4 * 15 * 1024, O_POOLS = O_RETS + (size_t)128 * 4 * 65536, O_END = O_POOLS + 128 * 15 * 1024;

constexpr size_t MiB = 1u << 20;
constexpr size_t WS_CTL = 0, CTL_ZERO_BYTES = 1 * MiB;
constexpr size_t CTL_MS_OFF = 16384, CTL_MS_BYTES = 16384;
constexpr size_t WS_CS = 1 * MiB;
constexpr size_t WS_WPOOL = 4 * MiB;
constexpr size_t WS_WIN = 8 * MiB;
constexpr size_t WS_WOUT = 28 * MiB;
constexpr size_t WS_WGU = 36 * MiB;
constexpr size_t WS_WD = 80 * MiB;
constexpr size_t WS_H = 102 * MiB;
constexpr size_t WS_PROJ = 138 * MiB;
constexpr size_t WS_MIX = 228 * MiB;
constexpr size_t WS_UT = 264 * MiB;
constexpr size_t WS_SCT = 296 * MiB;
constexpr size_t WS_POOLED = 328 * MiB;
constexpr size_t WS_MO = 346 * MiB;
constexpr size_t WS_HID = 138 * MiB;
constexpr size_t WS_FF = 382 * MiB;
constexpr size_t WS_PART3 = 264 * MiB;
constexpr size_t WS_PART5 = 296 * MiB;
#ifndef SPLIT_MODE
#define SPLIT_MODE 1
#endif
constexpr size_t WS_END = 418 * MiB;
static_assert(WS_HID + (size_t)M * DFF * 2 <= WS_UT, "hid overlay");

constexpr int CW_SK = 16384;
#ifndef SK_RS_P3
#define SK_RS_P3 2
#endif
#ifndef SK_RS_P4
#define SK_RS_P4 7
#endif
#ifndef SK_RS_P5
#define SK_RS_P5 2
#endif
constexpr int CW_BAR = 4096;
constexpr int LDS_BYTES = 147456;
constexpr int RING_BYTES = 131072, MISC_OFF = RING_BYTES + 320, ARG_OFF = RING_BYTES + 512;

__device__ __forceinline__ unsigned f2bf(float f) { unsigned u = __builtin_bit_cast(unsigned, f); return (u + 0x7fffu + ((u >> 16) & 1u)) >> 16; }
__device__ __forceinline__ unsigned cvt_pk_bf16(float lo, float hi) { unsigned r; asm volatile("v_cvt_pk_bf16_f32 %0, %1, %2" : "=v"(r) : "v"(lo), "v"(hi)); return r; }
__device__ __forceinline__ unsigned pk2(float lo, float hi) { unsigned r; asm("v_cvt_pk_bf16_f32 %0, %1, %2" : "=v"(r) : "v"(lo), "v"(hi)); return r; }
__device__ __forceinline__ float bflo(unsigned w) { return __builtin_bit_cast(float, w << 16); }
__device__ __forceinline__ float bfhi(unsigned w) { return __builtin_bit_cast(float, w & 0xffff0000u); }
__device__ __forceinline__ float bf2f(bf16_t b) { return __builtin_bit_cast(float, (unsigned)b << 16); }
__device__ __forceinline__ float wave_sum(float v) {
#pragma unroll
    for (int o = 1; o < 64; o <<= 1) v += __shfl_xor(v, o);
    return v;
}
__device__ __forceinline__ float silu(float x) { return x * __builtin_amdgcn_rcpf(1.0f + __builtin_amdgcn_exp2f(-1.4426950408889634f * x)); }
__device__ __forceinline__ float lg2gamma(int h) { return h == 0 ? -0.04580368961312479f : h == 1 ? -0.02272007650008353f : h == 2 ? -0.011315313227834146f : -0.005646563141142063f; }
#define LDS_WAIT() asm volatile("s_waitcnt lgkmcnt(0)" ::: "memory")
__device__ __forceinline__ int opaque(int x) { asm volatile("" : "+v"(x)); return x; }

namespace pg8 {
constexpr int BM = 256, BK = 64, HALF = 128, HTB = HALF * BK * 2, STAGE_BYTES = 8 * HTB, NXCD = 8, WGM = 8;
__host__ __device__ __forceinline__ int lds_byte(int r, int c) { const int st = (r >> 4) * 2 + (c >> 5), rr = r & 15, cc = c & 31, ob = rr * 64 + cc * 2; return st * 1024 + (ob ^ (((ob >> 9) & 1) << 5)); }
__host__ __device__ __forceinline__ void stage_rc(int b, int& R, int& C) { const int st = b / 1024, sb = b % 1024, swz = sb ^ (((sb >> 9) & 1) << 5); R = (st >> 1) * 16 + swz / 64; C = (st & 1) * 32 + (swz % 64) / 2; }
__host__ __device__ __forceinline__ int perm32(int rho) { const int n = rho >> 4, i = rho & 15; return 8 * (i >> 2) + 4 * n + (i & 3); }

struct Unit { int pm, pn, kt0, nkt, role; };
struct Gemm { const bf16_t* A; const bf16_t* Bt; int lda, ldb, K, a_pn_col; };
struct HybridOrder {
    int nM, nN, nwg, G, c, Rs, P, n32, q, s, e, mode;
    __device__ void init(int nM_, int nN_, int K, int G_, int c_, int Rs_, int mode_ = 0) {
        mode = mode_; nM = nM_; nN = nN_; nwg = nM * nN; G = G_; c = c_; Rs = Rs_; P = K / (2 * BK); n32 = G / NXCD; q = nwg / NXCD;
        const int Ux = (q - Rs * n32) > 0 ? (q - Rs * n32) : 0, j = c / NXCD; const long T = (long)Ux * P;
        s = (int)((long)j * T / n32); e = (int)((long)(j + 1) * T / n32);
    }
    __device__ void tile(int wgid, Unit& u) const {
        const int nig = WGM * nN, gid = wgid / nig, fm = gid * WGM, gsz = (nM - fm) < WGM ? (nM - fm) : WGM;
        u.pm = fm + ((wgid % nig) % gsz); u.pn = (wgid % nig) / gsz;
    }
    __device__ bool next(int i, Unit& u) const {
        const int x = c % NXCD, j = c / NXCD;
        if (mode == 1) {
            if (i == 0) { u.pm = 8 * (x >> 1) + (j & 7); u.pn = 4 * (x & 1) + (j >> 3); u.kt0 = 0; u.nkt = 2 * P; u.role = 0; return true; }
            if (i == 1) { u.pm = 32 + (j >> 3); u.pn = j & 7; const int lo = x * P / 8, hi = (x + 1) * P / 8; u.kt0 = 2 * lo; u.nkt = 2 * (hi - lo); u.role = 3; return true; }
            return false;
        }
        if (i < Rs) { if (i * n32 + j >= q) return false; tile(x * q + i * n32 + j, u); u.kt0 = 0; u.nkt = 2 * P; u.role = 0; return true; }
        const int uidx = s / P + (i - Rs), lo = s > uidx * P ? s : uidx * P, hi = e < (uidx + 1) * P ? e : (uidx + 1) * P;
        if (lo >= hi) return false;
        tile(x * q + Rs * n32 + uidx, u);
        u.kt0 = 2 * (lo - uidx * P); u.nkt = 2 * (hi - lo); u.role = (lo > uidx * P) ? 1 : ((hi < (uidx + 1) * P) ? 2 : 0);
        return true;
    }
};
struct SkBuf { float* slab; unsigned* flags; bf16_t* part; };

template <class Epi>
__device__ __forceinline__ void gemm_phase(LAS unsigned char* lds, const Gemm g, const HybridOrder& S, const Epi& E, const SkBuf sk) {
    const int tid = threadIdx.x, wid = __builtin_amdgcn_readfirstlane(tid >> 6), lane = tid & 63, wr = wid >> 2, wc = wid & 3, fr = lane & 15, fq = lane >> 4;
    unsigned voffA[2], voffB[2];
#pragma unroll
    for (int i = 0; i < 2; ++i) { int R, C; stage_rc(tid * 16 + i * 8192, R, C); const int Rb = (R & ~31) + perm32(R & 31);
        voffA[i] = (unsigned)(R * g.lda + C) * 2u; voffB[i] = (unsigned)(Rb * g.ldb + C) * 2u; }
    const size_t kstep = (size_t)(BK * 2);
    const size_t hstepA = (size_t)HALF * g.lda * 2, hstepB = (size_t)HALF * g.ldb * 2;
    const unsigned ldsw = (unsigned)wid * 1024u;
    const int aoff = lds_byte(wr * 64 + fr, fq * 8), boff = lds_byte(wc * 32 + fr, fq * 8);
#define PG8_UA(u) ((const char*)g.A + ((size_t)(u).pm * BM * g.lda + (size_t)(u).pn * g.a_pn_col + (size_t)(u).kt0 * BK) * 2)
#define PG8_UB(u) ((const char*)g.Bt + ((size_t)(u).pn * BM * g.ldb + (size_t)(u).kt0 * BK) * 2)
#define PG8_SA(b, h) (((b) * 2 + (h)) * HTB)
#define PG8_SB(b, h) ((4 + (b) * 2 + (h)) * HTB)
#define PG8_STAGE(bufoff, gbase, voff) do { _Pragma("unroll") for (int _i = 0; _i < 2; ++_i) \
        __builtin_amdgcn_global_load_lds((const unsigned*)((const char*)(gbase) + (voff)[_i]), (LAS unsigned*)(lds + (bufoff) + ldsw + _i * 8192), 16, 0, 0); } while (0)
#define PG8_LDA(dst, b, h) do { _Pragma("unroll") for (int m = 0; m < 4; ++m) _Pragma("unroll") for (int k = 0; k < 2; ++k) dst[m][k] = *(const LAS bf16x8*)(lds + PG8_SA(b, h) + aoff + m * 2048 + k * 1024); } while (0)
#define PG8_LDB(dst, b, h) do { _Pragma("unroll") for (int n = 0; n < 2; ++n) _Pragma("unroll") for (int k = 0; k < 2; ++k) dst[n][k] = *(const LAS bf16x8*)(lds + PG8_SB(b, h) + boff + n * 2048 + k * 1024); } while (0)
#define PG8_MMA(ai, bj, At, Bt) do { __builtin_amdgcn_s_setprio(1); _Pragma("unroll") for (int m = 0; m < 4; ++m) _Pragma("unroll") for (int n = 0; n < 2; ++n) _Pragma("unroll") for (int k = 0; k < 2; ++k) \
        acc[ai][bj][m][n] = __builtin_amdgcn_mfma_f32_16x16x32_bf16(Bt[n][k], At[m][k], acc[ai][bj][m][n], 0, 0, 0); __builtin_amdgcn_s_setprio(0); } while (0)
#define PG8_WAIT_V(n) asm volatile("s_waitcnt vmcnt(" #n ")" ::: "memory")
#define PG8_WAIT_L(n) asm volatile("s_waitcnt lgkmcnt(" #n ")" ::: "memory")
#define PG8_BAR __builtin_amdgcn_s_barrier()
#define PG8_SCHED __builtin_amdgcn_sched_barrier(0)
    Unit cur, nxt; int ui = 0;
    if (!S.next(0, cur)) return;
    f32x4 acc[2][2][4][2];
#pragma unroll
    for (int a = 0; a < 2; ++a)
#pragma unroll
        for (int b = 0; b < 2; ++b)
#pragma unroll
            for (int m = 0; m < 4; ++m)
#pragma unroll
                for (int n = 0; n < 2; ++n) acc[a][b][m][n] = (f32x4){0.f, 0.f, 0.f, 0.f};
    bf16x8 At[4][2], B0[2][2], B1[2][2];
    const char* cA = PG8_UA(cur); const char* cB = PG8_UB(cur);
    PG8_STAGE(PG8_SB(0, 0), cB, voffB); PG8_STAGE(PG8_SB(0, 1), cB + hstepB, voffB); PG8_STAGE(PG8_SA(0, 0), cA, voffA); PG8_STAGE(PG8_SA(0, 1), cA + hstepA, voffA);
    if (wr == 1) PG8_BAR;
    PG8_WAIT_V(2); PG8_BAR;
    PG8_STAGE(PG8_SB(1, 0), cB + kstep, voffB); PG8_STAGE(PG8_SA(1, 0), cA + kstep, voffA); PG8_STAGE(PG8_SB(1, 1), cB + hstepB + kstep, voffB);
    PG8_WAIT_V(6); PG8_BAR;
    for (;;) {
        const bool has_next = S.next(ui + 1, nxt);
        const char* nA = has_next ? PG8_UA(nxt) : cA; const char* nB = has_next ? PG8_UB(nxt) : cB;
        const int nt = cur.nkt;
        for (int t = 0; t < nt; t += 2) {
            const bool last = (t == nt - 2);
            const char* a1 = cA + (size_t)(t + 1) * kstep;
            const char* a2 = last ? nA : cA + (size_t)(t + 2) * kstep; const char* b2 = last ? nB : cB + (size_t)(t + 2) * kstep;
            const char* a3 = a2 + kstep; const char* b3 = b2 + kstep;
            PG8_LDB(B0, 0, 0); PG8_LDB(B1, 0, 1); PG8_SCHED; PG8_LDA(At, 0, 0); PG8_STAGE(PG8_SA(1, 1), a1 + hstepA, voffA);
            PG8_WAIT_V(8); PG8_WAIT_L(0); PG8_BAR; PG8_MMA(0, 0, At, B0); PG8_MMA(0, 1, At, B1); PG8_BAR; PG8_SCHED;
            PG8_LDA(At, 0, 1); PG8_STAGE(PG8_SB(0, 0), b2, voffB); PG8_STAGE(PG8_SB(0, 1), b2 + hstepB, voffB); PG8_STAGE(PG8_SA(0, 0), a2, voffA);
            PG8_WAIT_V(8); PG8_WAIT_L(0); PG8_BAR; PG8_MMA(1, 0, At, B0); PG8_MMA(1, 1, At, B1); PG8_BAR; PG8_SCHED;
            PG8_LDB(B0, 1, 0); PG8_LDB(B1, 1, 1); PG8_SCHED; PG8_LDA(At, 1, 0); PG8_STAGE(PG8_SA(0, 1), a2 + hstepA, voffA);
            PG8_WAIT_V(8); PG8_WAIT_L(0); PG8_BAR; PG8_MMA(0, 0, At, B0); PG8_MMA(0, 1, At, B1); PG8_BAR; PG8_SCHED;
            PG8_LDA(At, 1, 1); PG8_STAGE(PG8_SB(1, 0), b3, voffB); PG8_STAGE(PG8_SB(1, 1), b3 + hstepB, voffB); PG8_STAGE(PG8_SA(1, 0), a3, voffA);
            PG8_WAIT_V(8); PG8_WAIT_L(0); PG8_BAR; PG8_MMA(1, 0, At, B0); PG8_MMA(1, 1, At, B1); PG8_BAR; PG8_SCHED;
        }
        if (wr == 0) PG8_BAR;
        if (cur.role == 1) {
            const __amdgpu_buffer_rsrc_t rs = __builtin_amdgcn_make_buffer_rsrc(sk.slab, 0, 0x7fffffff, 0x00020000);
            const unsigned base = ((unsigned)S.c * 16384u + (unsigned)opaque(tid)) * 16u;
#pragma unroll
            for (int a = 0; a < 2; ++a)
#pragma unroll
                for (int b = 0; b < 2; ++b)
#pragma unroll
                    for (int m = 0; m < 4; ++m)
#pragma unroll
                        for (int n = 0; n < 2; ++n)
                            __builtin_amdgcn_raw_buffer_store_b128(__builtin_bit_cast(u32x4, acc[a][b][m][n]), rs, base + (unsigned)(((a * 2 + b) * 4 + m) * 2 + n) * 8192u, 0, 16);
            PG8_WAIT_V(0); PG8_BAR;
            if (tid == 0) __hip_atomic_store(sk.flags + 64 * S.c, 1u, __ATOMIC_RELAXED, __HIP_MEMORY_SCOPE_AGENT);
        } else if (cur.role == 3) {
            bf16_t* O = sk.part + (size_t)(S.c % NXCD) * 1024 * 2048;
            const int row0 = (cur.pm - 32) * BM + wr * 64 + fr, col0 = cur.pn * BM + wc * 32 + 8 * fq;
#pragma unroll
            for (int ai = 0; ai < 2; ++ai)
#pragma unroll
                for (int m = 0; m < 4; ++m) {
                    bf16_t* rp = O + (size_t)(row0 + ai * HALF + m * 16) * 2048 + col0;
#pragma unroll
                    for (int bj = 0; bj < 2; ++bj) {
                        u32x4 wv; wv.x = cvt_pk_bf16(acc[ai][bj][m][0][0], acc[ai][bj][m][0][1]); wv.y = cvt_pk_bf16(acc[ai][bj][m][0][2], acc[ai][bj][m][0][3]);
                        wv.z = cvt_pk_bf16(acc[ai][bj][m][1][0], acc[ai][bj][m][1][1]); wv.w = cvt_pk_bf16(acc[ai][bj][m][1][2], acc[ai][bj][m][1][3]);
                        *(u32x4*)(rp + bj * HALF) = wv;
                    }
                }
        } else {
            E(acc, cur, wr, wc, fr, fq);
        }
        if (!has_next) break;
        if (nxt.role == 2) {
            const int pc = S.c + NXCD;
            if (wid == 0) {
                unsigned spins = 0;
                while (__builtin_amdgcn_readfirstlane(__hip_atomic_load(sk.flags + 64 * pc, __ATOMIC_RELAXED, __HIP_MEMORY_SCOPE_AGENT)) == 0u) { __builtin_amdgcn_s_sleep(2); if (++spins > (1u << 22)) break; }
                __builtin_amdgcn_fence(__ATOMIC_ACQUIRE, "agent");
                PG8_WAIT_V(0);
            }
            asm volatile("" ::: "memory"); PG8_BAR; asm volatile("" ::: "memory");
            const f32x4* sl = (const f32x4*)sk.slab + (size_t)pc * 16384 + opaque(tid);
#pragma unroll
            for (int a = 0; a < 2; ++a)
#pragma unroll
                for (int b = 0; b < 2; ++b)
#pragma unroll
                    for (int m = 0; m < 4; ++m)
#pragma unroll
                        for (int n = 0; n < 2; ++n) acc[a][b][m][n] = *(const GAS f32x4*)(sl + (((a * 2 + b) * 4 + m) * 2 + n) * 512);
#pragma unroll
            for (int a = 0; a < 2; ++a)
#pragma unroll
                for (int b = 0; b < 2; ++b)
#pragma unroll
                    for (int m = 0; m < 4; ++m)
#pragma unroll
                        for (int n = 0; n < 2; ++n) asm volatile("" : "+v"(acc[a][b][m][n]));
        } else {
#pragma unroll
        for (int a = 0; a < 2; ++a)
#pragma unroll
            for (int b = 0; b < 2; ++b)
#pragma unroll
                for (int m = 0; m < 4; ++m)
#pragma unroll
                    for (int n = 0; n < 2; ++n) acc[a][b][m][n] = (f32x4){0.f, 0.f, 0.f, 0.f};
        }
        cur = nxt; cA = nA; cB = nB; ++ui;
        if (wr == 1) PG8_BAR;
    }
    PG8_WAIT_V(0);
    PG8_BAR;
#undef PG8_UA
#undef PG8_UB
#undef PG8_SA
#undef PG8_SB
#undef PG8_STAGE
#undef PG8_LDA
#undef PG8_LDB
#undef PG8_MMA
#undef PG8_WAIT_V
#undef PG8_WAIT_L
#undef PG8_BAR
#undef PG8_SCHED
}

__device__ __forceinline__ void st8(bf16_t* p, const f32x4 v0, const f32x4 v1) {
    u32x4 w; w.x = cvt_pk_bf16(v0[0], v0[1]); w.y = cvt_pk_bf16(v0[2], v0[3]); w.z = cvt_pk_bf16(v1[0], v1[1]); w.w = cvt_pk_bf16(v1[2], v1[3]);
    *(u32x4*)p = w;
}
struct EpiProj {
    bf16_t* P; const float* cs;
    __device__ __forceinline__ void operator()(const f32x4 (&acc)[2][2][4][2], const Unit& u, int wr, int wc, int fr, int fq) const {
        const int row0 = u.pm * BM + wr * 64 + fr, type = u.pn >> 2, cl = wc * 32 + 8 * fq;
        bf16_t* Pt = P + (size_t)u.pn * PTILE + cl;
#ifdef ABL_NO_ROPE
        if (false) {
#else
        if (type <= 1) {
#endif
            const float sc = type == 1 ? 0.0625f : 1.0f;
#pragma unroll
            for (int ai = 0; ai < 2; ++ai)
#pragma unroll
                for (int m = 0; m < 4; ++m) {
                    const int row = row0 + ai * HALF + m * 16;
                    const int pidx = row < MP ? (row & (SEQ - 1)) : SEQ + ((row - MP) & 7);
                    const f32x4* t = (const f32x4*)cs + (size_t)(cl >> 3) * 4 * NPOS + pidx;
                    const f32x4 t0 = t[0], t1 = t[NPOS], t2 = t[2 * NPOS], t3 = t[3 * NPOS];
                    const f32x4 x1a = acc[ai][0][m][0], x1b = acc[ai][0][m][1], x2a = acc[ai][1][m][0], x2b = acc[ai][1][m][1];
                    f32x4 o1a, o1b, o2a, o2b;
                    o1a[0] = (x1a[0] * t0[0] - x2a[0] * t0[1]) * sc; o2a[0] = (x2a[0] * t0[0] + x1a[0] * t0[1]) * sc;
                    o1a[1] = (x1a[1] * t0[2] - x2a[1] * t0[3]) * sc; o2a[1] = (x2a[1] * t0[2] + x1a[1] * t0[3]) * sc;
                    o1a[2] = (x1a[2] * t1[0] - x2a[2] * t1[1]) * sc; o2a[2] = (x2a[2] * t1[0] + x1a[2] * t1[1]) * sc;
                    o1a[3] = (x1a[3] * t1[2] - x2a[3] * t1[3]) * sc; o2a[3] = (x2a[3] * t1[2] + x1a[3] * t1[3]) * sc;
                    o1b[0] = (x1b[0] * t2[0] - x2b[0] * t2[1]) * sc; o2b[0] = (x2b[0] * t2[0] + x1b[0] * t2[1]) * sc;
                    o1b[1] = (x1b[1] * t2[2] - x2b[1] * t2[3]) * sc; o2b[1] = (x2b[1] * t2[2] + x1b[1] * t2[3]) * sc;
                    o1b[2] = (x1b[2] * t3[0] - x2b[2] * t3[1]) * sc; o2b[2] = (x2b[2] * t3[0] + x1b[2] * t3[1]) * sc;
                    o1b[3] = (x1b[3] * t3[2] - x2b[3] * t3[3]) * sc; o2b[3] = (x2b[3] * t3[2] + x1b[3] * t3[3]) * sc;
                    bf16_t* rp = Pt + (size_t)row * PLD;
                    st8(rp, o1a, o1b); st8(rp + HALF, o2a, o2b);
                }
        } else {
            const bool act = type == 3;
#pragma unroll
            for (int ai = 0; ai < 2; ++ai)
#pragma unroll
                for (int m = 0; m < 4; ++m) {
                    bf16_t* rp = Pt + (size_t)(row0 + ai * HALF + m * 16) * PLD;
#pragma unroll
                    for (int bj = 0; bj < 2; ++bj) {
                        f32x4 v0 = acc[ai][bj][m][0], v1 = acc[ai][bj][m][1];
                        if (act) {
#pragma unroll
                            for (int i = 0; i < 4; ++i) { v0[i] = silu(v0[i]); v1[i] = silu(v1[i]); }
                        }
                        st8(rp + bj * HALF, v0, v1);
                    }
                }
        }
    }
};
struct EpiPlain {
    bf16_t* O; int ldc, coff; const float* scale;
    __device__ __forceinline__ void operator()(const f32x4 (&acc)[2][2][4][2], const Unit& u, int wr, int wc, int fr, int fq) const {
        const int row0 = u.pm * BM + wr * 64 + fr, cl = wc * 32 + 8 * fq, col0 = u.pn * BM + cl;
        f32x4 s[2][2];
#pragma unroll
        for (int bj = 0; bj < 2; ++bj)
#pragma unroll
            for (int n = 0; n < 2; ++n) s[bj][n] = scale ? *(const f32x4*)(scale + col0 + bj * HALF + 4 * n) : (f32x4){1.f, 1.f, 1.f, 1.f};
#pragma unroll
        for (int ai = 0; ai < 2; ++ai)
#pragma unroll
            for (int m = 0; m < 4; ++m) {
                bf16_t* rp = O + (size_t)(row0 + ai * HALF + m * 16) * ldc + coff + col0;
#pragma unroll
                for (int bj = 0; bj < 2; ++bj) st8(rp + bj * HALF, acc[ai][bj][m][0] * s[bj][0], acc[ai][bj][m][1] * s[bj][1]);
            }
    }
};
struct EpiGU {
    bf16_t* Hd;
    __device__ __forceinline__ void operator()(const f32x4 (&acc)[2][2][4][2], const Unit& u, int wr, int wc, int fr, int fq) const {
        const int row0 = u.pm * BM + wr * 64 + fr, cl = wc * 32 + 8 * fq, col0 = u.pn * HALF + cl;
#pragma unroll
        for (int ai = 0; ai < 2; ++ai)
#pragma unroll
            for (int m = 0; m < 4; ++m) {
                f32x4 v0, v1;
#pragma unroll
                for (int i = 0; i < 4; ++i) { v0[i] = silu(acc[ai][0][m][0][i]) * acc[ai][1][m][0][i]; v1[i] = silu(acc[ai][0][m][1][i]) * acc[ai][1][m][1][i]; }
                st8(Hd + (size_t)(row0 + ai * HALF + m * 16) * DFF + col0, v0, v1);
            }
    }
};
}

#define XB_TMO      128
#define XB_XCNT(j)  (256  + 64 * (j))
#define XB_XSUB(j)  (1280 + 64 * (j))
#define XB_XGEN(j)  (2304 + 64 * (j))
#define XB_TOP      3328
#define XB_TOPGEN   3392
#define XCD_BAR_WORDS 3456
#define XB_SPIN_CAP (1u << 18)
__device__ __forceinline__ unsigned xb_ld(unsigned* p)              { return __hip_atomic_load(p, __ATOMIC_RELAXED, __HIP_MEMORY_SCOPE_AGENT); }
__device__ __forceinline__ unsigned xb_add(unsigned* p, unsigned v) { return __hip_atomic_fetch_add(p, v, __ATOMIC_RELAXED, __HIP_MEMORY_SCOPE_AGENT); }
__device__ __forceinline__ unsigned xb_xcc_id() { return (unsigned)__builtin_amdgcn_s_getreg((3 << 11) | 20) & 0xFu; }
#define XB_SPIN(cond, bar) do { unsigned _sp = 0; while (cond) { __builtin_amdgcn_s_sleep(1); \
    if ((++_sp & 255u) == 0u) { if (xb_ld(&(bar)[XB_TMO])) break; if (_sp > XB_SPIN_CAP) { atomicAdd(&(bar)[XB_TMO], 1u); break; } } } } while (0)
__device__ __forceinline__ void xcd_barrier_post(unsigned* bar) {
    if (threadIdx.x == 0) (void)xb_add(&bar[XB_XCNT(xb_xcc_id())], 1u);
}
__device__ __forceinline__ void xcd_barrier_complete(unsigned* bar, unsigned x, unsigned& nloc, unsigned& nx) {
    const unsigned G = gridDim.x * gridDim.y * gridDim.z;
    unsigned sum, cnt, mine, sp = 0u;
    for (;;) {
        sum = 0u; cnt = 0u; mine = 0u;
#pragma unroll
        for (unsigned j = 0; j < 16; ++j) { const unsigned c = xb_ld(&bar[XB_XCNT(j)]); sum += c; cnt += (c > 0u) ? 1u : 0u; mine = (j == x) ? c : mine; }
        if (sum == G) break;
        __builtin_amdgcn_s_sleep(1);
        if ((++sp & 255u) == 0u) { if (xb_ld(&bar[XB_TMO])) break; if (sp > XB_SPIN_CAP) { atomicAdd(&bar[XB_TMO], 1u); break; } }
    }
    nloc = mine > 0u ? mine : 1u; nx = cnt > 0u ? cnt : 1u;
}
__device__ __forceinline__ void xcd_barrier(unsigned* bar, volatile LAS unsigned* st) {
    asm volatile("s_waitcnt vmcnt(0)" ::: "memory");
    __syncthreads();
    if (threadIdx.x == 0) {
        const unsigned x = xb_xcc_id();
        __builtin_amdgcn_s_waitcnt(0);
        unsigned nloc = st[0], nx = st[1];
        if (nloc == 0u) { xcd_barrier_complete(bar, x, nloc, nx); st[0] = nloc; st[1] = nx; }
        const unsigned old = xb_add(&bar[XB_XSUB(x)], 1u);
        const unsigned gen = old / nloc;
        if (old + 1u == (gen + 1u) * nloc) {
            __builtin_amdgcn_fence(__ATOMIC_RELEASE, "agent");
            asm volatile("s_waitcnt vmcnt(0)" ::: "memory");
            const unsigned og = xb_add(&bar[XB_TOP], 1u);
            const unsigned tg = og / nx;
            if (og + 1u == (tg + 1u) * nx) xb_add(&bar[XB_TOPGEN], 1u);
            else XB_SPIN(xb_ld(&bar[XB_TOPGEN]) == tg, bar);
            __builtin_amdgcn_fence(__ATOMIC_ACQUIRE, "agent");
            xb_add(&bar[XB_XGEN(x)], 1u);
            asm volatile("s_waitcnt vmcnt(0)" ::: "memory");
        } else {
            XB_SPIN(xb_ld(&bar[XB_XGEN(x)]) == gen, bar);
            __builtin_amdgcn_fence(__ATOMIC_ACQUIRE, "agent");
            asm volatile("s_waitcnt vmcnt(0)" ::: "memory");
        }
    }
    __syncthreads();
}

struct Args { const float* in[16]; float* out; unsigned char* ws; int ph_lo, ph_hi, use_cg, pad; };

struct Frame {
    LAS unsigned char* lds;
    int tid, lane, wave, vcu, G;
};
__device__ __forceinline__ const float* ldarg(const Frame& F, int k) {
    const volatile LAS unsigned* p = (const volatile LAS unsigned*)(F.lds + ARG_OFF) + 2 * k;
    const unsigned lo = __builtin_amdgcn_readfirstlane(p[0]), hi = __builtin_amdgcn_readfirstlane(p[1]);
    return (const float*)(((unsigned long long)hi << 32) | lo);
}
#define AIN(k) ldarg(F, (k))
#define AOUT ((float*)ldarg(F, 16))
#define AWS ((unsigned char*)ldarg(F, 17))

struct TrItem { const float* W; bf16_t* WT; int K, N, mode, k0, n0; };
constexpr int TR_IN = (D / 64) * (INW / 256), TR_OUT = (D / 64) * (D / 256), TR_G = (D / 64) * (DFF / 256), TR_D = (DFF / 64) * (D / 256);
struct P0Ptrs { const float *w_in, *w_out, *w_gate, *w_up, *w_down, *w_pool; unsigned char* ws; };
__device__ __forceinline__ TrItem p0_decode(const P0Ptrs& a, unsigned char* ws, int it) {
    TrItem t; int r = it, nblk;
    if (r < TR_IN) { t.W = a.w_in; t.WT = (bf16_t*)(ws + WS_WIN); t.K = D; t.N = INW; t.mode = 0; }
    else if ((r -= TR_IN) < TR_OUT) { t.W = a.w_out; t.WT = (bf16_t*)(ws + WS_WOUT); t.K = D; t.N = D; t.mode = 0; }
    else if ((r -= TR_OUT) < 16) { const int g = r >> 2; r &= 3; t.W = a.w_pool + (size_t)g * 65536; t.WT = (bf16_t*)(ws + WS_WPOOL) + (size_t)g * 65536; t.K = 256; t.N = 256; t.mode = 0; }
    else if ((r -= 16) < TR_G) { t.W = a.w_gate; t.WT = (bf16_t*)(ws + WS_WGU); t.K = D; t.N = DFF; t.mode = 1; }
    else if ((r -= TR_G) < TR_G) { t.W = a.w_up; t.WT = (bf16_t*)(ws + WS_WGU); t.K = D; t.N = DFF; t.mode = 2; }
    else { r -= TR_G; t.W = a.w_down; t.WT = (bf16_t*)(ws + WS_WD); t.K = DFF; t.N = D; t.mode = 0; }
    nblk = t.N >> 8; t.k0 = 64 * (r / nblk); t.n0 = 256 * (r % nblk);
    return t;
}
constexpr int P0_NITEMS = TR_IN + TR_OUT + 16 + 2 * TR_G + TR_D;
constexpr int TR_B = TR_IN + TR_OUT + 16 + 2 * TR_G, TR_C = P0_NITEMS;
#ifndef TR_P1_ITEMS
#define TR_P1_ITEMS 800
#endif
constexpr int TR_A = TR_B - TR_P1_ITEMS;
__device__ __forceinline__ void p0_transposes(Frame& F, int it_begin, int it_end, int worker, int nworkers) {
    P0Ptrs a; a.w_in = AIN(6); a.w_out = AIN(10); a.w_gate = AIN(13); a.w_up = AIN(14); a.w_down = AIN(15); a.w_pool = AIN(8); a.ws = AWS;
    unsigned char* ws = a.ws;
    LAS float* buf = (LAS float*)F.lds;
    const int w = F.wave, l = opaque(F.lane);
#define TR_LOAD(V, T) do { _Pragma("unroll") for (int i = 0; i < 8; ++i) V[i] = *(const GAS f32x4*)((T).W + (size_t)((T).k0 + 8 * w + i) * (T).N + (T).n0 + 4 * l); } while (0)
#define TR_STEP(V, CUR) do { \
        _Pragma("unroll") for (int i = 0; i < 8; ++i) *(LAS f32x4*)(buf + (8 * w + i) * 260 + ((4 * l) ^ (4 * (w & 7)))) = V[i]; \
        __syncthreads(); \
        const TrItem cur_ = (CUR); \
        const int nit_ = it + 2 * nworkers; \
        if (nit_ < it_end) { (CUR) = p0_decode(a, ws, nit_); TR_LOAD(V, (CUR)); } \
        const int ko = l & 7; \
        _Pragma("unroll") for (int sidx = 0; sidx < 4; ++sidx) { \
            const int nl = 32 * w + 8 * sidx + (l >> 3), n = cur_.n0 + nl; \
            const LAS float* p = buf + (8 * ko) * 260 + (nl ^ (4 * ko)); \
            u32x4 o; o.x = pk2(p[0], p[260]); o.y = pk2(p[2 * 260], p[3 * 260]); o.z = pk2(p[4 * 260], p[5 * 260]); o.w = pk2(p[6 * 260], p[7 * 260]); \
            const int row = cur_.mode == 0 ? n : (256 * (n >> 7) + (n & 127) + (cur_.mode == 2 ? 128 : 0)); \
            *(GAS u32x4*)(cur_.WT + (size_t)row * cur_.K + cur_.k0 + 8 * ko) = o; } \
        __syncthreads(); } while (0)
    int it = it_begin + worker;
    if (it >= it_end) return;
    TrItem tA = p0_decode(a, ws, it), tB = tA;
    f32x4 vA[8], vB[8];
    TR_LOAD(vA, tA);
    if (it + nworkers < it_end) { tB = p0_decode(a, ws, it + nworkers); TR_LOAD(vB, tB); }
    for (;;) {
        TR_STEP(vA, tA);
        it += nworkers; if (it >= it_end) break;
        TR_STEP(vB, tB);
        it += nworkers; if (it >= it_end) break;
    }
#undef TR_LOAD
#undef TR_STEP
}
__device__ __forceinline__ void rms_row_to_bf16(const float* xrow, const float* w, bf16_t* orow, int lane) {
    const GAS f32x4* xr = (const GAS f32x4*)xrow + lane; const GAS f32x4* wr = (const GAS f32x4*)w + lane;
    f32x4 v[8]; float s = 0.f;
#pragma unroll
    for (int j = 0; j < 8; ++j) { v[j] = xr[64 * j]; s += (v[j].x * v[j].x + v[j].y * v[j].y) + (v[j].z * v[j].z + v[j].w * v[j].w); }
    const float rstd = 1.0f / sqrtf(wave_sum(s) * (1.f / D) + EPS);
    GAS u32x2* o8 = (GAS u32x2*)orow + lane;
#pragma unroll
    for (int j = 0; j < 8; ++j) { const f32x4 ww = wr[64 * j]; u32x2 o; o.x = pk2(v[j].x * rstd * ww.x, v[j].y * rstd * ww.y); o.y = pk2(v[j].z * rstd * ww.z, v[j].w * rstd * ww.w); o8[64 * j] = o; }
}
__device__ __forceinline__ const float* xrow_ptr(const float* xp, const float* xs, int m) { return m < MP ? xp + (size_t)m * D : xs + (size_t)(m - MP) * D; }

__device__ __forceinline__ void p0_prologue(Frame& F) {
    p0_transposes(F, 0, TR_A, F.vcu, F.G);
    unsigned char* ws = AWS;
    const int gw = F.vcu * NWAVES + F.wave, NGW = F.G * NWAVES;
    const float* xp_ = AIN(0); const float* xs_ = AIN(1); const float* nw_ = AIN(4);
    for (int m = gw; m < M; m += NGW) rms_row_to_bf16(xrow_ptr(xp_, xs_, m), nw_, (bf16_t*)(ws + WS_H) + (size_t)m * D, F.lane);
    float* cs = (float*)(ws + WS_CS);
    for (int idx = F.vcu * NTHR + F.tid; idx < NPOS * 128; idx += F.G * NTHR) {
        const int p = idx >> 7, j = idx & 127;
        double r = 0.930572040929699, inv = 1.0;
#pragma unroll
        for (int b = 0; b < 7; ++b) { if ((j >> b) & 1) inv *= r; r *= r; }
        const float invf = (float)inv;
        const float pos = (float)(p < SEQ ? p : 16384 + (p - SEQ));
        const float ang = pos * invf;
        double t = (double)ang * 0.15915494309189535; t -= __builtin_rint(t);
        const float tf = (float)t;
        f32x2 o; o.x = __builtin_amdgcn_cosf(tf); o.y = __builtin_amdgcn_sinf(tf);
        *(f32x2*)(cs + ((size_t)(((j >> 3) * 4 + ((j & 7) >> 1)) * NPOS + p)) * 4 + (j & 1) * 2) = o;
    }
}

__device__ __forceinline__ unsigned toff(int r, int c16, int RB) { return (unsigned)(r * RB + ((((c16 & ~15) | ((c16 ^ r ^ (r >> 4)) & 15))) << 4)); }
#define MFMA32(a, b, c) __builtin_amdgcn_mfma_f32_32x32x16_bf16((a), (b), (c), 0, 0, 0)
__device__ __forceinline__ int crow(int reg, int h) { return (reg & 3) + 8 * (reg >> 2) + 4 * h; }
__device__ __forceinline__ bf16x8 frag(const LAS unsigned char* tile, int r, int c16, int RB) { return *(const LAS bf16x8*)(tile + toff(r, c16, RB)); }

__device__ __forceinline__ void load_nat128(LAS unsigned char* dst, const bf16_t* src, int ld, int tid) {
    tid = opaque(tid);
    u32x4 v[4];
#pragma unroll
    for (int it = 0; it < 4; ++it) { const int idx = tid + it * NTHR, r = idx >> 4, c = idx & 15; v[it] = *(const GAS u32x4*)(src + (size_t)r * ld + c * 8); }
#pragma unroll
    for (int it = 0; it < 4; ++it) { const int idx = tid + it * NTHR, r = idx >> 4, c = idx & 15; *(LAS u32x4*)(dst + toff(r, c, 256)) = v[it]; }
}
template <bool SCALE>
__device__ __forceinline__ void load_tr(LAS unsigned char* dst, const bf16_t* src, int ld, int tid, float sc_a, float sc_b) {
    tid = opaque(tid);
#pragma unroll
    for (int it = 0; it < 4; ++it) {
        const int T = it * NTHR + tid, ch_lo = T & 15, pp = (T >> 4) & 3, half = (T >> 6) & 1, quad = T >> 7;
        const int pair = 4 * quad + pp, chunk = 16 * half + ch_lo, j0 = 2 * pair, d0 = 8 * chunk;
        const u32x4 a = *(const GAS u32x4*)(src + (size_t)j0 * ld + d0), b = *(const GAS u32x4*)(src + (size_t)(j0 + 1) * ld + d0);
        float s0 = 1.f, s1 = 1.f;
        if (SCALE) { s0 = __builtin_amdgcn_exp2f(sc_a * (sc_b - (float)j0)); s1 = __builtin_amdgcn_exp2f(sc_a * (sc_b - (float)(j0 + 1))); }
#pragma unroll
        for (int i = 0; i < 8; ++i) {
            const unsigned wa = a[i >> 1], wb = b[i >> 1];
            unsigned w;
            if (SCALE) { const float fa = ((i & 1) ? bfhi(wa) : bflo(wa)) * s0, fb = ((i & 1) ? bfhi(wb) : bflo(wb)) * s1; w = pk2(fa, fb); }
            else w = (i & 1) ? ((wa >> 16) | (wb & 0xffff0000u)) : ((wa & 0xffffu) | (wb << 16));
            const int d = d0 + i;
            *(LAS unsigned*)(dst + toff(d, quad, 256) + pp * 4) = w;
        }
    }
}

__device__ __forceinline__ void u_item(Frame& F, const bf16_t* PROJ, bf16_t* UT, int item) {
    const int b = item >> 6, h = (item >> 4) & 3, c = item & 15, rows0 = b * SEQ + c * 128;
    const bf16_t* Ks = PROJ + (size_t)(4 + h) * PTILE + (size_t)rows0 * PLD; const bf16_t* Vs = Ks + 4 * PTILE;
    LAS unsigned char* KT = F.lds; LAS unsigned char* VT = F.lds + 65536;
    const float lg = lg2gamma(h);
    load_tr<true>(KT, Ks, PLD, F.tid, lg, 127.f);
    load_tr<false>(VT, Vs, PLD, F.tid, 0.f, 0.f);
    __syncthreads();
    const int w = F.wave, r = opaque(F.lane) & 31, hh = opaque(F.lane) >> 5;
    bf16_t* Up = UT + ((size_t)((b * 4 + h) * 16 + c) * 256) * 256;
#pragma unroll 1
    for (int eh = 0; eh < 2; ++eh) {
        f32x16 acc[4];
#pragma unroll
        for (int t = 0; t < 4; ++t)
#pragma unroll
            for (int i = 0; i < 16; ++i) acc[t][i] = 0.f;
#pragma unroll 1
        for (int ks = 0; ks < 8; ++ks) {
            const bf16x8 a = frag(KT, 32 * w + r, 2 * ks + hh, 256);
#pragma unroll
            for (int et = 0; et < 4; ++et) { const bf16x8 bb = frag(VT, 32 * (4 * eh + et) + r, 2 * ks + hh, 256); acc[et] = MFMA32(a, bb, acc[et]); }
        }
#pragma unroll
        for (int et = 0; et < 4; ++et)
#pragma unroll
            for (int g = 0; g < 4; ++g) {
                u32x2 o; o.x = cvt_pk_bf16(acc[et][4 * g], acc[et][4 * g + 1]); o.y = cvt_pk_bf16(acc[et][4 * g + 2], acc[et][4 * g + 3]);
                *(GAS u32x2*)(Up + (size_t)(32 * (4 * eh + et) + r) * 256 + 32 * w + 8 * g + 4 * hh) = o;
            }
    }
    __syncthreads();
}

__device__ __forceinline__ void o_item(Frame& F, const bf16_t* PROJ, const bf16_t* SCT, const float* retw, bf16_t* MIX, int item) {
    const int b = item >> 6, h = (item >> 4) & 3, c = item & 15, rows0 = b * SEQ + c * 128;
    const bf16_t* Qs = PROJ + (size_t)h * PTILE + (size_t)rows0 * PLD; const bf16_t* Ks = Qs + 4 * PTILE; const bf16_t* Vs = Qs + 8 * PTILE; const bf16_t* Gs = Qs + 12 * PTILE;
    LAS unsigned char* QF = F.lds; LAS unsigned char* KH = F.lds + 65536; LAS unsigned char* PB = F.lds + 98304; LAS unsigned char* VT = F.lds; LAS unsigned char* OB = F.lds;
    const float lg = lg2gamma(h);
    const int w = F.wave; int r = opaque(F.lane) & 31, hh = opaque(F.lane) >> 5; const int tid = opaque(F.tid);
    u32x4 qv[8], kv[4]; bf16x8 sfr[16];
#pragma unroll
    for (int it = 0; it < 8; ++it) { const int idx = tid + it * NTHR, rr = idx >> 5, cc = idx & 31; qv[it] = *(const GAS u32x4*)(Qs + (size_t)rr * PLD + cc * 8); }
#pragma unroll
    for (int it = 0; it < 4; ++it) { const int idx = tid + it * NTHR, rr = idx >> 4, cc = idx & 15; kv[it] = *(const GAS u32x4*)(Ks + (size_t)rr * PLD + cc * 8); }
    {
        const bf16_t* Sp = SCT + ((size_t)((b * 4 + h) * 16 + c) * 256) * 256 + (size_t)(32 * w + r) * 256 + 8 * hh;
#pragma unroll
        for (int ks = 0; ks < 16; ++ks) sfr[ks] = *(const GAS bf16x8*)(Sp + 16 * ks);
    }
#pragma unroll
    for (int it = 0; it < 8; ++it) { const int idx = tid + it * NTHR, rr = idx >> 5, cc = idx & 31; *(LAS u32x4*)(QF + toff(rr, cc, 512)) = qv[it]; }
#pragma unroll
    for (int it = 0; it < 4; ++it) { const int idx = tid + it * NTHR, rr = idx >> 4, cc = idx & 15; *(LAS u32x4*)(KH + toff(rr, cc, 256)) = kv[it]; }
    __syncthreads();
#pragma unroll
    for (int it = 0; it < 4; ++it) { const int idx = tid + it * NTHR, rr = idx >> 4, cc = idx & 15; kv[it] = *(const GAS u32x4*)(Ks + 128 + (size_t)rr * PLD + cc * 8); }
    const int ib_s = w >> 1, jb0 = 2 * (w & 1);
    f32x16 sc[2];
#pragma unroll
    for (int t = 0; t < 2; ++t)
#pragma unroll
        for (int i = 0; i < 16; ++i) sc[t][i] = 0.f;
    if (jb0 <= ib_s) {
#pragma unroll 1
        for (int ks = 0; ks < 8; ++ks) {
            const bf16x8 a = frag(QF, 32 * ib_s + r, 2 * ks + hh, 512);
            const bf16x8 b0 = frag(KH, 32 * jb0 + r, 2 * ks + hh, 256), b1 = frag(KH, 32 * (jb0 + 1) + r, 2 * ks + hh, 256);
            sc[0] = MFMA32(a, b0, sc[0]); sc[1] = MFMA32(a, b1, sc[1]);
        }
    }
    __syncthreads();
#pragma unroll
    for (int it = 0; it < 4; ++it) { const int idx = tid + it * NTHR, rr = idx >> 4, cc = idx & 15; *(LAS u32x4*)(KH + toff(rr, cc, 256)) = kv[it]; }
    __syncthreads();
    u32x4 va[4], vb[4];
#pragma unroll
    for (int it = 0; it < 4; ++it) {
        const int T = it * NTHR + tid, ch_lo = T & 15, pp = (T >> 4) & 3, half = (T >> 6) & 1, quad = T >> 7;
        const int pair = 4 * quad + pp, chunk = 16 * half + ch_lo, j0 = 2 * pair, d0 = 8 * chunk;
        va[it] = *(const GAS u32x4*)(Vs + (size_t)j0 * PLD + d0); vb[it] = *(const GAS u32x4*)(Vs + (size_t)(j0 + 1) * PLD + d0);
    }
    if (jb0 <= ib_s) {
#pragma unroll 1
        for (int ks = 0; ks < 8; ++ks) {
            const bf16x8 a = frag(QF, 32 * ib_s + r, 16 + 2 * ks + hh, 512);
            const bf16x8 b0 = frag(KH, 32 * jb0 + r, 2 * ks + hh, 256), b1 = frag(KH, 32 * (jb0 + 1) + r, 2 * ks + hh, 256);
            sc[0] = MFMA32(a, b0, sc[0]); sc[1] = MFMA32(a, b1, sc[1]);
        }
    }
    r = opaque(r); hh = opaque(hh);
#pragma unroll
    for (int t = 0; t < 2; ++t) {
        const int j = 32 * (jb0 + t) + r;
#pragma unroll
        for (int reg = 0; reg < 16; ++reg) {
            const int i = 32 * ib_s + crow(reg, hh);
            const float v = (i >= j) ? sc[t][reg] * __builtin_amdgcn_exp2f(lg * (float)(i - j)) : 0.f;
            *(LAS bf16_t*)(PB + toff(i, j >> 3, 256) + (j & 7) * 2) = (bf16_t)f2bf(v);
        }
    }
    f32x16 o[4];
#pragma unroll
    for (int t = 0; t < 4; ++t)
#pragma unroll
        for (int i = 0; i < 16; ++i) o[t][i] = 0.f;
    r = opaque(r); hh = opaque(hh);
#pragma unroll
    for (int ks = 0; ks < 16; ++ks) {
#pragma unroll
        for (int ib = 0; ib < 4; ++ib) { const bf16x8 a = frag(QF, 32 * ib + r, 2 * ks + hh, 512); o[ib] = MFMA32(a, sfr[ks], o[ib]); }
    }
#pragma unroll
    for (int ib = 0; ib < 4; ++ib)
#pragma unroll
        for (int reg = 0; reg < 16; ++reg) o[ib][reg] *= __builtin_amdgcn_exp2f(lg * (float)(32 * ib + crow(reg, hh) + 1));
    __syncthreads();
#pragma unroll
    for (int it = 0; it < 4; ++it) {
        const int T = it * NTHR + tid, ch_lo = T & 15, pp = (T >> 4) & 3, half = (T >> 6) & 1, quad = T >> 7;
        const int chunk = 16 * half + ch_lo, d0 = 8 * chunk;
#pragma unroll
        for (int i = 0; i < 8; ++i) {
            const unsigned wa = va[it][i >> 1], wb = vb[it][i >> 1];
            const unsigned wv = (i & 1) ? ((wa >> 16) | (wb & 0xffff0000u)) : ((wa & 0xffffu) | (wb << 16));
            *(LAS unsigned*)(VT + toff(d0 + i, quad, 256) + pp * 4) = wv;
        }
    }
    __syncthreads();
    r = opaque(r); hh = opaque(hh);
#pragma unroll 1
    for (int ks = 0; ks < 8; ++ks) {
        const bf16x8 bb = frag(VT, 32 * w + r, 2 * ks + hh, 256);
#pragma unroll
        for (int ib = 0; ib < 4; ++ib)
            if (ks < 2 * (ib + 1)) { const bf16x8 a = frag(PB, 32 * ib + r, 2 * ks + hh, 256); o[ib] = MFMA32(a, bb, o[ib]); }
    }
    __syncthreads();
    r = opaque(r); hh = opaque(hh);
#pragma unroll
    for (int ib = 0; ib < 4; ++ib)
#pragma unroll
        for (int reg = 0; reg < 16; ++reg) { const int i = 32 * ib + crow(reg, hh);
            *(LAS bf16_t*)(OB + i * 512 + (32 * w + r) * 2) = (bf16_t)f2bf(o[ib][reg]); }
    __syncthreads();
    {
        const int tid2 = opaque(F.tid), cc = tid2 & 31;
        const f32x4 wa = *(const GAS f32x4*)(retw + h * 256 + cc * 8), wb = *(const GAS f32x4*)(retw + h * 256 + cc * 8 + 4);
        u32x4 gv[8];
#pragma unroll
        for (int it = 0; it < 8; ++it) gv[it] = *(const GAS u32x4*)(Gs + (size_t)((tid2 >> 5) + 16 * it) * PLD + cc * 8);
#pragma unroll
        for (int it = 0; it < 8; ++it) {
            const int i = (tid2 >> 5) + 16 * it;
            const u32x4 ov = *(const LAS u32x4*)(OB + i * 512 + cc * 16);
            float x[8];
#pragma unroll
            for (int k = 0; k < 4; ++k) { x[2 * k] = bflo(ov[k]); x[2 * k + 1] = bfhi(ov[k]); }
            float sq = 0.f;
#pragma unroll
            for (int k = 0; k < 8; ++k) sq += x[k] * x[k];
            sq += __shfl_xor(sq, 1); sq += __shfl_xor(sq, 2); sq += __shfl_xor(sq, 4); sq += __shfl_xor(sq, 8); sq += __shfl_xor(sq, 16);
            const float rstd = 1.0f / sqrtf(sq * (1.f / 256.f) + EPS);
            u32x4 res;
            res[0] = pk2(x[0] * rstd * wa[0] * bflo(gv[it][0]), x[1] * rstd * wa[1] * bfhi(gv[it][0]));
            res[1] = pk2(x[2] * rstd * wa[2] * bflo(gv[it][1]), x[3] * rstd * wa[3] * bfhi(gv[it][1]));
            res[2] = pk2(x[4] * rstd * wb[0] * bflo(gv[it][2]), x[5] * rstd * wb[1] * bfhi(gv[it][2]));
            res[3] = pk2(x[6] * rstd * wb[2] * bflo(gv[it][3]), x[7] * rstd * wb[3] * bfhi(gv[it][3]));
            *(GAS u32x4*)(MIX + (size_t)(rows0 + i) * D + h * 256 + cc * 8) = res;
        }
    }
    __syncthreads();
}

__device__ __forceinline__ void s_item(Frame& F, const bf16_t* PROJ, const float* state, const float* retw, float* newstate, bf16_t* MIX, int item) {
    const int sb = item >> 2, h = item & 3, rows0 = MP + sb * 8;
    const float lg = lg2gamma(h);
    LAS float* QK = (LAS float*)F.lds;
    LAS float* QR = (LAS float*)(F.lds + 16384);
    LAS float* KR = (LAS float*)(F.lds + 16384 + 8224);
    LAS float* SCP = (LAS float*)(F.lds + 16384 + 2 * 8224);
    LAS float* SCO = (LAS float*)(F.lds + 16384 + 2 * 8224 + 2048);
    LAS float* RED = (LAS float*)(F.lds + 40960);
    const int w = opaque(F.wave), l = opaque(F.lane), tid_o = opaque(F.tid);
    {
        const int isk = tid_o >> 8, i = (tid_o >> 5) & 7, d8 = (tid_o & 31) * 8;
        const u32x4 raw = *(const GAS u32x4*)(PROJ + (size_t)(isk * 4 + h) * PTILE + (size_t)(rows0 + i) * PLD + d8);
        float f[8];
#pragma unroll
        for (int q = 0; q < 4; ++q) { f[2 * q] = bflo(raw[q]); f[2 * q + 1] = bfhi(raw[q]); }
        const float sc = __builtin_amdgcn_exp2f(lg * (float)(isk ? 7 - i : i + 1));
        LAS float* R = isk ? KR : QR;
#pragma unroll
        for (int k = 0; k < 8; ++k) { R[i * 257 + d8 + k] = f[k]; QK[(d8 + k) * 16 + isk * 8 + i] = f[k] * sc; }
    }
    float v[8][4];
#pragma unroll
    for (int j = 0; j < 8; ++j) { const u32x2 t = *(const GAS u32x2*)(PROJ + (size_t)(8 + h) * PTILE + (size_t)(rows0 + j) * PLD + 4 * l); v[j][0] = bflo(t.x); v[j][1] = bfhi(t.x); v[j][2] = bflo(t.y); v[j][3] = bfhi(t.y); }
    __syncthreads();
    {
        const int i = l >> 3, j = l & 7; float s = 0.f;
#pragma unroll 8
        for (int d = 32 * w; d < 32 * w + 32; ++d) s += QR[i * 257 + d] * KR[j * 257 + d];
        SCP[w * 64 + l] = s;
    }
    float oacc[8][4];
#pragma unroll
    for (int i = 0; i < 8; ++i)
#pragma unroll
        for (int c = 0; c < 4; ++c) oacc[i][c] = 0.f;
    const float g8 = __builtin_amdgcn_exp2f(lg * 8.f);
    const GAS f32x4* Sp = (const GAS f32x4*)(state + ((size_t)(sb * 4 + h) * 256 + 32 * w) * 256) + l;
    GAS f32x4* Np = (GAS f32x4*)(newstate + ((size_t)(sb * 4 + h) * 256 + 32 * w) * 256) + l;
    f32x4 sA[4], sB[4];
#define S_LOAD4(dst, row0) do { const GAS f32x4* p0_ = Sp + (size_t)(row0) * 64; asm volatile("" : "+v"(p0_)); \
        _Pragma("unroll") for (int k = 0; k < 4; ++k) dst[k] = p0_[k * 64]; } while (0)
#define S_COMP4(src, row0) do { GAS f32x4* n0_ = Np + (size_t)(row0) * 64; asm volatile("" : "+v"(n0_)); \
        _Pragma("unroll") for (int k = 0; k < 4; ++k) { \
            const LAS f32x4* qk = (const LAS f32x4*)(QK + (32 * w + (row0) + k) * 16); \
            const f32x4 qa = qk[0], qb = qk[1], ka = qk[2], kb = qk[3]; f32x4 n; \
            _Pragma("unroll") for (int c = 0; c < 4; ++c) { const float sv = src[k][c]; \
                oacc[0][c] += qa[0] * sv; oacc[1][c] += qa[1] * sv; oacc[2][c] += qa[2] * sv; oacc[3][c] += qa[3] * sv; \
                oacc[4][c] += qb[0] * sv; oacc[5][c] += qb[1] * sv; oacc[6][c] += qb[2] * sv; oacc[7][c] += qb[3] * sv; \
                float t = g8 * sv; \
                t += ka[0] * v[0][c]; t += ka[1] * v[1][c]; t += ka[2] * v[2][c]; t += ka[3] * v[3][c]; \
                t += kb[0] * v[4][c]; t += kb[1] * v[5][c]; t += kb[2] * v[6][c]; t += kb[3] * v[7][c]; n[c] = t; } \
            n0_[k * 64] = n; \
            if (k & 1) asm volatile("" ::: "memory"); } } while (0)
    S_LOAD4(sA, 0);
#pragma unroll 1
    for (int h2 = 0; h2 < 4; ++h2) {
        S_LOAD4(sB, 8 * h2 + 4);
        S_COMP4(sA, 8 * h2);
        if (h2 < 3) S_LOAD4(sA, 8 * h2 + 8);
        S_COMP4(sB, 8 * h2 + 4);
    }
#undef S_LOAD4
#undef S_COMP4
#pragma unroll
    for (int i = 0; i < 8; ++i) *(LAS f32x4*)(RED + (w * 8 + i) * 256 + 4 * l) = (f32x4){oacc[i][0], oacc[i][1], oacc[i][2], oacc[i][3]};
    __syncthreads();
    if (tid_o < 64) { const int i = l >> 3, j = l & 7; float s = 0.f;
#pragma unroll
        for (int ww = 0; ww < 8; ++ww) s += SCP[ww * 64 + l];
        SCO[l] = (i >= j) ? s * __builtin_amdgcn_exp2f(lg * (float)(i - j)) : 0.f; }
    __syncthreads();
    {
        const int i = w; f32x4 tot = (f32x4){0.f, 0.f, 0.f, 0.f};
#pragma unroll
        for (int ww = 0; ww < 8; ++ww) tot += *(const LAS f32x4*)(RED + (ww * 8 + i) * 256 + 4 * l);
#pragma unroll
        for (int j = 0; j < 8; ++j) { const float s = SCO[i * 8 + j];
#pragma unroll
            for (int c = 0; c < 4; ++c) tot[c] += s * v[j][c]; }
        const float ss = wave_sum((tot[0] * tot[0] + tot[1] * tot[1]) + (tot[2] * tot[2] + tot[3] * tot[3]));
        const float rstd = 1.0f / sqrtf(ss * (1.f / 256.f) + EPS);
        const f32x4 wn = *(const GAS f32x4*)(retw + h * 256 + 4 * l);
        const u32x2 gv = *(const GAS u32x2*)(PROJ + (size_t)(12 + h) * PTILE + (size_t)(rows0 + i) * PLD + 4 * l);
        u32x2 res; res.x = pk2(tot[0] * rstd * wn[0] * bflo(gv.x), tot[1] * rstd * wn[1] * bfhi(gv.x)); res.y = pk2(tot[2] * rstd * wn[2] * bflo(gv.y), tot[3] * rstd * wn[3] * bfhi(gv.y));
        *(GAS u32x2*)(MIX + (size_t)(rows0 + i) * D + h * 256 + 4 * l) = res;
    }
    __syncthreads();
}

__device__ __forceinline__ void unpk8(const u32x4 v, float (&f)[8]) {
#pragma unroll
    for (int q = 0; q < 4; ++q) { f[2 * q] = bflo(v[q]); f[2 * q + 1] = bfhi(v[q]); }
}
template <int W>
__device__ __forceinline__ void pool_prompt_blk(const bf16_t* PROJ, bf16_t* POOLED, float* outp, int rb, int ch) {
    const int m0 = rb * 8, t0 = m0 & (SEQ - 1), bseq = m0 >> 11;
    const bf16_t* U = PROJ + (size_t)(16 + (ch >> 8)) * PTILE + (ch & 255);
    u32x4 x[W + 7];
#pragma unroll
    for (int i = 0; i < W + 7; ++i) { const int t = t0 - (W - 1) + i; const int mi = (t >= 0) ? m0 - (W - 1) + i : m0; x[i] = *(const GAS u32x4*)(U + (size_t)mi * PLD); }
#pragma unroll
    for (int i = 0; i < W - 1; ++i) { const int t = t0 - (W - 1) + i; if (t < 0) x[i] = (u32x4){0u, 0u, 0u, 0u}; }
    float sum[8];
#pragma unroll
    for (int k = 0; k < 8; ++k) sum[k] = 0.f;
#pragma unroll
    for (int i = 0; i < W - 1; ++i) { float f[8]; unpk8(x[i], f);
#pragma unroll
        for (int k = 0; k < 8; ++k) sum[k] += f[k]; }
#pragma unroll
    for (int r = 0; r < 8; ++r) {
        float cur[8]; unpk8(x[W - 1 + r], cur);
#pragma unroll
        for (int k = 0; k < 8; ++k) sum[k] += cur[k];
        const int t = t0 + r; const int cnt = (t + 1 < W) ? t + 1 : W; const float inv = 1.0f / (float)cnt;
        u32x4 o;
#pragma unroll
        for (int q = 0; q < 4; ++q) o[q] = pk2(sum[2 * q] * inv - cur[2 * q], sum[2 * q + 1] * inv - cur[2 * q + 1]);
        *(GAS u32x4*)(POOLED + (size_t)(m0 + r) * 1024 + ch) = o;
        float sub[8]; unpk8(x[r], sub);
#pragma unroll
        for (int k = 0; k < 8; ++k) sum[k] -= sub[k];
        if (t >= SEQ - 15) { float* op = outp + ((size_t)bseq * 15 + (t - (SEQ - 15))) * 1024 + ch;
            *(GAS f32x4*)op = (f32x4){cur[0], cur[1], cur[2], cur[3]}; *(GAS f32x4*)(op + 4) = (f32x4){cur[4], cur[5], cur[6], cur[7]}; }
    }
}
template <int W>
__device__ __forceinline__ void pool_sample_blk(const bf16_t* PROJ, const float* spool, bf16_t* POOLED, float* outs, int sb, int ch) {
    const bf16_t* U = PROJ + (size_t)(16 + (ch >> 8)) * PTILE + (size_t)(MP + sb * 8) * PLD + (ch & 255);
    const float* B = spool + (size_t)sb * 15 * 1024 + ch;
    f32x4 ba[W - 1], bb[W - 1]; u32x4 xn[8]; f32x4 ca[7], cb[7];
#pragma unroll
    for (int i = 0; i < W - 1; ++i) { ba[i] = *(const GAS f32x4*)(B + (size_t)(15 - (W - 1) + i) * 1024); bb[i] = *(const GAS f32x4*)(B + (size_t)(15 - (W - 1) + i) * 1024 + 4); }
#pragma unroll
    for (int r = 0; r < 8; ++r) xn[r] = *(const GAS u32x4*)(U + (size_t)r * PLD);
#pragma unroll
    for (int rr = 0; rr < 7; ++rr) { ca[rr] = *(const GAS f32x4*)(B + (size_t)(8 + rr) * 1024); cb[rr] = *(const GAS f32x4*)(B + (size_t)(8 + rr) * 1024 + 4); }
    float sum[8];
#pragma unroll
    for (int k = 0; k < 8; ++k) sum[k] = 0.f;
#pragma unroll
    for (int i = 0; i < W - 1; ++i)
#pragma unroll
        for (int q = 0; q < 4; ++q) { sum[q] += ba[i][q]; sum[4 + q] += bb[i][q]; }
    const float inv = 1.0f / (float)W;
#pragma unroll
    for (int r = 0; r < 8; ++r) {
        float cur[8]; unpk8(xn[r], cur);
#pragma unroll
        for (int k = 0; k < 8; ++k) sum[k] += cur[k];
        u32x4 o;
#pragma unroll
        for (int q = 0; q < 4; ++q) o[q] = pk2(sum[2 * q] * inv - cur[2 * q], sum[2 * q + 1] * inv - cur[2 * q + 1]);
        *(GAS u32x4*)(POOLED + (size_t)(MP + sb * 8 + r) * 1024 + ch) = o;
        if (r < W - 1) {
#pragma unroll
            for (int q = 0; q < 4; ++q) { sum[q] -= ba[r < W - 1 ? r : 0][q]; sum[4 + q] -= bb[r < W - 1 ? r : 0][q]; }
        } else { float sub[8]; unpk8(xn[r >= W - 1 ? r - (W - 1) : 0], sub);
#pragma unroll
            for (int k = 0; k < 8; ++k) sum[k] -= sub[k]; }
        float* op = outs + ((size_t)sb * 15 + 7 + r) * 1024 + ch;
        *(GAS f32x4*)op = (f32x4){cur[0], cur[1], cur[2], cur[3]}; *(GAS f32x4*)(op + 4) = (f32x4){cur[4], cur[5], cur[6], cur[7]};
    }
#pragma unroll
    for (int rr = 0; rr < 7; ++rr) { float* op = outs + ((size_t)sb * 15 + rr) * 1024 + ch; *(GAS f32x4*)op = ca[rr]; *(GAS f32x4*)(op + 4) = cb[rr]; }
}
__device__ __forceinline__ void pool_tasks(Frame& F, const bf16_t* PROJ, const float* spool, bf16_t* POOLED, float* outp, float* outs) {
    for (int gt = F.vcu * NTHR + opaque(F.tid); gt < 1024 * 128; gt += F.G * NTHR) {
        const int cgp = gt & 31, rbl = (gt >> 5) & 1, grp = (gt >> 6) & 3, rb = (gt >> 8) * 2 + rbl, ch = grp * 256 + cgp * 8;
        if (grp == 0) pool_prompt_blk<2>(PROJ, POOLED, outp, rb, ch); else if (grp == 1) pool_prompt_blk<4>(PROJ, POOLED, outp, rb, ch);
        else if (grp == 2) pool_prompt_blk<8>(PROJ, POOLED, outp, rb, ch); else pool_prompt_blk<16>(PROJ, POOLED, outp, rb, ch);
    }
    if (F.G * 64 >= 128 * 128 ? F.tid < 64 : true)
    for (int gt = (F.G * 64 >= 128 * 128) ? F.vcu * 64 + opaque(F.tid) : F.vcu * NTHR + opaque(F.tid); gt < 128 * 128; gt += (F.G * 64 >= 128 * 128) ? F.G * 64 : F.G * NTHR) {
        const int cgp = gt & 31, sbl = (gt >> 5) & 1, grp = (gt >> 6) & 3, sb = (gt >> 8) * 2 + sbl, ch = grp * 256 + cgp * 8;
        if (grp == 0) pool_sample_blk<2>(PROJ, spool, POOLED, outs, sb, ch); else if (grp == 1) pool_sample_blk<4>(PROJ, spool, POOLED, outs, sb, ch);
        else if (grp == 2) pool_sample_blk<8>(PROJ, spool, POOLED, outs, sb, ch); else pool_sample_blk<16>(PROJ, spool, POOLED, outs, sb, ch);
    }
}

__device__ __forceinline__ void load_row_bf16(const bf16_t* row, int nparts, size_t pstride, int lane, float (&f)[4][8]) {
#pragma unroll
    for (int j = 0; j < 4; ++j)
#pragma unroll
        for (int q = 0; q < 8; ++q) f[j][q] = 0.f;
    for (int p = 0; p < nparts; ++p) {
        u32x4 v[4];
#pragma unroll
        for (int j = 0; j < 4; ++j) v[j] = *(const GAS u32x4*)(row + (size_t)p * pstride + 8 * lane + 512 * j);
#pragma unroll
        for (int j = 0; j < 4; ++j)
#pragma unroll
            for (int q = 0; q < 4; ++q) { f[j][2 * q] += bflo(v[j][q]); f[j][2 * q + 1] += bfhi(v[j][q]); }
    }
}
__device__ __forceinline__ void n1_row(const float* xrow, const bf16_t* mo, int nparts, size_t pstride, const float* wpost, const float* wpre, bf16_t* x1row, bf16_t* hrow, int lane) {
    f32x4 xa[4], xb[4]; float s = 0.f;
#pragma unroll
    for (int j = 0; j < 4; ++j) { const int c = 8 * lane + 512 * j; xa[j] = *(const GAS f32x4*)(xrow + c); xb[j] = *(const GAS f32x4*)(xrow + c + 4); }
    float mf[4][8];
    load_row_bf16(mo, nparts, pstride, lane, mf);
#pragma unroll
    for (int j = 0; j < 4; ++j)
#pragma unroll
        for (int q = 0; q < 8; ++q) s += mf[j][q] * mf[j][q];
    const float r1 = 1.0f / sqrtf(wave_sum(s) * (1.f / D) + EPS);
    float s2 = 0.f;
#pragma unroll
    for (int j = 0; j < 4; ++j) { const int c = 8 * lane + 512 * j; const f32x4 wa = *(const GAS f32x4*)(wpost + c), wb = *(const GAS f32x4*)(wpost + c + 4);
#pragma unroll
        for (int q = 0; q < 4; ++q) { xa[j][q] += mf[j][q] * r1 * wa[q]; xb[j][q] += mf[j][4 + q] * r1 * wb[q]; s2 += xa[j][q] * xa[j][q] + xb[j][q] * xb[j][q]; }
        { u32x4 o1; o1.x = pk2(xa[j][0], xa[j][1]); o1.y = pk2(xa[j][2], xa[j][3]); o1.z = pk2(xb[j][0], xb[j][1]); o1.w = pk2(xb[j][2], xb[j][3]); *(GAS u32x4*)(x1row + c) = o1; } }
    const float r2 = 1.0f / sqrtf(wave_sum(s2) * (1.f / D) + EPS);
#pragma unroll
    for (int j = 0; j < 4; ++j) { const int c = 8 * lane + 512 * j; const f32x4 wa = *(const GAS f32x4*)(wpre + c), wb = *(const GAS f32x4*)(wpre + c + 4);
        u32x4 o; o.x = pk2(xa[j][0] * r2 * wa[0], xa[j][1] * r2 * wa[1]); o.y = pk2(xa[j][2] * r2 * wa[2], xa[j][3] * r2 * wa[3]);
        o.z = pk2(xb[j][0] * r2 * wb[0], xb[j][1] * r2 * wb[1]); o.w = pk2(xb[j][2] * r2 * wb[2], xb[j][3] * r2 * wb[3]);
        *(GAS u32x4*)(hrow + c) = o; }
}
__device__ __forceinline__ void n2_row(const bf16_t* ff, int nparts, size_t pstride, const float* wpost, const bf16_t* x1row, float* yrow, int lane) {
    float s = 0.f; float ffl[4][8];
    load_row_bf16(ff, nparts, pstride, lane, ffl);
#pragma unroll
    for (int j = 0; j < 4; ++j)
#pragma unroll
        for (int q = 0; q < 8; ++q) s += ffl[j][q] * ffl[j][q];
    const float r1 = 1.0f / sqrtf(wave_sum(s) * (1.f / D) + EPS);
#pragma unroll
    for (int j = 0; j < 4; ++j) { const int c = 8 * lane + 512 * j; const f32x4 wa = *(const GAS f32x4*)(wpost + c), wb = *(const GAS f32x4*)(wpost + c + 4);
        const u32x4 xv = *(const GAS u32x4*)(x1row + c);
        f32x4 ya = (f32x4){bflo(xv.x), bfhi(xv.x), bflo(xv.y), bfhi(xv.y)}, yb = (f32x4){bflo(xv.z), bfhi(xv.z), bflo(xv.w), bfhi(xv.w)};
#pragma unroll
        for (int q = 0; q < 4; ++q) { ya[q] += ffl[j][q] * r1 * wa[q]; yb[q] += ffl[j][4 + q] * r1 * wb[q]; }
        *(GAS f32x4*)(yrow + c) = ya; *(GAS f32x4*)(yrow + c + 4) = yb; }
}

constexpr int NPH = 10;
__global__ void __launch_bounds__(NTHR, 2) hyb_fwd(Args args) {
    extern __shared__ __attribute__((aligned(16))) unsigned char lds[];
    Frame F;
    F.lds = (LAS unsigned char*)lds;
    F.tid = threadIdx.x; F.lane = F.tid & 63; F.wave = __builtin_amdgcn_readfirstlane(F.tid >> 6);
    F.G = gridDim.x; { const int bx = blockIdx.x; F.vcu = (F.G % 8 == 0) ? (bx % 8) * (F.G / 8) + bx / 8 : bx; }
    if (F.tid == 0) {
        volatile LAS unsigned long long* at = (volatile LAS unsigned long long*)(F.lds + ARG_OFF);
#pragma unroll
        for (int i = 0; i < 16; ++i) at[i] = (unsigned long long)args.in[i];
        at[16] = (unsigned long long)args.out; at[17] = (unsigned long long)args.ws;
    }
    const int lo = args.ph_lo, hi = args.ph_hi;
    if (F.tid < 32) ((volatile LAS unsigned*)(F.lds + MISC_OFF))[F.tid] = 0u;
    __syncthreads();
#if NO_MEMSET_NODE
    if (blockIdx.x == 0) { unsigned* bw = (unsigned*)(AWS + WS_CTL) + CW_BAR; for (int i = F.tid; i < XCD_BAR_WORDS; i += NTHR) __hip_atomic_store(bw + i, 0u, __ATOMIC_RELAXED, __HIP_MEMORY_SCOPE_AGENT); }
#else
    if (args.use_cg) xcd_barrier_post((unsigned*)(AWS + WS_CTL) + CW_BAR);
#endif
    if (args.pad == 0x5a5a5a5a) cg::this_grid().sync();
#ifndef PH_ENABLE
#define PH_ENABLE 0x3ff
#endif
#define IN(k) (((PH_ENABLE >> (k)) & 1) && lo <= (k) && (k) < hi)
#define BOTH(k) (IN(k) && IN((k) + 1))
#ifndef REP_MASK
#define REP_MASK 0
#endif
#define REPS(k) for (int rep_ = 0; rep_ <= ((REP_MASK >> (k)) & 1); ++rep_)
#define REP_MORE(k) (rep_ < ((REP_MASK >> (k)) & 1))
#ifndef CG_SEAMS
#define CG_SEAMS (NO_MEMSET_NODE ? 0x001 : 0x000)
#endif
#define GRID_BAR(k) do { if ((CG_SEAMS >> (k)) & 1) cg::this_grid().sync(); else xcd_barrier((unsigned*)(AWS + WS_CTL) + CW_BAR, (volatile LAS unsigned*)(F.lds + MISC_OFF) + 8); } while (0)
#define WSP(off) ((bf16_t*)(ws + (off)))
#ifdef TS_PHASE
#define TS_MARK(k) do { if (blockIdx.x == 0 && F.tid == 0) ((volatile LAS unsigned long long*)(F.lds + ARG_OFF + 256))[(k)] = __builtin_amdgcn_s_memrealtime(); } while (0)
#else
#define TS_MARK(k) do {} while (0)
#endif
    TS_MARK(0);
#ifndef SUBREP_MASK
#define SUBREP_MASK 0
#endif
#define SUBREP(k) for (int sr_ = 0; sr_ <= ((SUBREP_MASK >> (k)) & 1); ++sr_)
    if (IN(0)) REPS(0) { p0_prologue(F); if (BOTH(0) || REP_MORE(0)) GRID_BAR(0); TS_MARK(1); }
#if NO_MEMSET_NODE
    if (args.use_cg) xcd_barrier_post((unsigned*)(AWS + WS_CTL) + CW_BAR);
#endif
    if (IN(1)) REPS(1) {
        unsigned char* ws = AWS;
        const int jx = (int)blockIdx.x / 8, spare = F.G / 8 - 30;
        if (F.G != 256 || jx < 30) {
            const int GG = F.G == 256 ? 240 : F.G;
            pg8::Gemm g{WSP(WS_H), WSP(WS_WIN), D, D, D, 0}; pg8::HybridOrder S; S.init(M / 256, INW / 256, D, GG, (int)blockIdx.x, 3);
            pg8::EpiProj E{WSP(WS_PROJ), (const float*)(ws + WS_CS)};
            pg8::gemm_phase(F.lds, g, S, E, pg8::SkBuf{nullptr, nullptr, nullptr});
        }
#ifndef ABL_NO_CONV1
        else p0_transposes(F, TR_A, TR_B, (jx - 30) * 8 + (int)blockIdx.x % 8, spare * 8);
#endif
        if (BOTH(1) || REP_MORE(1)) GRID_BAR(1); TS_MARK(2);
    }
    if (IN(2)) REPS(2) {
        unsigned char* ws = AWS; float* out = AOUT;
#pragma unroll 1
        for (int step = 0; step < 2; ++step) {
            if (((step ^ F.vcu) & 1) == 0) {
                for (int it = F.vcu; it < 256; it += F.G) u_item(F, WSP(WS_PROJ), WSP(WS_UT), it);
                pool_tasks(F, WSP(WS_PROJ), AIN(3), WSP(WS_POOLED), out + O_POOLP, out + O_POOLS);
            } else {
                const float* st = AIN(2); const float* rw = AIN(7);
                for (int it = F.vcu; it < 512; it += F.G) s_item(F, WSP(WS_PROJ), st, rw, out + O_RETS, WSP(WS_MIX), it);
            }
        }
        if (BOTH(2) || REP_MORE(2)) GRID_BAR(2); TS_MARK(3);
    }
    if (IN(3)) REPS(3) {
        unsigned char* ws = AWS;
#ifdef POOL_TWICE
        { float* out2 = AOUT; pool_tasks(F, WSP(WS_PROJ), AIN(3), WSP(WS_POOLED), out2 + O_POOLP, out2 + O_POOLS); asm volatile("s_waitcnt vmcnt(0)" ::: "memory"); __syncthreads(); }
#endif
        {
        float* out = AOUT; const bf16_t* UT = WSP(WS_UT); bf16_t* SCT = WSP(WS_SCT);
        for (int idx = F.vcu * NTHR + F.tid; idx < 16 * 256 * 32; idx += F.G * NTHR) {
            const int bh = idx >> 13, e = (idx >> 5) & 255, d8 = (idx & 31) * 8;
            const float g128 = __builtin_amdgcn_exp2f(lg2gamma(bh & 3) * 128.f);
            float s[8];
#pragma unroll
            for (int k = 0; k < 8; ++k) s[k] = 0.f;
            u32x4 uv[16];
#pragma unroll
            for (int c = 0; c < 16; ++c) uv[c] = *(const GAS u32x4*)(UT + ((size_t)(bh * 16 + c) * 256 + e) * 256 + d8);
#pragma unroll
            for (int c = 0; c < 16; ++c) {
                u32x4 o; o.x = pk2(s[0], s[1]); o.y = pk2(s[2], s[3]); o.z = pk2(s[4], s[5]); o.w = pk2(s[6], s[7]);
                *(GAS u32x4*)(SCT + ((size_t)(bh * 16 + c) * 256 + e) * 256 + d8) = o;
#pragma unroll
                for (int k = 0; k < 4; ++k) { s[2 * k] = g128 * s[2 * k] + bflo(uv[c][k]); s[2 * k + 1] = g128 * s[2 * k + 1] + bfhi(uv[c][k]); }
            }
            float* op = out + O_RETP + (size_t)bh * 65536 + e;
#pragma unroll
            for (int k = 0; k < 8; ++k) op[(size_t)(d8 + k) * 256] = s[k];
        }
        }
        TS_MARK(13);
        {
            pg8::Gemm g{WSP(WS_POOLED), WSP(WS_WPOOL), 1024, 256, 256, 256}; pg8::HybridOrder S; S.init(M / 256, 4, 256, F.G, (int)blockIdx.x, 1);
            pg8::EpiPlain E{WSP(WS_MIX), D, 1024, AIN(9)};
            pg8::gemm_phase(F.lds, g, S, E, pg8::SkBuf{nullptr, nullptr, nullptr});
        }
        TS_MARK(14);
        if (BOTH(3) || REP_MORE(3)) GRID_BAR(3); TS_MARK(4);
    }
    if (IN(4)) REPS(4) {
        unsigned char* ws = AWS; const float* rw = AIN(7);
        for (int it = F.vcu; it < 256; it += F.G) o_item(F, WSP(WS_PROJ), WSP(WS_SCT), rw, WSP(WS_MIX), it);
        TS_MARK(15);
#ifdef ABL_O_TWICE
        for (int it = F.vcu; it < 256; it += F.G) o_item(F, WSP(WS_PROJ), WSP(WS_SCT), rw, WSP(WS_MIX), (it + 128) & 255);
        TS_MARK(16);
#endif
        if (BOTH(4) || REP_MORE(4)) GRID_BAR(4); TS_MARK(5);
    }
    if (IN(5)) REPS(5) {
        unsigned char* ws = AWS;
        pg8::Gemm g{WSP(WS_MIX), WSP(WS_WOUT), D, D, D, 0}; pg8::HybridOrder S; S.init(M / 256, D / 256, D, F.G, (int)blockIdx.x, SK_RS_P3, SPLIT_MODE);
        pg8::EpiPlain E{WSP(WS_MO), D, 0, nullptr};
        pg8::gemm_phase(F.lds, g, S, E, pg8::SkBuf{(float*)(ws + WS_POOLED), (unsigned*)(ws + WS_CTL) + CW_SK, WSP(WS_PART3)});
        if (BOTH(5) || REP_MORE(5)) GRID_BAR(5); TS_MARK(6);
    }
    if (IN(6)) REPS(6) {
        unsigned char* ws = AWS; float* out = AOUT;
        const float* xp_ = AIN(0); const float* xs_ = AIN(1); const float* w5 = AIN(5); const float* w11 = AIN(11);
        const int gw = F.vcu * NWAVES + F.wave, NGW = F.G * NWAVES;
        for (int m = gw; m < M; m += NGW) { const bool sp = SPLIT_MODE && m >= MP;
            n1_row(xrow_ptr(xp_, xs_, m), sp ? WSP(WS_PART3) + (size_t)(m - MP) * D : WSP(WS_MO) + (size_t)m * D, sp ? 8 : 1, (size_t)1024 * 2048, w5, w11, WSP(WS_MO) + (size_t)m * D, WSP(WS_H) + (size_t)m * D, F.lane); }
        if (BOTH(6) || REP_MORE(6)) GRID_BAR(6); TS_MARK(7);
    }
    if (IN(7)) REPS(7) {
        unsigned char* ws = AWS;
        const int jx = (int)blockIdx.x / 8;
        if (jx < 29) {
            pg8::Gemm g{WSP(WS_H), WSP(WS_WGU), D, D, D, 0}; pg8::HybridOrder S; S.init(M / 256, NGU / 256, D, 232, (int)blockIdx.x, SK_RS_P4);
            pg8::EpiGU E{WSP(WS_HID)};
            pg8::gemm_phase(F.lds, g, S, E, pg8::SkBuf{(float*)(ws + WS_MO), (unsigned*)(ws + WS_CTL) + CW_SK + 16384, nullptr});
        } else p0_transposes(F, TR_B, TR_C, (jx - 29) * 8 + (int)blockIdx.x % 8, 24);
        if (BOTH(7) || REP_MORE(7)) GRID_BAR(7); TS_MARK(8);
    }
    if (IN(8)) REPS(8) {
        unsigned char* ws = AWS;
        pg8::Gemm g{WSP(WS_HID), WSP(WS_WD), DFF, DFF, DFF, 0}; pg8::HybridOrder S; S.init(M / 256, D / 256, DFF, F.G, (int)blockIdx.x, SK_RS_P5, SPLIT_MODE);
        pg8::EpiPlain E{WSP(WS_FF), D, 0, nullptr};
        pg8::gemm_phase(F.lds, g, S, E, pg8::SkBuf{(float*)(ws + WS_POOLED), (unsigned*)(ws + WS_CTL) + CW_SK + 32768, WSP(WS_PART5)});
        if (BOTH(8) || REP_MORE(8)) GRID_BAR(8); TS_MARK(9);
    }
    if (IN(9)) {
        unsigned char* ws = AWS; float* out = AOUT; const float* w12 = AIN(12);
        const int gw = F.vcu * NWAVES + F.wave, NGW = F.G * NWAVES;
        for (int m = gw; m < M; m += NGW) { const bool sp = SPLIT_MODE && m >= MP;
            n2_row(sp ? WSP(WS_PART5) + (size_t)(m - MP) * D : WSP(WS_FF) + (size_t)m * D, sp ? 8 : 1, (size_t)1024 * 2048, w12, WSP(WS_MO) + (size_t)m * D, out + O_Y + (size_t)m * D, F.lane); }
#ifdef TS_PHASE
        asm volatile("s_waitcnt vmcnt(0)" ::: "memory"); __syncthreads(); TS_MARK(10);
        if (blockIdx.x == 0 && F.tid == 0) {
            volatile LAS unsigned long long* ts = (volatile LAS unsigned long long*)(F.lds + ARG_OFF + 256);
            const unsigned long long d = ts[TS_B] - ts[TS_A];
            out[O_POOLP] += (float)d * 1e-4f * TS_SCALE;
        }
#endif
    }
#undef IN
#undef BOTH
}

extern "C" void kernel_launch(void* const* d_in, const int* in_sizes, int n_in, void* d_out, int out_size, void* d_ws, size_t ws_size, hipStream_t stream) {
    static int grid = 0;
    if (grid == 0) {
        if (n_in != 16 || (size_t)out_size != O_END || ws_size < WS_END) { fprintf(stderr, "kernel_launch: unexpected shapes: n_in %d out %d ws %zu (need %zu)\n", n_in, out_size, ws_size, (size_t)WS_END); grid = -1; return; }
        int dev = 0, cus = 0, per_cu = 0;
        if (hipGetDevice(&dev) != hipSuccess || hipDeviceGetAttribute(&cus, hipDeviceAttributeMultiprocessorCount, dev) != hipSuccess) { grid = -1; return; }
        if (hipFuncSetAttribute((const void*)hyb_fwd, hipFuncAttributeMaxDynamicSharedMemorySize, LDS_BYTES) != hipSuccess) { fprintf(stderr, "kernel_launch: hipFuncSetAttribute failed\n"); grid = -1; return; }
        if (hipOccupancyMaxActiveBlocksPerMultiprocessor(&per_cu, (const void*)hyb_fwd, NTHR, LDS_BYTES) != hipSuccess || per_cu < 1) { fprintf(stderr, "kernel_launch: occupancy query says %d\n", per_cu); per_cu = 1; }
        (void)hipGetLastError();
        grid = cus * 1;
        if (SPLIT_MODE && grid != 256) { fprintf(stderr, "kernel_launch: this build's unit schedule needs exactly 256 workgroups (got %d CUs); nothing launched\n", cus); grid = -1; return; }
        fprintf(stderr, "kernel_launch: grid %d (occupancy query %d per CU)\n", grid, per_cu);
    }
    if (grid < 0) return;
    Args a{};
    for (int i = 0; i < 16; ++i) a.in[i] = (const float*)d_in[i];
    a.out = (float*)d_out; a.ws = (unsigned char*)d_ws;
    if (!NO_MEMSET_NODE && hipMemsetAsync((char*)d_ws + WS_CTL + CTL_MS_OFF, 0, CTL_MS_BYTES, stream) != hipSuccess) { fprintf(stderr, "kernel_launch: memset failed\n"); return; }
    if (MK_N_LAUNCHES == 1) {
        a.ph_lo = 0; a.ph_hi = NPH; a.use_cg = 1;
        void* kargs[] = {&a};
        hipError_t e = hipLaunchCooperativeKernel((const void*)hyb_fwd, dim3(grid), dim3(NTHR), kargs, LDS_BYTES, stream);
        if (e != hipSuccess) fprintf(stderr, "kernel_launch: cooperative launch failed: %s (grid %d)\n", hipGetErrorString(e), grid);
    } else {
        for (int p = 0; p < NPH; ++p) {
            a.ph_lo = p; a.ph_hi = p + 1; a.use_cg = 0;
            hipLaunchKernelGGL(hyb_fwd, dim3(grid), dim3(NTHR), LDS_BYTES, stream, a);
        }
    }
}
```

```cpp
#include <hip/hip_runtime.h>
#include <hip/hip_cooperative_groups.h>
#include <cstdio>
#include <cstdint>
namespace cg = cooperative_groups;

#ifndef NO_MEMSET_NODE
#define NO_MEMSET_NODE 0
#endif
#ifndef TS_SCALE
#define TS_SCALE 1.0f
#endif
#ifndef MK_N_LAUNCHES
#define MK_N_LAUNCHES 1
#endif

#define GAS __attribute__((address_space(1)))
#define LAS __attribute__((address_space(3)))
typedef unsigned short bf16_t;
typedef short bf16x8 __attribute__((ext_vector_type(8)));
typedef float f32x2 __attribute__((ext_vector_type(2)));
typedef float f32x4 __attribute__((ext_vector_type(4)));
typedef float f32x16 __attribute__((ext_vector_type(16)));
typedef unsigned u32x2 __attribute__((ext_vector_type(2)));
typedef unsigned u32x4 __attribute__((ext_vector_type(4)));

constexpr int D = 2048, MP = 8192, MS = 1024, M = MP + MS, SEQ = 2048;
constexpr int INW = 5120, DFF = 5632, NGU = 2 * DFF;
constexpr int PLD = 256;
constexpr size_t PTILE = (size_t)9216 * 256;
constexpr int NPOS = 2048 + 8;
constexpr float EPS = 1e-6f;
constexpr int NWAVES = 8, NTHR = 512;

constexpr size_t O_Y = 0, O_RETP = (size_t)M * D, O_POOLP = O_RETP + 4 * 4 * 65536, O_RETS = O_POOLP + 4 * 15 * 1024, O_POOLS = O_RETS + (size_t)128 * 4 * 65536, O_END = O_POOLS + 128 * 15 * 1024;

constexpr size_t MiB = 1u << 20;
constexpr size_t WS_CTL = 0, CTL_ZERO_BYTES = 1 * MiB;
constexpr size_t CTL_MS_OFF = 16384, CTL_MS_BYTES = 16384;
constexpr size_t WS_CS = 1 * MiB;
constexpr size_t WS_WPOOL = 4 * MiB;
constexpr size_t WS_WIN = 8 * MiB;
constexpr size_t WS_WOUT = 28 * MiB;
constexpr size_t WS_WGU = 36 * MiB;
constexpr size_t WS_WD = 80 * MiB;
constexpr size_t WS_H = 102 * MiB;
constexpr size_t WS_PROJ = 138 * MiB;
constexpr size_t WS_MIX = 228 * MiB;
constexpr size_t WS_UT = 264 * MiB;
constexpr size_t WS_SCT = 296 * MiB;
constexpr size_t WS_POOLED = 328 * MiB;
constexpr size_t WS_MO = 346 * MiB;
constexpr size_t WS_HID = 138 * MiB;
constexpr size_t WS_FF = 382 * MiB;
constexpr size_t WS_PART3 = 264 * MiB;
constexpr size_t WS_PART5 = 296 * MiB;
#ifndef SPLIT_MODE
#define SPLIT_MODE 1
#endif
constexpr size_t WS_END = 418 * MiB;
static_assert(WS_HID + (size_t)M * DFF * 2 <= WS_UT, "hid overlay");

constexpr int CW_SK = 16384;
#ifndef SK_RS_P3
#define SK_RS_P3 2
#endif
#ifndef SK_RS_P4
#define SK_RS_P4 7
#endif
#ifndef SK_RS_P5
#define SK_RS_P5 2
#endif
constexpr int CW_BAR = 4096;
constexpr int LDS_BYTES = 147456;
constexpr int RING_BYTES = 131072, MISC_OFF = RING_BYTES + 320, ARG_OFF = RING_BYTES + 512;

__device__ __forceinline__ unsigned f2bf(float f) { unsigned u = __builtin_bit_cast(unsigned, f); return (u + 0x7fffu + ((u >> 16) & 1u)) >> 16; }
__device__ __forceinline__ unsigned cvt_pk_bf16(float lo, float hi) { unsigned r; asm volatile("v_cvt_pk_bf16_f32 %0, %1, %2" : "=v"(r) : "v"(lo), "v"(hi)); return r; }
__device__ __forceinline__ unsigned pk2(float lo, float hi) { unsigned r; asm("v_cvt_pk_bf16_f32 %0, %1, %2" : "=v"(r) : "v"(lo), "v"(hi)); return r; }
__device__ __forceinline__ float bflo(unsigned w) { return __builtin_bit_cast(float, w << 16); }
__device__ __forceinline__ float bfhi(unsigned w) { return __builtin_bit_cast(float, w & 0xffff0000u); }
__device__ __forceinline__ float bf2f(bf16_t b) { return __builtin_bit_cast(float, (unsigned)b << 16); }
__device__ __forceinline__ float wave_sum(float v) {
#pragma unroll
    for (int o = 1; o < 64; o <<= 1) v += __shfl_xor(v, o);
    return v;
}
__device__ __forceinline__ float silu(float x) { return x * __builtin_amdgcn_rcpf(1.0f + __builtin_amdgcn_exp2f(-1.4426950408889634f * x)); }
__device__ __forceinline__ float lg2gamma(int h) { return h == 0 ? -0.04580368961312479f : h == 1 ? -0.02272007650008353f : h == 2 ? -0.011315313227834146f : -0.005646563141142063f; }
#define LDS_WAIT() asm volatile("s_waitcnt lgkmcnt(0)" ::: "memory")
__device__ __forceinline__ int opaque(int x) { asm volatile("" : "+v"(x)); return x; }

namespace pg8 {
constexpr int BM = 256, BK = 64, HALF = 128, HTB = HALF * BK * 2, STAGE_BYTES = 8 * HTB, NXCD = 8, WGM = 8;
__host__ __device__ __forceinline__ int lds_byte(int r, int c) { const int st = (r >> 4) * 2 + (c >> 5), rr = r & 15, cc = c & 31, ob = rr * 64 + cc * 2; return st * 1024 + (ob ^ (((ob >> 9) & 1) << 5)); }
__host__ __device__ __forceinline__ void stage_rc(int b, int& R, int& C) { const int st = b / 1024, sb = b % 1024, swz = sb ^ (((sb >> 9) & 1) << 5); R = (st >> 1) * 16 + swz / 64; C = (st & 1) * 32 + (swz % 64) / 2; }
__host__ __device__ __forceinline__ int perm32(int rho) { const int n = rho >> 4, i = rho & 15; return 8 * (i >> 2) + 4 * n + (i & 3); }

struct Unit { int pm, pn, kt0, nkt, role; };
struct Gemm { const bf16_t* A; const bf16_t* Bt; int lda, ldb, K, a_pn_col; };
struct HybridOrder {
    int nM, nN, nwg, G, c, Rs, P, n32, q, s, e, mode;
    __device__ void init(int nM_, int nN_, int K, int G_, int c_, int Rs_, int mode_ = 0) {
        mode = mode_; nM = nM_; nN = nN_; nwg = nM * nN; G = G_; c = c_; Rs = Rs_; P = K / (2 * BK); n32 = G / NXCD; q = nwg / NXCD;
        const int Ux = (q - Rs * n32) > 0 ? (q - Rs * n32) : 0, j = c / NXCD; const long T = (long)Ux * P;
        s = (int)((long)j * T / n32); e = (int)((long)(j + 1) * T / n32);
    }
    __device__ void tile(int wgid, Unit& u) const {
        const int nig = WGM * nN, gid = wgid / nig, fm = gid * WGM, gsz = (nM - fm) < WGM ? (nM - fm) : WGM;
        u.pm = fm + ((wgid % nig) % gsz); u.pn = (wgid % nig) / gsz;
    }
    __device__ bool next(int i, Unit& u) const {
        const int x = c % NXCD, j = c / NXCD;
        if (mode == 1) {
            if (i == 0) { u.pm = 8 * (x >> 1) + (j & 7); u.pn = 4 * (x & 1) + (j >> 3); u.kt0 = 0; u.nkt = 2 * P; u.role = 0; return true; }
            if (i == 1) { u.pm = 32 + (j >> 3); u.pn = j & 7; const int lo = x * P / 8, hi = (x + 1) * P / 8; u.kt0 = 2 * lo; u.nkt = 2 * (hi - lo); u.role = 3; return true; }
            return false;
        }
        if (i < Rs) { if (i * n32 + j >= q) return false; tile(x * q + i * n32 + j, u); u.kt0 = 0; u.nkt = 2 * P; u.role = 0; return true; }
        const int uidx = s / P + (i - Rs), lo = s > uidx * P ? s : uidx * P, hi = e < (uidx + 1) * P ? e : (uidx + 1) * P;
        if (lo >= hi) return false;
        tile(x * q + Rs * n32 + uidx, u);
        u.kt0 = 2 * (lo - uidx * P); u.nkt = 2 * (hi - lo); u.role = (lo > uidx * P) ? 1 : ((hi < (uidx + 1) * P) ? 2 : 0);
        return true;
    }
};
struct SkBuf { float* slab; unsigned* flags; bf16_t* part; };

template <class Epi>
__device__ __forceinline__ void gemm_phase(LAS unsigned char* lds, const Gemm g, const HybridOrder& S, const Epi& E, const SkBuf sk) {
    const int tid = threadIdx.x, wid = __builtin_amdgcn_readfirstlane(tid >> 6), lane = tid & 63, wr = wid >> 2, wc = wid & 3, fr = lane & 15, fq = lane >> 4;
    unsigned voffA[2], voffB[2];
#pragma unroll
    for (int i = 0; i < 2; ++i) { int R, C; stage_rc(tid * 16 + i * 8192, R, C); const int Rb = (R & ~31) + perm32(R & 31);
        voffA[i] = (unsigned)(R * g.lda + C) * 2u; voffB[i] = (unsigned)(Rb * g.ldb + C) * 2u; }
    const size_t kstep = (size_t)(BK * 2);
    const size_t hstepA = (size_t)HALF * g.lda * 2, hstepB = (size_t)HALF * g.ldb * 2;
    const unsigned ldsw = (unsigned)wid * 1024u;
    const int aoff = lds_byte(wr * 64 + fr, fq * 8), boff = lds_byte(wc * 32 + fr, fq * 8);
#define PG8_UA(u) ((const char*)g.A + ((size_t)(u).pm * BM * g.lda + (size_t)(u).pn * g.a_pn_col + (size_t)(u).kt0 * BK) * 2)
#define PG8_UB(u) ((const char*)g.Bt + ((size_t)(u).pn * BM * g.ldb + (size_t)(u).kt0 * BK) * 2)
#define PG8_SA(b, h) (((b) * 2 + (h)) * HTB)
#define PG8_SB(b, h) ((4 + (b) * 2 + (h)) * HTB)
#define PG8_STAGE(bufoff, gbase, voff) do { _Pragma("unroll") for (int _i = 0; _i < 2; ++_i) \
        __builtin_amdgcn_global_load_lds((const unsigned*)((const char*)(gbase) + (voff)[_i]), (LAS unsigned*)(lds + (bufoff) + ldsw + _i * 8192), 16, 0, 0); } while (0)
#define PG8_LDA(dst, b, h) do { _Pragma("unroll") for (int m = 0; m < 4; ++m) _Pragma("unroll") for (int k = 0; k < 2; ++k) dst[m][k] = *(const LAS bf16x8*)(lds + PG8_SA(b, h) + aoff + m * 2048 + k * 1024); } while (0)
#define PG8_LDB(dst, b, h) do { _Pragma("unroll") for (int n = 0; n < 2; ++n) _Pragma("unroll") for (int k = 0; k < 2; ++k) dst[n][k] = *(const LAS bf16x8*)(lds + PG8_SB(b, h) + boff + n * 2048 + k * 1024); } while (0)
#define PG8_MMA(ai, bj, At, Bt) do { __builtin_amdgcn_s_setprio(1); _Pragma("unroll") for (int m = 0; m < 4; ++m) _Pragma("unroll") for (int n = 0; n < 2; ++n) _Pragma("unroll") for (int k = 0; k < 2; ++k) \
        acc[ai][bj][m][n] = __builtin_amdgcn_mfma_f32_16x16x32_bf16(Bt[n][k], At[m][k], acc[ai][bj][m][n], 0, 0, 0); __builtin_amdgcn_s_setprio(0); } while (0)
#define PG8_WAIT_V(n) asm volatile("s_waitcnt vmcnt(" #n ")" ::: "memory")
#define PG8_WAIT_L(n) asm volatile("s_waitcnt lgkmcnt(" #n ")" ::: "memory")
#define PG8_BAR __builtin_amdgcn_s_barrier()
#define PG8_SCHED __builtin_amdgcn_sched_barrier(0)
    Unit cur, nxt; int ui = 0;
    if (!S.next(0, cur)) return;
    f32x4 acc[2][2][4][2];
#pragma unroll
    for (int a = 0; a < 2; ++a)
#pragma unroll
        for (int b = 0; b < 2; ++b)
#pragma unroll
            for (int m = 0; m < 4; ++m)
#pragma unroll
                for (int n = 0; n < 2; ++n) acc[a][b][m][n] = (f32x4){0.f, 0.f, 0.f, 0.f};
    bf16x8 At[4][2], B0[2][2], B1[2][2];
    const char* cA = PG8_UA(cur); const char* cB = PG8_UB(cur);
    PG8_STAGE(PG8_SB(0, 0), cB, voffB); PG8_STAGE(PG8_SB(0, 1), cB + hstepB, voffB); PG8_STAGE(PG8_SA(0, 0), cA, voffA); PG8_STAGE(PG8_SA(0, 1), cA + hstepA, voffA);
    if (wr == 1) PG8_BAR;
    PG8_WAIT_V(2); PG8_BAR;
    PG8_STAGE(PG8_SB(1, 0), cB + kstep, voffB); PG8_STAGE(PG8_SA(1, 0), cA + kstep, voffA); PG8_STAGE(PG8_SB(1, 1), cB + hstepB + kstep, voffB);
    PG8_WAIT_V(6); PG8_BAR;
    for (;;) {
        const bool has_next = S.next(ui + 1, nxt);
        const char* nA = has_next ? PG8_UA(nxt) : cA; const char* nB = has_next ? PG8_UB(nxt) : cB;
        const int nt = cur.nkt;
        for (int t = 0; t < nt; t += 2) {
            const bool last = (t == nt - 2);
            const char* a1 = cA + (size_t)(t + 1) * kstep;
            const char* a2 = last ? nA : cA + (size_t)(t + 2) * kstep; const char* b2 = last ? nB : cB + (size_t)(t + 2) * kstep;
            const char* a3 = a2 + kstep; const char* b3 = b2 + kstep;
            PG8_LDB(B0, 0, 0); PG8_LDB(B1, 0, 1); PG8_SCHED; PG8_LDA(At, 0, 0); PG8_STAGE(PG8_SA(1, 1), a1 + hstepA, voffA);
            PG8_WAIT_V(8); PG8_WAIT_L(0); PG8_BAR; PG8_MMA(0, 0, At, B0); PG8_MMA(0, 1, At, B1); PG8_BAR; PG8_SCHED;
            PG8_LDA(At, 0, 1); PG8_STAGE(PG8_SB(0, 0), b2, voffB); PG8_STAGE(PG8_SB(0, 1), b2 + hstepB, voffB); PG8_STAGE(PG8_SA(0, 0), a2, voffA);
            PG8_WAIT_V(8); PG8_WAIT_L(0); PG8_BAR; PG8_MMA(1, 0, At, B0); PG8_MMA(1, 1, At, B1); PG8_BAR; PG8_SCHED;
            PG8_LDB(B0, 1, 0); PG8_LDB(B1, 1, 1); PG8_SCHED; PG8_LDA(At, 1, 0); PG8_STAGE(PG8_SA(0, 1), a2 + hstepA, voffA);
            PG8_WAIT_V(8); PG8_WAIT_L(0); PG8_BAR; PG8_MMA(0, 0, At, B0); PG8_MMA(0, 1, At, B1); PG8_BAR; PG8_SCHED;
            PG8_LDA(At, 1, 1); PG8_STAGE(PG8_SB(1, 0), b3, voffB); PG8_STAGE(PG8_SB(1, 1), b3 + hstepB, voffB); PG8_STAGE(PG8_SA(1, 0), a3, voffA);
            PG8_WAIT_V(8); PG8_WAIT_L(0); PG8_BAR; PG8_MMA(1, 0, At, B0); PG8_MMA(1, 1, At, B1); PG8_BAR; PG8_SCHED;
        }
        if (wr == 0) PG8_BAR;
        if (cur.role == 1) {
            const __amdgpu_buffer_rsrc_t rs = __builtin_amdgcn_make_buffer_rsrc(sk.slab, 0, 0x7fffffff, 0x00020000);
            const unsigned base = ((unsigned)S.c * 16384u + (unsigned)opaque(tid)) * 16u;
#pragma unroll
            for (int a = 0; a < 2; ++a)
#pragma unroll
                for (int b = 0; b < 2; ++b)
#pragma unroll
                    for (int m = 0; m < 4; ++m)
#pragma unroll
                        for (int n = 0; n < 2; ++n)
                            __builtin_amdgcn_raw_buffer_store_b128(__builtin_bit_cast(u32x4, acc[a][b][m][n]), rs, base + (unsigned)(((a * 2 + b) * 4 + m) * 2 + n) * 8192u, 0, 16);
            PG8_WAIT_V(0); PG8_BAR;
            if (tid == 0) __hip_atomic_store(sk.flags + 64 * S.c, 1u, __ATOMIC_RELAXED, __HIP_MEMORY_SCOPE_AGENT);
        } else if (cur.role == 3) {
            bf16_t* O = sk.part + (size_t)(S.c % NXCD) * 1024 * 2048;
            const int row0 = (cur.pm - 32) * BM + wr * 64 + fr, col0 = cur.pn * BM + wc * 32 + 8 * fq;
#pragma unroll
            for (int ai = 0; ai < 2; ++ai)
#pragma unroll
                for (int m = 0; m < 4; ++m) {
                    bf16_t* rp = O + (size_t)(row0 + ai * HALF + m * 16) * 2048 + col0;
#pragma unroll
                    for (int bj = 0; bj < 2; ++bj) {
                        u32x4 wv; wv.x = cvt_pk_bf16(acc[ai][bj][m][0][0], acc[ai][bj][m][0][1]); wv.y = cvt_pk_bf16(acc[ai][bj][m][0][2], acc[ai][bj][m][0][3]);
                        wv.z = cvt_pk_bf16(acc[ai][bj][m][1][0], acc[ai][bj][m][1][1]); wv.w = cvt_pk_bf16(acc[ai][bj][m][1][2], acc[ai][bj][m][1][3]);
                        *(u32x4*)(rp + bj * HALF) = wv;
                    }
                }
        } else {
            E(acc, cur, wr, wc, fr, fq);
        }
        if (!has_next) break;
        if (nxt.role == 2) {
            const int pc = S.c + NXCD;
            if (wid == 0) {
                unsigned spins = 0;
                while (__builtin_amdgcn_readfirstlane(__hip_atomic_load(sk.flags + 64 * pc, __ATOMIC_RELAXED, __HIP_MEMORY_SCOPE_AGENT)) == 0u) { __builtin_amdgcn_s_sleep(2); if (++spins > (1u << 22)) break; }
                __builtin_amdgcn_fence(__ATOMIC_ACQUIRE, "agent");
                PG8_WAIT_V(0);
            }
            asm volatile("" ::: "memory"); PG8_BAR; asm volatile("" ::: "memory");
            const f32x4* sl = (const f32x4*)sk.slab + (size_t)pc * 16384 + opaque(tid);
#pragma unroll
            for (int a = 0; a < 2; ++a)
#pragma unroll
                for (int b = 0; b < 2; ++b)
#pragma unroll
                    for (int m = 0; m < 4; ++m)
#pragma unroll
                        for (int n = 0; n < 2; ++n) acc[a][b][m][n] = *(const GAS f32x4*)(sl + (((a * 2 + b) * 4 + m) * 2 + n) * 512);
#pragma unroll
            for (int a = 0; a < 2; ++a)
#pragma unroll
                for (int b = 0; b < 2; ++b)
#pragma unroll
                    for (int m = 0; m < 4; ++m)
#pragma unroll
                        for (int n = 0; n < 2; ++n) asm volatile("" : "+v"(acc[a][b][m][n]));
        } else {
#pragma unroll
        for (int a = 0; a < 2; ++a)
#pragma unroll
            for (int b = 0; b < 2; ++b)
#pragma unroll
                for (int m = 0; m < 4; ++m)
#pragma unroll
                    for (int n = 0; n < 2; ++n) acc[a][b][m][n] = (f32x4){0.f, 0.f, 0.f, 0.f};
        }
        cur = nxt; cA = nA; cB = nB; ++ui;
        if (wr == 1) PG8_BAR;
    }
    PG8_WAIT_V(0);
    PG8_BAR;
#undef PG8_UA
#undef PG8_UB
#undef PG8_SA
#undef PG8_SB
#undef PG8_STAGE
#undef PG8_LDA
#undef PG8_LDB
#undef PG8_MMA
#undef PG8_WAIT_V
#undef PG8_WAIT_L
#undef PG8_BAR
#undef PG8_SCHED
}

__device__ __forceinline__ void st8(bf16_t* p, const f32x4 v0, const f32x4 v1) {
    u32x4 w; w.x = cvt_pk_bf16(v0[0], v0[1]); w.y = cvt_pk_bf16(v0[2], v0[3]); w.z = cvt_pk_bf16(v1[0], v1[1]); w.w = cvt_pk_bf16(v1[2], v1[3]);
    *(u32x4*)p = w;
}
struct EpiProj {
    bf16_t* P; const float* cs;
    __device__ __forceinline__ void operator()(const f32x4 (&acc)[2][2][4][2], const Unit& u, int wr, int wc, int fr, int fq) const {
        const int row0 = u.pm * BM + wr * 64 + fr, type = u.pn >> 2, cl = wc * 32 + 8 * fq;
        bf16_t* Pt = P + (size_t)u.pn * PTILE + cl;
#ifdef ABL_NO_ROPE
        if (false) {
#else
        if (type <= 1) {
#endif
            const float sc = type == 1 ? 0.0625f : 1.0f;
#pragma unroll
            for (int ai = 0; ai < 2; ++ai)
#pragma unroll
                for (int m = 0; m < 4; ++m) {
                    const int row = row0 + ai * HALF + m * 16;
                    const int pidx = row < MP ? (row & (SEQ - 1)) : SEQ + ((row - MP) & 7);
                    const f32x4* t = (const f32x4*)cs + (size_t)(cl >> 3) * 4 * NPOS + pidx;
                    const f32x4 t0 = t[0], t1 = t[NPOS], t2 = t[2 * NPOS], t3 = t[3 * NPOS];
                    const f32x4 x1a = acc[ai][0][m][0], x1b = acc[ai][0][m][1], x2a = acc[ai][1][m][0], x2b = acc[ai][1][m][1];
                    f32x4 o1a, o1b, o2a, o2b;
                    o1a[0] = (x1a[0] * t0[0] - x2a[0] * t0[1]) * sc; o2a[0] = (x2a[0] * t0[0] + x1a[0] * t0[1]) * sc;
                    o1a[1] = (x1a[1] * t0[2] - x2a[1] * t0[3]) * sc; o2a[1] = (x2a[1] * t0[2] + x1a[1] * t0[3]) * sc;
                    o1a[2] = (x1a[2] * t1[0] - x2a[2] * t1[1]) * sc; o2a[2] = (x2a[2] * t1[0] + x1a[2] * t1[1]) * sc;
                    o1a[3] = (x1a[3] * t1[2] - x2a[3] * t1[3]) * sc; o2a[3] = (x2a[3] * t1[2] + x1a[3] * t1[3]) * sc;
                    o1b[0] = (x1b[0] * t2[0] - x2b[0] * t2[1]) * sc; o2b[0] = (x2b[0] * t2[0] + x1b[0] * t2[1]) * sc;
                    o1b[1] = (x1b[1] * t2[2] - x2b[1] * t2[3]) * sc; o2b[1] = (x2b[1] * t2[2] + x1b[1] * t2[3]) * sc;
                    o1b[2] = (x1b[2] * t3[0] - x2b[2] * t3[1]) * sc; o2b[2] = (x2b[2] * t3[0] + x1b[2] * t3[1]) * sc;
                    o1b[3] = (x1b[3] * t3[2] - x2b[3] * t3[3]) * sc; o2b[3] = (x2b[3] * t3[2] + x1b[3] * t3[3]) * sc;
                    bf16_t* rp = Pt + (size_t)row * PLD;
                    st8(rp, o1a, o1b); st8(rp + HALF, o2a, o2b);
                }
        } else {
            const bool act = type == 3;
#pragma unroll
            for (int ai = 0; ai < 2; ++ai)
#pragma unroll
                for (int m = 0; m < 4; ++m) {
                    bf16_t* rp = Pt + (size_t)(row0 + ai * HALF + m * 16) * PLD;
#pragma unroll
                    for (int bj = 0; bj < 2; ++bj) {
                        f32x4 v0 = acc[ai][bj][m][0], v1 = acc[ai][bj][m][1];
                        if (act) {
#pragma unroll
                            for (int i = 0; i < 4; ++i) { v0[i] = silu(v0[i]); v1[i] = silu(v1[i]); }
                        }
                        st8(rp + bj * HALF, v0, v1);
                    }
                }
        }
    }
};
struct EpiPlain {
    bf16_t* O; int ldc, coff; const float* scale;
    __device__ __forceinline__ void operator()(const f32x4 (&acc)[2][2][4][2], const Unit& u, int wr, int wc, int fr, int fq) const {
        const int row0 = u.pm * BM + wr * 64 + fr, cl = wc * 32 + 8 * fq, col0 = u.pn * BM + cl;
        f32x4 s[2][2];
#pragma unroll
        for (int bj = 0; bj < 2; ++bj)
#pragma unroll
            for (int n = 0; n < 2; ++n) s[bj][n] = scale ? *(const f32x4*)(scale + col0 + bj * HALF + 4 * n) : (f32x4){1.f, 1.f, 1.f, 1.f};
#pragma unroll
        for (int ai = 0; ai < 2; ++ai)
#pragma unroll
            for (int m = 0; m < 4; ++m) {
                bf16_t* rp = O + (size_t)(row0 + ai * HALF + m * 16) * ldc + coff + col0;
#pragma unroll
                for (int bj = 0; bj < 2; ++bj) st8(rp + bj * HALF, acc[ai][bj][m][0] * s[bj][0], acc[ai][bj][m][1] * s[bj][1]);
            }
    }
};
struct EpiGU {
    bf16_t* Hd;
    __device__ __forceinline__ void operator()(const f32x4 (&acc)[2][2][4][2], const Unit& u, int wr, int wc, int fr, int fq) const {
        const int row0 = u.pm * BM + wr * 64 + fr, cl = wc * 32 + 8 * fq, col0 = u.pn * HALF + cl;
#pragma unroll
        for (int ai = 0; ai < 2; ++ai)
#pragma unroll
            for (int m = 0; m < 4; ++m) {
                f32x4 v0, v1;
#pragma unroll
                for (int i = 0; i < 4; ++i) { v0[i] = silu(acc[ai][0][m][0][i]) * acc[ai][1][m][0][i]; v1[i] = silu(acc[ai][0][m][1][i]) * acc[ai][1][m][1][i]; }
                st8(Hd + (size_t)(row0 + ai * HALF + m * 16) * DFF + col0, v0, v1);
            }
    }
};
}

#define XB_TMO      128
#define XB_XCNT(j)  (256  + 64 * (j))
#define XB_XSUB(j)  (1280 + 64 * (j))
#define XB_XGEN(j)  (2304 + 64 * (j))
#define XB_TOP      3328
#define XB_TOPGEN   3392
#define XCD_BAR_WORDS 3456
#define XB_SPIN_CAP (1u << 18)
__device__ __forceinline__ unsigned xb_ld(unsigned* p)              { return __hip_atomic_load(p, __ATOMIC_RELAXED, __HIP_MEMORY_SCOPE_AGENT); }
__device__ __forceinline__ unsigned xb_add(unsigned* p, unsigned v) { return __hip_atomic_fetch_add(p, v, __ATOMIC_RELAXED, __HIP_MEMORY_SCOPE_AGENT); }
__device__ __forceinline__ unsigned xb_xcc_id() { return (unsigned)__builtin_amdgcn_s_getreg((3 << 11) | 20) & 0xFu; }
#define XB_SPIN(cond, bar) do { unsigned _sp = 0; while (cond) { __builtin_amdgcn_s_sleep(1); \
    if ((++_sp & 255u) == 0u) { if (xb_ld(&(bar)[XB_TMO])) break; if (_sp > XB_SPIN_CAP) { atomicAdd(&(bar)[XB_TMO], 1u); break; } } } } while (0)
__device__ __forceinline__ void xcd_barrier_post(unsigned* bar) {
    if (threadIdx.x == 0) (void)xb_add(&bar[XB_XCNT(xb_xcc_id())], 1u);
}
__device__ __forceinline__ void xcd_barrier_complete(unsigned* bar, unsigned x, unsigned& nloc, unsigned& nx) {
    const unsigned G = gridDim.x * gridDim.y * gridDim.z;
    unsigned sum, cnt, mine, sp = 0u;
    for (;;) {
        sum = 0u; cnt = 0u; mine = 0u;
#pragma unroll
        for (unsigned j = 0; j < 16; ++j) { const unsigned c = xb_ld(&bar[XB_XCNT(j)]); sum += c; cnt += (c > 0u) ? 1u : 0u; mine = (j == x) ? c : mine; }
        if (sum == G) break;
        __builtin_amdgcn_s_sleep(1);
        if ((++sp & 255u) == 0u) { if (xb_ld(&bar[XB_TMO])) break; if (sp > XB_SPIN_CAP) { atomicAdd(&bar[XB_TMO], 1u); break; } }
    }
    nloc = mine > 0u ? mine : 1u; nx = cnt > 0u ? cnt : 1u;
}
__device__ __forceinline__ void xcd_barrier(unsigned* bar, volatile LAS unsigned* st) {
    asm volatile("s_waitcnt vmcnt(0)" ::: "memory");
    __syncthreads();
    if (threadIdx.x == 0) {
        const unsigned x = xb_xcc_id();
        __builtin_amdgcn_s_waitcnt(0);
        unsigned nloc = st[0], nx = st[1];
        if (nloc == 0u) { xcd_barrier_complete(bar, x, nloc, nx); st[0] = nloc; st[1] = nx; }
        const unsigned old = xb_add(&bar[XB_XSUB(x)], 1u);
        const unsigned gen = old / nloc;
        if (old + 1u == (gen + 1u) * nloc) {
            __builtin_amdgcn_fence(__ATOMIC_RELEASE, "agent");
            asm volatile("s_waitcnt vmcnt(0)" ::: "memory");
            const unsigned og = xb_add(&bar[XB_TOP], 1u);
            const unsigned tg = og / nx;
            if (og + 1u == (tg + 1u) * nx) xb_add(&bar[XB_TOPGEN], 1u);
            else XB_SPIN(xb_ld(&bar[XB_TOPGEN]) == tg, bar);
            __builtin_amdgcn_fence(__ATOMIC_ACQUIRE, "agent");
            xb_add(&bar[XB_XGEN(x)], 1u);
            asm volatile("s_waitcnt vmcnt(0)" ::: "memory");
        } else {
            XB_SPIN(xb_ld(&bar[XB_XGEN(x)]) == gen, bar);
            __builtin_amdgcn_fence(__ATOMIC_ACQUIRE, "agent");
            asm volatile("s_waitcnt vmcnt(0)" ::: "memory");
        }
    }
    __syncthreads();
}

struct Args { const float* in[16]; float* out; unsigned char* ws; int ph_lo, ph_hi, use_cg, pad; };

struct Frame {
    LAS unsigned char* lds;
    int tid, lane, wave, vcu, G;
};
__device__ __forceinline__ const float* ldarg(const Frame& F, int k) {
    const volatile LAS unsigned* p = (const volatile LAS unsigned*)(F.lds + ARG_OFF) + 2 * k;
    const unsigned lo = __builtin_amdgcn_readfirstlane(p[0]), hi = __builtin_amdgcn_readfirstlane(p[1]);
    return (const float*)(((unsigned long long)hi << 32) | lo);
}
#ifdef TS_PHASE
#define TS_MARK(k) do { if (blockIdx.x == 0 && F.tid == 0) ((volatile LAS unsigned long long*)(F.lds + ARG_OFF + 256))[(k)] = __builtin_amdgcn_s_memrealtime(); } while (0)
#else
#define TS_MARK(k) do {} while (0)
#endif
#define AIN(k) ldarg(F, (k))
#define AOUT ((float*)ldarg(F, 16))
#define AWS ((unsigned char*)ldarg(F, 17))

struct TrItem { const float* W; bf16_t* WT; int K, N, mode, k0, n0; };
constexpr int TR_IN = (D / 64) * (INW / 256), TR_OUT = (D / 64) * (D / 256), TR_G = (D / 64) * (DFF / 256), TR_D = (DFF / 64) * (D / 256);
struct P0Ptrs { const float *w_in, *w_out, *w_gate, *w_up, *w_down, *w_pool; unsigned char* ws; };
__device__ __forceinline__ TrItem p0_decode(const P0Ptrs& a, unsigned char* ws, int it) {
    TrItem t; int r = it, nblk;
    if (r < TR_IN) { t.W = a.w_in; t.WT = (bf16_t*)(ws + WS_WIN); t.K = D; t.N = INW; t.mode = 0; }
    else if ((r -= TR_IN) < TR_OUT) { t.W = a.w_out; t.WT = (bf16_t*)(ws + WS_WOUT); t.K = D; t.N = D; t.mode = 0; }
    else if ((r -= TR_OUT) < 16) { const int g = r >> 2; r &= 3; t.W = a.w_pool + (size_t)g * 65536; t.WT = (bf16_t*)(ws + WS_WPOOL) + (size_t)g * 65536; t.K = 256; t.N = 256; t.mode = 0; }
    else if ((r -= 16) < TR_G) { t.W = a.w_gate; t.WT = (bf16_t*)(ws + WS_WGU); t.K = D; t.N = DFF; t.mode = 1; }
    else if ((r -= TR_G) < TR_G) { t.W = a.w_up; t.WT = (bf16_t*)(ws + WS_WGU); t.K = D; t.N = DFF; t.mode = 2; }
    else { r -= TR_G; t.W = a.w_down; t.WT = (bf16_t*)(ws + WS_WD); t.K = DFF; t.N = D; t.mode = 0; }
    nblk = t.N >> 8; t.k0 = 64 * (r / nblk); t.n0 = 256 * (r % nblk);
    return t;
}
constexpr int P0_NITEMS = TR_IN + TR_OUT + 16 + 2 * TR_G + TR_D;
constexpr int TR_B = TR_IN + TR_OUT + 16 + 2 * TR_G, TR_C = P0_NITEMS;
#ifndef TR_P1_ITEMS
#define TR_P1_ITEMS 800
#endif
constexpr int TR_A = TR_B - TR_P1_ITEMS;
__device__ __forceinline__ void p0_transposes(Frame& F, int it_begin, int it_end, int worker, int nworkers) {
    P0Ptrs a; a.w_in = AIN(6); a.w_out = AIN(10); a.w_gate = AIN(13); a.w_up = AIN(14); a.w_down = AIN(15); a.w_pool = AIN(8); a.ws = AWS;
    unsigned char* ws = a.ws;
    LAS float* buf = (LAS float*)F.lds;
    const int w = F.wave, l = opaque(F.lane);
#define TR_LOAD(V, T) do { _Pragma("unroll") for (int i = 0; i < 8; ++i) V[i] = *(const GAS f32x4*)((T).W + (size_t)((T).k0 + 8 * w + i) * (T).N + (T).n0 + 4 * l); } while (0)
#define TR_STEP(V, CUR) do { \
        _Pragma("unroll") for (int i = 0; i < 8; ++i) *(LAS f32x4*)(buf + (8 * w + i) * 260 + ((4 * l) ^ (4 * (w & 7)))) = V[i]; \
        __syncthreads(); \
        const TrItem cur_ = (CUR); \
        const int nit_ = it + 2 * nworkers; \
        if (nit_ < it_end) { (CUR) = p0_decode(a, ws, nit_); TR_LOAD(V, (CUR)); } \
        const int ko = l & 7; \
        _Pragma("unroll") for (int sidx = 0; sidx < 4; ++sidx) { \
            const int nl = 32 * w + 8 * sidx + (l >> 3), n = cur_.n0 + nl; \
            const LAS float* p = buf + (8 * ko) * 260 + (nl ^ (4 * ko)); \
            u32x4 o; o.x = pk2(p[0], p[260]); o.y = pk2(p[2 * 260], p[3 * 260]); o.z = pk2(p[4 * 260], p[5 * 260]); o.w = pk2(p[6 * 260], p[7 * 260]); \
            const int row = cur_.mode == 0 ? n : (256 * (n >> 7) + (n & 127) + (cur_.mode == 2 ? 128 : 0)); \
            *(GAS u32x4*)(cur_.WT + (size_t)row * cur_.K + cur_.k0 + 8 * ko) = o; } \
        __syncthreads(); } while (0)
    int it = it_begin + worker;
    if (it >= it_end) return;
    TrItem tA = p0_decode(a, ws, it), tB = tA;
    f32x4 vA[8], vB[8];
    TR_LOAD(vA, tA);
    if (it + nworkers < it_end) { tB = p0_decode(a, ws, it + nworkers); TR_LOAD(vB, tB); }
    for (;;) {
        TR_STEP(vA, tA);
        it += nworkers; if (it >= it_end) break;
        TR_STEP(vB, tB);
        it += nworkers; if (it >= it_end) break;
    }
#undef TR_LOAD
#undef TR_STEP
}
__device__ __forceinline__ void rms_row_to_bf16(const float* xrow, const float* w, bf16_t* orow, int lane) {
    const GAS f32x4* xr = (const GAS f32x4*)xrow + lane; const GAS f32x4* wr = (const GAS f32x4*)w + lane;
    f32x4 v[8]; float s = 0.f;
#pragma unroll
    for (int j = 0; j < 8; ++j) { v[j] = xr[64 * j]; s += (v[j].x * v[j].x + v[j].y * v[j].y) + (v[j].z * v[j].z + v[j].w * v[j].w); }
    const float rstd = 1.0f / sqrtf(wave_sum(s) * (1.f / D) + EPS);
    GAS u32x2* o8 = (GAS u32x2*)orow + lane;
#pragma unroll
    for (int j = 0; j < 8; ++j) { const f32x4 ww = wr[64 * j]; u32x2 o; o.x = pk2(v[j].x * rstd * ww.x, v[j].y * rstd * ww.y); o.y = pk2(v[j].z * rstd * ww.z, v[j].w * rstd * ww.w); o8[64 * j] = o; }
}
__device__ __forceinline__ const float* xrow_ptr(const float* xp, const float* xs, int m) { return m < MP ? xp + (size_t)m * D : xs + (size_t)(m - MP) * D; }

__device__ __forceinline__ void p0_prologue(Frame& F) {
    p0_transposes(F, 0, TR_A, F.vcu, F.G);
    unsigned char* ws = AWS;
    const int gw = F.vcu * NWAVES + F.wave, NGW = F.G * NWAVES;
    const float* xp_ = AIN(0); const float* xs_ = AIN(1); const float* nw_ = AIN(4);
    for (int m = gw; m < M; m += NGW) rms_row_to_bf16(xrow_ptr(xp_, xs_, m), nw_, (bf16_t*)(ws + WS_H) + (size_t)m * D, F.lane);
    float* cs = (float*)(ws + WS_CS);
    for (int idx = F.vcu * NTHR + F.tid; idx < NPOS * 128; idx += F.G * NTHR) {
        const int p = idx >> 7, j = idx & 127;
        double r = 0.930572040929699, inv = 1.0;
#pragma unroll
        for (int b = 0; b < 7; ++b) { if ((j >> b) & 1) inv *= r; r *= r; }
        const float invf = (float)inv;
        const float pos = (float)(p < SEQ ? p : 16384 + (p - SEQ));
        const float ang = pos * invf;
        double t = (double)ang * 0.15915494309189535; t -= __builtin_rint(t);
        const float tf = (float)t;
        f32x2 o; o.x = __builtin_amdgcn_cosf(tf); o.y = __builtin_amdgcn_sinf(tf);
        *(f32x2*)(cs + ((size_t)(((j >> 3) * 4 + ((j & 7) >> 1)) * NPOS + p)) * 4 + (j & 1) * 2) = o;
    }
}

__device__ __forceinline__ unsigned toff(int r, int c16, int RB) { return (unsigned)(r * RB + ((((c16 & ~15) | ((c16 ^ r ^ (r >> 4)) & 15))) << 4)); }
#define MFMA32(a, b, c) __builtin_amdgcn_mfma_f32_32x32x16_bf16((a), (b), (c), 0, 0, 0)
__device__ __forceinline__ int crow(int reg, int h) { return (reg & 3) + 8 * (reg >> 2) + 4 * h; }
__device__ __forceinline__ bf16x8 frag(const LAS unsigned char* tile, int r, int c16, int RB) { return *(const LAS bf16x8*)(tile + toff(r, c16, RB)); }

__device__ __forceinline__ void load_nat128(LAS unsigned char* dst, const bf16_t* src, int ld, int tid) {
    tid = opaque(tid);
    u32x4 v[4];
#pragma unroll
    for (int it = 0; it < 4; ++it) { const int idx = tid + it * NTHR, r = idx >> 4, c = idx & 15; v[it] = *(const GAS u32x4*)(src + (size_t)r * ld + c * 8); }
#pragma unroll
    for (int it = 0; it < 4; ++it) { const int idx = tid + it * NTHR, r = idx >> 4, c = idx & 15; *(LAS u32x4*)(dst + toff(r, c, 256)) = v[it]; }
}
template <bool SCALE>
__device__ __forceinline__ void load_tr(LAS unsigned char* dst, const bf16_t* src, int ld, int tid, float sc_a, float sc_b) {
    tid = opaque(tid);
#pragma unroll
    for (int it = 0; it < 4; ++it) {
        const int T = it * NTHR + tid, ch_lo = T & 15, pp = (T >> 4) & 3, half = (T >> 6) & 1, quad = T >> 7;
        const int pair = 4 * quad + pp, chunk = 16 * half + ch_lo, j0 = 2 * pair, d0 = 8 * chunk;
        const u32x4 a = *(const GAS u32x4*)(src + (size_t)j0 * ld + d0), b = *(const GAS u32x4*)(src + (size_t)(j0 + 1) * ld + d0);
        float s0 = 1.f, s1 = 1.f;
        if (SCALE) { s0 = __builtin_amdgcn_exp2f(sc_a * (sc_b - (float)j0)); s1 = __builtin_amdgcn_exp2f(sc_a * (sc_b - (float)(j0 + 1))); }
#pragma unroll
        for (int i = 0; i < 8; ++i) {
            const unsigned wa = a[i >> 1], wb = b[i >> 1];
            unsigned w;
            if (SCALE) { const float fa = ((i & 1) ? bfhi(wa) : bflo(wa)) * s0, fb = ((i & 1) ? bfhi(wb) : bflo(wb)) * s1; w = pk2(fa, fb); }
            else w = (i & 1) ? ((wa >> 16) | (wb & 0xffff0000u)) : ((wa & 0xffffu) | (wb << 16));
            const int d = d0 + i;
            *(LAS unsigned*)(dst + toff(d, quad, 256) + pp * 4) = w;
        }
    }
}

__device__ __forceinline__ void u_item(Frame& F, const bf16_t* PROJ, bf16_t* UT, int item) {
    const int b = item >> 6, h = (item >> 4) & 3, c = item & 15, rows0 = b * SEQ + c * 128;
    const bf16_t* Ks = PROJ + (size_t)(4 + h) * PTILE + (size_t)rows0 * PLD; const bf16_t* Vs = Ks + 4 * PTILE;
    LAS unsigned char* KT = F.lds; LAS unsigned char* VT = F.lds + 65536;
    const float lg = lg2gamma(h);
    load_tr<true>(KT, Ks, PLD, F.tid, lg, 127.f);
    load_tr<false>(VT, Vs, PLD, F.tid, 0.f, 0.f);
    __syncthreads();
    const int w = F.wave, r = opaque(F.lane) & 31, hh = opaque(F.lane) >> 5;
    bf16_t* Up = UT + ((size_t)((b * 4 + h) * 16 + c) * 256) * 256;
#pragma unroll 1
    for (int eh = 0; eh < 2; ++eh) {
        f32x16 acc[4];
#pragma unroll
        for (int t = 0; t < 4; ++t)
#pragma unroll
            for (int i = 0; i < 16; ++i) acc[t][i] = 0.f;
#pragma unroll 1
        for (int ks = 0; ks < 8; ++ks) {
            const bf16x8 a = frag(KT, 32 * w + r, 2 * ks + hh, 256);
#pragma unroll
            for (int et = 0; et < 4; ++et) { const bf16x8 bb = frag(VT, 32 * (4 * eh + et) + r, 2 * ks + hh, 256); acc[et] = MFMA32(a, bb, acc[et]); }
        }
#pragma unroll
        for (int et = 0; et < 4; ++et)
#pragma unroll
            for (int g = 0; g < 4; ++g) {
                u32x2 o; o.x = cvt_pk_bf16(acc[et][4 * g], acc[et][4 * g + 1]); o.y = cvt_pk_bf16(acc[et][4 * g + 2], acc[et][4 * g + 3]);
                *(GAS u32x2*)(Up + (size_t)(32 * (4 * eh + et) + r) * 256 + 32 * w + 8 * g + 4 * hh) = o;
            }
    }
    __syncthreads();
}

__device__ __forceinline__ void o_item(Frame& F, const bf16_t* PROJ, const bf16_t* SCT, const float* retw, bf16_t* MIX, int item) {
    const int b = item >> 6, h = (item >> 4) & 3, c = item & 15, rows0 = b * SEQ + c * 128;
    const bf16_t* Qs = PROJ + (size_t)h * PTILE + (size_t)rows0 * PLD; const bf16_t* Ks = Qs + 4 * PTILE; const bf16_t* Vs = Qs + 8 * PTILE; const bf16_t* Gs = Qs + 12 * PTILE;
    LAS unsigned char* QF = F.lds; LAS unsigned char* KH = F.lds + 65536; LAS unsigned char* PB = F.lds + 98304; LAS unsigned char* VT = F.lds; LAS unsigned char* OB = F.lds;
    const float lg = lg2gamma(h);
    const int w = F.wave; int r = opaque(F.lane) & 31, hh = opaque(F.lane) >> 5; const int tid = opaque(F.tid);
    TS_MARK(20);
    u32x4 qv[8], kv[4]; bf16x8 sfr[16];
#pragma unroll
    for (int it = 0; it < 8; ++it) { const int idx = tid + it * NTHR, rr = idx >> 5, cc = idx & 31; qv[it] = *(const GAS u32x4*)(Qs + (size_t)rr * PLD + cc * 8); }
#pragma unroll
    for (int it = 0; it < 4; ++it) { const int idx = tid + it * NTHR, rr = idx >> 4, cc = idx & 15; kv[it] = *(const GAS u32x4*)(Ks + (size_t)rr * PLD + cc * 8); }
    {
        const bf16_t* Sp = SCT + ((size_t)((b * 4 + h) * 16 + c) * 256) * 256 + (size_t)(32 * w + r) * 256 + 8 * hh;
#pragma unroll
        for (int ks = 0; ks < 16; ++ks) sfr[ks] = *(const GAS bf16x8*)(Sp + 16 * ks);
    }
#pragma unroll
    for (int it = 0; it < 8; ++it) { const int idx = tid + it * NTHR, rr = idx >> 5, cc = idx & 31; *(LAS u32x4*)(QF + toff(rr, cc, 512)) = qv[it]; }
#pragma unroll
    for (int it = 0; it < 4; ++it) { const int idx = tid + it * NTHR, rr = idx >> 4, cc = idx & 15; *(LAS u32x4*)(KH + toff(rr, cc, 256)) = kv[it]; }
    __syncthreads();
    TS_MARK(21);
#pragma unroll
    for (int it = 0; it < 4; ++it) { const int idx = tid + it * NTHR, rr = idx >> 4, cc = idx & 15; kv[it] = *(const GAS u32x4*)(Ks + 128 + (size_t)rr * PLD + cc * 8); }
    const int ib_s = w >> 1, jb0 = 2 * (w & 1);
    f32x16 sc[2];
#pragma unroll
    for (int t = 0; t < 2; ++t)
#pragma unroll
        for (int i = 0; i < 16; ++i) sc[t][i] = 0.f;
    if (jb0 <= ib_s) {
#pragma unroll 1
        for (int ks = 0; ks < 8; ++ks) {
            const bf16x8 a = frag(QF, 32 * ib_s + r, 2 * ks + hh, 512);
            const bf16x8 b0 = frag(KH, 32 * jb0 + r, 2 * ks + hh, 256), b1 = frag(KH, 32 * (jb0 + 1) + r, 2 * ks + hh, 256);
            sc[0] = MFMA32(a, b0, sc[0]); sc[1] = MFMA32(a, b1, sc[1]);
        }
    }
    __syncthreads();
#pragma unroll
    for (int it = 0; it < 4; ++it) { const int idx = tid + it * NTHR, rr = idx >> 4, cc = idx & 15; *(LAS u32x4*)(KH + toff(rr, cc, 256)) = kv[it]; }
    __syncthreads();
    TS_MARK(22);
    u32x4 va[4], vb[4];
#pragma unroll
    for (int it = 0; it < 4; ++it) {
        const int T = it * NTHR + tid, ch_lo = T & 15, pp = (T >> 4) & 3, half = (T >> 6) & 1, quad = T >> 7;
        const int pair = 4 * quad + pp, chunk = 16 * half + ch_lo, j0 = 2 * pair, d0 = 8 * chunk;
        va[it] = *(const GAS u32x4*)(Vs + (size_t)j0 * PLD + d0); vb[it] = *(const GAS u32x4*)(Vs + (size_t)(j0 + 1) * PLD + d0);
    }
    if (jb0 <= ib_s) {
#pragma unroll 1
        for (int ks = 0; ks < 8; ++ks) {
            const bf16x8 a = frag(QF, 32 * ib_s + r, 16 + 2 * ks + hh, 512);
            const bf16x8 b0 = frag(KH, 32 * jb0 + r, 2 * ks + hh, 256), b1 = frag(KH, 32 * (jb0 + 1) + r, 2 * ks + hh, 256);
            sc[0] = MFMA32(a, b0, sc[0]); sc[1] = MFMA32(a, b1, sc[1]);
        }
    }
    r = opaque(r); hh = opaque(hh);
#pragma unroll
    for (int t = 0; t < 2; ++t) {
        const int j = 32 * (jb0 + t) + r;
#pragma unroll
        for (int reg = 0; reg < 16; ++reg) {
            const int i = 32 * ib_s + crow(reg, hh);
            const float v = (i >= j) ? sc[t][reg] * __builtin_amdgcn_exp2f(lg * (float)(i - j)) : 0.f;
            *(LAS bf16_t*)(PB + toff(i, j >> 3, 256) + (j & 7) * 2) = (bf16_t)f2bf(v);
        }
    }
    TS_MARK(23);
    f32x16 o[4];
#pragma unroll
    for (int t = 0; t < 4; ++t)
#pragma unroll
        for (int i = 0; i < 16; ++i) o[t][i] = 0.f;
    r = opaque(r); hh = opaque(hh);
#pragma unroll
    for (int ks = 0; ks < 16; ++ks) {
#pragma unroll
        for (int ib = 0; ib < 4; ++ib) { const bf16x8 a = frag(QF, 32 * ib + r, 2 * ks + hh, 512); o[ib] = MFMA32(a, sfr[ks], o[ib]); }
    }
#pragma unroll
    for (int ib = 0; ib < 4; ++ib)
#pragma unroll
        for (int reg = 0; reg < 16; ++reg) o[ib][reg] *= __builtin_amdgcn_exp2f(lg * (float)(32 * ib + crow(reg, hh) + 1));
    __syncthreads();
    TS_MARK(24);
#pragma unroll
    for (int it = 0; it < 4; ++it) {
        const int T = it * NTHR + tid, ch_lo = T & 15, pp = (T >> 4) & 3, half = (T >> 6) & 1, quad = T >> 7;
        const int chunk = 16 * half + ch_lo, d0 = 8 * chunk;
#pragma unroll
        for (int i = 0; i < 8; ++i) {
            const unsigned wa = va[it][i >> 1], wb = vb[it][i >> 1];
            const unsigned wv = (i & 1) ? ((wa >> 16) | (wb & 0xffff0000u)) : ((wa & 0xffffu) | (wb << 16));
            *(LAS unsigned*)(VT + toff(d0 + i, quad, 256) + pp * 4) = wv;
        }
    }
    __syncthreads();
    TS_MARK(25);
    u32x4 gv[8];
    { const int tid3 = opaque(F.tid);
#pragma unroll
      for (int it = 0; it < 8; ++it) gv[it] = *(const GAS u32x4*)(Gs + (size_t)((tid3 >> 5) + 16 * it) * PLD + (tid3 & 31) * 8); }
    r = opaque(r); hh = opaque(hh);
#pragma unroll 1
    for (int ks = 0; ks < 8; ++ks) {
        const bf16x8 bb = frag(VT, 32 * w + r, 2 * ks + hh, 256);
#pragma unroll
        for (int ib = 0; ib < 4; ++ib)
            if (ks < 2 * (ib + 1)) { const bf16x8 a = frag(PB, 32 * ib + r, 2 * ks + hh, 256); o[ib] = MFMA32(a, bb, o[ib]); }
    }
    __syncthreads();
    TS_MARK(26);
    r = opaque(r); hh = opaque(hh);
#pragma unroll
    for (int ib = 0; ib < 4; ++ib)
#pragma unroll
        for (int reg = 0; reg < 16; ++reg) { const int i = 32 * ib + crow(reg, hh);
            *(LAS bf16_t*)(OB + i * 512 + (32 * w + r) * 2) = (bf16_t)f2bf(o[ib][reg]); }
    __syncthreads();
    TS_MARK(27);
    {
        const int tid2 = opaque(F.tid), cc = tid2 & 31;
        const f32x4 wa = *(const GAS f32x4*)(retw + h * 256 + cc * 8), wb = *(const GAS f32x4*)(retw + h * 256 + cc * 8 + 4);
#pragma unroll
        for (int it = 0; it < 8; ++it) {
            const int i = (tid2 >> 5) + 16 * it;
            const u32x4 ov = *(const LAS u32x4*)(OB + i * 512 + cc * 16);
            float x[8];
#pragma unroll
            for (int k = 0; k < 4; ++k) { x[2 * k] = bflo(ov[k]); x[2 * k + 1] = bfhi(ov[k]); }
            float sq = 0.f;
#pragma unroll
            for (int k = 0; k < 8; ++k) sq += x[k] * x[k];
            sq += __shfl_xor(sq, 1); sq += __shfl_xor(sq, 2); sq += __shfl_xor(sq, 4); sq += __shfl_xor(sq, 8); sq += __shfl_xor(sq, 16);
            const float rstd = 1.0f / sqrtf(sq * (1.f / 256.f) + EPS);
            u32x4 res;
            res[0] = pk2(x[0] * rstd * wa[0] * bflo(gv[it][0]), x[1] * rstd * wa[1] * bfhi(gv[it][0]));
            res[1] = pk2(x[2] * rstd * wa[2] * bflo(gv[it][1]), x[3] * rstd * wa[3] * bfhi(gv[it][1]));
            res[2] = pk2(x[4] * rstd * wb[0] * bflo(gv[it][2]), x[5] * rstd * wb[1] * bfhi(gv[it][2]));
            res[3] = pk2(x[6] * rstd * wb[2] * bflo(gv[it][3]), x[7] * rstd * wb[3] * bfhi(gv[it][3]));
            *(GAS u32x4*)(MIX + (size_t)(rows0 + i) * D + h * 256 + cc * 8) = res;
        }
    }
    __syncthreads();
}

__device__ __forceinline__ void s_item(Frame& F, const bf16_t* PROJ, const float* state, const float* retw, float* newstate, bf16_t* MIX, int item) {
    const int sb = item >> 2, h = item & 3, rows0 = MP + sb * 8;
    const float lg = lg2gamma(h);
    LAS float* QK = (LAS float*)F.lds;
    LAS float* QR = (LAS float*)(F.lds + 16384);
    LAS float* KR = (LAS float*)(F.lds + 16384 + 8224);
    LAS float* SCP = (LAS float*)(F.lds + 16384 + 2 * 8224);
    LAS float* SCO = (LAS float*)(F.lds + 16384 + 2 * 8224 + 2048);
    LAS float* RED = (LAS float*)(F.lds + 40960);
    const int w = opaque(F.wave), l = opaque(F.lane), tid_o = opaque(F.tid);
    {
        const int isk = tid_o >> 8, i = (tid_o >> 5) & 7, d8 = (tid_o & 31) * 8;
        const u32x4 raw = *(const GAS u32x4*)(PROJ + (size_t)(isk * 4 + h) * PTILE + (size_t)(rows0 + i) * PLD + d8);
        float f[8];
#pragma unroll
        for (int q = 0; q < 4; ++q) { f[2 * q] = bflo(raw[q]); f[2 * q + 1] = bfhi(raw[q]); }
        const float sc = __builtin_amdgcn_exp2f(lg * (float)(isk ? 7 - i : i + 1));
        LAS float* R = isk ? KR : QR;
#pragma unroll
        for (int k = 0; k < 8; ++k) { R[i * 257 + d8 + k] = f[k]; QK[(d8 + k) * 16 + isk * 8 + i] = f[k] * sc; }
    }
    float v[8][4];
#pragma unroll
    for (int j = 0; j < 8; ++j) { const u32x2 t = *(const GAS u32x2*)(PROJ + (size_t)(8 + h) * PTILE + (size_t)(rows0 + j) * PLD + 4 * l); v[j][0] = bflo(t.x); v[j][1] = bfhi(t.x); v[j][2] = bflo(t.y); v[j][3] = bfhi(t.y); }
    __syncthreads();
    {
        const int i = l >> 3, j = l & 7; float s = 0.f;
#pragma unroll 8
        for (int d = 32 * w; d < 32 * w + 32; ++d) s += QR[i * 257 + d] * KR[j * 257 + d];
        SCP[w * 64 + l] = s;
    }
    float oacc[8][4];
#pragma unroll
    for (int i = 0; i < 8; ++i)
#pragma unroll
        for (int c = 0; c < 4; ++c) oacc[i][c] = 0.f;
    const float g8 = __builtin_amdgcn_exp2f(lg * 8.f);
    const GAS f32x4* Sp = (const GAS f32x4*)(state + ((size_t)(sb * 4 + h) * 256 + 32 * w) * 256) + l;
    GAS f32x4* Np = (GAS f32x4*)(newstate + ((size_t)(sb * 4 + h) * 256 + 32 * w) * 256) + l;
    f32x4 sA[4], sB[4];
#define S_LOAD4(dst, row0) do { const GAS f32x4* p0_ = Sp + (size_t)(row0) * 64; asm volatile("" : "+v"(p0_)); \
        _Pragma("unroll") for (int k = 0; k < 4; ++k) dst[k] = p0_[k * 64]; } while (0)
#define S_COMP4(src, row0) do { GAS f32x4* n0_ = Np + (size_t)(row0) * 64; asm volatile("" : "+v"(n0_)); \
        _Pragma("unroll") for (int k = 0; k < 4; ++k) { \
            const LAS f32x4* qk = (const LAS f32x4*)(QK + (32 * w + (row0) + k) * 16); \
            const f32x4 qa = qk[0], qb = qk[1], ka = qk[2], kb = qk[3]; f32x4 n; \
            _Pragma("unroll") for (int c = 0; c < 4; ++c) { const float sv = src[k][c]; \
                oacc[0][c] += qa[0] * sv; oacc[1][c] += qa[1] * sv; oacc[2][c] += qa[2] * sv; oacc[3][c] += qa[3] * sv; \
                oacc[4][c] += qb[0] * sv; oacc[5][c] += qb[1] * sv; oacc[6][c] += qb[2] * sv; oacc[7][c] += qb[3] * sv; \
                float t = g8 * sv; \
                t += ka[0] * v[0][c]; t += ka[1] * v[1][c]; t += ka[2] * v[2][c]; t += ka[3] * v[3][c]; \
                t += kb[0] * v[4][c]; t += kb[1] * v[5][c]; t += kb[2] * v[6][c]; t += kb[3] * v[7][c]; n[c] = t; } \
            n0_[k * 64] = n; \
            if (k & 1) asm volatile("" ::: "memory"); } } while (0)
    S_LOAD4(sA, 0);
#pragma unroll 1
    for (int h2 = 0; h2 < 4; ++h2) {
        S_LOAD4(sB, 8 * h2 + 4);
        S_COMP4(sA, 8 * h2);
        if (h2 < 3) S_LOAD4(sA, 8 * h2 + 8);
        S_COMP4(sB, 8 * h2 + 4);
    }
#undef S_LOAD4
#undef S_COMP4
#pragma unroll
    for (int i = 0; i < 8; ++i) *(LAS f32x4*)(RED + (w * 8 + i) * 256 + 4 * l) = (f32x4){oacc[i][0], oacc[i][1], oacc[i][2], oacc[i][3]};
    __syncthreads();
    if (tid_o < 64) { const int i = l >> 3, j = l & 7; float s = 0.f;
#pragma unroll
        for (int ww = 0; ww < 8; ++ww) s += SCP[ww * 64 + l];
        SCO[l] = (i >= j) ? s * __builtin_amdgcn_exp2f(lg * (float)(i - j)) : 0.f; }
    __syncthreads();
    {
        const int i = w; f32x4 tot = (f32x4){0.f, 0.f, 0.f, 0.f};
#pragma unroll
        for (int ww = 0; ww < 8; ++ww) tot += *(const LAS f32x4*)(RED + (ww * 8 + i) * 256 + 4 * l);
#pragma unroll
        for (int j = 0; j < 8; ++j) { const float s = SCO[i * 8 + j];
#pragma unroll
            for (int c = 0; c < 4; ++c) tot[c] += s * v[j][c]; }
        const float ss = wave_sum((tot[0] * tot[0] + tot[1] * tot[1]) + (tot[2] * tot[2] + tot[3] * tot[3]));
        const float rstd = 1.0f / sqrtf(ss * (1.f / 256.f) + EPS);
        const f32x4 wn = *(const GAS f32x4*)(retw + h * 256 + 4 * l);
        const u32x2 gv = *(const GAS u32x2*)(PROJ + (size_t)(12 + h) * PTILE + (size_t)(rows0 + i) * PLD + 4 * l);
        u32x2 res; res.x = pk2(tot[0] * rstd * wn[0] * bflo(gv.x), tot[1] * rstd * wn[1] * bfhi(gv.x)); res.y = pk2(tot[2] * rstd * wn[2] * bflo(gv.y), tot[3] * rstd * wn[3] * bfhi(gv.y));
        *(GAS u32x2*)(MIX + (size_t)(rows0 + i) * D + h * 256 + 4 * l) = res;
    }
    __syncthreads();
}

__device__ __forceinline__ void unpk8(const u32x4 v, float (&f)[8]) {
#pragma unroll
    for (int q = 0; q < 4; ++q) { f[2 * q] = bflo(v[q]); f[2 * q + 1] = bfhi(v[q]); }
}
template <int W>
__device__ __forceinline__ void pool_prompt_blk(const bf16_t* PROJ, bf16_t* POOLED, float* outp, int rb, int ch) {
    const int m0 = rb * 8, t0 = m0 & (SEQ - 1), bseq = m0 >> 11;
    const bf16_t* U = PROJ + (size_t)(16 + (ch >> 8)) * PTILE + (ch & 255);
    u32x4 x[W + 7];
#pragma unroll
    for (int i = 0; i < W + 7; ++i) { const int t = t0 - (W - 1) + i; const int mi = (t >= 0) ? m0 - (W - 1) + i : m0; x[i] = *(const GAS u32x4*)(U + (size_t)mi * PLD); }
#pragma unroll
    for (int i = 0; i < W - 1; ++i) { const int t = t0 - (W - 1) + i; if (t < 0) x[i] = (u32x4){0u, 0u, 0u, 0u}; }
    float sum[8];
#pragma unroll
    for (int k = 0; k < 8; ++k) sum[k] = 0.f;
#pragma unroll
    for (int i = 0; i < W - 1; ++i) { float f[8]; unpk8(x[i], f);
#pragma unroll
        for (int k = 0; k < 8; ++k) sum[k] += f[k]; }
#pragma unroll
    for (int r = 0; r < 8; ++r) {
        float cur[8]; unpk8(x[W - 1 + r], cur);
#pragma unroll
        for (int k = 0; k < 8; ++k) sum[k] += cur[k];
        const int t = t0 + r; const int cnt = (t + 1 < W) ? t + 1 : W; const float inv = 1.0f / (float)cnt;
        u32x4 o;
#pragma unroll
        for (int q = 0; q < 4; ++q) o[q] = pk2(sum[2 * q] * inv - cur[2 * q], sum[2 * q + 1] * inv - cur[2 * q + 1]);
        *(GAS u32x4*)(POOLED + (size_t)(m0 + r) * 1024 + ch) = o;
        float sub[8]; unpk8(x[r], sub);
#pragma unroll
        for (int k = 0; k < 8; ++k) sum[k] -= sub[k];
        if (t >= SEQ - 15) { float* op = outp + ((size_t)bseq * 15 + (t - (SEQ - 15))) * 1024 + ch;
            *(GAS f32x4*)op = (f32x4){cur[0], cur[1], cur[2], cur[3]}; *(GAS f32x4*)(op + 4) = (f32x4){cur[4], cur[5], cur[6], cur[7]}; }
    }
}
template <int W>
__device__ __forceinline__ void pool_sample_blk(const bf16_t* PROJ, const float* spool, bf16_t* POOLED, float* outs, int sb, int ch) {
    const bf16_t* U = PROJ + (size_t)(16 + (ch >> 8)) * PTILE + (size_t)(MP + sb * 8) * PLD + (ch & 255);
    const float* B = spool + (size_t)sb * 15 * 1024 + ch;
    f32x4 ba[W - 1], bb[W - 1]; u32x4 xn[8]; f32x4 ca[7], cb[7];
#pragma unroll
    for (int i = 0; i < W - 1; ++i) { ba[i] = *(const GAS f32x4*)(B + (size_t)(15 - (W - 1) + i) * 1024); bb[i] = *(const GAS f32x4*)(B + (size_t)(15 - (W - 1) + i) * 1024 + 4); }
#pragma unroll
    for (int r = 0; r < 8; ++r) xn[r] = *(const GAS u32x4*)(U + (size_t)r * PLD);
#pragma unroll
    for (int rr = 0; rr < 7; ++rr) { ca[rr] = *(const GAS f32x4*)(B + (size_t)(8 + rr) * 1024); cb[rr] = *(const GAS f32x4*)(B + (size_t)(8 + rr) * 1024 + 4); }
    float sum[8];
#pragma unroll
    for (int k = 0; k < 8; ++k) sum[k] = 0.f;
#pragma unroll
    for (int i = 0; i < W - 1; ++i)
#pragma unroll
        for (int q = 0; q < 4; ++q) { sum[q] += ba[i][q]; sum[4 + q] += bb[i][q]; }
    const float inv = 1.0f / (float)W;
#pragma unroll
    for (int r = 0; r < 8; ++r) {
        float cur[8]; unpk8(xn[r], cur);
#pragma unroll
        for (int k = 0; k < 8; ++k) sum[k] += cur[k];
        u32x4 o;
#pragma unroll
        for (int q = 0; q < 4; ++q) o[q] = pk2(sum[2 * q] * inv - cur[2 * q], sum[2 * q + 1] * inv - cur[2 * q + 1]);
        *(GAS u32x4*)(POOLED + (size_t)(MP + sb * 8 + r) * 1024 + ch) = o;
        if (r < W - 1) {
#pragma unroll
            for (int q = 0; q < 4; ++q) { sum[q] -= ba[r < W - 1 ? r : 0][q]; sum[4 + q] -= bb[r < W - 1 ? r : 0][q]; }
        } else { float sub[8]; unpk8(xn[r >= W - 1 ? r - (W - 1) : 0], sub);
#pragma unroll
            for (int k = 0; k < 8; ++k) sum[k] -= sub[k]; }
        float* op = outs + ((size_t)sb * 15 + 7 + r) * 1024 + ch;
        *(GAS f32x4*)op = (f32x4){cur[0], cur[1], cur[2], cur[3]}; *(GAS f32x4*)(op + 4) = (f32x4){cur[4], cur[5], cur[6], cur[7]};
    }
#pragma unroll
    for (int rr = 0; rr < 7; ++rr) { float* op = outs + ((size_t)sb * 15 + rr) * 1024 + ch; *(GAS f32x4*)op = ca[rr]; *(GAS f32x4*)(op + 4) = cb[rr]; }
}
__device__ __forceinline__ void pool_tasks(Frame& F, const bf16_t* PROJ, const float* spool, bf16_t* POOLED, float* outp, float* outs) {
    for (int gt = F.vcu * NTHR + opaque(F.tid); gt < 1024 * 128; gt += F.G * NTHR) {
        const int cgp = gt & 31, rbl = (gt >> 5) & 1, grp = (gt >> 6) & 3, rb = (gt >> 8) * 2 + rbl, ch = grp * 256 + cgp * 8;
        if (grp == 0) pool_prompt_blk<2>(PROJ, POOLED, outp, rb, ch); else if (grp == 1) pool_prompt_blk<4>(PROJ, POOLED, outp, rb, ch);
        else if (grp == 2) pool_prompt_blk<8>(PROJ, POOLED, outp, rb, ch); else pool_prompt_blk<16>(PROJ, POOLED, outp, rb, ch);
    }
    if (F.G * 64 >= 128 * 128 ? F.tid < 64 : true)
    for (int gt = (F.G * 64 >= 128 * 128) ? F.vcu * 64 + opaque(F.tid) : F.vcu * NTHR + opaque(F.tid); gt < 128 * 128; gt += (F.G * 64 >= 128 * 128) ? F.G * 64 : F.G * NTHR) {
        const int cgp = gt & 31, sbl = (gt >> 5) & 1, grp = (gt >> 6) & 3, sb = (gt >> 8) * 2 + sbl, ch = grp * 256 + cgp * 8;
        if (grp == 0) pool_sample_blk<2>(PROJ, spool, POOLED, outs, sb, ch); else if (grp == 1) pool_sample_blk<4>(PROJ, spool, POOLED, outs, sb, ch);
        else if (grp == 2) pool_sample_blk<8>(PROJ, spool, POOLED, outs, sb, ch); else pool_sample_blk<16>(PROJ, spool, POOLED, outs, sb, ch);
    }
}

__device__ __forceinline__ void load_row_bf16(const bf16_t* row, int nparts, size_t pstride, int lane, float (&f)[4][8]) {
#pragma unroll
    for (int j = 0; j < 4; ++j)
#pragma unroll
        for (int q = 0; q < 8; ++q) f[j][q] = 0.f;
    for (int p = 0; p < nparts; ++p) {
        u32x4 v[4];
#pragma unroll
        for (int j = 0; j < 4; ++j) v[j] = *(const GAS u32x4*)(row + (size_t)p * pstride + 8 * lane + 512 * j);
#pragma unroll
        for (int j = 0; j < 4; ++j)
#pragma unroll
            for (int q = 0; q < 4; ++q) { f[j][2 * q] += bflo(v[j][q]); f[j][2 * q + 1] += bfhi(v[j][q]); }
    }
}
__device__ __forceinline__ void n1_row(const float* xrow, const bf16_t* mo, int nparts, size_t pstride, const float* wpost, const float* wpre, bf16_t* x1row, bf16_t* hrow, int lane) {
    f32x4 xa[4], xb[4]; float s = 0.f;
#pragma unroll
    for (int j = 0; j < 4; ++j) { const int c = 8 * lane + 512 * j; xa[j] = *(const GAS f32x4*)(xrow + c); xb[j] = *(const GAS f32x4*)(xrow + c + 4); }
    float mf[4][8];
    load_row_bf16(mo, nparts, pstride, lane, mf);
#pragma unroll
    for (int j = 0; j < 4; ++j)
#pragma unroll
        for (int q = 0; q < 8; ++q) s += mf[j][q] * mf[j][q];
    const float r1 = 1.0f / sqrtf(wave_sum(s) * (1.f / D) + EPS);
    float s2 = 0.f;
#pragma unroll
    for (int j = 0; j < 4; ++j) { const int c = 8 * lane + 512 * j; const f32x4 wa = *(const GAS f32x4*)(wpost + c), wb = *(const GAS f32x4*)(wpost + c + 4);
#pragma unroll
        for (int q = 0; q < 4; ++q) { xa[j][q] += mf[j][q] * r1 * wa[q]; xb[j][q] += mf[j][4 + q] * r1 * wb[q]; s2 += xa[j][q] * xa[j][q] + xb[j][q] * xb[j][q]; }
        { u32x4 o1; o1.x = pk2(xa[j][0], xa[j][1]); o1.y = pk2(xa[j][2], xa[j][3]); o1.z = pk2(xb[j][0], xb[j][1]); o1.w = pk2(xb[j][2], xb[j][3]); *(GAS u32x4*)(x1row + c) = o1; } }
    const float r2 = 1.0f / sqrtf(wave_sum(s2) * (1.f / D) + EPS);
#pragma unroll
    for (int j = 0; j < 4; ++j) { const int c = 8 * lane + 512 * j; const f32x4 wa = *(const GAS f32x4*)(wpre + c), wb = *(const GAS f32x4*)(wpre + c + 4);
        u32x4 o; o.x = pk2(xa[j][0] * r2 * wa[0], xa[j][1] * r2 * wa[1]); o.y = pk2(xa[j][2] * r2 * wa[2], xa[j][3] * r2 * wa[3]);
        o.z = pk2(xb[j][0] * r2 * wb[0], xb[j][1] * r2 * wb[1]); o.w = pk2(xb[j][2] * r2 * wb[2], xb[j][3] * r2 * wb[3]);
        *(GAS u32x4*)(hrow + c) = o; }
}
__device__ __forceinline__ void n2_row(const bf16_t* ff, int nparts, size_t pstride, const float* wpost, const bf16_t* x1row, float* yrow, int lane) {
    float s = 0.f; float ffl[4][8];
    load_row_bf16(ff, nparts, pstride, lane, ffl);
#pragma unroll
    for (int j = 0; j < 4; ++j)
#pragma unroll
        for (int q = 0; q < 8; ++q) s += ffl[j][q] * ffl[j][q];
    const float r1 = 1.0f / sqrtf(wave_sum(s) * (1.f / D) + EPS);
#pragma unroll
    for (int j = 0; j < 4; ++j) { const int c = 8 * lane + 512 * j; const f32x4 wa = *(const GAS f32x4*)(wpost + c), wb = *(const GAS f32x4*)(wpost + c + 4);
        const u32x4 xv = *(const GAS u32x4*)(x1row + c);
        f32x4 ya = (f32x4){bflo(xv.x), bfhi(xv.x), bflo(xv.y), bfhi(xv.y)}, yb = (f32x4){bflo(xv.z), bfhi(xv.z), bflo(xv.w), bfhi(xv.w)};
#pragma unroll
        for (int q = 0; q < 4; ++q) { ya[q] += ffl[j][q] * r1 * wa[q]; yb[q] += ffl[j][4 + q] * r1 * wb[q]; }
        *(GAS f32x4*)(yrow + c) = ya; *(GAS f32x4*)(yrow + c + 4) = yb; }
}

constexpr int NPH = 10;
__global__ void __launch_bounds__(NTHR, 2) hyb_fwd(Args args) {
    extern __shared__ __attribute__((aligned(16))) unsigned char lds[];
    Frame F;
    F.lds = (LAS unsigned char*)lds;
    F.tid = threadIdx.x; F.lane = F.tid & 63; F.wave = __builtin_amdgcn_readfirstlane(F.tid >> 6);
    F.G = gridDim.x; { const int bx = blockIdx.x; F.vcu = (F.G % 8 == 0) ? (bx % 8) * (F.G / 8) + bx / 8 : bx; }
    if (F.tid == 0) {
        volatile LAS unsigned long long* at = (volatile LAS unsigned long long*)(F.lds + ARG_OFF);
#pragma unroll
        for (int i = 0; i < 16; ++i) at[i] = (unsigned long long)args.in[i];
        at[16] = (unsigned long long)args.out; at[17] = (unsigned long long)args.ws;
    }
    const int lo = args.ph_lo, hi = args.ph_hi;
    if (F.tid < 32) ((volatile LAS unsigned*)(F.lds + MISC_OFF))[F.tid] = 0u;
    __syncthreads();
#if NO_MEMSET_NODE
    if (blockIdx.x == 0) { unsigned* bw = (unsigned*)(AWS + WS_CTL) + CW_BAR; for (int i = F.tid; i < XCD_BAR_WORDS; i += NTHR) __hip_atomic_store(bw + i, 0u, __ATOMIC_RELAXED, __HIP_MEMORY_SCOPE_AGENT); }
#else
    if (args.use_cg) xcd_barrier_post((unsigned*)(AWS + WS_CTL) + CW_BAR);
#endif
    if (args.pad == 0x5a5a5a5a) cg::this_grid().sync();
#ifndef PH_ENABLE
#define PH_ENABLE 0x3ff
#endif
#define IN(k) (((PH_ENABLE >> (k)) & 1) && lo <= (k) && (k) < hi)
#define BOTH(k) (IN(k) && IN((k) + 1))
#ifndef REP_MASK
#define REP_MASK 0
#endif
#define REPS(k) for (int rep_ = 0; rep_ <= ((REP_MASK >> (k)) & 1); ++rep_)
#define REP_MORE(k) (rep_ < ((REP_MASK >> (k)) & 1))
#ifndef CG_SEAMS
#define CG_SEAMS (NO_MEMSET_NODE ? 0x001 : 0x000)
#endif
#define GRID_BAR(k) do { if ((CG_SEAMS >> (k)) & 1) cg::this_grid().sync(); else xcd_barrier((unsigned*)(AWS + WS_CTL) + CW_BAR, (volatile LAS unsigned*)(F.lds + MISC_OFF) + 8); } while (0)
#define WSP(off) ((bf16_t*)(ws + (off)))
    TS_MARK(0);
#ifndef SUBREP_MASK
#define SUBREP_MASK 0
#endif
#define SUBREP(k) for (int sr_ = 0; sr_ <= ((SUBREP_MASK >> (k)) & 1); ++sr_)
    if (IN(0)) REPS(0) { p0_prologue(F); if (BOTH(0) || REP_MORE(0)) GRID_BAR(0); TS_MARK(1); }
#if NO_MEMSET_NODE
    if (args.use_cg) xcd_barrier_post((unsigned*)(AWS + WS_CTL) + CW_BAR);
#endif
    if (IN(1)) REPS(1) {
        unsigned char* ws = AWS;
        const int jx = (int)blockIdx.x / 8, spare = F.G / 8 - 30;
        if (F.G != 256 || jx < 30) {
            const int GG = F.G == 256 ? 240 : F.G;
            pg8::Gemm g{WSP(WS_H), WSP(WS_WIN), D, D, D, 0}; pg8::HybridOrder S; S.init(M / 256, INW / 256, D, GG, (int)blockIdx.x, 3);
            pg8::EpiProj E{WSP(WS_PROJ), (const float*)(ws + WS_CS)};
            pg8::gemm_phase(F.lds, g, S, E, pg8::SkBuf{nullptr, nullptr, nullptr});
        }
#ifndef ABL_NO_CONV1
        else p0_transposes(F, TR_A, TR_B, (jx - 30) * 8 + (int)blockIdx.x % 8, spare * 8);
#endif
        if (BOTH(1) || REP_MORE(1)) GRID_BAR(1); TS_MARK(2);
    }
    if (IN(2)) REPS(2) {
        unsigned char* ws = AWS; float* out = AOUT;
#pragma unroll 1
        for (int step = 0; step < 2; ++step) {
            if (((step ^ F.vcu) & 1) == 0) {
                for (int it = F.vcu; it < 256; it += F.G) u_item(F, WSP(WS_PROJ), WSP(WS_UT), it);
                pool_tasks(F, WSP(WS_PROJ), AIN(3), WSP(WS_POOLED), out + O_POOLP, out + O_POOLS);
            } else {
                const float* st = AIN(2); const float* rw = AIN(7);
                for (int it = F.vcu; it < 512; it += F.G) s_item(F, WSP(WS_PROJ), st, rw, out + O_RETS, WSP(WS_MIX), it);
            }
        }
        if (BOTH(2) || REP_MORE(2)) GRID_BAR(2); TS_MARK(3);
    }
    if (IN(3)) REPS(3) {
        unsigned char* ws = AWS;
#ifdef POOL_TWICE
        { float* out2 = AOUT; pool_tasks(F, WSP(WS_PROJ), AIN(3), WSP(WS_POOLED), out2 + O_POOLP, out2 + O_POOLS); asm volatile("s_waitcnt vmcnt(0)" ::: "memory"); __syncthreads(); }
#endif
        {
        float* out = AOUT; const bf16_t* UT = WSP(WS_UT); bf16_t* SCT = WSP(WS_SCT);
        int t_lo, t_hi;
        { const int jx = (int)blockIdx.x / 8, xx = (int)blockIdx.x % 8;
          if (F.G == 256) { const int slot = jx < 18 ? jx * 8 + xx : 144 + 5 * ((jx - 18) * 8 + xx), ns = jx < 18 ? 1 : 5;
              t_lo = (int)((long)slot * 131072 / 704); t_hi = (int)((long)(slot + ns) * 131072 / 704); }
          else { t_lo = (int)((long)blockIdx.x * 131072 / F.G); t_hi = (int)((long)(blockIdx.x + 1) * 131072 / F.G); } }
        for (int idx = t_lo + F.tid; idx < t_hi; idx += NTHR) {
            const int bh = idx >> 13, e = (idx >> 5) & 255, d8 = (idx & 31) * 8;
            const float g128 = __builtin_amdgcn_exp2f(lg2gamma(bh & 3) * 128.f);
            float s[8];
#pragma unroll
            for (int k = 0; k < 8; ++k) s[k] = 0.f;
            u32x4 uv[16];
#pragma unroll
            for (int c = 0; c < 16; ++c) uv[c] = *(const GAS u32x4*)(UT + ((size_t)(bh * 16 + c) * 256 + e) * 256 + d8);
#pragma unroll
            for (int c = 0; c < 16; ++c) {
                u32x4 o; o.x = pk2(s[0], s[1]); o.y = pk2(s[2], s[3]); o.z = pk2(s[4], s[5]); o.w = pk2(s[6], s[7]);
                *(GAS u32x4*)(SCT + ((size_t)(bh * 16 + c) * 256 + e) * 256 + d8) = o;
#pragma unroll
                for (int k = 0; k < 4; ++k) { s[2 * k] = g128 * s[2 * k] + bflo(uv[c][k]); s[2 * k + 1] = g128 * s[2 * k + 1] + bfhi(uv[c][k]); }
            }
            float* op = out + O_RETP + (size_t)bh * 65536 + e;
#pragma unroll
            for (int k = 0; k < 8; ++k) op[(size_t)(d8 + k) * 256] = s[k];
        }
        }
        TS_MARK(13);
        {
            pg8::Gemm g{WSP(WS_POOLED), WSP(WS_WPOOL), 1024, 256, 256, 256}; pg8::HybridOrder S; S.init(M / 256, 4, 256, F.G, (int)blockIdx.x, 1);
            pg8::EpiPlain E{WSP(WS_MIX), D, 1024, AIN(9)};
            pg8::gemm_phase(F.lds, g, S, E, pg8::SkBuf{nullptr, nullptr, nullptr});
        }
        TS_MARK(14);
        if (BOTH(3) || REP_MORE(3)) GRID_BAR(3); TS_MARK(4);
    }
    if (IN(4)) REPS(4) {
        unsigned char* ws = AWS; const float* rw = AIN(7);
        for (int it = F.vcu; it < 256; it += F.G) o_item(F, WSP(WS_PROJ), WSP(WS_SCT), rw, WSP(WS_MIX), it);
        TS_MARK(15);
#ifdef ABL_O_TWICE
        for (int it = F.vcu; it < 256; it += F.G) o_item(F, WSP(WS_PROJ), WSP(WS_SCT), rw, WSP(WS_MIX), (it + 128) & 255);
        TS_MARK(16);
#endif
        if (BOTH(4) || REP_MORE(4)) GRID_BAR(4); TS_MARK(5);
    }
    if (IN(5)) REPS(5) {
        unsigned char* ws = AWS;
        pg8::Gemm g{WSP(WS_MIX), WSP(WS_WOUT), D, D, D, 0}; pg8::HybridOrder S; S.init(M / 256, D / 256, D, F.G, (int)blockIdx.x, SK_RS_P3, SPLIT_MODE);
        pg8::EpiPlain E{WSP(WS_MO), D, 0, nullptr};
        pg8::gemm_phase(F.lds, g, S, E, pg8::SkBuf{(float*)(ws + WS_POOLED), (unsigned*)(ws + WS_CTL) + CW_SK, WSP(WS_PART3)});
        if (BOTH(5) || REP_MORE(5)) GRID_BAR(5); TS_MARK(6);
    }
    if (IN(6)) REPS(6) {
        unsigned char* ws = AWS; float* out = AOUT;
        const float* xp_ = AIN(0); const float* xs_ = AIN(1); const float* w5 = AIN(5); const float* w11 = AIN(11);
        const int gw = F.vcu * NWAVES + F.wave, NGW = F.G * NWAVES;
        for (int m = gw; m < M; m += NGW) { const bool sp = SPLIT_MODE && m >= MP;
            n1_row(xrow_ptr(xp_, xs_, m), sp ? WSP(WS_PART3) + (size_t)(m - MP) * D : WSP(WS_MO) + (size_t)m * D, sp ? 8 : 1, (size_t)1024 * 2048, w5, w11, WSP(WS_MO) + (size_t)m * D, WSP(WS_H) + (size_t)m * D, F.lane); }
        if (BOTH(6) || REP_MORE(6)) GRID_BAR(6); TS_MARK(7);
    }
    if (IN(7)) REPS(7) {
        unsigned char* ws = AWS;
        const int jx = (int)blockIdx.x / 8;
        if (jx < 29) {
            pg8::Gemm g{WSP(WS_H), WSP(WS_WGU), D, D, D, 0}; pg8::HybridOrder S; S.init(M / 256, NGU / 256, D, 232, (int)blockIdx.x, SK_RS_P4);
            pg8::EpiGU E{WSP(WS_HID)};
            pg8::gemm_phase(F.lds, g, S, E, pg8::SkBuf{(float*)(ws + WS_MO), (unsigned*)(ws + WS_CTL) + CW_SK + 16384, nullptr});
        } else p0_transposes(F, TR_B, TR_C, (jx - 29) * 8 + (int)blockIdx.x % 8, 24);
        if (BOTH(7) || REP_MORE(7)) GRID_BAR(7); TS_MARK(8);
    }
    if (IN(8)) REPS(8) {
        unsigned char* ws = AWS;
        pg8::Gemm g{WSP(WS_HID), WSP(WS_WD), DFF, DFF, DFF, 0}; pg8::HybridOrder S; S.init(M / 256, D / 256, DFF, F.G, (int)blockIdx.x, SK_RS_P5, SPLIT_MODE);
        pg8::EpiPlain E{WSP(WS_FF), D, 0, nullptr};
        pg8::gemm_phase(F.lds, g, S, E, pg8::SkBuf{(float*)(ws + WS_POOLED), (unsigned*)(ws + WS_CTL) + CW_SK + 32768, WSP(WS_PART5)});
        if (BOTH(8) || REP_MORE(8)) GRID_BAR(8); TS_MARK(9);
    }
    if (IN(9)) {
        unsigned char* ws = AWS; float* out = AOUT; const float* w12 = AIN(12);
        const int gw = F.vcu * NWAVES + F.wave, NGW = F.G * NWAVES;
        for (int m = gw; m < M; m += NGW) { const bool sp = SPLIT_MODE && m >= MP;
            n2_row(sp ? WSP(WS_PART5) + (size_t)(m - MP) * D : WSP(WS_FF) + (size_t)m * D, sp ? 8 : 1, (size_t)1024 * 2048, w12, WSP(WS_MO) + (size_t)m * D, out + O_Y + (size_t)m * D, F.lane); }
#ifdef TS_PHASE
        asm volatile("s_waitcnt vmcnt(0)" ::: "memory"); __syncthreads(); TS_MARK(10);
        if (blockIdx.x == 0 && F.tid == 0) {
            volatile LAS unsigned long long* ts = (volatile LAS unsigned long long*)(F.lds + ARG_OFF + 256);
            const unsigned long long d = ts[TS_B] - ts[TS_A];
            out[O_POOLP] += (float)d * 1e-4f * TS_SCALE;
        }
#endif
    }
#undef IN
#undef BOTH
}

extern "C" void kernel_launch(void* const* d_in, const int* in_sizes, int n_in, void* d_out, int out_size, void* d_ws, size_t ws_size, hipStream_t stream) {
    static int grid = 0;
    if (grid == 0) {
        if (n_in != 16 || (size_t)out_size != O_END || ws_size < WS_END) { fprintf(stderr, "kernel_launch: unexpected shapes: n_in %d out %d ws %zu (need %zu)\n", n_in, out_size, ws_size, (size_t)WS_END); grid = -1; return; }
        int dev = 0, cus = 0, per_cu = 0;
        if (hipGetDevice(&dev) != hipSuccess || hipDeviceGetAttribute(&cus, hipDeviceAttributeMultiprocessorCount, dev) != hipSuccess) { grid = -1; return; }
        if (hipFuncSetAttribute((const void*)hyb_fwd, hipFuncAttributeMaxDynamicSharedMemorySize, LDS_BYTES) != hipSuccess) { fprintf(stderr, "kernel_launch: hipFuncSetAttribute failed\n"); grid = -1; return; }
        if (hipOccupancyMaxActiveBlocksPerMultiprocessor(&per_cu, (const void*)hyb_fwd, NTHR, LDS_BYTES) != hipSuccess || per_cu < 1) { fprintf(stderr, "kernel_launch: occupancy query says %d\n", per_cu); per_cu = 1; }
        (void)hipGetLastError();
        grid = cus * 1;
        if (SPLIT_MODE && grid != 256) { fprintf(stderr, "kernel_launch: this build's unit schedule needs exactly 256 workgroups (got %d CUs); nothing launched\n", cus); grid = -1; return; }
        fprintf(stderr, "kernel_launch: grid %d (occupancy query %d per CU)\n", grid, per_cu);
    }
    if (grid < 0) return;
    Args a{};
    for (int i = 0; i < 16; ++i) a.in[i] = (const float*)d_in[i];
    a.out = (float*)d_out; a.ws = (unsigned char*)d_ws;
    if (!NO_MEMSET_NODE && hipMemsetAsync((char*)d_ws + WS_CTL + CTL_MS_OFF, 0, CTL_MS_BYTES, stream) != hipSuccess) { fprintf(stderr, "kernel_launch: memset failed\n"); return; }
    if (MK_N_LAUNCHES == 1) {
        a.ph_lo = 0; a.ph_hi = NPH; a.use_cg = 1;
        void* kargs[] = {&a};
        hipError_t e = hipLaunchCooperativeKernel((const void*)hyb_fwd, dim3(grid), dim3(NTHR), kargs, LDS_BYTES, stream);
        if (e != hipSuccess) fprintf(stderr, "kernel_launch: cooperative launch failed: %s (grid %d)\n", hipGetErrorString(e), grid);
    } else {
        for (int p = 0; p < NPH; ++p) {
            a.ph_lo = p; a.ph_hi = p + 1; a.use_cg = 0;
            hipLaunchKernelGGL(hyb_fwd, dim3(grid), dim3(NTHR), LDS_BYTES, stream, a);
        }
    }
}
```

```cpp
#include <hip/hip_runtime.h>
#include <hip/hip_cooperative_groups.h>
#include <cstdio>
#include <cstdint>
namespace cg = cooperative_groups;

#ifndef NO_MEMSET_NODE
#define NO_MEMSET_NODE 0
#endif
#ifndef TS_SCALE
#define TS_SCALE 1.0f
#endif
#ifndef MK_N_LAUNCHES
#define MK_N_LAUNCHES 1
#endif

#define GAS __attribute__((address_space(1)))
#define LAS __attribute__((address_space(3)))
typedef unsigned short bf16_t;
typedef short bf16x8 __attribute__((ext_vector_type(8)));
typedef float f32x2 __attribute__((ext_vector_type(2)));
typedef float f32x4 __attribute__((ext_vector_type(4)));
typedef float f32x16 __attribute__((ext_vector_type(16)));
typedef unsigned u32x2 __attribute__((ext_vector_type(2)));
typedef unsigned u32x4 __attribute__((ext_vector_type(4)));

constexpr int D = 2048, MP = 8192, MS = 1024, M = MP + MS, SEQ = 2048;
constexpr int INW = 5120, DFF = 5632, NGU = 2 * DFF;
constexpr int PLD = 256;
constexpr size_t PTILE = (size_t)9216 * 256;
constexpr int NPOS = 2048 + 8;
constexpr float EPS = 1e-6f;
constexpr int NWAVES = 8, NTHR = 512;

constexpr size_t O_Y = 0, O_RETP = (size_t)M * D, O_POOLP = O_RETP + 4 * 4 * 65536, O_RETS = O_POOLP + 4 * 15 * 1024, O_POOLS = O_RETS + (size_t)128 * 4 * 65536, O_END = O_POOLS + 128 * 15 * 1024;

constexpr size_t MiB = 1u << 20;
constexpr size_t WS_CTL = 0, CTL_ZERO_BYTES = 1 * MiB;
constexpr size_t CTL_MS_OFF = 16384, CTL_MS_BYTES = 16384;
constexpr size_t WS_CS = 1 * MiB;
constexpr size_t WS_WPOOL = 4 * MiB;
constexpr size_t WS_WIN = 8 * MiB;
constexpr size_t WS_WOUT = 28 * MiB;
constexpr size_t WS_WGU = 36 * MiB;
constexpr size_t WS_WD = 80 * MiB;
constexpr size_t WS_H = 102 * MiB;
constexpr size_t WS_PROJ = 138 * MiB;
constexpr size_t WS_MIX = 228 * MiB;
constexpr size_t WS_UT = 264 * MiB;
constexpr size_t WS_SCT = 296 * MiB;
constexpr size_t WS_POOLED = 328 * MiB;
constexpr size_t WS_MO = 346 * MiB;
constexpr size_t WS_HID = 138 * MiB;
constexpr size_t WS_FF = 382 * MiB;
constexpr size_t WS_PART3 = 264 * MiB;
constexpr size_t WS_PART5 = 296 * MiB;
#ifndef SPLIT_MODE
#define SPLIT_MODE 1
#endif
constexpr size_t WS_END = 418 * MiB;
static_assert(WS_HID + (size_t)M * DFF * 2 <= WS_UT, "hid overlay");

constexpr int CW_SK = 16384;
#ifndef SK_RS_P3
#define SK_RS_P3 2
#endif
#ifndef SK_RS_P4
#define SK_RS_P4 7
#endif
#ifndef SK_RS_P5
#define SK_RS_P5 2
#endif
constexpr int CW_BAR = 4096;
constexpr int LDS_BYTES = 147456;
constexpr int RING_BYTES = 131072, MISC_OFF = RING_BYTES + 320, ARG_OFF = RING_BYTES + 512;

__device__ __forceinline__ unsigned f2bf(float f) { unsigned u = __builtin_bit_cast(unsigned, f); return (u + 0x7fffu + ((u >> 16) & 1u)) >> 16; }
__device__ __forceinline__ unsigned cvt_pk_bf16(float lo, float hi) { unsigned r; asm volatile("v_cvt_pk_bf16_f32 %0, %1, %2" : "=v"(r) : "v"(lo), "v"(hi)); return r; }
__device__ __forceinline__ unsigned pk2(float lo, float hi) { unsigned r; asm("v_cvt_pk_bf16_f32 %0, %1, %2" : "=v"(r) : "v"(lo), "v"(hi)); return r; }
__device__ __forceinline__ float bflo(unsigned w) { return __builtin_bit_cast(float, w << 16); }
__device__ __forceinline__ float bfhi(unsigned w) { return __builtin_bit_cast(float, w & 0xffff0000u); }
__device__ __forceinline__ float bf2f(bf16_t b) { return __builtin_bit_cast(float, (unsigned)b << 16); }
__device__ __forceinline__ float wave_sum(float v) {
#pragma unroll
    for (int o = 1; o < 64; o <<= 1) v += __shfl_xor(v, o);
    return v;
}
__device__ __forceinline__ float silu(float x) { return x * __builtin_amdgcn_rcpf(1.0f + __builtin_amdgcn_exp2f(-1.4426950408889634f * x)); }
__device__ __forceinline__ float lg2gamma(int h) { return h == 0 ? -0.04580368961312479f : h == 1 ? -0.02272007650008353f : h == 2 ? -0.011315313227834146f : -0.005646563141142063f; }
#define LDS_WAIT() asm volatile("s_waitcnt lgkmcnt(0)" ::: "memory")
__device__ __forceinline__ int opaque(int x) { asm volatile("" : "+v"(x)); return x; }

namespace pg8 {
constexpr int BM = 256, BK = 64, HALF = 128, HTB = HALF * BK * 2, STAGE_BYTES = 8 * HTB, NXCD = 8, WGM = 8;
__host__ __device__ __forceinline__ int lds_byte(int r, int c) { const int st = (r >> 4) * 2 + (c >> 5), rr = r & 15, cc = c & 31, ob = rr * 64 + cc * 2; return st * 1024 + (ob ^ (((ob >> 9) & 1) << 5)); }
__host__ __device__ __forceinline__ void stage_rc(int b, int& R, int& C) { const int st = b / 1024, sb = b % 1024, swz = sb ^ (((sb >> 9) & 1) << 5); R = (st >> 1) * 16 + swz / 64; C = (st & 1) * 32 + (swz % 64) / 2; }
__host__ __device__ __forceinline__ int perm32(int rho) { const int n = rho >> 4, i = rho & 15; return 8 * (i >> 2) + 4 * n + (i & 3); }

struct Unit { int pm, pn, kt0, nkt, role; };
struct Gemm { const bf16_t* A; const bf16_t* Bt; int lda, ldb, K, a_pn_col; };
struct HybridOrder {
    int nM, nN, nwg, G, c, Rs, P, n32, q, s, e, mode;
    __device__ void init(int nM_, int nN_, int K, int G_, int c_, int Rs_, int mode_ = 0) {
        mode = mode_; nM = nM_; nN = nN_; nwg = nM * nN; G = G_; c = c_; Rs = Rs_; P = K / (2 * BK); n32 = G / NXCD; q = nwg / NXCD;
        const int Ux = (q - Rs * n32) > 0 ? (q - Rs * n32) : 0, j = c / NXCD; const long T = (long)Ux * P;
        s = (int)((long)j * T / n32); e = (int)((long)(j + 1) * T / n32);
    }
    __device__ void tile(int wgid, Unit& u) const {
        const int nig = WGM * nN, gid = wgid / nig, fm = gid * WGM, gsz = (nM - fm) < WGM ? (nM - fm) : WGM;
        u.pm = fm + ((wgid % nig) % gsz); u.pn = (wgid % nig) / gsz;
    }
    __device__ bool next(int i, Unit& u) const {
        const int x = c % NXCD, j = c / NXCD;
        if (mode == 1) {
            if (i == 0) { u.pm = 8 * (x >> 1) + (j & 7); u.pn = 4 * (x & 1) + (j >> 3); u.kt0 = 0; u.nkt = 2 * P; u.role = 0; return true; }
            if (i == 1) { u.pm = 32 + (j >> 3); u.pn = j & 7; const int lo = x * P / 8, hi = (x + 1) * P / 8; u.kt0 = 2 * lo; u.nkt = 2 * (hi - lo); u.role = 3; return true; }
            return false;
        }
        if (i < Rs) { if (i * n32 + j >= q) return false; tile(x * q + i * n32 + j, u); u.kt0 = 0; u.nkt = 2 * P; u.role = 0; return true; }
        const int uidx = s / P + (i - Rs), lo = s > uidx * P ? s : uidx * P, hi = e < (uidx + 1) * P ? e : (uidx + 1) * P;
        if (lo >= hi) return false;
        tile(x * q + Rs * n32 + uidx, u);
        u.kt0 = 2 * (lo - uidx * P); u.nkt = 2 * (hi - lo); u.role = (lo > uidx * P) ? 1 : ((hi < (uidx + 1) * P) ? 2 : 0);
        return true;
    }
};
struct SkBuf { float* slab; unsigned* flags; bf16_t* part; };

#ifdef TS_GEMM
#define GTS_MARK(k) do { if (blockIdx.x == 0 && threadIdx.x == 0 && (k) < 48 && S.nN * 100 + S.P == TS_GEMM) ((volatile LAS unsigned long long*)(lds + ARG_OFF + 256))[(k)] = __builtin_amdgcn_s_memrealtime(); } while (0)
#else
#define GTS_MARK(k) do {} while (0)
#endif
template <class Epi>
__device__ __forceinline__ void gemm_phase(LAS unsigned char* lds, const Gemm g, const HybridOrder& S, const Epi& E, const SkBuf sk) {
    const int tid = threadIdx.x, wid = __builtin_amdgcn_readfirstlane(tid >> 6), lane = tid & 63, wr = wid >> 2, wc = wid & 3, fr = lane & 15, fq = lane >> 4;
    unsigned voffA[2], voffB[2];
#pragma unroll
    for (int i = 0; i < 2; ++i) { int R, C; stage_rc(tid * 16 + i * 8192, R, C); const int Rb = (R & ~31) + perm32(R & 31);
        voffA[i] = (unsigned)(R * g.lda + C) * 2u; voffB[i] = (unsigned)(Rb * g.ldb + C) * 2u; }
    const size_t kstep = (size_t)(BK * 2);
    const size_t hstepA = (size_t)HALF * g.lda * 2, hstepB = (size_t)HALF * g.ldb * 2;
    const unsigned ldsw = (unsigned)wid * 1024u;
    const int aoff = lds_byte(wr * 64 + fr, fq * 8), boff = lds_byte(wc * 32 + fr, fq * 8);
#define PG8_UA(u) ((const char*)g.A + ((size_t)(u).pm * BM * g.lda + (size_t)(u).pn * g.a_pn_col + (size_t)(u).kt0 * BK) * 2)
#define PG8_UB(u) ((const char*)g.Bt + ((size_t)(u).pn * BM * g.ldb + (size_t)(u).kt0 * BK) * 2)
#define PG8_SA(b, h) (((b) * 2 + (h)) * HTB)
#define PG8_SB(b, h) ((4 + (b) * 2 + (h)) * HTB)
#define PG8_STAGE(bufoff, gbase, voff) do { _Pragma("unroll") for (int _i = 0; _i < 2; ++_i) \
        __builtin_amdgcn_global_load_lds((const unsigned*)((const char*)(gbase) + (voff)[_i]), (LAS unsigned*)(lds + (bufoff) + ldsw + _i * 8192), 16, 0, 0); } while (0)
#define PG8_LDA(dst, b, h) do { _Pragma("unroll") for (int m = 0; m < 4; ++m) _Pragma("unroll") for (int k = 0; k < 2; ++k) dst[m][k] = *(const LAS bf16x8*)(lds + PG8_SA(b, h) + aoff + m * 2048 + k * 1024); } while (0)
#define PG8_LDB(dst, b, h) do { _Pragma("unroll") for (int n = 0; n < 2; ++n) _Pragma("unroll") for (int k = 0; k < 2; ++k) dst[n][k] = *(const LAS bf16x8*)(lds + PG8_SB(b, h) + boff + n * 2048 + k * 1024); } while (0)
#define PG8_MMA(ai, bj, At, Bt) do { __builtin_amdgcn_s_setprio(1); _Pragma("unroll") for (int m = 0; m < 4; ++m) _Pragma("unroll") for (int n = 0; n < 2; ++n) _Pragma("unroll") for (int k = 0; k < 2; ++k) \
        acc[ai][bj][m][n] = __builtin_amdgcn_mfma_f32_16x16x32_bf16(Bt[n][k], At[m][k], acc[ai][bj][m][n], 0, 0, 0); __builtin_amdgcn_s_setprio(0); } while (0)
#define PG8_WAIT_V(n) asm volatile("s_waitcnt vmcnt(" #n ")" ::: "memory")
#define PG8_WAIT_L(n) asm volatile("s_waitcnt lgkmcnt(" #n ")" ::: "memory")
#define PG8_BAR __builtin_amdgcn_s_barrier()
#define PG8_SCHED __builtin_amdgcn_sched_barrier(0)
    Unit cur, nxt; int ui = 0;
    if (!S.next(0, cur)) return;
    f32x4 acc[2][2][4][2];
#pragma unroll
    for (int a = 0; a < 2; ++a)
#pragma unroll
        for (int b = 0; b < 2; ++b)
#pragma unroll
            for (int m = 0; m < 4; ++m)
#pragma unroll
                for (int n = 0; n < 2; ++n) acc[a][b][m][n] = (f32x4){0.f, 0.f, 0.f, 0.f};
    bf16x8 At[4][2], B0[2][2], B1[2][2];
    const char* cA = PG8_UA(cur); const char* cB = PG8_UB(cur);
    PG8_STAGE(PG8_SB(0, 0), cB, voffB); PG8_STAGE(PG8_SB(0, 1), cB + hstepB, voffB); PG8_STAGE(PG8_SA(0, 0), cA, voffA); PG8_STAGE(PG8_SA(0, 1), cA + hstepA, voffA);
    if (wr == 1) PG8_BAR;
    PG8_WAIT_V(2); PG8_BAR;
    PG8_STAGE(PG8_SB(1, 0), cB + kstep, voffB); PG8_STAGE(PG8_SA(1, 0), cA + kstep, voffA); PG8_STAGE(PG8_SB(1, 1), cB + hstepB + kstep, voffB);
    PG8_WAIT_V(6); PG8_BAR;
    for (;;) {
        const bool has_next = S.next(ui + 1, nxt);
        const char* nA = has_next ? PG8_UA(nxt) : cA; const char* nB = has_next ? PG8_UB(nxt) : cB;
        const int nt = cur.nkt;
        for (int t = 0; t < nt; t += 2) {
            const bool last = (t == nt - 2);
            const char* a1 = cA + (size_t)(t + 1) * kstep;
            const char* a2 = last ? nA : cA + (size_t)(t + 2) * kstep; const char* b2 = last ? nB : cB + (size_t)(t + 2) * kstep;
            const char* a3 = a2 + kstep; const char* b3 = b2 + kstep;
            PG8_LDB(B0, 0, 0); PG8_LDB(B1, 0, 1); PG8_SCHED; PG8_LDA(At, 0, 0); PG8_STAGE(PG8_SA(1, 1), a1 + hstepA, voffA);
            PG8_WAIT_V(8); PG8_WAIT_L(0); PG8_BAR; PG8_MMA(0, 0, At, B0); PG8_MMA(0, 1, At, B1); PG8_BAR; PG8_SCHED;
            PG8_LDA(At, 0, 1); PG8_STAGE(PG8_SB(0, 0), b2, voffB); PG8_STAGE(PG8_SB(0, 1), b2 + hstepB, voffB); PG8_STAGE(PG8_SA(0, 0), a2, voffA);
            PG8_WAIT_V(8); PG8_WAIT_L(0); PG8_BAR; PG8_MMA(1, 0, At, B0); PG8_MMA(1, 1, At, B1); PG8_BAR; PG8_SCHED;
            PG8_LDB(B0, 1, 0); PG8_LDB(B1, 1, 1); PG8_SCHED; PG8_LDA(At, 1, 0); PG8_STAGE(PG8_SA(0, 1), a2 + hstepA, voffA);
            PG8_WAIT_V(8); PG8_WAIT_L(0); PG8_BAR; PG8_MMA(0, 0, At, B0); PG8_MMA(0, 1, At, B1); PG8_BAR; PG8_SCHED;
            PG8_LDA(At, 1, 1); PG8_STAGE(PG8_SB(1, 0), b3, voffB); PG8_STAGE(PG8_SB(1, 1), b3 + hstepB, voffB); PG8_STAGE(PG8_SA(1, 0), a3, voffA);
            PG8_WAIT_V(8); PG8_WAIT_L(0); PG8_BAR; PG8_MMA(1, 0, At, B0); PG8_MMA(1, 1, At, B1); PG8_BAR; PG8_SCHED;
        }
        if (wr == 0) PG8_BAR;
        GTS_MARK(30 + 2 * ui);
        if (cur.role == 1) {
            const __amdgpu_buffer_rsrc_t rs = __builtin_amdgcn_make_buffer_rsrc(sk.slab, 0, 0x7fffffff, 0x00020000);
            const unsigned base = ((unsigned)S.c * 16384u + (unsigned)opaque(tid)) * 16u;
#pragma unroll
            for (int a = 0; a < 2; ++a)
#pragma unroll
                for (int b = 0; b < 2; ++b)
#pragma unroll
                    for (int m = 0; m < 4; ++m)
#pragma unroll
                        for (int n = 0; n < 2; ++n)
                            __builtin_amdgcn_raw_buffer_store_b128(__builtin_bit_cast(u32x4, acc[a][b][m][n]), rs, base + (unsigned)(((a * 2 + b) * 4 + m) * 2 + n) * 8192u, 0, 16);
            PG8_WAIT_V(0); PG8_BAR;
            if (tid == 0) __hip_atomic_store(sk.flags + 64 * S.c, 1u, __ATOMIC_RELAXED, __HIP_MEMORY_SCOPE_AGENT);
        } else if (cur.role == 3) {
            bf16_t* O = sk.part + (size_t)(S.c % NXCD) * 1024 * 2048;
            const int row0 = (cur.pm - 32) * BM + wr * 64 + fr, col0 = cur.pn * BM + wc * 32 + 8 * fq;
#pragma unroll
            for (int ai = 0; ai < 2; ++ai)
#pragma unroll
                for (int m = 0; m < 4; ++m) {
                    bf16_t* rp = O + (size_t)(row0 + ai * HALF + m * 16) * 2048 + col0;
#pragma unroll
                    for (int bj = 0; bj < 2; ++bj) {
                        u32x4 wv; wv.x = cvt_pk_bf16(acc[ai][bj][m][0][0], acc[ai][bj][m][0][1]); wv.y = cvt_pk_bf16(acc[ai][bj][m][0][2], acc[ai][bj][m][0][3]);
                        wv.z = cvt_pk_bf16(acc[ai][bj][m][1][0], acc[ai][bj][m][1][1]); wv.w = cvt_pk_bf16(acc[ai][bj][m][1][2], acc[ai][bj][m][1][3]);
                        *(GAS u32x4*)(rp + bj * HALF) = wv;
                    }
                }
        } else {
            E(acc, cur, wr, wc, fr, fq);
        }
        GTS_MARK(31 + 2 * ui);
        if (!has_next) break;
        if (nxt.role == 2) {
            const int pc = S.c + NXCD;
            if (wid == 0) {
                unsigned spins = 0;
                while (__builtin_amdgcn_readfirstlane(__hip_atomic_load(sk.flags + 64 * pc, __ATOMIC_RELAXED, __HIP_MEMORY_SCOPE_AGENT)) == 0u) { __builtin_amdgcn_s_sleep(2); if (++spins > (1u << 22)) break; }
                __builtin_amdgcn_fence(__ATOMIC_ACQUIRE, "agent");
                PG8_WAIT_V(0);
            }
            asm volatile("" ::: "memory"); PG8_BAR; asm volatile("" ::: "memory");
            const f32x4* sl = (const f32x4*)sk.slab + (size_t)pc * 16384 + opaque(tid);
#pragma unroll
            for (int a = 0; a < 2; ++a)
#pragma unroll
                for (int b = 0; b < 2; ++b)
#pragma unroll
                    for (int m = 0; m < 4; ++m)
#pragma unroll
                        for (int n = 0; n < 2; ++n) acc[a][b][m][n] = *(const GAS f32x4*)(sl + (((a * 2 + b) * 4 + m) * 2 + n) * 512);
#pragma unroll
            for (int a = 0; a < 2; ++a)
#pragma unroll
                for (int b = 0; b < 2; ++b)
#pragma unroll
                    for (int m = 0; m < 4; ++m)
#pragma unroll
                        for (int n = 0; n < 2; ++n) asm volatile("" : "+v"(acc[a][b][m][n]));
        } else {
#pragma unroll
        for (int a = 0; a < 2; ++a)
#pragma unroll
            for (int b = 0; b < 2; ++b)
#pragma unroll
                for (int m = 0; m < 4; ++m)
#pragma unroll
                    for (int n = 0; n < 2; ++n) acc[a][b][m][n] = (f32x4){0.f, 0.f, 0.f, 0.f};
        }
        cur = nxt; cA = nA; cB = nB; ++ui;
        if (wr == 1) PG8_BAR;
    }
    PG8_WAIT_V(0);
    PG8_BAR;
#undef PG8_UA
#undef PG8_UB
#undef PG8_SA
#undef PG8_SB
#undef PG8_STAGE
#undef PG8_LDA
#undef PG8_LDB
#undef PG8_MMA
#undef PG8_WAIT_V
#undef PG8_WAIT_L
#undef PG8_BAR
#undef PG8_SCHED
}

__device__ __forceinline__ void st8(bf16_t* p, const f32x4 v0, const f32x4 v1) {
    u32x4 w; w.x = cvt_pk_bf16(v0[0], v0[1]); w.y = cvt_pk_bf16(v0[2], v0[3]); w.z = cvt_pk_bf16(v1[0], v1[1]); w.w = cvt_pk_bf16(v1[2], v1[3]);
    *(GAS u32x4*)p = w;
}
struct EpiProj {
    bf16_t* P; const float* cs;
    __device__ __forceinline__ void operator()(const f32x4 (&acc)[2][2][4][2], const Unit& u, int wr, int wc, int fr, int fq) const {
        const int row0 = u.pm * BM + wr * 64 + fr, type = u.pn >> 2, cl = wc * 32 + 8 * fq;
        bf16_t* Pt = P + (size_t)u.pn * PTILE + cl;
#ifdef ABL_NO_ROPE
        if (false) {
#else
        if (type <= 1) {
#endif
            const float sc = type == 1 ? 0.0625f : 1.0f;
            const GAS f32x4* tb = (const GAS f32x4*)cs + (size_t)(cl >> 3) * 4 * NPOS;
#pragma unroll
            for (int ai = 0; ai < 2; ++ai) {
                u32x4 res[4][2];
                f32x4 tt[4][4];
#pragma unroll
                for (int m = 0; m < 4; ++m) { const int row = row0 + ai * HALF + m * 16; const int pidx = row < MP ? (row & (SEQ - 1)) : SEQ + ((row - MP) & 7);
#pragma unroll
                    for (int q = 0; q < 4; ++q) tt[m][q] = tb[(size_t)q * NPOS + pidx]; }
#pragma unroll
                for (int m = 0; m < 4; ++m) {
                    const f32x4 t0 = tt[m][0], t1 = tt[m][1], t2 = tt[m][2], t3 = tt[m][3];
                    const f32x4 x1a = acc[ai][0][m][0], x1b = acc[ai][0][m][1], x2a = acc[ai][1][m][0], x2b = acc[ai][1][m][1];
                    f32x4 o1a, o1b, o2a, o2b;
                    o1a[0] = (x1a[0] * t0[0] - x2a[0] * t0[1]) * sc; o2a[0] = (x2a[0] * t0[0] + x1a[0] * t0[1]) * sc;
                    o1a[1] = (x1a[1] * t0[2] - x2a[1] * t0[3]) * sc; o2a[1] = (x2a[1] * t0[2] + x1a[1] * t0[3]) * sc;
                    o1a[2] = (x1a[2] * t1[0] - x2a[2] * t1[1]) * sc; o2a[2] = (x2a[2] * t1[0] + x1a[2] * t1[1]) * sc;
                    o1a[3] = (x1a[3] * t1[2] - x2a[3] * t1[3]) * sc; o2a[3] = (x2a[3] * t1[2] + x1a[3] * t1[3]) * sc;
                    o1b[0] = (x1b[0] * t2[0] - x2b[0] * t2[1]) * sc; o2b[0] = (x2b[0] * t2[0] + x1b[0] * t2[1]) * sc;
                    o1b[1] = (x1b[1] * t2[2] - x2b[1] * t2[3]) * sc; o2b[1] = (x2b[1] * t2[2] + x1b[1] * t2[3]) * sc;
                    o1b[2] = (x1b[2] * t3[0] - x2b[2] * t3[1]) * sc; o2b[2] = (x2b[2] * t3[0] + x1b[2] * t3[1]) * sc;
                    o1b[3] = (x1b[3] * t3[2] - x2b[3] * t3[3]) * sc; o2b[3] = (x2b[3] * t3[2] + x1b[3] * t3[3]) * sc;
                    u32x4 w1, w2;
                    w1.x = cvt_pk_bf16(o1a[0], o1a[1]); w1.y = cvt_pk_bf16(o1a[2], o1a[3]); w1.z = cvt_pk_bf16(o1b[0], o1b[1]); w1.w = cvt_pk_bf16(o1b[2], o1b[3]);
                    w2.x = cvt_pk_bf16(o2a[0], o2a[1]); w2.y = cvt_pk_bf16(o2a[2], o2a[3]); w2.z = cvt_pk_bf16(o2b[0], o2b[1]); w2.w = cvt_pk_bf16(o2b[2], o2b[3]);
                    res[m][0] = w1; res[m][1] = w2;
                }
                asm volatile("" ::: "memory");
#pragma unroll
                for (int m = 0; m < 4; ++m) {
                    bf16_t* rp = Pt + (size_t)(row0 + ai * HALF + m * 16) * PLD;
                    *(GAS u32x4*)rp = res[m][0]; *(GAS u32x4*)(rp + HALF) = res[m][1];
                }
                asm volatile("" ::: "memory");
            }
        } else {
            const bool act = type == 3;
#pragma unroll
            for (int ai = 0; ai < 2; ++ai)
#pragma unroll
                for (int m = 0; m < 4; ++m) {
                    bf16_t* rp = Pt + (size_t)(row0 + ai * HALF + m * 16) * PLD;
#pragma unroll
                    for (int bj = 0; bj < 2; ++bj) {
                        f32x4 v0 = acc[ai][bj][m][0], v1 = acc[ai][bj][m][1];
                        if (act) {
#pragma unroll
                            for (int i = 0; i < 4; ++i) { v0[i] = silu(v0[i]); v1[i] = silu(v1[i]); }
                        }
                        st8(rp + bj * HALF, v0, v1);
                    }
                }
        }
    }
};
struct EpiPlain {
    bf16_t* O; int ldc, coff; const float* scale;
    __device__ __forceinline__ void operator()(const f32x4 (&acc)[2][2][4][2], const Unit& u, int wr, int wc, int fr, int fq) const {
        const int row0 = u.pm * BM + wr * 64 + fr, cl = wc * 32 + 8 * fq, col0 = u.pn * BM + cl;
        f32x4 s[2][2];
#pragma unroll
        for (int bj = 0; bj < 2; ++bj)
#pragma unroll
            for (int n = 0; n < 2; ++n) s[bj][n] = scale ? *(const GAS f32x4*)(scale + col0 + bj * HALF + 4 * n) : (f32x4){1.f, 1.f, 1.f, 1.f};
#pragma unroll
        for (int ai = 0; ai < 2; ++ai)
#pragma unroll
            for (int m = 0; m < 4; ++m) {
                bf16_t* rp = O + (size_t)(row0 + ai * HALF + m * 16) * ldc + coff + col0;
#pragma unroll
                for (int bj = 0; bj < 2; ++bj) st8(rp + bj * HALF, acc[ai][bj][m][0] * s[bj][0], acc[ai][bj][m][1] * s[bj][1]);
            }
    }
};
struct EpiGU {
    bf16_t* Hd;
    __device__ __forceinline__ void operator()(const f32x4 (&acc)[2][2][4][2], const Unit& u, int wr, int wc, int fr, int fq) const {
        const int row0 = u.pm * BM + wr * 64 + fr, cl = wc * 32 + 8 * fq, col0 = u.pn * HALF + cl;
#pragma unroll
        for (int ai = 0; ai < 2; ++ai)
#pragma unroll
            for (int m = 0; m < 4; ++m) {
                f32x4 v0, v1;
#pragma unroll
                for (int i = 0; i < 4; ++i) { v0[i] = silu(acc[ai][0][m][0][i]) * acc[ai][1][m][0][i]; v1[i] = silu(acc[ai][0][m][1][i]) * acc[ai][1][m][1][i]; }
                st8(Hd + (size_t)(row0 + ai * HALF + m * 16) * DFF + col0, v0, v1);
            }
    }
};
}

#define XB_TMO      128
#define XB_XCNT(j)  (256  + 64 * (j))
#define XB_XSUB(j)  (1280 + 64 * (j))
#define XB_XGEN(j)  (2304 + 64 * (j))
#define XB_TOP      3328
#define XB_TOPGEN   3392
#define XCD_BAR_WORDS 3456
#define XB_SPIN_CAP (1u << 18)
__device__ __forceinline__ unsigned xb_ld(unsigned* p)              { return __hip_atomic_load(p, __ATOMIC_RELAXED, __HIP_MEMORY_SCOPE_AGENT); }
__device__ __forceinline__ unsigned xb_add(unsigned* p, unsigned v) { return __hip_atomic_fetch_add(p, v, __ATOMIC_RELAXED, __HIP_MEMORY_SCOPE_AGENT); }
__device__ __forceinline__ unsigned xb_xcc_id() { return (unsigned)__builtin_amdgcn_s_getreg((3 << 11) | 20) & 0xFu; }
#define XB_SPIN(cond, bar) do { unsigned _sp = 0; while (cond) { __builtin_amdgcn_s_sleep(1); \
    if ((++_sp & 255u) == 0u) { if (xb_ld(&(bar)[XB_TMO])) break; if (_sp > XB_SPIN_CAP) { atomicAdd(&(bar)[XB_TMO], 1u); break; } } } } while (0)
__device__ __forceinline__ void xcd_barrier_post(unsigned* bar) {
    if (threadIdx.x == 0) (void)xb_add(&bar[XB_XCNT(xb_xcc_id())], 1u);
}
__device__ __forceinline__ void xcd_barrier_complete(unsigned* bar, unsigned x, unsigned& nloc, unsigned& nx) {
    const unsigned G = gridDim.x * gridDim.y * gridDim.z;
    unsigned sum, cnt, mine, sp = 0u;
    for (;;) {
        sum = 0u; cnt = 0u; mine = 0u;
#pragma unroll
        for (unsigned j = 0; j < 16; ++j) { const unsigned c = xb_ld(&bar[XB_XCNT(j)]); sum += c; cnt += (c > 0u) ? 1u : 0u; mine = (j == x) ? c : mine; }
        if (sum == G) break;
        __builtin_amdgcn_s_sleep(1);
        if ((++sp & 255u) == 0u) { if (xb_ld(&bar[XB_TMO])) break; if (sp > XB_SPIN_CAP) { atomicAdd(&bar[XB_TMO], 1u); break; } }
    }
    nloc = mine > 0u ? mine : 1u; nx = cnt > 0u ? cnt : 1u;
}
__device__ __forceinline__ void xcd_barrier(unsigned* bar, volatile LAS unsigned* st) {
    asm volatile("s_waitcnt vmcnt(0)" ::: "memory");
    __syncthreads();
    if (threadIdx.x == 0) {
        const unsigned x = xb_xcc_id();
        __builtin_amdgcn_s_waitcnt(0);
        unsigned nloc = st[0], nx = st[1];
        if (nloc == 0u) { xcd_barrier_complete(bar, x, nloc, nx); st[0] = nloc; st[1] = nx; }
        const unsigned old = xb_add(&bar[XB_XSUB(x)], 1u);
        const unsigned gen = old / nloc;
        if (old + 1u == (gen + 1u) * nloc) {
            __builtin_amdgcn_fence(__ATOMIC_RELEASE, "agent");
            asm volatile("s_waitcnt vmcnt(0)" ::: "memory");
            const unsigned og = xb_add(&bar[XB_TOP], 1u);
            const unsigned tg = og / nx;
            if (og + 1u == (tg + 1u) * nx) xb_add(&bar[XB_TOPGEN], 1u);
            else XB_SPIN(xb_ld(&bar[XB_TOPGEN]) == tg, bar);
            __builtin_amdgcn_fence(__ATOMIC_ACQUIRE, "agent");
            xb_add(&bar[XB_XGEN(x)], 1u);
            asm volatile("s_waitcnt vmcnt(0)" ::: "memory");
        } else {
            XB_SPIN(xb_ld(&bar[XB_XGEN(x)]) == gen, bar);
            __builtin_amdgcn_fence(__ATOMIC_ACQUIRE, "agent");
            asm volatile("s_waitcnt vmcnt(0)" ::: "memory");
        }
    }
    __syncthreads();
}

struct Args { const float* in[16]; float* out; unsigned char* ws; int ph_lo, ph_hi, use_cg, pad; };

struct Frame {
    LAS unsigned char* lds;
    int tid, lane, wave, vcu, G;
};
__device__ __forceinline__ const float* ldarg(const Frame& F, int k) {
    const volatile LAS unsigned* p = (const volatile LAS unsigned*)(F.lds + ARG_OFF) + 2 * k;
    const unsigned lo = __builtin_amdgcn_readfirstlane(p[0]), hi = __builtin_amdgcn_readfirstlane(p[1]);
    return (const float*)(((unsigned long long)hi << 32) | lo);
}
#ifdef TS_PHASE
#define TS_MARK(k) do { if (blockIdx.x == 0 && F.tid == 0) ((volatile LAS unsigned long long*)(F.lds + ARG_OFF + 256))[(k)] = __builtin_amdgcn_s_memrealtime(); } while (0)
#else
#define TS_MARK(k) do {} while (0)
#endif
#define AIN(k) ldarg(F, (k))
#define AOUT ((float*)ldarg(F, 16))
#define AWS ((unsigned char*)ldarg(F, 17))

struct TrItem { const float* W; bf16_t* WT; int K, N, mode, k0, n0; };
constexpr int TR_IN = (D / 64) * (INW / 256), TR_OUT = (D / 64) * (D / 256), TR_G = (D / 64) * (DFF / 256), TR_D = (DFF / 64) * (D / 256);
struct P0Ptrs { const float *w_in, *w_out, *w_gate, *w_up, *w_down, *w_pool; unsigned char* ws; };
__device__ __forceinline__ TrItem p0_decode(const P0Ptrs& a, unsigned char* ws, int it) {
    TrItem t; int r = it, nblk;
    if (r < TR_IN) { t.W = a.w_in; t.WT = (bf16_t*)(ws + WS_WIN); t.K = D; t.N = INW; t.mode = 0; }
    else if ((r -= TR_IN) < TR_OUT) { t.W = a.w_out; t.WT = (bf16_t*)(ws + WS_WOUT); t.K = D; t.N = D; t.mode = 0; }
    else if ((r -= TR_OUT) < 16) { const int g = r >> 2; r &= 3; t.W = a.w_pool + (size_t)g * 65536; t.WT = (bf16_t*)(ws + WS_WPOOL) + (size_t)g * 65536; t.K = 256; t.N = 256; t.mode = 0; }
    else if ((r -= 16) < TR_G) { t.W = a.w_gate; t.WT = (bf16_t*)(ws + WS_WGU); t.K = D; t.N = DFF; t.mode = 1; }
    else if ((r -= TR_G) < TR_G) { t.W = a.w_up; t.WT = (bf16_t*)(ws + WS_WGU); t.K = D; t.N = DFF; t.mode = 2; }
    else { r -= TR_G; t.W = a.w_down; t.WT = (bf16_t*)(ws + WS_WD); t.K = DFF; t.N = D; t.mode = 0; }
    nblk = t.N >> 8; t.k0 = 64 * (r / nblk); t.n0 = 256 * (r % nblk);
    return t;
}
constexpr int P0_NITEMS = TR_IN + TR_OUT + 16 + 2 * TR_G + TR_D;
constexpr int TR_B = TR_IN + TR_OUT + 16 + 2 * TR_G, TR_C = P0_NITEMS;
#ifndef TR_P1_ITEMS
#define TR_P1_ITEMS 800
#endif
constexpr int TR_A = TR_B - TR_P1_ITEMS;
__device__ __forceinline__ void p0_transposes(Frame& F, int it_begin, int it_end, int worker, int nworkers) {
    P0Ptrs a; a.w_in = AIN(6); a.w_out = AIN(10); a.w_gate = AIN(13); a.w_up = AIN(14); a.w_down = AIN(15); a.w_pool = AIN(8); a.ws = AWS;
    unsigned char* ws = a.ws;
    LAS float* buf = (LAS float*)F.lds;
    const int w = F.wave, l = opaque(F.lane);
#define TR_LOAD(V, T) do { _Pragma("unroll") for (int i = 0; i < 8; ++i) V[i] = *(const GAS f32x4*)((T).W + (size_t)((T).k0 + 8 * w + i) * (T).N + (T).n0 + 4 * l); } while (0)
#define TR_STEP(V, CUR) do { \
        _Pragma("unroll") for (int i = 0; i < 8; ++i) *(LAS f32x4*)(buf + (8 * w + i) * 260 + ((4 * l) ^ (4 * (w & 7)))) = V[i]; \
        __syncthreads(); \
        const TrItem cur_ = (CUR); \
        const int nit_ = it + 2 * nworkers; \
        if (nit_ < it_end) { (CUR) = p0_decode(a, ws, nit_); TR_LOAD(V, (CUR)); } \
        const int ko = l & 7; \
        _Pragma("unroll") for (int sidx = 0; sidx < 4; ++sidx) { \
            const int nl = 32 * w + 8 * sidx + (l >> 3), n = cur_.n0 + nl; \
            const LAS float* p = buf + (8 * ko) * 260 + (nl ^ (4 * ko)); \
            u32x4 o; o.x = pk2(p[0], p[260]); o.y = pk2(p[2 * 260], p[3 * 260]); o.z = pk2(p[4 * 260], p[5 * 260]); o.w = pk2(p[6 * 260], p[7 * 260]); \
            const int row = cur_.mode == 0 ? n : (256 * (n >> 7) + (n & 127) + (cur_.mode == 2 ? 128 : 0)); \
            *(GAS u32x4*)(cur_.WT + (size_t)row * cur_.K + cur_.k0 + 8 * ko) = o; } \
        __syncthreads(); } while (0)
    int it = it_begin + worker;
    if (it >= it_end) return;
    TrItem tA = p0_decode(a, ws, it), tB = tA;
    f32x4 vA[8], vB[8];
    TR_LOAD(vA, tA);
    if (it + nworkers < it_end) { tB = p0_decode(a, ws, it + nworkers); TR_LOAD(vB, tB); }
    for (;;) {
        TR_STEP(vA, tA);
        it += nworkers; if (it >= it_end) break;
        TR_STEP(vB, tB);
        it += nworkers; if (it >= it_end) break;
    }
#undef TR_LOAD
#undef TR_STEP
}
__device__ __forceinline__ void rms_row_to_bf16(const float* xrow, const f32x4 (&ww)[8], bf16_t* orow, int lane) {
    const GAS f32x4* xr = (const GAS f32x4*)xrow + lane;
    f32x4 v[8]; float s = 0.f;
#pragma unroll
    for (int j = 0; j < 8; ++j) { v[j] = xr[64 * j]; s += (v[j].x * v[j].x + v[j].y * v[j].y) + (v[j].z * v[j].z + v[j].w * v[j].w); }
    const float rstd = 1.0f / sqrtf(wave_sum(s) * (1.f / D) + EPS);
    GAS u32x2* o8 = (GAS u32x2*)orow + lane;
#pragma unroll
    for (int j = 0; j < 8; ++j) { u32x2 o; o.x = pk2(v[j].x * rstd * ww[j].x, v[j].y * rstd * ww[j].y); o.y = pk2(v[j].z * rstd * ww[j].z, v[j].w * rstd * ww[j].w); o8[64 * j] = o; }
}
__device__ __forceinline__ const float* xrow_ptr(const float* xp, const float* xs, int m) { return m < MP ? xp + (size_t)m * D : xs + (size_t)(m - MP) * D; }

__device__ __forceinline__ void p0_prologue(Frame& F) {
    p0_transposes(F, 0, TR_A, F.vcu, F.G);
    unsigned char* ws = AWS;
    const int gw = F.vcu * NWAVES + F.wave, NGW = F.G * NWAVES;
    const float* xp_ = AIN(0); const float* xs_ = AIN(1); const float* nw_ = AIN(4);
    f32x4 ww0[8];
#pragma unroll
    for (int j = 0; j < 8; ++j) ww0[j] = *((const GAS f32x4*)nw_ + F.lane + 64 * j);
    for (int m = gw; m < M; m += NGW) rms_row_to_bf16(xrow_ptr(xp_, xs_, m), ww0, (bf16_t*)(ws + WS_H) + (size_t)m * D, F.lane);
    float* cs = (float*)(ws + WS_CS);
    for (int idx = F.vcu * NTHR + F.tid; idx < NPOS * 128; idx += F.G * NTHR) {
        const int p = idx >> 7, j = idx & 127;
        double r = 0.930572040929699, inv = 1.0;
#pragma unroll
        for (int b = 0; b < 7; ++b) { if ((j >> b) & 1) inv *= r; r *= r; }
        const float invf = (float)inv;
        const float pos = (float)(p < SEQ ? p : 16384 + (p - SEQ));
        const float ang = pos * invf;
        double t = (double)ang * 0.15915494309189535; t -= __builtin_rint(t);
        const float tf = (float)t;
        f32x2 o; o.x = __builtin_amdgcn_cosf(tf); o.y = __builtin_amdgcn_sinf(tf);
        *(f32x2*)(cs + ((size_t)(((j >> 3) * 4 + ((j & 7) >> 1)) * NPOS + p)) * 4 + (j & 1) * 2) = o;
    }
}

__device__ __forceinline__ unsigned toff(int r, int c16, int RB) { return (unsigned)(r * RB + ((((c16 & ~15) | ((c16 ^ r ^ (r >> 4)) & 15))) << 4)); }
#define MFMA32(a, b, c) __builtin_amdgcn_mfma_f32_32x32x16_bf16((a), (b), (c), 0, 0, 0)
__device__ __forceinline__ int crow(int reg, int h) { return (reg & 3) + 8 * (reg >> 2) + 4 * h; }
__device__ __forceinline__ bf16x8 frag(const LAS unsigned char* tile, int r, int c16, int RB) { return *(const LAS bf16x8*)(tile + toff(r, c16, RB)); }

__device__ __forceinline__ void load_nat128(LAS unsigned char* dst, const bf16_t* src, int ld, int tid) {
    tid = opaque(tid);
    u32x4 v[4];
#pragma unroll
    for (int it = 0; it < 4; ++it) { const int idx = tid + it * NTHR, r = idx >> 4, c = idx & 15; v[it] = *(const GAS u32x4*)(src + (size_t)r * ld + c * 8); }
#pragma unroll
    for (int it = 0; it < 4; ++it) { const int idx = tid + it * NTHR, r = idx >> 4, c = idx & 15; *(LAS u32x4*)(dst + toff(r, c, 256)) = v[it]; }
}
template <bool SCALE>
__device__ __forceinline__ void load_tr(LAS unsigned char* dst, const bf16_t* src, int ld, int tid, float sc_a, float sc_b) {
    tid = opaque(tid);
#pragma unroll
    for (int it = 0; it < 4; ++it) {
        const int T = it * NTHR + tid, ch_lo = T & 15, pp = (T >> 4) & 3, half = (T >> 6) & 1, quad = T >> 7;
        const int pair = 4 * quad + pp, chunk = 16 * half + ch_lo, j0 = 2 * pair, d0 = 8 * chunk;
        const u32x4 a = *(const GAS u32x4*)(src + (size_t)j0 * ld + d0), b = *(const GAS u32x4*)(src + (size_t)(j0 + 1) * ld + d0);
        float s0 = 1.f, s1 = 1.f;
        if (SCALE) { s0 = __builtin_amdgcn_exp2f(sc_a * (sc_b - (float)j0)); s1 = __builtin_amdgcn_exp2f(sc_a * (sc_b - (float)(j0 + 1))); }
#pragma unroll
        for (int i = 0; i < 8; ++i) {
            const unsigned wa = a[i >> 1], wb = b[i >> 1];
            unsigned w;
            if (SCALE) { const float fa = ((i & 1) ? bfhi(wa) : bflo(wa)) * s0, fb = ((i & 1) ? bfhi(wb) : bflo(wb)) * s1; w = pk2(fa, fb); }
            else w = (i & 1) ? ((wa >> 16) | (wb & 0xffff0000u)) : ((wa & 0xffffu) | (wb << 16));
            const int d = d0 + i;
            *(LAS unsigned*)(dst + toff(d, quad, 256) + pp * 4) = w;
        }
    }
}

__device__ __forceinline__ void u_item(Frame& F, const bf16_t* PROJ, bf16_t* UT, int item) {
    const int b = item >> 6, h = (item >> 4) & 3, c = item & 15, rows0 = b * SEQ + c * 128;
    const bf16_t* Ks = PROJ + (size_t)(4 + h) * PTILE + (size_t)rows0 * PLD; const bf16_t* Vs = Ks + 4 * PTILE;
    LAS unsigned char* KT = F.lds; LAS unsigned char* VT = F.lds + 65536;
    const float lg = lg2gamma(h);
    load_tr<true>(KT, Ks, PLD, F.tid, lg, 127.f);
    load_tr<false>(VT, Vs, PLD, F.tid, 0.f, 0.f);
    __syncthreads();
    const int w = F.wave, r = opaque(F.lane) & 31, hh = opaque(F.lane) >> 5;
    bf16_t* Up = UT + ((size_t)((b * 4 + h) * 16 + c) * 256) * 256;
#pragma unroll 1
    for (int eh = 0; eh < 2; ++eh) {
        f32x16 acc[4];
#pragma unroll
        for (int t = 0; t < 4; ++t)
#pragma unroll
            for (int i = 0; i < 16; ++i) acc[t][i] = 0.f;
#pragma unroll 1
        for (int ks = 0; ks < 8; ++ks) {
            const bf16x8 a = frag(KT, 32 * w + r, 2 * ks + hh, 256);
#pragma unroll
            for (int et = 0; et < 4; ++et) { const bf16x8 bb = frag(VT, 32 * (4 * eh + et) + r, 2 * ks + hh, 256); acc[et] = MFMA32(a, bb, acc[et]); }
        }
#pragma unroll
        for (int et = 0; et < 4; ++et)
#pragma unroll
            for (int g = 0; g < 4; ++g) {
                u32x2 o; o.x = cvt_pk_bf16(acc[et][4 * g], acc[et][4 * g + 1]); o.y = cvt_pk_bf16(acc[et][4 * g + 2], acc[et][4 * g + 3]);
                *(GAS u32x2*)(Up + (size_t)(32 * (4 * eh + et) + r) * 256 + 32 * w + 8 * g + 4 * hh) = o;
            }
    }
    __syncthreads();
}

__device__ __forceinline__ void o_item(Frame& F, const bf16_t* PROJ, const bf16_t* SCT, const float* retw, bf16_t* MIX, int item) {
    const int b = item >> 6, h = (item >> 4) & 3, c = item & 15, rows0 = b * SEQ + c * 128;
    const bf16_t* Qs = PROJ + (size_t)h * PTILE + (size_t)rows0 * PLD; const bf16_t* Ks = Qs + 4 * PTILE; const bf16_t* Vs = Qs + 8 * PTILE; const bf16_t* Gs = Qs + 12 * PTILE;
    LAS unsigned char* QF = F.lds; LAS unsigned char* KH = F.lds + 65536; LAS unsigned char* PB = F.lds + 98304; LAS unsigned char* VT = F.lds; LAS unsigned char* OB = F.lds;
    const float lg = lg2gamma(h);
    const int w = F.wave; int r = opaque(F.lane) & 31, hh = opaque(F.lane) >> 5; const int tid = opaque(F.tid);
    TS_MARK(20);
    u32x4 qv[8], kv[4]; bf16x8 sfr[16];
#pragma unroll
    for (int it = 0; it < 8; ++it) { const int idx = tid + it * NTHR, rr = idx >> 5, cc = idx & 31; qv[it] = *(const GAS u32x4*)(Qs + (size_t)rr * PLD + cc * 8); }
#pragma unroll
    for (int it = 0; it < 4; ++it) { const int idx = tid + it * NTHR, rr = idx >> 4, cc = idx & 15; kv[it] = *(const GAS u32x4*)(Ks + (size_t)rr * PLD + cc * 8); }
    {
        const bf16_t* Sp = SCT + ((size_t)((b * 4 + h) * 16 + c) * 256) * 256 + (size_t)(32 * w + r) * 256 + 8 * hh;
#pragma unroll
        for (int ks = 0; ks < 16; ++ks) sfr[ks] = *(const GAS bf16x8*)(Sp + 16 * ks);
    }
#pragma unroll
    for (int it = 0; it < 8; ++it) { const int idx = tid + it * NTHR, rr = idx >> 5, cc = idx & 31; *(LAS u32x4*)(QF + toff(rr, cc, 512)) = qv[it]; }
#pragma unroll
    for (int it = 0; it < 4; ++it) { const int idx = tid + it * NTHR, rr = idx >> 4, cc = idx & 15; *(LAS u32x4*)(KH + toff(rr, cc, 256)) = kv[it]; }
    __syncthreads();
    TS_MARK(21);
#pragma unroll
    for (int it = 0; it < 4; ++it) { const int idx = tid + it * NTHR, rr = idx >> 4, cc = idx & 15; kv[it] = *(const GAS u32x4*)(Ks + 128 + (size_t)rr * PLD + cc * 8); }
    const int ib_s = w >> 1, jb0 = 2 * (w & 1);
    f32x16 sc[2];
#pragma unroll
    for (int t = 0; t < 2; ++t)
#pragma unroll
        for (int i = 0; i < 16; ++i) sc[t][i] = 0.f;
    if (jb0 <= ib_s) {
#pragma unroll 1
        for (int ks = 0; ks < 8; ++ks) {
            const bf16x8 a = frag(QF, 32 * ib_s + r, 2 * ks + hh, 512);
            const bf16x8 b0 = frag(KH, 32 * jb0 + r, 2 * ks + hh, 256), b1 = frag(KH, 32 * (jb0 + 1) + r, 2 * ks + hh, 256);
            sc[0] = MFMA32(a, b0, sc[0]); sc[1] = MFMA32(a, b1, sc[1]);
        }
    }
    __syncthreads();
#pragma unroll
    for (int it = 0; it < 4; ++it) { const int idx = tid + it * NTHR, rr = idx >> 4, cc = idx & 15; *(LAS u32x4*)(KH + toff(rr, cc, 256)) = kv[it]; }
    __syncthreads();
    TS_MARK(22);
    u32x4 va[4], vb[4];
#pragma unroll
    for (int it = 0; it < 4; ++it) {
        const int T = it * NTHR + tid, ch_lo = T & 15, pp = (T >> 4) & 3, half = (T >> 6) & 1, quad = T >> 7;
        const int pair = 4 * quad + pp, chunk = 16 * half + ch_lo, j0 = 2 * pair, d0 = 8 * chunk;
        va[it] = *(const GAS u32x4*)(Vs + (size_t)j0 * PLD + d0); vb[it] = *(const GAS u32x4*)(Vs + (size_t)(j0 + 1) * PLD + d0);
    }
    if (jb0 <= ib_s) {
#pragma unroll 1
        for (int ks = 0; ks < 8; ++ks) {
            const bf16x8 a = frag(QF, 32 * ib_s + r, 16 + 2 * ks + hh, 512);
            const bf16x8 b0 = frag(KH, 32 * jb0 + r, 2 * ks + hh, 256), b1 = frag(KH, 32 * (jb0 + 1) + r, 2 * ks + hh, 256);
            sc[0] = MFMA32(a, b0, sc[0]); sc[1] = MFMA32(a, b1, sc[1]);
        }
    }
    r = opaque(r); hh = opaque(hh);
#pragma unroll
    for (int t = 0; t < 2; ++t) {
        const int j = 32 * (jb0 + t) + r;
#pragma unroll
        for (int reg = 0; reg < 16; ++reg) {
            const int i = 32 * ib_s + crow(reg, hh);
            const float v = (i >= j) ? sc[t][reg] * __builtin_amdgcn_exp2f(lg * (float)(i - j)) : 0.f;
            *(LAS bf16_t*)(PB + toff(i, j >> 3, 256) + (j & 7) * 2) = (bf16_t)f2bf(v);
        }
    }
    TS_MARK(23);
    f32x16 o[4];
#pragma unroll
    for (int t = 0; t < 4; ++t)
#pragma unroll
        for (int i = 0; i < 16; ++i) o[t][i] = 0.f;
    r = opaque(r); hh = opaque(hh);
#pragma unroll
    for (int ks = 0; ks < 16; ++ks) {
#pragma unroll
        for (int ib = 0; ib < 4; ++ib) { const bf16x8 a = frag(QF, 32 * ib + r, 2 * ks + hh, 512); o[ib] = MFMA32(a, sfr[ks], o[ib]); }
    }
#pragma unroll
    for (int ib = 0; ib < 4; ++ib)
#pragma unroll
        for (int reg = 0; reg < 16; ++reg) o[ib][reg] *= __builtin_amdgcn_exp2f(lg * (float)(32 * ib + crow(reg, hh) + 1));
    __syncthreads();
    TS_MARK(24);
#pragma unroll
    for (int it = 0; it < 4; ++it) {
        const int T = it * NTHR + tid, ch_lo = T & 15, pp = (T >> 4) & 3, half = (T >> 6) & 1, quad = T >> 7;
        const int chunk = 16 * half + ch_lo, d0 = 8 * chunk;
#pragma unroll
        for (int i = 0; i < 8; ++i) {
            const unsigned wa = va[it][i >> 1], wb = vb[it][i >> 1];
            const unsigned wv = (i & 1) ? ((wa >> 16) | (wb & 0xffff0000u)) : ((wa & 0xffffu) | (wb << 16));
            *(LAS unsigned*)(VT + toff(d0 + i, quad, 256) + pp * 4) = wv;
        }
    }
    __syncthreads();
    TS_MARK(25);
    u32x4 gv[8];
    { const int tid3 = opaque(F.tid);
#pragma unroll
      for (int it = 0; it < 8; ++it) gv[it] = *(const GAS u32x4*)(Gs + (size_t)((tid3 >> 5) + 16 * it) * PLD + (tid3 & 31) * 8); }
    r = opaque(r); hh = opaque(hh);
#pragma unroll 1
    for (int ks = 0; ks < 8; ++ks) {
        const bf16x8 bb = frag(VT, 32 * w + r, 2 * ks + hh, 256);
#pragma unroll
        for (int ib = 0; ib < 4; ++ib)
            if (ks < 2 * (ib + 1)) { const bf16x8 a = frag(PB, 32 * ib + r, 2 * ks + hh, 256); o[ib] = MFMA32(a, bb, o[ib]); }
    }
    __syncthreads();
    TS_MARK(26);
    r = opaque(r); hh = opaque(hh);
#pragma unroll
    for (int ib = 0; ib < 4; ++ib)
#pragma unroll
        for (int reg = 0; reg < 16; ++reg) { const int i = 32 * ib + crow(reg, hh);
            *(LAS bf16_t*)(OB + i * 512 + (32 * w + r) * 2) = (bf16_t)f2bf(o[ib][reg]); }
    __syncthreads();
    TS_MARK(27);
    {
        const int tid2 = opaque(F.tid), cc = tid2 & 31;
        const f32x4 wa = *(const GAS f32x4*)(retw + h * 256 + cc * 8), wb = *(const GAS f32x4*)(retw + h * 256 + cc * 8 + 4);
#pragma unroll
        for (int it = 0; it < 8; ++it) {
            const int i = (tid2 >> 5) + 16 * it;
            const u32x4 ov = *(const LAS u32x4*)(OB + i * 512 + cc * 16);
            float x[8];
#pragma unroll
            for (int k = 0; k < 4; ++k) { x[2 * k] = bflo(ov[k]); x[2 * k + 1] = bfhi(ov[k]); }
            float sq = 0.f;
#pragma unroll
            for (int k = 0; k < 8; ++k) sq += x[k] * x[k];
            sq += __shfl_xor(sq, 1); sq += __shfl_xor(sq, 2); sq += __shfl_xor(sq, 4); sq += __shfl_xor(sq, 8); sq += __shfl_xor(sq, 16);
            const float rstd = 1.0f / sqrtf(sq * (1.f / 256.f) + EPS);
            u32x4 res;
            res[0] = pk2(x[0] * rstd * wa[0] * bflo(gv[it][0]), x[1] * rstd * wa[1] * bfhi(gv[it][0]));
            res[1] = pk2(x[2] * rstd * wa[2] * bflo(gv[it][1]), x[3] * rstd * wa[3] * bfhi(gv[it][1]));
            res[2] = pk2(x[4] * rstd * wb[0] * bflo(gv[it][2]), x[5] * rstd * wb[1] * bfhi(gv[it][2]));
            res[3] = pk2(x[6] * rstd * wb[2] * bflo(gv[it][3]), x[7] * rstd * wb[3] * bfhi(gv[it][3]));
            *(GAS u32x4*)(MIX + (size_t)(rows0 + i) * D + h * 256 + cc * 8) = res;
        }
    }
    __syncthreads();
}

__device__ __forceinline__ void s_item(Frame& F, const bf16_t* PROJ, const float* state, const float* retw, float* newstate, bf16_t* MIX, int item) {
    const int sb = item >> 2, h = item & 3, rows0 = MP + sb * 8;
    const float lg = lg2gamma(h);
    LAS float* QK = (LAS float*)F.lds;
    LAS float* QR = (LAS float*)(F.lds + 16384);
    LAS float* KR = (LAS float*)(F.lds + 16384 + 8224);
    LAS float* SCP = (LAS float*)(F.lds + 16384 + 2 * 8224);
    LAS float* SCO = (LAS float*)(F.lds + 16384 + 2 * 8224 + 2048);
    LAS float* RED = (LAS float*)(F.lds + 40960);
    const int w = opaque(F.wave), l = opaque(F.lane), tid_o = opaque(F.tid);
    {
        const int isk = tid_o >> 8, i = (tid_o >> 5) & 7, d8 = (tid_o & 31) * 8;
        const u32x4 raw = *(const GAS u32x4*)(PROJ + (size_t)(isk * 4 + h) * PTILE + (size_t)(rows0 + i) * PLD + d8);
        float f[8];
#pragma unroll
        for (int q = 0; q < 4; ++q) { f[2 * q] = bflo(raw[q]); f[2 * q + 1] = bfhi(raw[q]); }
        const float sc = __builtin_amdgcn_exp2f(lg * (float)(isk ? 7 - i : i + 1));
        LAS float* R = isk ? KR : QR;
#pragma unroll
        for (int k = 0; k < 8; ++k) { R[i * 257 + d8 + k] = f[k]; QK[(d8 + k) * 16 + isk * 8 + i] = f[k] * sc; }
    }
    float v[8][4];
#pragma unroll
    for (int j = 0; j < 8; ++j) { const u32x2 t = *(const GAS u32x2*)(PROJ + (size_t)(8 + h) * PTILE + (size_t)(rows0 + j) * PLD + 4 * l); v[j][0] = bflo(t.x); v[j][1] = bfhi(t.x); v[j][2] = bflo(t.y); v[j][3] = bfhi(t.y); }
    __syncthreads();
    {
        const int i = l >> 3, j = l & 7; float s = 0.f;
#pragma unroll 8
        for (int d = 32 * w; d < 32 * w + 32; ++d) s += QR[i * 257 + d] * KR[j * 257 + d];
        SCP[w * 64 + l] = s;
    }
    float oacc[8][4];
#pragma unroll
    for (int i = 0; i < 8; ++i)
#pragma unroll
        for (int c = 0; c < 4; ++c) oacc[i][c] = 0.f;
    const float g8 = __builtin_amdgcn_exp2f(lg * 8.f);
    const GAS f32x4* Sp = (const GAS f32x4*)(state + ((size_t)(sb * 4 + h) * 256 + 32 * w) * 256) + l;
    GAS f32x4* Np = (GAS f32x4*)(newstate + ((size_t)(sb * 4 + h) * 256 + 32 * w) * 256) + l;
    f32x4 sA[4], sB[4];
#define S_LOAD4(dst, row0) do { const GAS f32x4* p0_ = Sp + (size_t)(row0) * 64; asm volatile("" : "+v"(p0_)); \
        _Pragma("unroll") for (int k = 0; k < 4; ++k) dst[k] = p0_[k * 64]; } while (0)
#define S_COMP4(src, row0) do { GAS f32x4* n0_ = Np + (size_t)(row0) * 64; asm volatile("" : "+v"(n0_)); \
        _Pragma("unroll") for (int k = 0; k < 4; ++k) { \
            const LAS f32x4* qk = (const LAS f32x4*)(QK + (32 * w + (row0) + k) * 16); \
            const f32x4 qa = qk[0], qb = qk[1], ka = qk[2], kb = qk[3]; f32x4 n; \
            _Pragma("unroll") for (int c = 0; c < 4; ++c) { const float sv = src[k][c]; \
                oacc[0][c] += qa[0] * sv; oacc[1][c] += qa[1] * sv; oacc[2][c] += qa[2] * sv; oacc[3][c] += qa[3] * sv; \
                oacc[4][c] += qb[0] * sv; oacc[5][c] += qb[1] * sv; oacc[6][c] += qb[2] * sv; oacc[7][c] += qb[3] * sv; \
                float t = g8 * sv; \
                t += ka[0] * v[0][c]; t += ka[1] * v[1][c]; t += ka[2] * v[2][c]; t += ka[3] * v[3][c]; \
                t += kb[0] * v[4][c]; t += kb[1] * v[5][c]; t += kb[2] * v[6][c]; t += kb[3] * v[7][c]; n[c] = t; } \
            n0_[k * 64] = n; \
            if (k & 1) asm volatile("" ::: "memory"); } } while (0)
    S_LOAD4(sA, 0);
#pragma unroll 1
    for (int h2 = 0; h2 < 4; ++h2) {
        S_LOAD4(sB, 8 * h2 + 4);
        S_COMP4(sA, 8 * h2);
        if (h2 < 3) S_LOAD4(sA, 8 * h2 + 8);
        S_COMP4(sB, 8 * h2 + 4);
    }
#undef S_LOAD4
#undef S_COMP4
#pragma unroll
    for (int i = 0; i < 8; ++i) *(LAS f32x4*)(RED + (w * 8 + i) * 256 + 4 * l) = (f32x4){oacc[i][0], oacc[i][1], oacc[i][2], oacc[i][3]};
    __syncthreads();
    if (tid_o < 64) { const int i = l >> 3, j = l & 7; float s = 0.f;
#pragma unroll
        for (int ww = 0; ww < 8; ++ww) s += SCP[ww * 64 + l];
        SCO[l] = (i >= j) ? s * __builtin_amdgcn_exp2f(lg * (float)(i - j)) : 0.f; }
    __syncthreads();
    {
        const int i = w; f32x4 tot = (f32x4){0.f, 0.f, 0.f, 0.f};
#pragma unroll
        for (int ww = 0; ww < 8; ++ww) tot += *(const LAS f32x4*)(RED + (ww * 8 + i) * 256 + 4 * l);
#pragma unroll
        for (int j = 0; j < 8; ++j) { const float s = SCO[i * 8 + j];
#pragma unroll
            for (int c = 0; c < 4; ++c) tot[c] += s * v[j][c]; }
        const float ss = wave_sum((tot[0] * tot[0] + tot[1] * tot[1]) + (tot[2] * tot[2] + tot[3] * tot[3]));
        const float rstd = 1.0f / sqrtf(ss * (1.f / 256.f) + EPS);
        const f32x4 wn = *(const GAS f32x4*)(retw + h * 256 + 4 * l);
        const u32x2 gv = *(const GAS u32x2*)(PROJ + (size_t)(12 + h) * PTILE + (size_t)(rows0 + i) * PLD + 4 * l);
        u32x2 res; res.x = pk2(tot[0] * rstd * wn[0] * bflo(gv.x), tot[1] * rstd * wn[1] * bfhi(gv.x)); res.y = pk2(tot[2] * rstd * wn[2] * bflo(gv.y), tot[3] * rstd * wn[3] * bfhi(gv.y));
        *(GAS u32x2*)(MIX + (size_t)(rows0 + i) * D + h * 256 + 4 * l) = res;
    }
    __syncthreads();
}

__device__ __forceinline__ void unpk8(const u32x4 v, float (&f)[8]) {
#pragma unroll
    for (int q = 0; q < 4; ++q) { f[2 * q] = bflo(v[q]); f[2 * q + 1] = bfhi(v[q]); }
}
template <int W>
__device__ __forceinline__ void pool_prompt_blk(const bf16_t* PROJ, bf16_t* POOLED, float* outp, int rb, int ch) {
    const int m0 = rb * 8, t0 = m0 & (SEQ - 1), bseq = m0 >> 11;
    const bf16_t* U = PROJ + (size_t)(16 + (ch >> 8)) * PTILE + (ch & 255);
    u32x4 x[W + 7];
#pragma unroll
    for (int i = 0; i < W + 7; ++i) { const int t = t0 - (W - 1) + i; const int mi = (t >= 0) ? m0 - (W - 1) + i : m0; x[i] = *(const GAS u32x4*)(U + (size_t)mi * PLD); }
#pragma unroll
    for (int i = 0; i < W - 1; ++i) { const int t = t0 - (W - 1) + i; if (t < 0) x[i] = (u32x4){0u, 0u, 0u, 0u}; }
    float sum[8];
#pragma unroll
    for (int k = 0; k < 8; ++k) sum[k] = 0.f;
#pragma unroll
    for (int i = 0; i < W - 1; ++i) { float f[8]; unpk8(x[i], f);
#pragma unroll
        for (int k = 0; k < 8; ++k) sum[k] += f[k]; }
#pragma unroll
    for (int r = 0; r < 8; ++r) {
        float cur[8]; unpk8(x[W - 1 + r], cur);
#pragma unroll
        for (int k = 0; k < 8; ++k) sum[k] += cur[k];
        const int t = t0 + r; const int cnt = (t + 1 < W) ? t + 1 : W; const float inv = 1.0f / (float)cnt;
        u32x4 o;
#pragma unroll
        for (int q = 0; q < 4; ++q) o[q] = pk2(sum[2 * q] * inv - cur[2 * q], sum[2 * q + 1] * inv - cur[2 * q + 1]);
        *(GAS u32x4*)(POOLED + (size_t)(m0 + r) * 1024 + ch) = o;
        float sub[8]; unpk8(x[r], sub);
#pragma unroll
        for (int k = 0; k < 8; ++k) sum[k] -= sub[k];
        if (t >= SEQ - 15) { float* op = outp + ((size_t)bseq * 15 + (t - (SEQ - 15))) * 1024 + ch;
            *(GAS f32x4*)op = (f32x4){cur[0], cur[1], cur[2], cur[3]}; *(GAS f32x4*)(op + 4) = (f32x4){cur[4], cur[5], cur[6], cur[7]}; }
    }
}
template <int W>
__device__ __forceinline__ void pool_sample_blk(const bf16_t* PROJ, const float* spool, bf16_t* POOLED, float* outs, int sb, int ch) {
    const bf16_t* U = PROJ + (size_t)(16 + (ch >> 8)) * PTILE + (size_t)(MP + sb * 8) * PLD + (ch & 255);
    const float* B = spool + (size_t)sb * 15 * 1024 + ch;
    f32x4 ba[W - 1], bb[W - 1]; u32x4 xn[8]; f32x4 ca[7], cb[7];
#pragma unroll
    for (int i = 0; i < W - 1; ++i) { ba[i] = *(const GAS f32x4*)(B + (size_t)(15 - (W - 1) + i) * 1024); bb[i] = *(const GAS f32x4*)(B + (size_t)(15 - (W - 1) + i) * 1024 + 4); }
#pragma unroll
    for (int r = 0; r < 8; ++r) xn[r] = *(const GAS u32x4*)(U + (size_t)r * PLD);
#pragma unroll
    for (int rr = 0; rr < 7; ++rr) { ca[rr] = *(const GAS f32x4*)(B + (size_t)(8 + rr) * 1024); cb[rr] = *(const GAS f32x4*)(B + (size_t)(8 + rr) * 1024 + 4); }
    float sum[8];
#pragma unroll
    for (int k = 0; k < 8; ++k) sum[k] = 0.f;
#pragma unroll
    for (int i = 0; i < W - 1; ++i)
#pragma unroll
        for (int q = 0; q < 4; ++q) { sum[q] += ba[i][q]; sum[4 + q] += bb[i][q]; }
    const float inv = 1.0f / (float)W;
#pragma unroll
    for (int r = 0; r < 8; ++r) {
        float cur[8]; unpk8(xn[r], cur);
#pragma unroll
        for (int k = 0; k < 8; ++k) sum[k] += cur[k];
        u32x4 o;
#pragma unroll
        for (int q = 0; q < 4; ++q) o[q] = pk2(sum[2 * q] * inv - cur[2 * q], sum[2 * q + 1] * inv - cur[2 * q + 1]);
        *(GAS u32x4*)(POOLED + (size_t)(MP + sb * 8 + r) * 1024 + ch) = o;
        if (r < W - 1) {
#pragma unroll
            for (int q = 0; q < 4; ++q) { sum[q] -= ba[r < W - 1 ? r : 0][q]; sum[4 + q] -= bb[r < W - 1 ? r : 0][q]; }
        } else { float sub[8]; unpk8(xn[r >= W - 1 ? r - (W - 1) : 0], sub);
#pragma unroll
            for (int k = 0; k < 8; ++k) sum[k] -= sub[k]; }
        float* op = outs + ((size_t)sb * 15 + 7 + r) * 1024 + ch;
        *(GAS f32x4*)op = (f32x4){cur[0], cur[1], cur[2], cur[3]}; *(GAS f32x4*)(op + 4) = (f32x4){cur[4], cur[5], cur[6], cur[7]};
    }
#pragma unroll
    for (int rr = 0; rr < 7; ++rr) { float* op = outs + ((size_t)sb * 15 + rr) * 1024 + ch; *(GAS f32x4*)op = ca[rr]; *(GAS f32x4*)(op + 4) = cb[rr]; }
}
__device__ __forceinline__ void pool_tasks(Frame& F, const bf16_t* PROJ, const float* spool, bf16_t* POOLED, float* outp, float* outs) {
    for (int gt = F.vcu * NTHR + opaque(F.tid); gt < 1024 * 128; gt += F.G * NTHR) {
        const int cgp = gt & 31, rbl = (gt >> 5) & 1, grp = (gt >> 6) & 3, rb = (gt >> 8) * 2 + rbl, ch = grp * 256 + cgp * 8;
        if (grp == 0) pool_prompt_blk<2>(PROJ, POOLED, outp, rb, ch); else if (grp == 1) pool_prompt_blk<4>(PROJ, POOLED, outp, rb, ch);
        else if (grp == 2) pool_prompt_blk<8>(PROJ, POOLED, outp, rb, ch); else pool_prompt_blk<16>(PROJ, POOLED, outp, rb, ch);
    }
    if (F.G * 64 >= 128 * 128 ? F.tid < 64 : true)
    for (int gt = (F.G * 64 >= 128 * 128) ? F.vcu * 64 + opaque(F.tid) : F.vcu * NTHR + opaque(F.tid); gt < 128 * 128; gt += (F.G * 64 >= 128 * 128) ? F.G * 64 : F.G * NTHR) {
        const int cgp = gt & 31, sbl = (gt >> 5) & 1, grp = (gt >> 6) & 3, sb = (gt >> 8) * 2 + sbl, ch = grp * 256 + cgp * 8;
        if (grp == 0) pool_sample_blk<2>(PROJ, spool, POOLED, outs, sb, ch); else if (grp == 1) pool_sample_blk<4>(PROJ, spool, POOLED, outs, sb, ch);
        else if (grp == 2) pool_sample_blk<8>(PROJ, spool, POOLED, outs, sb, ch); else pool_sample_blk<16>(PROJ, spool, POOLED, outs, sb, ch);
    }
}

__device__ __forceinline__ void load_row_bf16(const bf16_t* row, int nparts, size_t pstride, int lane, float (&f)[4][8]) {
#pragma unroll
    for (int j = 0; j < 4; ++j)
#pragma unroll
        for (int q = 0; q < 8; ++q) f[j][q] = 0.f;
    for (int p = 0; p < nparts; ++p) {
        u32x4 v[4];
#pragma unroll
        for (int j = 0; j < 4; ++j) v[j] = *(const GAS u32x4*)(row + (size_t)p * pstride + 8 * lane + 512 * j);
#pragma unroll
        for (int j = 0; j < 4; ++j)
#pragma unroll
            for (int q = 0; q < 4; ++q) { f[j][2 * q] += bflo(v[j][q]); f[j][2 * q + 1] += bfhi(v[j][q]); }
    }
}
__device__ __forceinline__ void n1_row(const float* xrow, const bf16_t* mo, int nparts, size_t pstride, const f32x4 (&wpa)[4], const f32x4 (&wpb)[4], const f32x4 (&wqa)[4], const f32x4 (&wqb)[4], bf16_t* x1row, bf16_t* hrow, int lane) {
    f32x4 xa[4], xb[4]; float s = 0.f;
#pragma unroll
    for (int j = 0; j < 4; ++j) { const int c = 8 * lane + 512 * j; xa[j] = *(const GAS f32x4*)(xrow + c); xb[j] = *(const GAS f32x4*)(xrow + c + 4); }
    float mf[4][8];
    load_row_bf16(mo, nparts, pstride, lane, mf);
#pragma unroll
    for (int j = 0; j < 4; ++j)
#pragma unroll
        for (int q = 0; q < 8; ++q) s += mf[j][q] * mf[j][q];
    const float r1 = 1.0f / sqrtf(wave_sum(s) * (1.f / D) + EPS);
    float s2 = 0.f;
#pragma unroll
    for (int j = 0; j < 4; ++j) { const int c = 8 * lane + 512 * j;
#pragma unroll
        for (int q = 0; q < 4; ++q) { xa[j][q] += mf[j][q] * r1 * wpa[j][q]; xb[j][q] += mf[j][4 + q] * r1 * wpb[j][q]; s2 += xa[j][q] * xa[j][q] + xb[j][q] * xb[j][q]; }
        { u32x4 o1; o1.x = pk2(xa[j][0], xa[j][1]); o1.y = pk2(xa[j][2], xa[j][3]); o1.z = pk2(xb[j][0], xb[j][1]); o1.w = pk2(xb[j][2], xb[j][3]); *(GAS u32x4*)(x1row + c) = o1; } }
    const float r2 = 1.0f / sqrtf(wave_sum(s2) * (1.f / D) + EPS);
#pragma unroll
    for (int j = 0; j < 4; ++j) { const int c = 8 * lane + 512 * j;
        u32x4 o; o.x = pk2(xa[j][0] * r2 * wqa[j][0], xa[j][1] * r2 * wqa[j][1]); o.y = pk2(xa[j][2] * r2 * wqa[j][2], xa[j][3] * r2 * wqa[j][3]);
        o.z = pk2(xb[j][0] * r2 * wqb[j][0], xb[j][1] * r2 * wqb[j][1]); o.w = pk2(xb[j][2] * r2 * wqb[j][2], xb[j][3] * r2 * wqb[j][3]);
        *(GAS u32x4*)(hrow + c) = o; }
}
__device__ __forceinline__ void n2_row(const bf16_t* ff, int nparts, size_t pstride, const f32x4 (&wpa)[4], const f32x4 (&wpb)[4], const bf16_t* x1row, float* yrow, int lane) {
    float s = 0.f; float ffl[4][8];
    u32x4 xv[4];
#pragma unroll
    for (int j = 0; j < 4; ++j) xv[j] = *(const GAS u32x4*)(x1row + 8 * lane + 512 * j);
    load_row_bf16(ff, nparts, pstride, lane, ffl);
#pragma unroll
    for (int j = 0; j < 4; ++j)
#pragma unroll
        for (int q = 0; q < 8; ++q) s += ffl[j][q] * ffl[j][q];
    const float r1 = 1.0f / sqrtf(wave_sum(s) * (1.f / D) + EPS);
#pragma unroll
    for (int j = 0; j < 4; ++j) { const int c = 8 * lane + 512 * j;
        f32x4 ya = (f32x4){bflo(xv[j].x), bfhi(xv[j].x), bflo(xv[j].y), bfhi(xv[j].y)}, yb = (f32x4){bflo(xv[j].z), bfhi(xv[j].z), bflo(xv[j].w), bfhi(xv[j].w)};
#pragma unroll
        for (int q = 0; q < 4; ++q) { ya[q] += ffl[j][q] * r1 * wpa[j][q]; yb[q] += ffl[j][4 + q] * r1 * wpb[j][q]; }
        *(GAS f32x4*)(yrow + c) = ya; *(GAS f32x4*)(yrow + c + 4) = yb; }
}

constexpr int NPH = 10;
__global__ void __launch_bounds__(NTHR, 2) hyb_fwd(Args args) {
    extern __shared__ __attribute__((aligned(16))) unsigned char lds[];
    Frame F;
    F.lds = (LAS unsigned char*)lds;
    F.tid = threadIdx.x; F.lane = F.tid & 63; F.wave = __builtin_amdgcn_readfirstlane(F.tid >> 6);
    F.G = gridDim.x; { const int bx = blockIdx.x; F.vcu = (F.G % 8 == 0) ? (bx % 8) * (F.G / 8) + bx / 8 : bx; }
    if (F.tid == 0) {
        volatile LAS unsigned long long* at = (volatile LAS unsigned long long*)(F.lds + ARG_OFF);
#pragma unroll
        for (int i = 0; i < 16; ++i) at[i] = (unsigned long long)args.in[i];
        at[16] = (unsigned long long)args.out; at[17] = (unsigned long long)args.ws;
    }
    const int lo = args.ph_lo, hi = args.ph_hi;
    if (F.tid < 32) ((volatile LAS unsigned*)(F.lds + MISC_OFF))[F.tid] = 0u;
    __syncthreads();
#if NO_MEMSET_NODE
    if (blockIdx.x == 0) { unsigned* bw = (unsigned*)(AWS + WS_CTL) + CW_BAR; for (int i = F.tid; i < XCD_BAR_WORDS; i += NTHR) __hip_atomic_store(bw + i, 0u, __ATOMIC_RELAXED, __HIP_MEMORY_SCOPE_AGENT); }
#else
    if (args.use_cg) xcd_barrier_post((unsigned*)(AWS + WS_CTL) + CW_BAR);
#endif
    if (args.pad == 0x5a5a5a5a) cg::this_grid().sync();
#ifndef PH_ENABLE
#define PH_ENABLE 0x3ff
#endif
#define IN(k) (((PH_ENABLE >> (k)) & 1) && lo <= (k) && (k) < hi)
#define BOTH(k) (IN(k) && IN((k) + 1))
#ifndef REP_MASK
#define REP_MASK 0
#endif
#define REPS(k) for (int rep_ = 0; rep_ <= ((REP_MASK >> (k)) & 1); ++rep_)
#define REP_MORE(k) (rep_ < ((REP_MASK >> (k)) & 1))
#ifndef CG_SEAMS
#define CG_SEAMS (NO_MEMSET_NODE ? 0x001 : 0x000)
#endif
#define GRID_BAR(k) do { if ((CG_SEAMS >> (k)) & 1) cg::this_grid().sync(); else xcd_barrier((unsigned*)(AWS + WS_CTL) + CW_BAR, (volatile LAS unsigned*)(F.lds + MISC_OFF) + 8); } while (0)
#define WSP(off) ((bf16_t*)(ws + (off)))
    TS_MARK(0);
#ifndef SUBREP_MASK
#define SUBREP_MASK 0
#endif
#define SUBREP(k) for (int sr_ = 0; sr_ <= ((SUBREP_MASK >> (k)) & 1); ++sr_)
    if (IN(0)) REPS(0) { p0_prologue(F); if (BOTH(0) || REP_MORE(0)) GRID_BAR(0); TS_MARK(1); }
#if NO_MEMSET_NODE
    if (args.use_cg) xcd_barrier_post((unsigned*)(AWS + WS_CTL) + CW_BAR);
#endif
    if (IN(1)) REPS(1) {
        unsigned char* ws = AWS;
        const int jx = (int)blockIdx.x / 8, spare = F.G / 8 - 30;
        if (F.G != 256 || jx < 30) {
            const int GG = F.G == 256 ? 240 : F.G;
            pg8::Gemm g{WSP(WS_H), WSP(WS_WIN), D, D, D, 0}; pg8::HybridOrder S; S.init(M / 256, INW / 256, D, GG, (int)blockIdx.x, 3);
            pg8::EpiProj E{WSP(WS_PROJ), (const float*)(ws + WS_CS)};
            pg8::gemm_phase(F.lds, g, S, E, pg8::SkBuf{nullptr, nullptr, nullptr});
        }
#ifndef ABL_NO_CONV1
        else p0_transposes(F, TR_A, TR_B, (jx - 30) * 8 + (int)blockIdx.x % 8, spare * 8);
#endif
        if (BOTH(1) || REP_MORE(1)) GRID_BAR(1); TS_MARK(2);
    }
    if (IN(2)) REPS(2) {
        unsigned char* ws = AWS; float* out = AOUT;
#pragma unroll 1
        for (int step = 0; step < 2; ++step) {
            if (((step ^ F.vcu) & 1) == 0) {
                for (int it = F.vcu; it < 256; it += F.G) u_item(F, WSP(WS_PROJ), WSP(WS_UT), it);
                pool_tasks(F, WSP(WS_PROJ), AIN(3), WSP(WS_POOLED), out + O_POOLP, out + O_POOLS);
            } else {
                const float* st = AIN(2); const float* rw = AIN(7);
                for (int it = F.vcu; it < 512; it += F.G) s_item(F, WSP(WS_PROJ), st, rw, out + O_RETS, WSP(WS_MIX), it);
            }
        }
        if (BOTH(2) || REP_MORE(2)) GRID_BAR(2); TS_MARK(3);
    }
    if (IN(3)) REPS(3) {
        unsigned char* ws = AWS;
#ifdef POOL_TWICE
        { float* out2 = AOUT; pool_tasks(F, WSP(WS_PROJ), AIN(3), WSP(WS_POOLED), out2 + O_POOLP, out2 + O_POOLS); asm volatile("s_waitcnt vmcnt(0)" ::: "memory"); __syncthreads(); }
#endif
        {
        float* out = AOUT; const bf16_t* UT = WSP(WS_UT); bf16_t* SCT = WSP(WS_SCT);
        int t_lo, t_hi;
        { const int jx = (int)blockIdx.x / 8, xx = (int)blockIdx.x % 8;
          if (F.G == 256) { const int slot = jx < 18 ? jx * 8 + xx : 144 + 5 * ((jx - 18) * 8 + xx), ns = jx < 18 ? 1 : 5;
              t_lo = (int)((long)slot * 131072 / 704); t_hi = (int)((long)(slot + ns) * 131072 / 704); }
          else { t_lo = (int)((long)blockIdx.x * 131072 / F.G); t_hi = (int)((long)(blockIdx.x + 1) * 131072 / F.G); } }
        for (int idx = t_lo + F.tid; idx < t_hi; idx += NTHR) {
            const int bh = idx >> 13, e = (idx >> 5) & 255, d8 = (idx & 31) * 8;
            const float g128 = __builtin_amdgcn_exp2f(lg2gamma(bh & 3) * 128.f);
            float s[8];
#pragma unroll
            for (int k = 0; k < 8; ++k) s[k] = 0.f;
            u32x4 uv[16];
#pragma unroll
            for (int c = 0; c < 16; ++c) uv[c] = *(const GAS u32x4*)(UT + ((size_t)(bh * 16 + c) * 256 + e) * 256 + d8);
#pragma unroll
            for (int c = 0; c < 16; ++c) {
                u32x4 o; o.x = pk2(s[0], s[1]); o.y = pk2(s[2], s[3]); o.z = pk2(s[4], s[5]); o.w = pk2(s[6], s[7]);
                *(GAS u32x4*)(SCT + ((size_t)(bh * 16 + c) * 256 + e) * 256 + d8) = o;
#pragma unroll
                for (int k = 0; k < 4; ++k) { s[2 * k] = g128 * s[2 * k] + bflo(uv[c][k]); s[2 * k + 1] = g128 * s[2 * k + 1] + bfhi(uv[c][k]); }
            }
            float* op = out + O_RETP + (size_t)bh * 65536 + e;
#pragma unroll
            for (int k = 0; k < 8; ++k) op[(size_t)(d8 + k) * 256] = s[k];
        }
        }
        TS_MARK(13);
        {
            pg8::Gemm g{WSP(WS_POOLED), WSP(WS_WPOOL), 1024, 256, 256, 256}; pg8::HybridOrder S; S.init(M / 256, 4, 256, F.G, (int)blockIdx.x, 1);
            pg8::EpiPlain E{WSP(WS_MIX), D, 1024, AIN(9)};
            pg8::gemm_phase(F.lds, g, S, E, pg8::SkBuf{nullptr, nullptr, nullptr});
        }
        TS_MARK(14);
        if (BOTH(3) || REP_MORE(3)) GRID_BAR(3); TS_MARK(4);
    }
    if (IN(4)) REPS(4) {
        unsigned char* ws = AWS; const float* rw = AIN(7);
        for (int it = F.vcu; it < 256; it += F.G) o_item(F, WSP(WS_PROJ), WSP(WS_SCT), rw, WSP(WS_MIX), it);
        TS_MARK(15);
#ifdef ABL_O_TWICE
        for (int it = F.vcu; it < 256; it += F.G) o_item(F, WSP(WS_PROJ), WSP(WS_SCT), rw, WSP(WS_MIX), (it + 128) & 255);
        TS_MARK(16);
#endif
        if (BOTH(4) || REP_MORE(4)) GRID_BAR(4); TS_MARK(5);
    }
    if (IN(5)) REPS(5) {
        unsigned char* ws = AWS;
        pg8::Gemm g{WSP(WS_MIX), WSP(WS_WOUT), D, D, D, 0}; pg8::HybridOrder S; S.init(M / 256, D / 256, D, F.G, (int)blockIdx.x, SK_RS_P3, SPLIT_MODE);
        pg8::EpiPlain E{WSP(WS_MO), D, 0, nullptr};
        pg8::gemm_phase(F.lds, g, S, E, pg8::SkBuf{(float*)(ws + WS_POOLED), (unsigned*)(ws + WS_CTL) + CW_SK, WSP(WS_PART3)});
        if (BOTH(5) || REP_MORE(5)) GRID_BAR(5); TS_MARK(6);
    }
    if (IN(6)) REPS(6) {
        unsigned char* ws = AWS; float* out = AOUT;
        const float* xp_ = AIN(0); const float* xs_ = AIN(1); const float* w5 = AIN(5); const float* w11 = AIN(11);
        const int gw = F.vcu * NWAVES + F.wave, NGW = F.G * NWAVES;
        f32x4 wpa[4], wpb[4], wqa[4], wqb[4];
#pragma unroll
        for (int j = 0; j < 4; ++j) { const int c = 8 * F.lane + 512 * j; wpa[j] = *(const GAS f32x4*)(w5 + c); wpb[j] = *(const GAS f32x4*)(w5 + c + 4); wqa[j] = *(const GAS f32x4*)(w11 + c); wqb[j] = *(const GAS f32x4*)(w11 + c + 4); }
        for (int m = gw; m < M; m += NGW) { const bool sp = SPLIT_MODE && m >= MP;
            n1_row(xrow_ptr(xp_, xs_, m), sp ? WSP(WS_PART3) + (size_t)(m - MP) * D : WSP(WS_MO) + (size_t)m * D, sp ? 8 : 1, (size_t)1024 * 2048, wpa, wpb, wqa, wqb, WSP(WS_MO) + (size_t)m * D, WSP(WS_H) + (size_t)m * D, F.lane); }
        if (BOTH(6) || REP_MORE(6)) GRID_BAR(6); TS_MARK(7);
    }
    if (IN(7)) REPS(7) {
        unsigned char* ws = AWS;
        const int jx = (int)blockIdx.x / 8;
        if (jx < 29) {
            pg8::Gemm g{WSP(WS_H), WSP(WS_WGU), D, D, D, 0}; pg8::HybridOrder S; S.init(M / 256, NGU / 256, D, 232, (int)blockIdx.x, SK_RS_P4);
            pg8::EpiGU E{WSP(WS_HID)};
            pg8::gemm_phase(F.lds, g, S, E, pg8::SkBuf{(float*)(ws + WS_MO), (unsigned*)(ws + WS_CTL) + CW_SK + 16384, nullptr});
        } else p0_transposes(F, TR_B, TR_C, (jx - 29) * 8 + (int)blockIdx.x % 8, 24);
        if (BOTH(7) || REP_MORE(7)) GRID_BAR(7); TS_MARK(8);
    }
    if (IN(8)) REPS(8) {
        unsigned char* ws = AWS;
        pg8::Gemm g{WSP(WS_HID), WSP(WS_WD), DFF, DFF, DFF, 0}; pg8::HybridOrder S; S.init(M / 256, D / 256, DFF, F.G, (int)blockIdx.x, SK_RS_P5, SPLIT_MODE);
        pg8::EpiPlain E{WSP(WS_FF), D, 0, nullptr};
        pg8::gemm_phase(F.lds, g, S, E, pg8::SkBuf{(float*)(ws + WS_POOLED), (unsigned*)(ws + WS_CTL) + CW_SK + 32768, WSP(WS_PART5)});
        if (BOTH(8) || REP_MORE(8)) GRID_BAR(8); TS_MARK(9);
    }
    if (IN(9)) {
        unsigned char* ws = AWS; float* out = AOUT; const float* w12 = AIN(12);
        const int gw = F.vcu * NWAVES + F.wave, NGW = F.G * NWAVES;
        f32x4 wpa[4], wpb[4];
#pragma unroll
        for (int j = 0; j < 4; ++j) { const int c = 8 * F.lane + 512 * j; wpa[j] = *(const GAS f32x4*)(w12 + c); wpb[j] = *(const GAS f32x4*)(w12 + c + 4); }
        for (int m = gw; m < M; m += NGW) { const bool sp = SPLIT_MODE && m >= MP;
            n2_row(sp ? WSP(WS_PART5) + (size_t)(m - MP) * D : WSP(WS_FF) + (size_t)m * D, sp ? 8 : 1, (size_t)1024 * 2048, wpa, wpb, WSP(WS_MO) + (size_t)m * D, out + O_Y + (size_t)m * D, F.lane); }
#ifdef TS_PHASE
        asm volatile("s_waitcnt vmcnt(0)" ::: "memory"); __syncthreads(); TS_MARK(10);
        if (blockIdx.x == 0 && F.tid == 0) {
            volatile LAS unsigned long long* ts = (volatile LAS unsigned long long*)(F.lds + ARG_OFF + 256);
            const unsigned long long d = ts[TS_B] - ts[TS_A];
            out[O_POOLP] += (float)d * 1e-4f * TS_SCALE;
        }
#endif
    }
#undef IN
#undef BOTH
}

extern "C" void kernel_launch(void* const* d_in, const int* in_sizes, int n_in, void* d_out, int out_size, void* d_ws, size_t ws_size, hipStream_t stream) {
    static int grid = 0;
    if (grid == 0) {
        if (n_in != 16 || (size_t)out_size != O_END || ws_size < WS_END) { fprintf(stderr, "kernel_launch: unexpected shapes: n_in %d out %d ws %zu (need %zu)\n", n_in, out_size, ws_size, (size_t)WS_END); grid = -1; return; }
        int dev = 0, cus = 0, per_cu = 0;
        if (hipGetDevice(&dev) != hipSuccess || hipDeviceGetAttribute(&cus, hipDeviceAttributeMultiprocessorCount, dev) != hipSuccess) { grid = -1; return; }
        if (hipFuncSetAttribute((const void*)hyb_fwd, hipFuncAttributeMaxDynamicSharedMemorySize, LDS_BYTES) != hipSuccess) { fprintf(stderr, "kernel_launch: hipFuncSetAttribute failed\n"); grid = -1; return; }
        if (hipOccupancyMaxActiveBlocksPerMultiprocessor(&per_cu, (const void*)hyb_fwd, NTHR, LDS_BYTES) != hipSuccess || per_cu < 1) { fprintf(stderr, "kernel_launch: occupancy query says %d\n", per_cu); per_cu = 1; }
        (void)hipGetLastError();
        grid = cus * 1;
        if (SPLIT_MODE && grid != 256) { fprintf(stderr, "kernel_launch: this build's unit schedule needs exactly 256 workgroups (got %d CUs); nothing launched\n", cus); grid = -1; return; }
        fprintf(stderr, "kernel_launch: grid %d (occupancy query %d per CU)\n", grid, per_cu);
    }
    if (grid < 0) return;
    Args a{};
    for (int i = 0; i < 16; ++i) a.in[i] = (const float*)d_in[i];
    a.out = (float*)d_out; a.ws = (unsigned char*)d_ws;
    if (!NO_MEMSET_NODE && hipMemsetAsync((char*)d_ws + WS_CTL + CTL_MS_OFF, 0, CTL_MS_BYTES, stream) != hipSuccess) { fprintf(stderr, "kernel_launch: memset failed\n"); return; }
    if (MK_N_LAUNCHES == 1) {
        a.ph_lo = 0; a.ph_hi = NPH; a.use_cg = 1;
        void* kargs[] = {&a};
        hipError_t e = hipLaunchCooperativeKernel((const void*)hyb_fwd, dim3(grid), dim3(NTHR), kargs, LDS_BYTES, stream);
        if (e != hipSuccess) fprintf(stderr, "kernel_launch: cooperative launch failed: %s (grid %d)\n", hipGetErrorString(e), grid);
    } else {
        for (int p = 0; p < NPH; ++p) {
            a.ph_lo = p; a.ph_hi = p + 1; a.use_cg = 0;
            hipLaunchKernelGGL(hyb_fwd, dim3(grid), dim3(NTHR), LDS_BYTES, stream, a);
        }
    }
}
```

```cpp
#include <hip/hip_runtime.h>
#include <hip/hip_cooperative_groups.h>
#include <cstdio>
#include <cstdint>
namespace cg = cooperative_groups;

#ifndef MK_N_LAUNCHES
#define MK_N_LAUNCHES 1
#endif

#define GAS __attribute__((address_space(1)))
#define LAS __attribute__((address_space(3)))
typedef unsigned short bf16_t;
typedef short bf16x8 __attribute__((ext_vector_type(8)));
typedef float f32x2 __attribute__((ext_vector_type(2)));
typedef float f32x4 __attribute__((ext_vector_type(4)));
typedef float f32x16 __attribute__((ext_vector_type(16)));
typedef unsigned u32x2 __attribute__((ext_vector_type(2)));
typedef unsigned u32x4 __attribute__((ext_vector_type(4)));

constexpr int D = 2048, MP = 8192, MS = 1024, M = MP + MS, SEQ = 2048;
constexpr int INW = 5120, DFF = 5632, NGU = 2 * DFF;
constexpr int PLD = 256;
constexpr size_t PTILE = (size_t)9216 * 256;
constexpr int NPOS = 2048 + 8;
constexpr float EPS = 1e-6f;
constexpr int NWAVES = 8, NTHR = 512;

constexpr size_t O_Y = 0, O_RETP = (size_t)M * D, O_POOLP = O_RETP + 4 * 4 * 65536, O_RETS = O_POOLP + 4 * 15 * 1024, O_POOLS = O_RETS + (size_t)128 * 4 * 65536, O_END = O_POOLS + 128 * 15 * 1024;

constexpr size_t MiB = 1u << 20;
constexpr size_t WS_CTL = 0, CTL_ZERO_BYTES = 1 * MiB;
constexpr size_t CTL_MS_OFF = 16384, CTL_MS_BYTES = 16384;
constexpr size_t WS_CS = 1 * MiB;
constexpr size_t WS_WPOOL = 4 * MiB;
constexpr size_t WS_WIN = 8 * MiB;
constexpr size_t WS_WOUT = 28 * MiB;
constexpr size_t WS_WGU = 36 * MiB;
constexpr size_t WS_WD = 80 * MiB;
constexpr size_t WS_H = 102 * MiB;
constexpr size_t WS_PROJ = 138 * MiB;
constexpr size_t WS_MIX = 228 * MiB;
constexpr size_t WS_UT = 264 * MiB;
constexpr size_t WS_SCT = 296 * MiB;
constexpr size_t WS_POOLED = 328 * MiB;
constexpr size_t WS_MO = 346 * MiB;
constexpr size_t WS_HID = 138 * MiB;
constexpr size_t WS_FF = 382 * MiB;
constexpr size_t WS_PART3 = 264 * MiB;
constexpr size_t WS_PART5 = 296 * MiB;
#ifndef SPLIT_MODE
#define SPLIT_MODE 1
#endif
constexpr size_t WS_END = 418 * MiB;
static_assert(WS_HID + (size_t)M * DFF * 2 <= WS_UT, "hid overlay");

constexpr int CW_BAR = 4096;
constexpr int LDS_BYTES = 147456;
constexpr int RING_BYTES = 131072, MISC_OFF = RING_BYTES + 320, ARG_OFF = RING_BYTES + 512;

__device__ __forceinline__ unsigned f2bf(float f) { unsigned u = __builtin_bit_cast(unsigned, f); return (u + 0x7fffu + ((u >> 16) & 1u)) >> 16; }
__device__ __forceinline__ unsigned cvt_pk_bf16(float lo, float hi) { unsigned r; asm volatile("v_cvt_pk_bf16_f32 %0, %1, %2" : "=v"(r) : "v"(lo), "v"(hi)); return r; }
__device__ __forceinline__ unsigned pk2(float lo, float hi) { unsigned r; asm("v_cvt_pk_bf16_f32 %0, %1, %2" : "=v"(r) : "v"(lo), "v"(hi)); return r; }
__device__ __forceinline__ float bflo(unsigned w) { return __builtin_bit_cast(float, w << 16); }
__device__ __forceinline__ float bfhi(unsigned w) { return __builtin_bit_cast(float, w & 0xffff0000u); }
__device__ __forceinline__ float bf2f(bf16_t b) { return __builtin_bit_cast(float, (unsigned)b << 16); }
__device__ __forceinline__ float wave_sum(float v) {
#pragma unroll
    for (int o = 1; o < 64; o <<= 1) v += __shfl_xor(v, o);
    return v;
}
__device__ __forceinline__ float silu(float x) { return x * __builtin_amdgcn_rcpf(1.0f + __builtin_amdgcn_exp2f(-1.4426950408889634f * x)); }
__device__ __forceinline__ float lg2gamma(int h) { return h == 0 ? -0.04580368961312479f : h == 1 ? -0.02272007650008353f : h == 2 ? -0.011315313227834146f : -0.005646563141142063f; }
#define LDS_WAIT() asm volatile("s_waitcnt lgkmcnt(0)" ::: "memory")
__device__ __forceinline__ int opaque(int x) { asm volatile("" : "+v"(x)); return x; }

namespace pg8 {
constexpr int BM = 256, BK = 64, HALF = 128, HTB = HALF * BK * 2, STAGE_BYTES = 8 * HTB, NXCD = 8, WGM = 8;
__host__ __device__ __forceinline__ int lds_byte(int r, int c) { const int st = (r >> 4) * 2 + (c >> 5), rr = r & 15, cc = c & 31, ob = rr * 64 + cc * 2; return st * 1024 + (ob ^ (((ob >> 9) & 1) << 5)); }
__host__ __device__ __forceinline__ void stage_rc(int b, int& R, int& C) { const int st = b / 1024, sb = b % 1024, swz = sb ^ (((sb >> 9) & 1) << 5); R = (st >> 1) * 16 + swz / 64; C = (st & 1) * 32 + (swz % 64) / 2; }
__host__ __device__ __forceinline__ int perm32(int rho) { const int n = rho >> 4, i = rho & 15; return 8 * (i >> 2) + 4 * n + (i & 3); }

struct Unit { int pm, pn, kt0, nkt, role; };
struct Gemm { const bf16_t* A; const bf16_t* Bt; int lda, ldb, K, a_pn_col; };
struct HybridOrder {
    int nM, nN, nwg, G, c, Rs, P, n32, q, mode;
    __device__ void init(int nM_, int nN_, int K, int G_, int c_, int Rs_, int mode_ = 0) {
        mode = mode_; nM = nM_; nN = nN_; nwg = nM * nN; G = G_; c = c_; Rs = Rs_; P = K / (2 * BK); n32 = G / NXCD; q = nwg / NXCD;
    }
    __device__ void tile(int wgid, Unit& u) const {
        const int nig = WGM * nN, gid = wgid / nig, fm = gid * WGM, gsz = (nM - fm) < WGM ? (nM - fm) : WGM;
        u.pm = fm + ((wgid % nig) % gsz); u.pn = (wgid % nig) / gsz;
    }
    __device__ bool next(int i, Unit& u) const {
        const int x = c % NXCD, j = c / NXCD;
        if (mode == 1) {
            if (i == 0) { u.pm = 8 * (x >> 1) + (j & 7); u.pn = 4 * (x & 1) + (j >> 3); u.kt0 = 0; u.nkt = 2 * P; u.role = 0; return true; }
            if (i == 1) { u.pm = 32 + (j >> 3); u.pn = j & 7; const int lo = x * P / 8, hi = (x + 1) * P / 8; u.kt0 = 2 * lo; u.nkt = 2 * (hi - lo); u.role = 3; return true; }
            return false;
        }
        if (i >= Rs || i * n32 + j >= q) return false;
        tile(x * q + i * n32 + j, u); u.kt0 = 0; u.nkt = 2 * P; u.role = 0; return true;
    }
};
struct SkBuf { bf16_t* part; };

template <class Epi>
__device__ __forceinline__ void gemm_phase(LAS unsigned char* lds, const Gemm g, const HybridOrder& S, const Epi& E, const SkBuf sk) {
    const int tid = threadIdx.x, wid = __builtin_amdgcn_readfirstlane(tid >> 6), lane = tid & 63, wr = wid >> 2, wc = wid & 3, fr = lane & 15, fq = lane >> 4;
    unsigned voffA[2], voffB[2];
#pragma unroll
    for (int i = 0; i < 2; ++i) { int R, C; stage_rc(tid * 16 + i * 8192, R, C); const int Rb = (R & ~31) + perm32(R & 31);
        voffA[i] = (unsigned)(R * g.lda + C) * 2u; voffB[i] = (unsigned)(Rb * g.ldb + C) * 2u; }
    const size_t kstep = (size_t)(BK * 2);
    const size_t hstepA = (size_t)HALF * g.lda * 2, hstepB = (size_t)HALF * g.ldb * 2;
    const unsigned ldsw = (unsigned)wid * 1024u;
    const int aoff = lds_byte(wr * 64 + fr, fq * 8), boff = lds_byte(wc * 32 + fr, fq * 8);
#define PG8_UA(u) ((const char*)g.A + ((size_t)(u).pm * BM * g.lda + (size_t)(u).pn * g.a_pn_col + (size_t)(u).kt0 * BK) * 2)
#define PG8_UB(u) ((const char*)g.Bt + ((size_t)(u).pn * BM * g.ldb + (size_t)(u).kt0 * BK) * 2)
#define PG8_SA(b, h) (((b) * 2 + (h)) * HTB)
#define PG8_SB(b, h) ((4 + (b) * 2 + (h)) * HTB)
#define PG8_STAGE(bufoff, gbase, voff) do { _Pragma("unroll") for (int _i = 0; _i < 2; ++_i) \
        __builtin_amdgcn_global_load_lds((const unsigned*)((const char*)(gbase) + (voff)[_i]), (LAS unsigned*)(lds + (bufoff) + ldsw + _i * 8192), 16, 0, 0); } while (0)
#define PG8_LDA(dst, b, h) do { _Pragma("unroll") for (int m = 0; m < 4; ++m) _Pragma("unroll") for (int k = 0; k < 2; ++k) dst[m][k] = *(const LAS bf16x8*)(lds + PG8_SA(b, h) + aoff + m * 2048 + k * 1024); } while (0)
#define PG8_LDB(dst, b, h) do { _Pragma("unroll") for (int n = 0; n < 2; ++n) _Pragma("unroll") for (int k = 0; k < 2; ++k) dst[n][k] = *(const LAS bf16x8*)(lds + PG8_SB(b, h) + boff + n * 2048 + k * 1024); } while (0)
#define PG8_MMA(ai, bj, At, Bt) do { __builtin_amdgcn_s_setprio(1); _Pragma("unroll") for (int m = 0; m < 4; ++m) _Pragma("unroll") for (int n = 0; n < 2; ++n) _Pragma("unroll") for (int k = 0; k < 2; ++k) \
        acc[ai][bj][m][n] = __builtin_amdgcn_mfma_f32_16x16x32_bf16(Bt[n][k], At[m][k], acc[ai][bj][m][n], 0, 0, 0); __builtin_amdgcn_s_setprio(0); } while (0)
#define PG8_WAIT_V(n) asm volatile("s_waitcnt vmcnt(" #n ")" ::: "memory")
#define PG8_WAIT_L(n) asm volatile("s_waitcnt lgkmcnt(" #n ")" ::: "memory")
#define PG8_BAR __builtin_amdgcn_s_barrier()
#define PG8_SCHED __builtin_amdgcn_sched_barrier(0)
    Unit cur, nxt; int ui = 0;
    if (!S.next(0, cur)) return;
    f32x4 acc[2][2][4][2];
#pragma unroll
    for (int a = 0; a < 2; ++a)
#pragma unroll
        for (int b = 0; b < 2; ++b)
#pragma unroll
            for (int m = 0; m < 4; ++m)
#pragma unroll
                for (int n = 0; n < 2; ++n) acc[a][b][m][n] = (f32x4){0.f, 0.f, 0.f, 0.f};
    bf16x8 At[4][2], B0[2][2], B1[2][2];
    const char* cA = PG8_UA(cur); const char* cB = PG8_UB(cur);
    PG8_STAGE(PG8_SB(0, 0), cB, voffB); PG8_STAGE(PG8_SB(0, 1), cB + hstepB, voffB); PG8_STAGE(PG8_SA(0, 0), cA, voffA); PG8_STAGE(PG8_SA(0, 1), cA + hstepA, voffA);
    if (wr == 1) PG8_BAR;
    PG8_WAIT_V(2); PG8_BAR;
    PG8_STAGE(PG8_SB(1, 0), cB + kstep, voffB); PG8_STAGE(PG8_SA(1, 0), cA + kstep, voffA); PG8_STAGE(PG8_SB(1, 1), cB + hstepB + kstep, voffB);
    PG8_WAIT_V(6); PG8_BAR;
    for (;;) {
        const bool has_next = S.next(ui + 1, nxt);
        const char* nA = has_next ? PG8_UA(nxt) : cA; const char* nB = has_next ? PG8_UB(nxt) : cB;
        const int nt = cur.nkt;
        for (int t = 0; t < nt; t += 2) {
            const bool last = (t == nt - 2);
            const char* a1 = cA + (size_t)(t + 1) * kstep;
            const char* a2 = last ? nA : cA + (size_t)(t + 2) * kstep; const char* b2 = last ? nB : cB + (size_t)(t + 2) * kstep;
            const char* a3 = a2 + kstep; const char* b3 = b2 + kstep;
            PG8_LDB(B0, 0, 0); PG8_LDB(B1, 0, 1); PG8_SCHED; PG8_LDA(At, 0, 0); PG8_STAGE(PG8_SA(1, 1), a1 + hstepA, voffA);
            PG8_WAIT_V(8); PG8_WAIT_L(0); PG8_BAR; PG8_MMA(0, 0, At, B0); PG8_MMA(0, 1, At, B1); PG8_BAR; PG8_SCHED;
            PG8_LDA(At, 0, 1); PG8_STAGE(PG8_SB(0, 0), b2, voffB); PG8_STAGE(PG8_SB(0, 1), b2 + hstepB, voffB); PG8_STAGE(PG8_SA(0, 0), a2, voffA);
            PG8_WAIT_V(8); PG8_WAIT_L(0); PG8_BAR; PG8_MMA(1, 0, At, B0); PG8_MMA(1, 1, At, B1); PG8_BAR; PG8_SCHED;
            PG8_LDB(B0, 1, 0); PG8_LDB(B1, 1, 1); PG8_SCHED; PG8_LDA(At, 1, 0); PG8_STAGE(PG8_SA(0, 1), a2 + hstepA, voffA);
            PG8_WAIT_V(8); PG8_WAIT_L(0); PG8_BAR; PG8_MMA(0, 0, At, B0); PG8_MMA(0, 1, At, B1); PG8_BAR; PG8_SCHED;
            PG8_LDA(At, 1, 1); PG8_STAGE(PG8_SB(1, 0), b3, voffB); PG8_STAGE(PG8_SB(1, 1), b3 + hstepB, voffB); PG8_STAGE(PG8_SA(1, 0), a3, voffA);
            PG8_WAIT_V(8); PG8_WAIT_L(0); PG8_BAR; PG8_MMA(1, 0, At, B0); PG8_MMA(1, 1, At, B1); PG8_BAR; PG8_SCHED;
        }
        if (wr == 0) PG8_BAR;
        if (cur.role == 3) {
            bf16_t* O = sk.part + (size_t)(S.c % NXCD) * 1024 * 2048;
            const int row0 = (cur.pm - 32) * BM + wr * 64 + fr, col0 = cur.pn * BM + wc * 32 + 8 * fq;
#pragma unroll
            for (int ai = 0; ai < 2; ++ai)
#pragma unroll
                for (int m = 0; m < 4; ++m) {
                    bf16_t* rp = O + (size_t)(row0 + ai * HALF + m * 16) * 2048 + col0;
#pragma unroll
                    for (int bj = 0; bj < 2; ++bj) {
                        u32x4 wv; wv.x = cvt_pk_bf16(acc[ai][bj][m][0][0], acc[ai][bj][m][0][1]); wv.y = cvt_pk_bf16(acc[ai][bj][m][0][2], acc[ai][bj][m][0][3]);
                        wv.z = cvt_pk_bf16(acc[ai][bj][m][1][0], acc[ai][bj][m][1][1]); wv.w = cvt_pk_bf16(acc[ai][bj][m][1][2], acc[ai][bj][m][1][3]);
                        *(GAS u32x4*)(rp + bj * HALF) = wv;
                    }
                }
        } else {
            E(acc, cur, wr, wc, fr, fq);
        }
        if (!has_next) break;
#pragma unroll
        for (int a = 0; a < 2; ++a)
#pragma unroll
            for (int b = 0; b < 2; ++b)
#pragma unroll
                for (int m = 0; m < 4; ++m)
#pragma unroll
                    for (int n = 0; n < 2; ++n) acc[a][b][m][n] = (f32x4){0.f, 0.f, 0.f, 0.f};
        cur = nxt; cA = nA; cB = nB; ++ui;
        if (wr == 1) PG8_BAR;
    }
    PG8_WAIT_V(0);
    PG8_BAR;
#undef PG8_UA
#undef PG8_UB
#undef PG8_SA
#undef PG8_SB
#undef PG8_STAGE
#undef PG8_LDA
#undef PG8_LDB
#undef PG8_MMA
#undef PG8_WAIT_V
#undef PG8_WAIT_L
#undef PG8_BAR
#undef PG8_SCHED
}

__device__ __forceinline__ void st8(bf16_t* p, const f32x4 v0, const f32x4 v1) {
    u32x4 w; w.x = cvt_pk_bf16(v0[0], v0[1]); w.y = cvt_pk_bf16(v0[2], v0[3]); w.z = cvt_pk_bf16(v1[0], v1[1]); w.w = cvt_pk_bf16(v1[2], v1[3]);
    *(GAS u32x4*)p = w;
}
struct EpiProj {
    bf16_t* P; const float* cs;
    __device__ __forceinline__ void operator()(const f32x4 (&acc)[2][2][4][2], const Unit& u, int wr, int wc, int fr, int fq) const {
        const int row0 = u.pm * BM + wr * 64 + fr, type = u.pn >> 2, cl = wc * 32 + 8 * fq;
        bf16_t* Pt = P + (size_t)u.pn * PTILE + cl;
        if (type <= 1) {
            const float sc = type == 1 ? 0.0625f : 1.0f;
            const GAS f32x4* tb = (const GAS f32x4*)cs + (size_t)(cl >> 3) * 4 * NPOS;
#pragma unroll
            for (int ai = 0; ai < 2; ++ai) {
                u32x4 res[4][2];
                f32x4 tt[4][4];
#pragma unroll
                for (int m = 0; m < 4; ++m) { const int row = row0 + ai * HALF + m * 16; const int pidx = row < MP ? (row & (SEQ - 1)) : SEQ + ((row - MP) & 7);
#pragma unroll
                    for (int q = 0; q < 4; ++q) tt[m][q] = tb[(size_t)q * NPOS + pidx]; }
#pragma unroll
                for (int m = 0; m < 4; ++m) {
                    const f32x4 t0 = tt[m][0], t1 = tt[m][1], t2 = tt[m][2], t3 = tt[m][3];
                    const f32x4 x1a = acc[ai][0][m][0], x1b = acc[ai][0][m][1], x2a = acc[ai][1][m][0], x2b = acc[ai][1][m][1];
                    f32x4 o1a, o1b, o2a, o2b;
                    o1a[0] = (x1a[0] * t0[0] - x2a[0] * t0[1]) * sc; o2a[0] = (x2a[0] * t0[0] + x1a[0] * t0[1]) * sc;
                    o1a[1] = (x1a[1] * t0[2] - x2a[1] * t0[3]) * sc; o2a[1] = (x2a[1] * t0[2] + x1a[1] * t0[3]) * sc;
                    o1a[2] = (x1a[2] * t1[0] - x2a[2] * t1[1]) * sc; o2a[2] = (x2a[2] * t1[0] + x1a[2] * t1[1]) * sc;
                    o1a[3] = (x1a[3] * t1[2] - x2a[3] * t1[3]) * sc; o2a[3] = (x2a[3] * t1[2] + x1a[3] * t1[3]) * sc;
                    o1b[0] = (x1b[0] * t2[0] - x2b[0] * t2[1]) * sc; o2b[0] = (x2b[0] * t2[0] + x1b[0] * t2[1]) * sc;
                    o1b[1] = (x1b[1] * t2[2] - x2b[1] * t2[3]) * sc; o2b[1] = (x2b[1] * t2[2] + x1b[1] * t2[3]) * sc;
                    o1b[2] = (x1b[2] * t3[0] - x2b[2] * t3[1]) * sc; o2b[2] = (x2b[2] * t3[0] + x1b[2] * t3[1]) * sc;
                    o1b[3] = (x1b[3] * t3[2] - x2b[3] * t3[3]) * sc; o2b[3] = (x2b[3] * t3[2] + x1b[3] * t3[3]) * sc;
                    u32x4 w1, w2;
                    w1.x = cvt_pk_bf16(o1a[0], o1a[1]); w1.y = cvt_pk_bf16(o1a[2], o1a[3]); w1.z = cvt_pk_bf16(o1b[0], o1b[1]); w1.w = cvt_pk_bf16(o1b[2], o1b[3]);
                    w2.x = cvt_pk_bf16(o2a[0], o2a[1]); w2.y = cvt_pk_bf16(o2a[2], o2a[3]); w2.z = cvt_pk_bf16(o2b[0], o2b[1]); w2.w = cvt_pk_bf16(o2b[2], o2b[3]);
                    res[m][0] = w1; res[m][1] = w2;
                }
                asm volatile("" ::: "memory");
#pragma unroll
                for (int m = 0; m < 4; ++m) {
                    bf16_t* rp = Pt + (size_t)(row0 + ai * HALF + m * 16) * PLD;
                    *(GAS u32x4*)rp = res[m][0]; *(GAS u32x4*)(rp + HALF) = res[m][1];
                }
                asm volatile("" ::: "memory");
            }
        } else {
            const bool act = type == 3;
#pragma unroll
            for (int ai = 0; ai < 2; ++ai)
#pragma unroll
                for (int m = 0; m < 4; ++m) {
                    bf16_t* rp = Pt + (size_t)(row0 + ai * HALF + m * 16) * PLD;
#pragma unroll
                    for (int bj = 0; bj < 2; ++bj) {
                        f32x4 v0 = acc[ai][bj][m][0], v1 = acc[ai][bj][m][1];
                        if (act) {
#pragma unroll
                            for (int i = 0; i < 4; ++i) { v0[i] = silu(v0[i]); v1[i] = silu(v1[i]); }
                        }
                        st8(rp + bj * HALF, v0, v1);
                    }
                }
        }
    }
};
struct EpiPlain {
    bf16_t* O; int ldc, coff; const float* scale;
    __device__ __forceinline__ void operator()(const f32x4 (&acc)[2][2][4][2], const Unit& u, int wr, int wc, int fr, int fq) const {
        const int row0 = u.pm * BM + wr * 64 + fr, cl = wc * 32 + 8 * fq, col0 = u.pn * BM + cl;
        f32x4 s[2][2];
#pragma unroll
        for (int bj = 0; bj < 2; ++bj)
#pragma unroll
            for (int n = 0; n < 2; ++n) s[bj][n] = scale ? *(const GAS f32x4*)(scale + col0 + bj * HALF + 4 * n) : (f32x4){1.f, 1.f, 1.f, 1.f};
#pragma unroll
        for (int ai = 0; ai < 2; ++ai)
#pragma unroll
            for (int m = 0; m < 4; ++m) {
                bf16_t* rp = O + (size_t)(row0 + ai * HALF + m * 16) * ldc + coff + col0;
#pragma unroll
                for (int bj = 0; bj < 2; ++bj) st8(rp + bj * HALF, acc[ai][bj][m][0] * s[bj][0], acc[ai][bj][m][1] * s[bj][1]);
            }
    }
};
struct EpiGU {
    bf16_t* Hd;
    __device__ __forceinline__ void operator()(const f32x4 (&acc)[2][2][4][2], const Unit& u, int wr, int wc, int fr, int fq) const {
        const int row0 = u.pm * BM + wr * 64 + fr, cl = wc * 32 + 8 * fq, col0 = u.pn * HALF + cl;
#pragma unroll
        for (int ai = 0; ai < 2; ++ai)
#pragma unroll
            for (int m = 0; m < 4; ++m) {
                f32x4 v0, v1;
#pragma unroll
                for (int i = 0; i < 4; ++i) { v0[i] = silu(acc[ai][0][m][0][i]) * acc[ai][1][m][0][i]; v1[i] = silu(acc[ai][0][m][1][i]) * acc[ai][1][m][1][i]; }
                st8(Hd + (size_t)(row0 + ai * HALF + m * 16) * DFF + col0, v0, v1);
            }
    }
};
}

#define XB_TMO      128
#define XB_XCNT(j)  (256  + 64 * (j))
#define XB_XSUB(j)  (1280 + 64 * (j))
#define XB_XGEN(j)  (2304 + 64 * (j))
#define XB_TOP      3328
#define XB_TOPGEN   3392
#define XCD_BAR_WORDS 3456
#define XB_SPIN_CAP (1u << 18)
__device__ __forceinline__ unsigned xb_ld(unsigned* p)              { return __hip_atomic_load(p, __ATOMIC_RELAXED, __HIP_MEMORY_SCOPE_AGENT); }
__device__ __forceinline__ unsigned xb_add(unsigned* p, unsigned v) { return __hip_atomic_fetch_add(p, v, __ATOMIC_RELAXED, __HIP_MEMORY_SCOPE_AGENT); }
__device__ __forceinline__ unsigned xb_xcc_id() { return (unsigned)__builtin_amdgcn_s_getreg((3 << 11) | 20) & 0xFu; }
#define XB_SPIN(cond, bar) do { unsigned _sp = 0; while (cond) { __builtin_amdgcn_s_sleep(1); \
    if ((++_sp & 255u) == 0u) { if (xb_ld(&(bar)[XB_TMO])) break; if (_sp > XB_SPIN_CAP) { atomicAdd(&(bar)[XB_TMO], 1u); break; } } } } while (0)
__device__ __forceinline__ void xcd_barrier_post(unsigned* bar) {
    if (threadIdx.x == 0) (void)xb_add(&bar[XB_XCNT(xb_xcc_id())], 1u);
}
__device__ __forceinline__ void xcd_barrier_complete(unsigned* bar, unsigned x, unsigned& nloc, unsigned& nx) {
    const unsigned G = gridDim.x * gridDim.y * gridDim.z;
    unsigned sum, cnt, mine, sp = 0u;
    for (;;) {
        sum = 0u; cnt = 0u; mine = 0u;
#pragma unroll
        for (unsigned j = 0; j < 16; ++j) { const unsigned c = xb_ld(&bar[XB_XCNT(j)]); sum += c; cnt += (c > 0u) ? 1u : 0u; mine = (j == x) ? c : mine; }
        if (sum == G) break;
        __builtin_amdgcn_s_sleep(1);
        if ((++sp & 255u) == 0u) { if (xb_ld(&bar[XB_TMO])) break; if (sp > XB_SPIN_CAP) { atomicAdd(&bar[XB_TMO], 1u); break; } }
    }
    nloc = mine > 0u ? mine : 1u; nx = cnt > 0u ? cnt : 1u;
}
__device__ __forceinline__ void xcd_barrier(unsigned* bar, volatile LAS unsigned* st) {
    asm volatile("s_waitcnt vmcnt(0)" ::: "memory");
    __syncthreads();
    if (threadIdx.x == 0) {
        const unsigned x = xb_xcc_id();
        __builtin_amdgcn_s_waitcnt(0);
        unsigned nloc = st[0], nx = st[1];
        if (nloc == 0u) { xcd_barrier_complete(bar, x, nloc, nx); st[0] = nloc; st[1] = nx; }
        const unsigned old = xb_add(&bar[XB_XSUB(x)], 1u);
        const unsigned gen = old / nloc;
        if (old + 1u == (gen + 1u) * nloc) {
            __builtin_amdgcn_fence(__ATOMIC_RELEASE, "agent");
            asm volatile("s_waitcnt vmcnt(0)" ::: "memory");
            const unsigned og = xb_add(&bar[XB_TOP], 1u);
            const unsigned tg = og / nx;
            if (og + 1u == (tg + 1u) * nx) xb_add(&bar[XB_TOPGEN], 1u);
            else XB_SPIN(xb_ld(&bar[XB_TOPGEN]) == tg, bar);
            __builtin_amdgcn_fence(__ATOMIC_ACQUIRE, "agent");
            xb_add(&bar[XB_XGEN(x)], 1u);
            asm volatile("s_waitcnt vmcnt(0)" ::: "memory");
        } else {
            XB_SPIN(xb_ld(&bar[XB_XGEN(x)]) == gen, bar);
            __builtin_amdgcn_fence(__ATOMIC_ACQUIRE, "agent");
            asm volatile("s_waitcnt vmcnt(0)" ::: "memory");
        }
    }
    __syncthreads();
}

struct Args { const float* in[16]; float* out; unsigned char* ws; int ph_lo, ph_hi, use_cg, pad; };

struct Frame {
    LAS unsigned char* lds;
    int tid, lane, wave, vcu, G;
};
__device__ __forceinline__ const float* ldarg(const Frame& F, int k) {
    const volatile LAS unsigned* p = (const volatile LAS unsigned*)(F.lds + ARG_OFF) + 2 * k;
    const unsigned lo = __builtin_amdgcn_readfirstlane(p[0]), hi = __builtin_amdgcn_readfirstlane(p[1]);
    return (const float*)(((unsigned long long)hi << 32) | lo);
}
#define AIN(k) ldarg(F, (k))
#define AOUT ((float*)ldarg(F, 16))
#define AWS ((unsigned char*)ldarg(F, 17))

struct TrItem { const float* W; bf16_t* WT; int K, N, mode, k0, n0; };
constexpr int TR_IN = (D / 64) * (INW / 256), TR_OUT = (D / 64) * (D / 256), TR_G = (D / 64) * (DFF / 256), TR_D = (DFF / 64) * (D / 256);
struct P0Ptrs { const float *w_in, *w_out, *w_gate, *w_up, *w_down, *w_pool; unsigned char* ws; };
__device__ __forceinline__ TrItem p0_decode(const P0Ptrs& a, unsigned char* ws, int it) {
    TrItem t; int r = it, nblk;
    if (r < TR_IN) { t.W = a.w_in; t.WT = (bf16_t*)(ws + WS_WIN); t.K = D; t.N = INW; t.mode = 0; }
    else if ((r -= TR_IN) < TR_OUT) { t.W = a.w_out; t.WT = (bf16_t*)(ws + WS_WOUT); t.K = D; t.N = D; t.mode = 0; }
    else if ((r -= TR_OUT) < 16) { const int g = r >> 2; r &= 3; t.W = a.w_pool + (size_t)g * 65536; t.WT = (bf16_t*)(ws + WS_WPOOL) + (size_t)g * 65536; t.K = 256; t.N = 256; t.mode = 0; }
    else if ((r -= 16) < TR_G) { t.W = a.w_gate; t.WT = (bf16_t*)(ws + WS_WGU); t.K = D; t.N = DFF; t.mode = 1; }
    else if ((r -= TR_G) < TR_G) { t.W = a.w_up; t.WT = (bf16_t*)(ws + WS_WGU); t.K = D; t.N = DFF; t.mode = 2; }
    else { r -= TR_G; t.W = a.w_down; t.WT = (bf16_t*)(ws + WS_WD); t.K = DFF; t.N = D; t.mode = 0; }
    nblk = t.N >> 8; t.k0 = 64 * (r / nblk); t.n0 = 256 * (r % nblk);
    return t;
}
constexpr int P0_NITEMS = TR_IN + TR_OUT + 16 + 2 * TR_G + TR_D;
constexpr int TR_B = TR_IN + TR_OUT + 16 + 2 * TR_G, TR_C = P0_NITEMS;
#ifndef TR_P1_ITEMS
#define TR_P1_ITEMS 800
#endif
constexpr int TR_A = TR_B - TR_P1_ITEMS;
__device__ __forceinline__ void p0_transposes(Frame& F, int it_begin, int it_end, int worker, int nworkers) {
    P0Ptrs a; a.w_in = AIN(6); a.w_out = AIN(10); a.w_gate = AIN(13); a.w_up = AIN(14); a.w_down = AIN(15); a.w_pool = AIN(8); a.ws = AWS;
    unsigned char* ws = a.ws;
    LAS float* buf = (LAS float*)F.lds;
    const int w = F.wave, l = opaque(F.lane);
#define TR_LOAD(V, T) do { _Pragma("unroll") for (int i = 0; i < 8; ++i) V[i] = *(const GAS f32x4*)((T).W + (size_t)((T).k0 + 8 * w + i) * (T).N + (T).n0 + 4 * l); } while (0)
#define TR_STEP(V, CUR) do { \
        _Pragma("unroll") for (int i = 0; i < 8; ++i) *(LAS f32x4*)(buf + (8 * w + i) * 260 + ((4 * l) ^ (4 * (w & 7)))) = V[i]; \
        __syncthreads(); \
        const TrItem cur_ = (CUR); \
        const int nit_ = it + 2 * nworkers; \
        if (nit_ < it_end) { (CUR) = p0_decode(a, ws, nit_); TR_LOAD(V, (CUR)); } \
        const int ko = l & 7; \
        _Pragma("unroll") for (int sidx = 0; sidx < 4; ++sidx) { \
            const int nl = 32 * w + 8 * sidx + (l >> 3), n = cur_.n0 + nl; \
            const LAS float* p = buf + (8 * ko) * 260 + (nl ^ (4 * ko)); \
            u32x4 o; o.x = pk2(p[0], p[260]); o.y = pk2(p[2 * 260], p[3 * 260]); o.z = pk2(p[4 * 260], p[5 * 260]); o.w = pk2(p[6 * 260], p[7 * 260]); \
            const int row = cur_.mode == 0 ? n : (256 * (n >> 7) + (n & 127) + (cur_.mode == 2 ? 128 : 0)); \
            *(GAS u32x4*)(cur_.WT + (size_t)row * cur_.K + cur_.k0 + 8 * ko) = o; } \
        __syncthreads(); } while (0)
    int it = it_begin + worker;
    if (it >= it_end) return;
    TrItem tA = p0_decode(a, ws, it), tB = tA;
    f32x4 vA[8], vB[8];
    TR_LOAD(vA, tA);
    if (it + nworkers < it_end) { tB = p0_decode(a, ws, it + nworkers); TR_LOAD(vB, tB); }
    for (;;) {
        TR_STEP(vA, tA);
        it += nworkers; if (it >= it_end) break;
        TR_STEP(vB, tB);
        it += nworkers; if (it >= it_end) break;
    }
#undef TR_LOAD
#undef TR_STEP
}
__device__ __forceinline__ void rms_row_to_bf16(const float* xrow, const f32x4 (&ww)[8], bf16_t* orow, int lane) {
    const GAS f32x4* xr = (const GAS f32x4*)xrow + lane;
    f32x4 v[8]; float s = 0.f;
#pragma unroll
    for (int j = 0; j < 8; ++j) { v[j] = xr[64 * j]; s += (v[j].x * v[j].x + v[j].y * v[j].y) + (v[j].z * v[j].z + v[j].w * v[j].w); }
    const float rstd = 1.0f / sqrtf(wave_sum(s) * (1.f / D) + EPS);
    GAS u32x2* o8 = (GAS u32x2*)orow + lane;
#pragma unroll
    for (int j = 0; j < 8; ++j) { u32x2 o; o.x = pk2(v[j].x * rstd * ww[j].x, v[j].y * rstd * ww[j].y); o.y = pk2(v[j].z * rstd * ww[j].z, v[j].w * rstd * ww[j].w); o8[64 * j] = o; }
}
__device__ __forceinline__ const float* xrow_ptr(const float* xp, const float* xs, int m) { return m < MP ? xp + (size_t)m * D : xs + (size_t)(m - MP) * D; }

__device__ __forceinline__ void p0_prologue(Frame& F) {
    p0_transposes(F, 0, TR_A, F.vcu, F.G);
    unsigned char* ws = AWS;
    const int gw = F.vcu * NWAVES + F.wave, NGW = F.G * NWAVES;
    const float* xp_ = AIN(0); const float* xs_ = AIN(1); const float* nw_ = AIN(4);
    f32x4 ww0[8];
#pragma unroll
    for (int j = 0; j < 8; ++j) ww0[j] = *((const GAS f32x4*)nw_ + F.lane + 64 * j);
    for (int m = gw; m < M; m += NGW) rms_row_to_bf16(xrow_ptr(xp_, xs_, m), ww0, (bf16_t*)(ws + WS_H) + (size_t)m * D, F.lane);
    float* cs = (float*)(ws + WS_CS);
    for (int idx = F.vcu * NTHR + F.tid; idx < NPOS * 128; idx += F.G * NTHR) {
        const int p = idx >> 7, j = idx & 127;
        double r = 0.930572040929699, inv = 1.0;
#pragma unroll
        for (int b = 0; b < 7; ++b) { if ((j >> b) & 1) inv *= r; r *= r; }
        const float invf = (float)inv;
        const float pos = (float)(p < SEQ ? p : 16384 + (p - SEQ));
        const float ang = pos * invf;
        double t = (double)ang * 0.15915494309189535; t -= __builtin_rint(t);
        const float tf = (float)t;
        f32x2 o; o.x = __builtin_amdgcn_cosf(tf); o.y = __builtin_amdgcn_sinf(tf);
        *(f32x2*)(cs + ((size_t)(((j >> 3) * 4 + ((j & 7) >> 1)) * NPOS + p)) * 4 + (j & 1) * 2) = o;
    }
}

__device__ __forceinline__ unsigned toff(int r, int c16, int RB) { return (unsigned)(r * RB + ((((c16 & ~15) | ((c16 ^ r ^ (r >> 4)) & 15))) << 4)); }
#define MFMA32(a, b, c) __builtin_amdgcn_mfma_f32_32x32x16_bf16((a), (b), (c), 0, 0, 0)
__device__ __forceinline__ int crow(int reg, int h) { return (reg & 3) + 8 * (reg >> 2) + 4 * h; }
__device__ __forceinline__ bf16x8 frag(const LAS unsigned char* tile, int r, int c16, int RB) { return *(const LAS bf16x8*)(tile + toff(r, c16, RB)); }

__device__ __forceinline__ void load_nat128(LAS unsigned char* dst, const bf16_t* src, int ld, int tid) {
    tid = opaque(tid);
    u32x4 v[4];
#pragma unroll
    for (int it = 0; it < 4; ++it) { const int idx = tid + it * NTHR, r = idx >> 4, c = idx & 15; v[it] = *(const GAS u32x4*)(src + (size_t)r * ld + c * 8); }
#pragma unroll
    for (int it = 0; it < 4; ++it) { const int idx = tid + it * NTHR, r = idx >> 4, c = idx & 15; *(LAS u32x4*)(dst + toff(r, c, 256)) = v[it]; }
}
template <bool SCALE>
__device__ __forceinline__ void load_tr(LAS unsigned char* dst, const bf16_t* src, int ld, int tid, float sc_a, float sc_b) {
    tid = opaque(tid);
#pragma unroll
    for (int it = 0; it < 4; ++it) {
        const int T = it * NTHR + tid, ch_lo = T & 15, pp = (T >> 4) & 3, half = (T >> 6) & 1, quad = T >> 7;
        const int pair = 4 * quad + pp, chunk = 16 * half + ch_lo, j0 = 2 * pair, d0 = 8 * chunk;
        const u32x4 a = *(const GAS u32x4*)(src + (size_t)j0 * ld + d0), b = *(const GAS u32x4*)(src + (size_t)(j0 + 1) * ld + d0);
        float s0 = 1.f, s1 = 1.f;
        if (SCALE) { s0 = __builtin_amdgcn_exp2f(sc_a * (sc_b - (float)j0)); s1 = __builtin_amdgcn_exp2f(sc_a * (sc_b - (float)(j0 + 1))); }
#pragma unroll
        for (int i = 0; i < 8; ++i) {
            const unsigned wa = a[i >> 1], wb = b[i >> 1];
            unsigned w;
            if (SCALE) { const float fa = ((i & 1) ? bfhi(wa) : bflo(wa)) * s0, fb = ((i & 1) ? bfhi(wb) : bflo(wb)) * s1; w = pk2(fa, fb); }
            else w = (i & 1) ? ((wa >> 16) | (wb & 0xffff0000u)) : ((wa & 0xffffu) | (wb << 16));
            const int d = d0 + i;
            *(LAS unsigned*)(dst + toff(d, quad, 256) + pp * 4) = w;
        }
    }
}

__device__ __forceinline__ void u_item(Frame& F, const bf16_t* PROJ, bf16_t* UT, int item) {
    const int b = item >> 6, h = (item >> 4) & 3, c = item & 15, rows0 = b * SEQ + c * 128;
    const bf16_t* Ks = PROJ + (size_t)(4 + h) * PTILE + (size_t)rows0 * PLD; const bf16_t* Vs = Ks + 4 * PTILE;
    LAS unsigned char* KT = F.lds; LAS unsigned char* VT = F.lds + 65536;
    const float lg = lg2gamma(h);
    load_tr<true>(KT, Ks, PLD, F.tid, lg, 127.f);
    load_tr<false>(VT, Vs, PLD, F.tid, 0.f, 0.f);
    __syncthreads();
    const int w = F.wave, r = opaque(F.lane) & 31, hh = opaque(F.lane) >> 5;
    bf16_t* Up = UT + ((size_t)((b * 4 + h) * 16 + c) * 256) * 256;
#pragma unroll 1
    for (int eh = 0; eh < 2; ++eh) {
        f32x16 acc[4];
#pragma unroll
        for (int t = 0; t < 4; ++t)
#pragma unroll
            for (int i = 0; i < 16; ++i) acc[t][i] = 0.f;
#pragma unroll 1
        for (int ks = 0; ks < 8; ++ks) {
            const bf16x8 a = frag(KT, 32 * w + r, 2 * ks + hh, 256);
#pragma unroll
            for (int et = 0; et < 4; ++et) { const bf16x8 bb = frag(VT, 32 * (4 * eh + et) + r, 2 * ks + hh, 256); acc[et] = MFMA32(a, bb, acc[et]); }
        }
#pragma unroll
        for (int et = 0; et < 4; ++et)
#pragma unroll
            for (int g = 0; g < 4; ++g) {
                u32x2 o; o.x = cvt_pk_bf16(acc[et][4 * g], acc[et][4 * g + 1]); o.y = cvt_pk_bf16(acc[et][4 * g + 2], acc[et][4 * g + 3]);
                *(GAS u32x2*)(Up + (size_t)(32 * (4 * eh + et) + r) * 256 + 32 * w + 8 * g + 4 * hh) = o;
            }
    }
    __syncthreads();
}

__device__ __forceinline__ void o_item(Frame& F, const bf16_t* PROJ, const bf16_t* SCT, const float* retw, bf16_t* MIX, int item) {
    const int b = item >> 6, h = (item >> 4) & 3, c = item & 15, rows0 = b * SEQ + c * 128;
    const bf16_t* Qs = PROJ + (size_t)h * PTILE + (size_t)rows0 * PLD; const bf16_t* Ks = Qs + 4 * PTILE; const bf16_t* Vs = Qs + 8 * PTILE; const bf16_t* Gs = Qs + 12 * PTILE;
    LAS unsigned char* QF = F.lds; LAS unsigned char* KH = F.lds + 65536; LAS unsigned char* PB = F.lds + 98304; LAS unsigned char* VT = F.lds; LAS unsigned char* OB = F.lds;
    const float lg = lg2gamma(h);
    const int w = F.wave; int r = opaque(F.lane) & 31, hh = opaque(F.lane) >> 5; const int tid = opaque(F.tid);
    u32x4 qv[8], kv[4]; bf16x8 sfr[16];
#pragma unroll
    for (int it = 0; it < 8; ++it) { const int idx = tid + it * NTHR, rr = idx >> 5, cc = idx & 31; qv[it] = *(const GAS u32x4*)(Qs + (size_t)rr * PLD + cc * 8); }
#pragma unroll
    for (int it = 0; it < 4; ++it) { const int idx = tid + it * NTHR, rr = idx >> 4, cc = idx & 15; kv[it] = *(const GAS u32x4*)(Ks + (size_t)rr * PLD + cc * 8); }
    {
        const bf16_t* Sp = SCT + ((size_t)((b * 4 + h) * 16 + c) * 256) * 256 + (size_t)(32 * w + r) * 256 + 8 * hh;
#pragma unroll
        for (int ks = 0; ks < 16; ++ks) sfr[ks] = *(const GAS bf16x8*)(Sp + 16 * ks);
    }
#pragma unroll
    for (int it = 0; it < 8; ++it) { const int idx = tid + it * NTHR, rr = idx >> 5, cc = idx & 31; *(LAS u32x4*)(QF + toff(rr, cc, 512)) = qv[it]; }
#pragma unroll
    for (int it = 0; it < 4; ++it) { const int idx = tid + it * NTHR, rr = idx >> 4, cc = idx & 15; *(LAS u32x4*)(KH + toff(rr, cc, 256)) = kv[it]; }
    __syncthreads();
#pragma unroll
    for (int it = 0; it < 4; ++it) { const int idx = tid + it * NTHR, rr = idx >> 4, cc = idx & 15; kv[it] = *(const GAS u32x4*)(Ks + 128 + (size_t)rr * PLD + cc * 8); }
    const int ib_s = w >> 1, jb0 = 2 * (w & 1);
    f32x16 sc[2];
#pragma unroll
    for (int t = 0; t < 2; ++t)
#pragma unroll
        for (int i = 0; i < 16; ++i) sc[t][i] = 0.f;
    if (jb0 <= ib_s) {
#pragma unroll 1
        for (int ks = 0; ks < 8; ++ks) {
            const bf16x8 a = frag(QF, 32 * ib_s + r, 2 * ks + hh, 512);
            const bf16x8 b0 = frag(KH, 32 * jb0 + r, 2 * ks + hh, 256), b1 = frag(KH, 32 * (jb0 + 1) + r, 2 * ks + hh, 256);
            sc[0] = MFMA32(a, b0, sc[0]); sc[1] = MFMA32(a, b1, sc[1]);
        }
    }
    __syncthreads();
#pragma unroll
    for (int it = 0; it < 4; ++it) { const int idx = tid + it * NTHR, rr = idx >> 4, cc = idx & 15; *(LAS u32x4*)(KH + toff(rr, cc, 256)) = kv[it]; }
    __syncthreads();
    u32x4 va[4], vb[4];
#pragma unroll
    for (int it = 0; it < 4; ++it) {
        const int T = it * NTHR + tid, ch_lo = T & 15, pp = (T >> 4) & 3, half = (T >> 6) & 1, quad = T >> 7;
        const int pair = 4 * quad + pp, chunk = 16 * half + ch_lo, j0 = 2 * pair, d0 = 8 * chunk;
        va[it] = *(const GAS u32x4*)(Vs + (size_t)j0 * PLD + d0); vb[it] = *(const GAS u32x4*)(Vs + (size_t)(j0 + 1) * PLD + d0);
    }
    if (jb0 <= ib_s) {
#pragma unroll 1
        for (int ks = 0; ks < 8; ++ks) {
            const bf16x8 a = frag(QF, 32 * ib_s + r, 16 + 2 * ks + hh, 512);
            const bf16x8 b0 = frag(KH, 32 * jb0 + r, 2 * ks + hh, 256), b1 = frag(KH, 32 * (jb0 + 1) + r, 2 * ks + hh, 256);
            sc[0] = MFMA32(a, b0, sc[0]); sc[1] = MFMA32(a, b1, sc[1]);
        }
    }
    r = opaque(r); hh = opaque(hh);
#pragma unroll
    for (int t = 0; t < 2; ++t) {
        const int j = 32 * (jb0 + t) + r;
#pragma unroll
        for (int reg = 0; reg < 16; ++reg) {
            const int i = 32 * ib_s + crow(reg, hh);
            const float v = (i >= j) ? sc[t][reg] * __builtin_amdgcn_exp2f(lg * (float)(i - j)) : 0.f;
            *(LAS bf16_t*)(PB + toff(i, j >> 3, 256) + (j & 7) * 2) = (bf16_t)f2bf(v);
        }
    }
    f32x16 o[4];
#pragma unroll
    for (int t = 0; t < 4; ++t)
#pragma unroll
        for (int i = 0; i < 16; ++i) o[t][i] = 0.f;
    r = opaque(r); hh = opaque(hh);
#pragma unroll
    for (int ks = 0; ks < 16; ++ks) {
#pragma unroll
        for (int ib = 0; ib < 4; ++ib) { const bf16x8 a = frag(QF, 32 * ib + r, 2 * ks + hh, 512); o[ib] = MFMA32(a, sfr[ks], o[ib]); }
    }
#pragma unroll
    for (int ib = 0; ib < 4; ++ib)
#pragma unroll
        for (int reg = 0; reg < 16; ++reg) o[ib][reg] *= __builtin_amdgcn_exp2f(lg * (float)(32 * ib + crow(reg, hh) + 1));
    __syncthreads();
#pragma unroll
    for (int it = 0; it < 4; ++it) {
        const int T = it * NTHR + tid, ch_lo = T & 15, pp = (T >> 4) & 3, half = (T >> 6) & 1, quad = T >> 7;
        const int chunk = 16 * half + ch_lo, d0 = 8 * chunk;
#pragma unroll
        for (int i = 0; i < 8; ++i) {
            const unsigned wa = va[it][i >> 1], wb = vb[it][i >> 1];
            const unsigned wv = (i & 1) ? ((wa >> 16) | (wb & 0xffff0000u)) : ((wa & 0xffffu) | (wb << 16));
            *(LAS unsigned*)(VT + toff(d0 + i, quad, 256) + pp * 4) = wv;
        }
    }
    __syncthreads();
    u32x4 gv[8];
    { const int tid3 = opaque(F.tid);
#pragma unroll
      for (int it = 0; it < 8; ++it) gv[it] = *(const GAS u32x4*)(Gs + (size_t)((tid3 >> 5) + 16 * it) * PLD + (tid3 & 31) * 8); }
    r = opaque(r); hh = opaque(hh);
#pragma unroll 1
    for (int ks = 0; ks < 8; ++ks) {
        const bf16x8 bb = frag(VT, 32 * w + r, 2 * ks + hh, 256);
#pragma unroll
        for (int ib = 0; ib < 4; ++ib)
            if (ks < 2 * (ib + 1)) { const bf16x8 a = frag(PB, 32 * ib + r, 2 * ks + hh, 256); o[ib] = MFMA32(a, bb, o[ib]); }
    }
    __syncthreads();
    r = opaque(r); hh = opaque(hh);
#pragma unroll
    for (int ib = 0; ib < 4; ++ib)
#pragma unroll
        for (int reg = 0; reg < 16; ++reg) { const int i = 32 * ib + crow(reg, hh);
            *(LAS bf16_t*)(OB + i * 512 + (32 * w + r) * 2) = (bf16_t)f2bf(o[ib][reg]); }
    __syncthreads();
    {
        const int tid2 = opaque(F.tid), cc = tid2 & 31;
        const f32x4 wa = *(const GAS f32x4*)(retw + h * 256 + cc * 8), wb = *(const GAS f32x4*)(retw + h * 256 + cc * 8 + 4);
#pragma unroll
        for (int it = 0; it < 8; ++it) {
            const int i = (tid2 >> 5) + 16 * it;
            const u32x4 ov = *(const LAS u32x4*)(OB + i * 512 + cc * 16);
            float x[8];
#pragma unroll
            for (int k = 0; k < 4; ++k) { x[2 * k] = bflo(ov[k]); x[2 * k + 1] = bfhi(ov[k]); }
            float sq = 0.f;
#pragma unroll
            for (int k = 0; k < 8; ++k) sq += x[k] * x[k];
            sq += __shfl_xor(sq, 1); sq += __shfl_xor(sq, 2); sq += __shfl_xor(sq, 4); sq += __shfl_xor(sq, 8); sq += __shfl_xor(sq, 16);
            const float rstd = 1.0f / sqrtf(sq * (1.f / 256.f) + EPS);
            u32x4 res;
            res[0] = pk2(x[0] * rstd * wa[0] * bflo(gv[it][0]), x[1] * rstd * wa[1] * bfhi(gv[it][0]));
            res[1] = pk2(x[2] * rstd * wa[2] * bflo(gv[it][1]), x[3] * rstd * wa[3] * bfhi(gv[it][1]));
            res[2] = pk2(x[4] * rstd * wb[0] * bflo(gv[it][2]), x[5] * rstd * wb[1] * bfhi(gv[it][2]));
            res[3] = pk2(x[6] * rstd * wb[2] * bflo(gv[it][3]), x[7] * rstd * wb[3] * bfhi(gv[it][3]));
            *(GAS u32x4*)(MIX + (size_t)(rows0 + i) * D + h * 256 + cc * 8) = res;
        }
    }
    __syncthreads();
}

__device__ __forceinline__ void s_item(Frame& F, const bf16_t* PROJ, const float* state, const float* retw, float* newstate, bf16_t* MIX, int item) {
    const int sb = item >> 2, h = item & 3, rows0 = MP + sb * 8;
    const float lg = lg2gamma(h);
    LAS float* QK = (LAS float*)F.lds;
    LAS float* QR = (LAS float*)(F.lds + 16384);
    LAS float* KR = (LAS float*)(F.lds + 16384 + 8224);
    LAS float* SCP = (LAS float*)(F.lds + 16384 + 2 * 8224);
    LAS float* SCO = (LAS float*)(F.lds + 16384 + 2 * 8224 + 2048);
    LAS float* RED = (LAS float*)(F.lds + 40960);
    const int w = opaque(F.wave), l = opaque(F.lane), tid_o = opaque(F.tid);
    {
        const int isk = tid_o >> 8, i = (tid_o >> 5) & 7, d8 = (tid_o & 31) * 8;
        const u32x4 raw = *(const GAS u32x4*)(PROJ + (size_t)(isk * 4 + h) * PTILE + (size_t)(rows0 + i) * PLD + d8);
        float f[8];
#pragma unroll
        for (int q = 0; q < 4; ++q) { f[2 * q] = bflo(raw[q]); f[2 * q + 1] = bfhi(raw[q]); }
        const float sc = __builtin_amdgcn_exp2f(lg * (float)(isk ? 7 - i : i + 1));
        LAS float* R = isk ? KR : QR;
#pragma unroll
        for (int k = 0; k < 8; ++k) { R[i * 257 + d8 + k] = f[k]; QK[(d8 + k) * 16 + isk * 8 + i] = f[k] * sc; }
    }
    float v[8][4];
#pragma unroll
    for (int j = 0; j < 8; ++j) { const u32x2 t = *(const GAS u32x2*)(PROJ + (size_t)(8 + h) * PTILE + (size_t)(rows0 + j) * PLD + 4 * l); v[j][0] = bflo(t.x); v[j][1] = bfhi(t.x); v[j][2] = bflo(t.y); v[j][3] = bfhi(t.y); }
    __syncthreads();
    {
        const int i = l >> 3, j = l & 7; float s = 0.f;
#pragma unroll 8
        for (int d = 32 * w; d < 32 * w + 32; ++d) s += QR[i * 257 + d] * KR[j * 257 + d];
        SCP[w * 64 + l] = s;
    }
    float oacc[8][4];
#pragma unroll
    for (int i = 0; i < 8; ++i)
#pragma unroll
        for (int c = 0; c < 4; ++c) oacc[i][c] = 0.f;
    const float g8 = __builtin_amdgcn_exp2f(lg * 8.f);
    const GAS f32x4* Sp = (const GAS f32x4*)(state + ((size_t)(sb * 4 + h) * 256 + 32 * w) * 256) + l;
    GAS f32x4* Np = (GAS f32x4*)(newstate + ((size_t)(sb * 4 + h) * 256 + 32 * w) * 256) + l;
    f32x4 sA[4], sB[4];
#define S_LOAD4(dst, row0) do { const GAS f32x4* p0_ = Sp + (size_t)(row0) * 64; asm volatile("" : "+v"(p0_)); \
        _Pragma("unroll") for (int k = 0; k < 4; ++k) dst[k] = p0_[k * 64]; } while (0)
#define S_COMP4(src, row0) do { GAS f32x4* n0_ = Np + (size_t)(row0) * 64; asm volatile("" : "+v"(n0_)); \
        _Pragma("unroll") for (int k = 0; k < 4; ++k) { \
            const LAS f32x4* qk = (const LAS f32x4*)(QK + (32 * w + (row0) + k) * 16); \
            const f32x4 qa = qk[0], qb = qk[1], ka = qk[2], kb = qk[3]; f32x4 n; \
            _Pragma("unroll") for (int c = 0; c < 4; ++c) { const float sv = src[k][c]; \
                oacc[0][c] += qa[0] * sv; oacc[1][c] += qa[1] * sv; oacc[2][c] += qa[2] * sv; oacc[3][c] += qa[3] * sv; \
                oacc[4][c] += qb[0] * sv; oacc[5][c] += qb[1] * sv; oacc[6][c] += qb[2] * sv; oacc[7][c] += qb[3] * sv; \
                float t = g8 * sv; \
                t += ka[0] * v[0][c]; t += ka[1] * v[1][c]; t += ka[2] * v[2][c]; t += ka[3] * v[3][c]; \
                t += kb[0] * v[4][c]; t += kb[1] * v[5][c]; t += kb[2] * v[6][c]; t += kb[3] * v[7][c]; n[c] = t; } \
            n0_[k * 64] = n; \
            if (k & 1) asm volatile("" ::: "memory"); } } while (0)
    S_LOAD4(sA, 0);
#pragma unroll 1
    for (int h2 = 0; h2 < 4; ++h2) {
        S_LOAD4(sB, 8 * h2 + 4);
        S_COMP4(sA, 8 * h2);
        if (h2 < 3) S_LOAD4(sA, 8 * h2 + 8);
        S_COMP4(sB, 8 * h2 + 4);
    }
#undef S_LOAD4
#undef S_COMP4
#pragma unroll
    for (int i = 0; i < 8; ++i) *(LAS f32x4*)(RED + (w * 8 + i) * 256 + 4 * l) = (f32x4){oacc[i][0], oacc[i][1], oacc[i][2], oacc[i][3]};
    __syncthreads();
    if (tid_o < 64) { const int i = l >> 3, j = l & 7; float s = 0.f;
#pragma unroll
        for (int ww = 0; ww < 8; ++ww) s += SCP[ww * 64 + l];
        SCO[l] = (i >= j) ? s * __builtin_amdgcn_exp2f(lg * (float)(i - j)) : 0.f; }
    __syncthreads();
    {
        const int i = w; f32x4 tot = (f32x4){0.f, 0.f, 0.f, 0.f};
#pragma unroll
        for (int ww = 0; ww < 8; ++ww) tot += *(const LAS f32x4*)(RED + (ww * 8 + i) * 256 + 4 * l);
#pragma unroll
        for (int j = 0; j < 8; ++j) { const float s = SCO[i * 8 + j];
#pragma unroll
            for (int c = 0; c < 4; ++c) tot[c] += s * v[j][c]; }
        const float ss = wave_sum((tot[0] * tot[0] + tot[1] * tot[1]) + (tot[2] * tot[2] + tot[3] * tot[3]));
        const float rstd = 1.0f / sqrtf(ss * (1.f / 256.f) + EPS);
        const f32x4 wn = *(const GAS f32x4*)(retw + h * 256 + 4 * l);
        const u32x2 gv = *(const GAS u32x2*)(PROJ + (size_t)(12 + h) * PTILE + (size_t)(rows0 + i) * PLD + 4 * l);
        u32x2 res; res.x = pk2(tot[0] * rstd * wn[0] * bflo(gv.x), tot[1] * rstd * wn[1] * bfhi(gv.x)); res.y = pk2(tot[2] * rstd * wn[2] * bflo(gv.y), tot[3] * rstd * wn[3] * bfhi(gv.y));
        *(GAS u32x2*)(MIX + (size_t)(rows0 + i) * D + h * 256 + 4 * l) = res;
    }
    __syncthreads();
}

__device__ __forceinline__ void unpk8(const u32x4 v, float (&f)[8]) {
#pragma unroll
    for (int q = 0; q < 4; ++q) { f[2 * q] = bflo(v[q]); f[2 * q + 1] = bfhi(v[q]); }
}
template <int W>
__device__ __forceinline__ void pool_prompt_blk(const bf16_t* PROJ, bf16_t* POOLED, float* outp, int rb, int ch) {
    const int m0 = rb * 8, t0 = m0 & (SEQ - 1), bseq = m0 >> 11;
    const bf16_t* U = PROJ + (size_t)(16 + (ch >> 8)) * PTILE + (ch & 255);
    u32x4 x[W + 7];
#pragma unroll
    for (int i = 0; i < W + 7; ++i) { const int t = t0 - (W - 1) + i; const int mi = (t >= 0) ? m0 - (W - 1) + i : m0; x[i] = *(const GAS u32x4*)(U + (size_t)mi * PLD); }
#pragma unroll
    for (int i = 0; i < W - 1; ++i) { const int t = t0 - (W - 1) + i; if (t < 0) x[i] = (u32x4){0u, 0u, 0u, 0u}; }
    float sum[8];
#pragma unroll
    for (int k = 0; k < 8; ++k) sum[k] = 0.f;
#pragma unroll
    for (int i = 0; i < W - 1; ++i) { float f[8]; unpk8(x[i], f);
#pragma unroll
        for (int k = 0; k < 8; ++k) sum[k] += f[k]; }
#pragma unroll
    for (int r = 0; r < 8; ++r) {
        float cur[8]; unpk8(x[W - 1 + r], cur);
#pragma unroll
        for (int k = 0; k < 8; ++k) sum[k] += cur[k];
        const int t = t0 + r; const int cnt = (t + 1 < W) ? t + 1 : W; const float inv = 1.0f / (float)cnt;
        u32x4 o;
#pragma unroll
        for (int q = 0; q < 4; ++q) o[q] = pk2(sum[2 * q] * inv - cur[2 * q], sum[2 * q + 1] * inv - cur[2 * q + 1]);
        *(GAS u32x4*)(POOLED + (size_t)(m0 + r) * 1024 + ch) = o;
        float sub[8]; unpk8(x[r], sub);
#pragma unroll
        for (int k = 0; k < 8; ++k) sum[k] -= sub[k];
        if (t >= SEQ - 15) { float* op = outp + ((size_t)bseq * 15 + (t - (SEQ - 15))) * 1024 + ch;
            *(GAS f32x4*)op = (f32x4){cur[0], cur[1], cur[2], cur[3]}; *(GAS f32x4*)(op + 4) = (f32x4){cur[4], cur[5], cur[6], cur[7]}; }
    }
}
template <int W>
__device__ __forceinline__ void pool_sample_blk(const bf16_t* PROJ, const float* spool, bf16_t* POOLED, float* outs, int sb, int ch) {
    const bf16_t* U = PROJ + (size_t)(16 + (ch >> 8)) * PTILE + (size_t)(MP + sb * 8) * PLD + (ch & 255);
    const float* B = spool + (size_t)sb * 15 * 1024 + ch;
    f32x4 ba[W - 1], bb[W - 1]; u32x4 xn[8]; f32x4 ca[7], cb[7];
#pragma unroll
    for (int i = 0; i < W - 1; ++i) { ba[i] = *(const GAS f32x4*)(B + (size_t)(15 - (W - 1) + i) * 1024); bb[i] = *(const GAS f32x4*)(B + (size_t)(15 - (W - 1) + i) * 1024 + 4); }
#pragma unroll
    for (int r = 0; r < 8; ++r) xn[r] = *(const GAS u32x4*)(U + (size_t)r * PLD);
#pragma unroll
    for (int rr = 0; rr < 7; ++rr) { ca[rr] = *(const GAS f32x4*)(B + (size_t)(8 + rr) * 1024); cb[rr] = *(const GAS f32x4*)(B + (size_t)(8 + rr) * 1024 + 4); }
    float sum[8];
#pragma unroll
    for (int k = 0; k < 8; ++k) sum[k] = 0.f;
#pragma unroll
    for (int i = 0; i < W - 1; ++i)
#pragma unroll
        for (int q = 0; q < 4; ++q) { sum[q] += ba[i][q]; sum[4 + q] += bb[i][q]; }
    const float inv = 1.0f / (float)W;
#pragma unroll
    for (int r = 0; r < 8; ++r) {
        float cur[8]; unpk8(xn[r], cur);
#pragma unroll
        for (int k = 0; k < 8; ++k) sum[k] += cur[k];
        u32x4 o;
#pragma unroll
        for (int q = 0; q < 4; ++q) o[q] = pk2(sum[2 * q] * inv - cur[2 * q], sum[2 * q + 1] * inv - cur[2 * q + 1]);
        *(GAS u32x4*)(POOLED + (size_t)(MP + sb * 8 + r) * 1024 + ch) = o;
        if (r < W - 1) {
#pragma unroll
            for (int q = 0; q < 4; ++q) { sum[q] -= ba[r < W - 1 ? r : 0][q]; sum[4 + q] -= bb[r < W - 1 ? r : 0][q]; }
        } else { float sub[8]; unpk8(xn[r >= W - 1 ? r - (W - 1) : 0], sub);
#pragma unroll
            for (int k = 0; k < 8; ++k) sum[k] -= sub[k]; }
        float* op = outs + ((size_t)sb * 15 + 7 + r) * 1024 + ch;
        *(GAS f32x4*)op = (f32x4){cur[0], cur[1], cur[2], cur[3]}; *(GAS f32x4*)(op + 4) = (f32x4){cur[4], cur[5], cur[6], cur[7]};
    }
#pragma unroll
    for (int rr = 0; rr < 7; ++rr) { float* op = outs + ((size_t)sb * 15 + rr) * 1024 + ch; *(GAS f32x4*)op = ca[rr]; *(GAS f32x4*)(op + 4) = cb[rr]; }
}
__device__ __forceinline__ void pool_tasks(Frame& F, const bf16_t* PROJ, const float* spool, bf16_t* POOLED, float* outp, float* outs) {
    for (int gt = F.vcu * NTHR + opaque(F.tid); gt < 1024 * 128; gt += F.G * NTHR) {
        const int cgp = gt & 31, rbl = (gt >> 5) & 1, grp = (gt >> 6) & 3, rb = (gt >> 8) * 2 + rbl, ch = grp * 256 + cgp * 8;
        if (grp == 0) pool_prompt_blk<2>(PROJ, POOLED, outp, rb, ch); else if (grp == 1) pool_prompt_blk<4>(PROJ, POOLED, outp, rb, ch);
        else if (grp == 2) pool_prompt_blk<8>(PROJ, POOLED, outp, rb, ch); else pool_prompt_blk<16>(PROJ, POOLED, outp, rb, ch);
    }
    if (F.G * 64 >= 128 * 128 ? F.tid < 64 : true)
    for (int gt = (F.G * 64 >= 128 * 128) ? F.vcu * 64 + opaque(F.tid) : F.vcu * NTHR + opaque(F.tid); gt < 128 * 128; gt += (F.G * 64 >= 128 * 128) ? F.G * 64 : F.G * NTHR) {
        const int cgp = gt & 31, sbl = (gt >> 5) & 1, grp = (gt >> 6) & 3, sb = (gt >> 8) * 2 + sbl, ch = grp * 256 + cgp * 8;
        if (grp == 0) pool_sample_blk<2>(PROJ, spool, POOLED, outs, sb, ch); else if (grp == 1) pool_sample_blk<4>(PROJ, spool, POOLED, outs, sb, ch);
        else if (grp == 2) pool_sample_blk<8>(PROJ, spool, POOLED, outs, sb, ch); else pool_sample_blk<16>(PROJ, spool, POOLED, outs, sb, ch);
    }
}

__device__ __forceinline__ void load_row_bf16(const bf16_t* row, int nparts, size_t pstride, int lane, float (&f)[4][8]) {
#pragma unroll
    for (int j = 0; j < 4; ++j)
#pragma unroll
        for (int q = 0; q < 8; ++q) f[j][q] = 0.f;
    for (int p = 0; p < nparts; ++p) {
        u32x4 v[4];
#pragma unroll
        for (int j = 0; j < 4; ++j) v[j] = *(const GAS u32x4*)(row + (size_t)p * pstride + 8 * lane + 512 * j);
#pragma unroll
        for (int j = 0; j < 4; ++j)
#pragma unroll
            for (int q = 0; q < 4; ++q) { f[j][2 * q] += bflo(v[j][q]); f[j][2 * q + 1] += bfhi(v[j][q]); }
    }
}
__device__ __forceinline__ void n1_row(const float* xrow, const bf16_t* mo, int nparts, size_t pstride, const f32x4 (&wpa)[4], const f32x4 (&wpb)[4], const f32x4 (&wqa)[4], const f32x4 (&wqb)[4], bf16_t* x1row, bf16_t* hrow, int lane) {
    f32x4 xa[4], xb[4]; float s = 0.f;
#pragma unroll
    for (int j = 0; j < 4; ++j) { const int c = 8 * lane + 512 * j; xa[j] = *(const GAS f32x4*)(xrow + c); xb[j] = *(const GAS f32x4*)(xrow + c + 4); }
    float mf[4][8];
    load_row_bf16(mo, nparts, pstride, lane, mf);
#pragma unroll
    for (int j = 0; j < 4; ++j)
#pragma unroll
        for (int q = 0; q < 8; ++q) s += mf[j][q] * mf[j][q];
    const float r1 = 1.0f / sqrtf(wave_sum(s) * (1.f / D) + EPS);
    float s2 = 0.f;
#pragma unroll
    for (int j = 0; j < 4; ++j) { const int c = 8 * lane + 512 * j;
#pragma unroll
        for (int q = 0; q < 4; ++q) { xa[j][q] += mf[j][q] * r1 * wpa[j][q]; xb[j][q] += mf[j][4 + q] * r1 * wpb[j][q]; s2 += xa[j][q] * xa[j][q] + xb[j][q] * xb[j][q]; }
        { u32x4 o1; o1.x = pk2(xa[j][0], xa[j][1]); o1.y = pk2(xa[j][2], xa[j][3]); o1.z = pk2(xb[j][0], xb[j][1]); o1.w = pk2(xb[j][2], xb[j][3]); *(GAS u32x4*)(x1row + c) = o1; } }
    const float r2 = 1.0f / sqrtf(wave_sum(s2) * (1.f / D) + EPS);
#pragma unroll
    for (int j = 0; j < 4; ++j) { const int c = 8 * lane + 512 * j;
        u32x4 o; o.x = pk2(xa[j][0] * r2 * wqa[j][0], xa[j][1] * r2 * wqa[j][1]); o.y = pk2(xa[j][2] * r2 * wqa[j][2], xa[j][3] * r2 * wqa[j][3]);
        o.z = pk2(xb[j][0] * r2 * wqb[j][0], xb[j][1] * r2 * wqb[j][1]); o.w = pk2(xb[j][2] * r2 * wqb[j][2], xb[j][3] * r2 * wqb[j][3]);
        *(GAS u32x4*)(hrow + c) = o; }
}
__device__ __forceinline__ void n2_row(const bf16_t* ff, int nparts, size_t pstride, const f32x4 (&wpa)[4], const f32x4 (&wpb)[4], const bf16_t* x1row, float* yrow, int lane) {
    float s = 0.f; float ffl[4][8];
    u32x4 xv[4];
#pragma unroll
    for (int j = 0; j < 4; ++j) xv[j] = *(const GAS u32x4*)(x1row + 8 * lane + 512 * j);
    load_row_bf16(ff, nparts, pstride, lane, ffl);
#pragma unroll
    for (int j = 0; j < 4; ++j)
#pragma unroll
        for (int q = 0; q < 8; ++q) s += ffl[j][q] * ffl[j][q];
    const float r1 = 1.0f / sqrtf(wave_sum(s) * (1.f / D) + EPS);
#pragma unroll
    for (int j = 0; j < 4; ++j) { const int c = 8 * lane + 512 * j;
        f32x4 ya = (f32x4){bflo(xv[j].x), bfhi(xv[j].x), bflo(xv[j].y), bfhi(xv[j].y)}, yb = (f32x4){bflo(xv[j].z), bfhi(xv[j].z), bflo(xv[j].w), bfhi(xv[j].w)};
#pragma unroll
        for (int q = 0; q < 4; ++q) { ya[q] += ffl[j][q] * r1 * wpa[j][q]; yb[q] += ffl[j][4 + q] * r1 * wpb[j][q]; }
        *(GAS f32x4*)(yrow + c) = ya; *(GAS f32x4*)(yrow + c + 4) = yb; }
}

constexpr int NPH = 10;
__global__ void __launch_bounds__(NTHR, 2) hyb_fwd(Args args) {
    extern __shared__ __attribute__((aligned(16))) unsigned char lds[];
    Frame F;
    F.lds = (LAS unsigned char*)lds;
    F.tid = threadIdx.x; F.lane = F.tid & 63; F.wave = __builtin_amdgcn_readfirstlane(F.tid >> 6);
    F.G = gridDim.x; { const int bx = blockIdx.x; F.vcu = (F.G % 8 == 0) ? (bx % 8) * (F.G / 8) + bx / 8 : bx; }
    if (F.tid == 0) {
        volatile LAS unsigned long long* at = (volatile LAS unsigned long long*)(F.lds + ARG_OFF);
#pragma unroll
        for (int i = 0; i < 16; ++i) at[i] = (unsigned long long)args.in[i];
        at[16] = (unsigned long long)args.out; at[17] = (unsigned long long)args.ws;
    }
    const int lo = args.ph_lo, hi = args.ph_hi;
    if (F.tid < 32) ((volatile LAS unsigned*)(F.lds + MISC_OFF))[F.tid] = 0u;
    __syncthreads();
    if (args.use_cg) xcd_barrier_post((unsigned*)(AWS + WS_CTL) + CW_BAR);
    if (args.pad == 0x5a5a5a5a) cg::this_grid().sync();
#define IN(k) (lo <= (k) && (k) < hi)
#define BOTH(k) (IN(k) && IN((k) + 1))
#define GRID_BAR(k) xcd_barrier((unsigned*)(AWS + WS_CTL) + CW_BAR, (volatile LAS unsigned*)(F.lds + MISC_OFF) + 8)
#define WSP(off) ((bf16_t*)(ws + (off)))
    if (IN(0)) { p0_prologue(F); if (BOTH(0)) GRID_BAR(0); }
    if (IN(1)) {
        unsigned char* ws = AWS;
        const int jx = (int)blockIdx.x / 8, spare = F.G / 8 - 30;
        if (F.G != 256 || jx < 30) {
            const int GG = F.G == 256 ? 240 : F.G;
            pg8::Gemm g{WSP(WS_H), WSP(WS_WIN), D, D, D, 0}; pg8::HybridOrder S; S.init(M / 256, INW / 256, D, GG, (int)blockIdx.x, 3);
            pg8::EpiProj E{WSP(WS_PROJ), (const float*)(ws + WS_CS)};
            pg8::gemm_phase(F.lds, g, S, E, pg8::SkBuf{nullptr});
        } else p0_transposes(F, TR_A, TR_B, (jx - 30) * 8 + (int)blockIdx.x % 8, spare * 8);
        if (BOTH(1)) GRID_BAR(1);
    }
    if (IN(2)) {
        unsigned char* ws = AWS; float* out = AOUT;
#pragma unroll 1
        for (int step = 0; step < 2; ++step) {
            if (((step ^ F.vcu) & 1) == 0) {
                for (int it = F.vcu; it < 256; it += F.G) u_item(F, WSP(WS_PROJ), WSP(WS_UT), it);
                pool_tasks(F, WSP(WS_PROJ), AIN(3), WSP(WS_POOLED), out + O_POOLP, out + O_POOLS);
            } else {
                const float* st = AIN(2); const float* rw = AIN(7);
                for (int it = F.vcu; it < 512; it += F.G) s_item(F, WSP(WS_PROJ), st, rw, out + O_RETS, WSP(WS_MIX), it);
            }
        }
        if (BOTH(2)) GRID_BAR(2);
    }
    if (IN(3)) {
        unsigned char* ws = AWS;
        {
        float* out = AOUT; const bf16_t* UT = WSP(WS_UT); bf16_t* SCT = WSP(WS_SCT);
        int t_lo, t_hi;
        { const int jx = (int)blockIdx.x / 8, xx = (int)blockIdx.x % 8;
          if (F.G == 256) { const int slot = jx < 18 ? jx * 8 + xx : 144 + 5 * ((jx - 18) * 8 + xx), ns = jx < 18 ? 1 : 5;
              t_lo = (int)((long)slot * 131072 / 704); t_hi = (int)((long)(slot + ns) * 131072 / 704); }
          else { t_lo = (int)((long)blockIdx.x * 131072 / F.G); t_hi = (int)((long)(blockIdx.x + 1) * 131072 / F.G); } }
        for (int idx = t_lo + F.tid; idx < t_hi; idx += NTHR) {
            const int bh = idx >> 13, e = (idx >> 5) & 255, d8 = (idx & 31) * 8;
            const float g128 = __builtin_amdgcn_exp2f(lg2gamma(bh & 3) * 128.f);
            float s[8];
#pragma unroll
            for (int k = 0; k < 8; ++k) s[k] = 0.f;
            u32x4 uv[16];
#pragma unroll
            for (int c = 0; c < 16; ++c) uv[c] = *(const GAS u32x4*)(UT + ((size_t)(bh * 16 + c) * 256 + e) * 256 + d8);
#pragma unroll
            for (int c = 0; c < 16; ++c) {
                u32x4 o; o.x = pk2(s[0], s[1]); o.y = pk2(s[2], s[3]); o.z = pk2(s[4], s[5]); o.w = pk2(s[6], s[7]);
                *(GAS u32x4*)(SCT + ((size_t)(bh * 16 + c) * 256 + e) * 256 + d8) = o;
#pragma unroll
                for (int k = 0; k < 4; ++k) { s[2 * k] = g128 * s[2 * k] + bflo(uv[c][k]); s[2 * k + 1] = g128 * s[2 * k + 1] + bfhi(uv[c][k]); }
            }
            float* op = out + O_RETP + (size_t)bh * 65536 + e;
#pragma unroll
            for (int k = 0; k < 8; ++k) op[(size_t)(d8 + k) * 256] = s[k];
        }
        }
        {
            pg8::Gemm g{WSP(WS_POOLED), WSP(WS_WPOOL), 1024, 256, 256, 256}; pg8::HybridOrder S; S.init(M / 256, 4, 256, F.G, (int)blockIdx.x, 1);
            pg8::EpiPlain E{WSP(WS_MIX), D, 1024, AIN(9)};
            pg8::gemm_phase(F.lds, g, S, E, pg8::SkBuf{nullptr});
        }
        if (BOTH(3)) GRID_BAR(3);
    }
    if (IN(4)) {
        unsigned char* ws = AWS; const float* rw = AIN(7);
        for (int it = F.vcu; it < 256; it += F.G) o_item(F, WSP(WS_PROJ), WSP(WS_SCT), rw, WSP(WS_MIX), it);
        if (BOTH(4)) GRID_BAR(4);
    }
    if (IN(5)) {
        unsigned char* ws = AWS;
        pg8::Gemm g{WSP(WS_MIX), WSP(WS_WOUT), D, D, D, 0}; pg8::HybridOrder S; S.init(M / 256, D / 256, D, F.G, (int)blockIdx.x, 2, SPLIT_MODE);
        pg8::EpiPlain E{WSP(WS_MO), D, 0, nullptr};
        pg8::gemm_phase(F.lds, g, S, E, pg8::SkBuf{WSP(WS_PART3)});
        if (BOTH(5)) GRID_BAR(5);
    }
    if (IN(6)) {
        unsigned char* ws = AWS; float* out = AOUT;
        const float* xp_ = AIN(0); const float* xs_ = AIN(1); const float* w5 = AIN(5); const float* w11 = AIN(11);
        const int gw = F.vcu * NWAVES + F.wave, NGW = F.G * NWAVES;
        f32x4 wpa[4], wpb[4], wqa[4], wqb[4];
#pragma unroll
        for (int j = 0; j < 4; ++j) { const int c = 8 * F.lane + 512 * j; wpa[j] = *(const GAS f32x4*)(w5 + c); wpb[j] = *(const GAS f32x4*)(w5 + c + 4); wqa[j] = *(const GAS f32x4*)(w11 + c); wqb[j] = *(const GAS f32x4*)(w11 + c + 4); }
        for (int m = gw; m < M; m += NGW) { const bool sp = SPLIT_MODE && m >= MP;
            n1_row(xrow_ptr(xp_, xs_, m), sp ? WSP(WS_PART3) + (size_t)(m - MP) * D : WSP(WS_MO) + (size_t)m * D, sp ? 8 : 1, (size_t)1024 * 2048, wpa, wpb, wqa, wqb, WSP(WS_MO) + (size_t)m * D, WSP(WS_H) + (size_t)m * D, F.lane); }
        if (BOTH(6)) GRID_BAR(6);
    }
    if (IN(7)) {
        unsigned char* ws = AWS;
        const int jx = (int)blockIdx.x / 8;
        if (jx < 29) {
            pg8::Gemm g{WSP(WS_H), WSP(WS_WGU), D, D, D, 0}; pg8::HybridOrder S; S.init(M / 256, NGU / 256, D, 232, (int)blockIdx.x, 7);
            pg8::EpiGU E{WSP(WS_HID)};
            pg8::gemm_phase(F.lds, g, S, E, pg8::SkBuf{nullptr});
        } else p0_transposes(F, TR_B, TR_C, (jx - 29) * 8 + (int)blockIdx.x % 8, 24);
        if (BOTH(7)) GRID_BAR(7);
    }
    if (IN(8)) {
        unsigned char* ws = AWS;
        pg8::Gemm g{WSP(WS_HID), WSP(WS_WD), DFF, DFF, DFF, 0}; pg8::HybridOrder S; S.init(M / 256, D / 256, DFF, F.G, (int)blockIdx.x, 2, SPLIT_MODE);
        pg8::EpiPlain E{WSP(WS_FF), D, 0, nullptr};
        pg8::gemm_phase(F.lds, g, S, E, pg8::SkBuf{WSP(WS_PART5)});
        if (BOTH(8)) GRID_BAR(8);
    }
    if (IN(9)) {
        unsigned char* ws = AWS; float* out = AOUT; const float* w12 = AIN(12);
        const int gw = F.vcu * NWAVES + F.wave, NGW = F.G * NWAVES;
        f32x4 wpa[4], wpb[4];
#pragma unroll
        for (int j = 0; j < 4; ++j) { const int c = 8 * F.lane + 512 * j; wpa[j] = *(const GAS f32x4*)(w12 + c); wpb[j] = *(const GAS f32x4*)(w12 + c + 4); }
        for (int m = gw; m < M; m += NGW) { const bool sp = SPLIT_MODE && m >= MP;
            n2_row(sp ? WSP(WS_PART5) + (size_t)(m - MP) * D : WSP(WS_FF) + (size_t)m * D, sp ? 8 : 1, (size_t)1024 * 2048, wpa, wpb, WSP(WS_MO) + (size_t)m * D, out + O_Y + (size_t)m * D, F.lane); }
    }
#undef IN
#undef BOTH
}

extern "C" void kernel_launch(void* const* d_in, const int* in_sizes, int n_in, void* d_out, int out_size, void* d_ws, size_t ws_size, hipStream_t stream) {
    static int grid = 0;
    if (grid == 0) {
        if (n_in != 16 || (size_t)out_size != O_END || ws_size < WS_END) { fprintf(stderr, "kernel_launch: unexpected shapes: n_in %d out %d ws %zu (need %zu)\n", n_in, out_size, ws_size, (size_t)WS_END); grid = -1; return; }
        int dev = 0, cus = 0, per_cu = 0;
        if (hipGetDevice(&dev) != hipSuccess || hipDeviceGetAttribute(&cus, hipDeviceAttributeMultiprocessorCount, dev) != hipSuccess) { grid = -1; return; }
        if (hipFuncSetAttribute((const void*)hyb_fwd, hipFuncAttributeMaxDynamicSharedMemorySize, LDS_BYTES) != hipSuccess) { fprintf(stderr, "kernel_launch: hipFuncSetAttribute failed\n"); grid = -1; return; }
        if (hipOccupancyMaxActiveBlocksPerMultiprocessor(&per_cu, (const void*)hyb_fwd, NTHR, LDS_BYTES) != hipSuccess || per_cu < 1) { fprintf(stderr, "kernel_launch: occupancy query says %d\n", per_cu); per_cu = 1; }
        (void)hipGetLastError();
        grid = cus * 1;
        if (SPLIT_MODE && grid != 256) { fprintf(stderr, "kernel_launch: this build's unit schedule needs exactly 256 workgroups (got %d CUs); nothing launched\n", cus); grid = -1; return; }
        fprintf(stderr, "kernel_launch: grid %d (occupancy query %d per CU)\n", grid, per_cu);
    }
    if (grid < 0) return;
    Args a{};
    for (int i = 0; i < 16; ++i) a.in[i] = (const float*)d_in[i];
    a.out = (float*)d_out; a.ws = (unsigned char*)d_ws;
    if (hipMemsetAsync((char*)d_ws + WS_CTL + CTL_MS_OFF, 0, CTL_MS_BYTES, stream) != hipSuccess) { fprintf(stderr, "kernel_launch: memset failed\n"); return; }
    if (MK_N_LAUNCHES == 1) {
        a.ph_lo = 0; a.ph_hi = NPH; a.use_cg = 1;
        void* kargs[] = {&a};
        hipError_t e = hipLaunchCooperativeKernel((const void*)hyb_fwd, dim3(grid), dim3(NTHR), kargs, LDS_BYTES, stream);
        if (e != hipSuccess) fprintf(stderr, "kernel_launch: cooperative launch failed: %s (grid %d)\n", hipGetErrorString(e), grid);
    } else {
        for (int p = 0; p < NPH; ++p) {
            a.ph_lo = p; a.ph_hi = p + 1; a.use_cg = 0;
            hipLaunchKernelGGL(hyb_fwd, dim3(grid), dim3(NTHR), LDS_BYTES, stream, a);
        }
    }
}
```

```cpp
#include <hip/hip_runtime.h>
#include <hip/hip_cooperative_groups.h>
#include <cstdio>
#include <cstdint>
namespace cg = cooperative_groups;

#ifndef MK_N_LAUNCHES
#define MK_N_LAUNCHES 1
#endif

#define GAS __attribute__((address_space(1)))
#define LAS __attribute__((address_space(3)))
typedef unsigned short bf16_t;
typedef short bf16x8 __attribute__((ext_vector_type(8)));
typedef float f32x2 __attribute__((ext_vector_type(2)));
typedef float f32x4 __attribute__((ext_vector_type(4)));
typedef float f32x16 __attribute__((ext_vector_type(16)));
typedef unsigned u32x2 __attribute__((ext_vector_type(2)));
typedef unsigned u32x4 __attribute__((ext_vector_type(4)));

constexpr int D = 2048, MP = 8192, MS = 1024, M = MP + MS, SEQ = 2048;
constexpr int INW = 5120, DFF = 5632, NGU = 2 * DFF;
constexpr int PLD = 256;
constexpr size_t PTILE = (size_t)9216 * 256;
constexpr int NPOS = 2048 + 8;
constexpr float EPS = 1e-6f;
constexpr int NWAVES = 8, NTHR = 512;

constexpr size_t O_Y = 0, O_RETP = (size_t)M * D, O_POOLP = O_RETP + 4 * 4 * 65536, O_RETS = O_POOLP + 4 * 15 * 1024, O_POOLS = O_RETS + (size_t)128 * 4 * 65536, O_END = O_POOLS + 128 * 15 * 1024;

constexpr size_t MiB = 1u << 20;
constexpr size_t WS_CTL = 0, CTL_ZERO_BYTES = 1 * MiB;
constexpr size_t CTL_MS_OFF = 16384, CTL_MS_BYTES = 16384;
constexpr size_t WS_CS = 1 * MiB;
constexpr size_t WS_WPOOL = 4 * MiB;
constexpr size_t WS_WIN = 8 * MiB;
constexpr size_t WS_WOUT = 28 * MiB;
constexpr size_t WS_WGU = 36 * MiB;
constexpr size_t WS_WD = 80 * MiB;
constexpr size_t WS_H = 102 * MiB;
constexpr size_t WS_PROJ = 138 * MiB;
constexpr size_t WS_MIX = 228 * MiB;
constexpr size_t WS_UT = 264 * MiB;
constexpr size_t WS_SCT = 296 * MiB;
constexpr size_t WS_POOLED = 328 * MiB;
constexpr size_t WS_MO = 346 * MiB;
constexpr size_t WS_HID = 138 * MiB;
constexpr size_t WS_FF = 382 * MiB;
constexpr size_t WS_PART3 = 264 * MiB;
constexpr size_t WS_PART5 = 296 * MiB;
#ifndef SPLIT_MODE
#define SPLIT_MODE 1
#endif
constexpr size_t WS_END = 418 * MiB;
static_assert(WS_HID + (size_t)M * DFF * 2 <= WS_UT, "hid overlay");

constexpr int CW_BAR = 4096;
constexpr int LDS_BYTES = 147456;
constexpr int RING_BYTES = 131072, MISC_OFF = RING_BYTES + 320, ARG_OFF = RING_BYTES + 512;

__device__ __forceinline__ unsigned f2bf(float f) { unsigned u = __builtin_bit_cast(unsigned, f); return (u + 0x7fffu + ((u >> 16) & 1u)) >> 16; }
__device__ __forceinline__ unsigned cvt_pk_bf16(float lo, float hi) { unsigned r; asm volatile("v_cvt_pk_bf16_f32 %0, %1, %2" : "=v"(r) : "v"(lo), "v"(hi)); return r; }
__device__ __forceinline__ unsigned pk2(float lo, float hi) { unsigned r; asm("v_cvt_pk_bf16_f32 %0, %1, %2" : "=v"(r) : "v"(lo), "v"(hi)); return r; }
__device__ __forceinline__ float bflo(unsigned w) { return __builtin_bit_cast(float, w << 16); }
__device__ __forceinline__ float bfhi(unsigned w) { return __builtin_bit_cast(float, w & 0xffff0000u); }
__device__ __forceinline__ float bf2f(bf16_t b) { return __builtin_bit_cast(float, (unsigned)b << 16); }
__device__ __forceinline__ float wave_sum(float v) {
#pragma unroll
    for (int o = 1; o < 64; o <<= 1) v += __shfl_xor(v, o);
    return v;
}
__device__ __forceinline__ float silu(float x) { return x * __builtin_amdgcn_rcpf(1.0f + __builtin_amdgcn_exp2f(-1.4426950408889634f * x)); }
__device__ __forceinline__ float lg2gamma(int h) { return h == 0 ? -0.04580368961312479f : h == 1 ? -0.02272007650008353f : h == 2 ? -0.011315313227834146f : -0.005646563141142063f; }
#define LDS_WAIT() asm volatile("s_waitcnt lgkmcnt(0)" ::: "memory")
__device__ __forceinline__ int opaque(int x) { asm volatile("" : "+v"(x)); return x; }

namespace pg8 {
constexpr int BM = 256, BK = 64, HALF = 128, HTB = HALF * BK * 2, STAGE_BYTES = 8 * HTB, NXCD = 8, WGM = 8;
__host__ __device__ __forceinline__ int lds_byte(int r, int c) { const int st = (r >> 4) * 2 + (c >> 5), rr = r & 15, cc = c & 31, ob = rr * 64 + cc * 2; return st * 1024 + (ob ^ (((ob >> 9) & 1) << 5)); }
__host__ __device__ __forceinline__ void stage_rc(int b, int& R, int& C) { const int st = b / 1024, sb = b % 1024, swz = sb ^ (((sb >> 9) & 1) << 5); R = (st >> 1) * 16 + swz / 64; C = (st & 1) * 32 + (swz % 64) / 2; }
__host__ __device__ __forceinline__ int perm32(int rho) { const int n = rho >> 4, i = rho & 15; return 8 * (i >> 2) + 4 * n + (i & 3); }

struct Unit { int pm, pn, kt0, nkt, role; };
struct Gemm { const bf16_t* A; const bf16_t* Bt; int lda, ldb, K, a_pn_col; };
struct HybridOrder {
    int nM, nN, nwg, G, c, Rs, P, n32, q, mode;
    __device__ void init(int nM_, int nN_, int K, int G_, int c_, int Rs_, int mode_ = 0) {
        mode = mode_; nM = nM_; nN = nN_; nwg = nM * nN; G = G_; c = c_; Rs = Rs_; P = K / (2 * BK); n32 = G / NXCD; q = nwg / NXCD;
    }
    __device__ void tile(int wgid, Unit& u) const {
        const int nig = WGM * nN, gid = wgid / nig, fm = gid * WGM, gsz = (nM - fm) < WGM ? (nM - fm) : WGM;
        u.pm = fm + ((wgid % nig) % gsz); u.pn = (wgid % nig) / gsz;
    }
    __device__ bool next(int i, Unit& u) const {
        const int x = c % NXCD, j = c / NXCD;
        if (mode == 1) {
            if (i == 0) { u.pm = 8 * (x >> 1) + (j & 7); u.pn = 4 * (x & 1) + (j >> 3); u.kt0 = 0; u.nkt = 2 * P; u.role = 0; return true; }
            if (i == 1) { u.pm = 32 + (j >> 3); u.pn = j & 7; const int lo = x * P / 8, hi = (x + 1) * P / 8; u.kt0 = 2 * lo; u.nkt = 2 * (hi - lo); u.role = 3; return true; }
            return false;
        }
        if (i >= Rs || i * n32 + j >= q) return false;
        tile(x * q + i * n32 + j, u); u.kt0 = 0; u.nkt = 2 * P; u.role = 0; return true;
    }
};
struct SkBuf { bf16_t* part; };

template <class Epi>
__device__ __forceinline__ void gemm_phase(LAS unsigned char* lds, const Gemm g, const HybridOrder& S, const Epi& E, const SkBuf sk) {
    const int tid = threadIdx.x, wid = __builtin_amdgcn_readfirstlane(tid >> 6), lane = tid & 63, wr = wid >> 2, wc = wid & 3, fr = lane & 15, fq = lane >> 4;
    unsigned voffA[2], voffB[2];
#pragma unroll
    for (int i = 0; i < 2; ++i) { int R, C; stage_rc(tid * 16 + i * 8192, R, C); const int Rb = (R & ~31) + perm32(R & 31);
        voffA[i] = (unsigned)(R * g.lda + C) * 2u; voffB[i] = (unsigned)(Rb * g.ldb + C) * 2u; }
    const size_t kstep = (size_t)(BK * 2);
    const size_t hstepA = (size_t)HALF * g.lda * 2, hstepB = (size_t)HALF * g.ldb * 2;
    const unsigned ldsw = (unsigned)wid * 1024u;
    const int aoff = lds_byte(wr * 64 + fr, fq * 8), boff = lds_byte(wc * 32 + fr, fq * 8);
#define PG8_UA(u) ((const char*)g.A + ((size_t)(u).pm * BM * g.lda + (size_t)(u).pn * g.a_pn_col + (size_t)(u).kt0 * BK) * 2)
#define PG8_UB(u) ((const char*)g.Bt + ((size_t)(u).pn * BM * g.ldb + (size_t)(u).kt0 * BK) * 2)
#define PG8_SA(b, h) (((b) * 2 + (h)) * HTB)
#define PG8_SB(b, h) ((4 + (b) * 2 + (h)) * HTB)
#define PG8_STAGE(bufoff, gbase, voff) do { _Pragma("unroll") for (int _i = 0; _i < 2; ++_i) \
        __builtin_amdgcn_global_load_lds((const unsigned*)((const char*)(gbase) + (voff)[_i]), (LAS unsigned*)(lds + (bufoff) + ldsw + _i * 8192), 16, 0, 0); } while (0)
#define PG8_LDA(dst, b, h) do { _Pragma("unroll") for (int m = 0; m < 4; ++m) _Pragma("unroll") for (int k = 0; k < 2; ++k) dst[m][k] = *(const LAS bf16x8*)(lds + PG8_SA(b, h) + aoff + m * 2048 + k * 1024); } while (0)
#define PG8_LDB(dst, b, h) do { _Pragma("unroll") for (int n = 0; n < 2; ++n) _Pragma("unroll") for (int k = 0; k < 2; ++k) dst[n][k] = *(const LAS bf16x8*)(lds + PG8_SB(b, h) + boff + n * 2048 + k * 1024); } while (0)
#define PG8_MMA(ai, bj, At, Bt) do { __builtin_amdgcn_s_setprio(1); _Pragma("unroll") for (int m = 0; m < 4; ++m) _Pragma("unroll") for (int n = 0; n < 2; ++n) _Pragma("unroll") for (int k = 0; k < 2; ++k) \
        acc[ai][bj][m][n] = __builtin_amdgcn_mfma_f32_16x16x32_bf16(Bt[n][k], At[m][k], acc[ai][bj][m][n], 0, 0, 0); __builtin_amdgcn_s_setprio(0); } while (0)
#define PG8_WAIT_V(n) asm volatile("s_waitcnt vmcnt(" #n ")" ::: "memory")
#define PG8_WAIT_L(n) asm volatile("s_waitcnt lgkmcnt(" #n ")" ::: "memory")
#define PG8_BAR __builtin_amdgcn_s_barrier()
#define PG8_SCHED __builtin_amdgcn_sched_barrier(0)
    Unit cur, nxt; int ui = 0;
    if (!S.next(0, cur)) return;
    f32x4 acc[2][2][4][2];
#pragma unroll
    for (int a = 0; a < 2; ++a)
#pragma unroll
        for (int b = 0; b < 2; ++b)
#pragma unroll
            for (int m = 0; m < 4; ++m)
#pragma unroll
                for (int n = 0; n < 2; ++n) acc[a][b][m][n] = (f32x4){0.f, 0.f, 0.f, 0.f};
    bf16x8 At[4][2], B0[2][2], B1[2][2];
    const char* cA = PG8_UA(cur); const char* cB = PG8_UB(cur);
    PG8_STAGE(PG8_SB(0, 0), cB, voffB); PG8_STAGE(PG8_SB(0, 1), cB + hstepB, voffB); PG8_STAGE(PG8_SA(0, 0), cA, voffA); PG8_STAGE(PG8_SA(0, 1), cA + hstepA, voffA);
    if (wr == 1) PG8_BAR;
    PG8_WAIT_V(2); PG8_BAR;
    PG8_STAGE(PG8_SB(1, 0), cB + kstep, voffB); PG8_STAGE(PG8_SA(1, 0), cA + kstep, voffA); PG8_STAGE(PG8_SB(1, 1), cB + hstepB + kstep, voffB);
    PG8_WAIT_V(6); PG8_BAR;
    for (;;) {
        const bool has_next = S.next(ui + 1, nxt);
        const char* nA = has_next ? PG8_UA(nxt) : cA; const char* nB = has_next ? PG8_UB(nxt) : cB;
        const int nt = cur.nkt;
        for (int t = 0; t < nt; t += 2) {
            const bool last = (t == nt - 2);
            const char* a1 = cA + (size_t)(t + 1) * kstep;
            const char* a2 = last ? nA : cA + (size_t)(t + 2) * kstep; const char* b2 = last ? nB : cB + (size_t)(t + 2) * kstep;
            const char* a3 = a2 + kstep; const char* b3 = b2 + kstep;
            PG8_LDB(B0, 0, 0); PG8_LDB(B1, 0, 1); PG8_SCHED; PG8_LDA(At, 0, 0); PG8_STAGE(PG8_SA(1, 1), a1 + hstepA, voffA);
            PG8_WAIT_V(8); PG8_WAIT_L(0); PG8_BAR; PG8_MMA(0, 0, At, B0); PG8_MMA(0, 1, At, B1); PG8_BAR; PG8_SCHED;
            PG8_LDA(At, 0, 1); PG8_STAGE(PG8_SB(0, 0), b2, voffB); PG8_STAGE(PG8_SB(0, 1), b2 + hstepB, voffB); PG8_STAGE(PG8_SA(0, 0), a2, voffA);
            PG8_WAIT_V(8); PG8_WAIT_L(0); PG8_BAR; PG8_MMA(1, 0, At, B0); PG8_MMA(1, 1, At, B1); PG8_BAR; PG8_SCHED;
            PG8_LDB(B0, 1, 0); PG8_LDB(B1, 1, 1); PG8_SCHED; PG8_LDA(At, 1, 0); PG8_STAGE(PG8_SA(0, 1), a2 + hstepA, voffA);
            PG8_WAIT_V(8); PG8_WAIT_L(0); PG8_BAR; PG8_MMA(0, 0, At, B0); PG8_MMA(0, 1, At, B1); PG8_BAR; PG8_SCHED;
            PG8_LDA(At, 1, 1); PG8_STAGE(PG8_SB(1, 0), b3, voffB); PG8_STAGE(PG8_SB(1, 1), b3 + hstepB, voffB); PG8_STAGE(PG8_SA(1, 0), a3, voffA);
            PG8_WAIT_V(8); PG8_WAIT_L(0); PG8_BAR; PG8_MMA(1, 0, At, B0); PG8_MMA(1, 1, At, B1); PG8_BAR; PG8_SCHED;
        }
        if (wr == 0) PG8_BAR;
        if (cur.role == 3) {
            bf16_t* O = sk.part + (size_t)(S.c % NXCD) * 1024 * 2048;
            const int row0 = (cur.pm - 32) * BM + wr * 64 + fr, col0 = cur.pn * BM + wc * 32 + 8 * fq;
#pragma unroll
            for (int ai = 0; ai < 2; ++ai)
#pragma unroll
                for (int m = 0; m < 4; ++m) {
                    bf16_t* rp = O + (size_t)(row0 + ai * HALF + m * 16) * 2048 + col0;
#pragma unroll
                    for (int bj = 0; bj < 2; ++bj) {
                        u32x4 wv; wv.x = cvt_pk_bf16(acc[ai][bj][m][0][0], acc[ai][bj][m][0][1]); wv.y = cvt_pk_bf16(acc[ai][bj][m][0][2], acc[ai][bj][m][0][3]);
                        wv.z = cvt_pk_bf16(acc[ai][bj][m][1][0], acc[ai][bj][m][1][1]); wv.w = cvt_pk_bf16(acc[ai][bj][m][1][2], acc[ai][bj][m][1][3]);
                        *(GAS u32x4*)(rp + bj * HALF) = wv;
                    }
                }
        } else {
            E(acc, cur, wr, wc, fr, fq);
        }
        if (!has_next) break;
#pragma unroll
        for (int a = 0; a < 2; ++a)
#pragma unroll
            for (int b = 0; b < 2; ++b)
#pragma unroll
                for (int m = 0; m < 4; ++m)
#pragma unroll
                    for (int n = 0; n < 2; ++n) acc[a][b][m][n] = (f32x4){0.f, 0.f, 0.f, 0.f};
        cur = nxt; cA = nA; cB = nB; ++ui;
        if (wr == 1) PG8_BAR;
    }
    PG8_WAIT_V(0);
    PG8_BAR;
#undef PG8_UA
#undef PG8_UB
#undef PG8_SA
#undef PG8_SB
#undef PG8_STAGE
#undef PG8_LDA
#undef PG8_LDB
#undef PG8_MMA
#undef PG8_WAIT_V
#undef PG8_WAIT_L
#undef PG8_BAR
#undef PG8_SCHED
}

__device__ __forceinline__ void st8(bf16_t* p, const f32x4 v0, const f32x4 v1) {
    u32x4 w; w.x = cvt_pk_bf16(v0[0], v0[1]); w.y = cvt_pk_bf16(v0[2], v0[3]); w.z = cvt_pk_bf16(v1[0], v1[1]); w.w = cvt_pk_bf16(v1[2], v1[3]);
    *(GAS u32x4*)p = w;
}
struct EpiProj {
    bf16_t* P; const float* cs;
    __device__ __forceinline__ void operator()(const f32x4 (&acc)[2][2][4][2], const Unit& u, int wr, int wc, int fr, int fq) const {
        const int row0 = u.pm * BM + wr * 64 + fr, type = u.pn >> 2, cl = wc * 32 + 8 * fq;
        bf16_t* Pt = P + (size_t)u.pn * PTILE + cl;
        if (type <= 1) {
            const float sc = type == 1 ? 0.0625f : 1.0f;
            const GAS f32x4* tb = (const GAS f32x4*)cs + (size_t)(cl >> 3) * 4 * NPOS;
#pragma unroll
            for (int ai = 0; ai < 2; ++ai) {
                u32x4 res[4][2];
                f32x4 tt[4][4];
#pragma unroll
                for (int m = 0; m < 4; ++m) { const int row = row0 + ai * HALF + m * 16; const int pidx = row < MP ? (row & (SEQ - 1)) : SEQ + ((row - MP) & 7);
#pragma unroll
                    for (int q = 0; q < 4; ++q) tt[m][q] = tb[(size_t)q * NPOS + pidx]; }
#pragma unroll
                for (int m = 0; m < 4; ++m) {
                    const f32x4 t0 = tt[m][0], t1 = tt[m][1], t2 = tt[m][2], t3 = tt[m][3];
                    const f32x4 x1a = acc[ai][0][m][0], x1b = acc[ai][0][m][1], x2a = acc[ai][1][m][0], x2b = acc[ai][1][m][1];
                    f32x4 o1a, o1b, o2a, o2b;
                    o1a[0] = (x1a[0] * t0[0] - x2a[0] * t0[1]) * sc; o2a[0] = (x2a[0] * t0[0] + x1a[0] * t0[1]) * sc;
                    o1a[1] = (x1a[1] * t0[2] - x2a[1] * t0[3]) * sc; o2a[1] = (x2a[1] * t0[2] + x1a[1] * t0[3]) * sc;
                    o1a[2] = (x1a[2] * t1[0] - x2a[2] * t1[1]) * sc; o2a[2] = (x2a[2] * t1[0] + x1a[2] * t1[1]) * sc;
                    o1a[3] = (x1a[3] * t1[2] - x2a[3] * t1[3]) * sc; o2a[3] = (x2a[3] * t1[2] + x1a[3] * t1[3]) * sc;
                    o1b[0] = (x1b[0] * t2[0] - x2b[0] * t2[1]) * sc; o2b[0] = (x2b[0] * t2[0] + x1b[0] * t2[1]) * sc;
                    o1b[1] = (x1b[1] * t2[2] - x2b[1] * t2[3]) * sc; o2b[1] = (x2b[1] * t2[2] + x1b[1] * t2[3]) * sc;
                    o1b[2] = (x1b[2] * t3[0] - x2b[2] * t3[1]) * sc; o2b[2] = (x2b[2] * t3[0] + x1b[2] * t3[1]) * sc;
                    o1b[3] = (x1b[3] * t3[2] - x2b[3] * t3[3]) * sc; o2b[3] = (x2b[3] * t3[2] + x1b[3] * t3[3]) * sc;
                    u32x4 w1, w2;
                    w1.x = cvt_pk_bf16(o1a[0], o1a[1]); w1.y = cvt_pk_bf16(o1a[2], o1a[3]); w1.z = cvt_pk_bf16(o1b[0], o1b[1]); w1.w = cvt_pk_bf16(o1b[2], o1b[3]);
                    w2.x = cvt_pk_bf16(o2a[0], o2a[1]); w2.y = cvt_pk_bf16(o2a[2], o2a[3]); w2.z = cvt_pk_bf16(o2b[0], o2b[1]); w2.w = cvt_pk_bf16(o2b[2], o2b[3]);
                    res[m][0] = w1; res[m][1] = w2;
                }
                asm volatile("" ::: "memory");
#pragma unroll
                for (int m = 0; m < 4; ++m) {
                    bf16_t* rp = Pt + (size_t)(row0 + ai * HALF + m * 16) * PLD;
                    *(GAS u32x4*)rp = res[m][0]; *(GAS u32x4*)(rp + HALF) = res[m][1];
                }
                asm volatile("" ::: "memory");
            }
        } else {
            const bool act = type == 3;
#pragma unroll
            for (int ai = 0; ai < 2; ++ai)
#pragma unroll
                for (int m = 0; m < 4; ++m) {
                    bf16_t* rp = Pt + (size_t)(row0 + ai * HALF + m * 16) * PLD;
#pragma unroll
                    for (int bj = 0; bj < 2; ++bj) {
                        f32x4 v0 = acc[ai][bj][m][0], v1 = acc[ai][bj][m][1];
                        if (act) {
#pragma unroll
                            for (int i = 0; i < 4; ++i) { v0[i] = silu(v0[i]); v1[i] = silu(v1[i]); }
                        }
                        st8(rp + bj * HALF, v0, v1);
                    }
                }
        }
    }
};
struct EpiPlain {
    bf16_t* O; int ldc, coff; const float* scale;
    __device__ __forceinline__ void operator()(const f32x4 (&acc)[2][2][4][2], const Unit& u, int wr, int wc, int fr, int fq) const {
        const int row0 = u.pm * BM + wr * 64 + fr, cl = wc * 32 + 8 * fq, col0 = u.pn * BM + cl;
        f32x4 s[2][2];
#pragma unroll
        for (int bj = 0; bj < 2; ++bj)
#pragma unroll
            for (int n = 0; n < 2; ++n) s[bj][n] = scale ? *(const GAS f32x4*)(scale + col0 + bj * HALF + 4 * n) : (f32x4){1.f, 1.f, 1.f, 1.f};
#pragma unroll
        for (int ai = 0; ai < 2; ++ai)
#pragma unroll
            for (int m = 0; m < 4; ++m) {
                bf16_t* rp = O + (size_t)(row0 + ai * HALF + m * 16) * ldc + coff + col0;
#pragma unroll
                for (int bj = 0; bj < 2; ++bj) st8(rp + bj * HALF, acc[ai][bj][m][0] * s[bj][0], acc[ai][bj][m][1] * s[bj][1]);
            }
    }
};
struct EpiGU {
    bf16_t* Hd;
    __device__ __forceinline__ void operator()(const f32x4 (&acc)[2][2][4][2], const Unit& u, int wr, int wc, int fr, int fq) const {
        const int row0 = u.pm * BM + wr * 64 + fr, cl = wc * 32 + 8 * fq, col0 = u.pn * HALF + cl;
#pragma unroll
        for (int ai = 0; ai < 2; ++ai)
#pragma unroll
            for (int m = 0; m < 4; ++m) {
                f32x4 v0, v1;
#pragma unroll
                for (int i = 0; i < 4; ++i) { v0[i] = silu(acc[ai][0][m][0][i]) * acc[ai][1][m][0][i]; v1[i] = silu(acc[ai][0][m][1][i]) * acc[ai][1][m][1][i]; }
                st8(Hd + (size_t)(row0 + ai * HALF + m * 16) * DFF + col0, v0, v1);
            }
    }
};
}

#define XB_TMO      128
#define XB_XCNT(j)  (256  + 64 * (j))
#define XB_XSUB(j)  (1280 + 64 * (j))
#define XB_XGEN(j)  (2304 + 64 * (j))
#define XB_TOP      3328
#define XB_TOPGEN   3392
#define XCD_BAR_WORDS 3456
#define XB_SPIN_CAP (1u << 18)
__device__ __forceinline__ unsigned xb_ld(unsigned* p)              { return __hip_atomic_load(p, __ATOMIC_RELAXED, __HIP_MEMORY_SCOPE_AGENT); }
__device__ __forceinline__ unsigned xb_add(unsigned* p, unsigned v) { return __hip_atomic_fetch_add(p, v, __ATOMIC_RELAXED, __HIP_MEMORY_SCOPE_AGENT); }
__device__ __forceinline__ unsigned xb_xcc_id() { return (unsigned)__builtin_amdgcn_s_getreg((3 << 11) | 20) & 0xFu; }
#define XB_SPIN(cond, bar) do { unsigned _sp = 0; while (cond) { __builtin_amdgcn_s_sleep(1); \
    if ((++_sp & 255u) == 0u) { if (xb_ld(&(bar)[XB_TMO])) break; if (_sp > XB_SPIN_CAP) { atomicAdd(&(bar)[XB_TMO], 1u); break; } } } } while (0)
__device__ __forceinline__ void xcd_barrier_post(unsigned* bar) {
    if (threadIdx.x == 0) (void)xb_add(&bar[XB_XCNT(xb_xcc_id())], 1u);
}
__device__ __forceinline__ void xcd_barrier_complete(unsigned* bar, unsigned x, unsigned& nloc, unsigned& nx) {
    const unsigned G = gridDim.x * gridDim.y * gridDim.z;
    unsigned sum, cnt, mine, sp = 0u;
    for (;;) {
        sum = 0u; cnt = 0u; mine = 0u;
#pragma unroll
        for (unsigned j = 0; j < 16; ++j) { const unsigned c = xb_ld(&bar[XB_XCNT(j)]); sum += c; cnt += (c > 0u) ? 1u : 0u; mine = (j == x) ? c : mine; }
        if (sum == G) break;
        __builtin_amdgcn_s_sleep(1);
        if ((++sp & 255u) == 0u) { if (xb_ld(&bar[XB_TMO])) break; if (sp > XB_SPIN_CAP) { atomicAdd(&bar[XB_TMO], 1u); break; } }
    }
    nloc = mine > 0u ? mine : 1u; nx = cnt > 0u ? cnt : 1u;
}
__device__ __forceinline__ void xcd_barrier(unsigned* bar, volatile LAS unsigned* st) {
    asm volatile("s_waitcnt vmcnt(0)" ::: "memory");
    __syncthreads();
    if (threadIdx.x == 0) {
        const unsigned x = xb_xcc_id();
        __builtin_amdgcn_s_waitcnt(0);
        unsigned nloc = st[0], nx = st[1];
        if (nloc == 0u) { xcd_barrier_complete(bar, x, nloc, nx); st[0] = nloc; st[1] = nx; }
        const unsigned old = xb_add(&bar[XB_XSUB(x)], 1u);
        const unsigned gen = old / nloc;
        if (old + 1u == (gen + 1u) * nloc) {
            __builtin_amdgcn_fence(__ATOMIC_RELEASE, "agent");
            asm volatile("s_waitcnt vmcnt(0)" ::: "memory");
            const unsigned og = xb_add(&bar[XB_TOP], 1u);
            const unsigned tg = og / nx;
            if (og + 1u == (tg + 1u) * nx) xb_add(&bar[XB_TOPGEN], 1u);
            else XB_SPIN(xb_ld(&bar[XB_TOPGEN]) == tg, bar);
            __builtin_amdgcn_fence(__ATOMIC_ACQUIRE, "agent");
            xb_add(&bar[XB_XGEN(x)], 1u);
            asm volatile("s_waitcnt vmcnt(0)" ::: "memory");
        } else {
            XB_SPIN(xb_ld(&bar[XB_XGEN(x)]) == gen, bar);
            __builtin_amdgcn_fence(__ATOMIC_ACQUIRE, "agent");
            asm volatile("s_waitcnt vmcnt(0)" ::: "memory");
        }
    }
    __syncthreads();
}

struct Args { const float* in[16]; float* out; unsigned char* ws; int ph_lo, ph_hi, use_cg, pad; };

struct Frame {
    LAS unsigned char* lds;
    int tid, lane, wave, vcu, G;
};
__device__ __forceinline__ const float* ldarg(const Frame& F, int k) {
    const volatile LAS unsigned* p = (const volatile LAS unsigned*)(F.lds + ARG_OFF) + 2 * k;
    const unsigned lo = __builtin_amdgcn_readfirstlane(p[0]), hi = __builtin_amdgcn_readfirstlane(p[1]);
    return (const float*)(((unsigned long long)hi << 32) | lo);
}
#define AIN(k) ldarg(F, (k))
#define AOUT ((float*)ldarg(F, 16))
#define AWS ((unsigned char*)ldarg(F, 17))

struct TrItem { const float* W; bf16_t* WT; int K, N, mode, k0, n0; };
constexpr int TR_IN = (D / 64) * (INW / 256), TR_OUT = (D / 64) * (D / 256), TR_G = (D / 64) * (DFF / 256), TR_D = (DFF / 64) * (D / 256);
struct P0Ptrs { const float *w_in, *w_out, *w_gate, *w_up, *w_down, *w_pool; unsigned char* ws; };
__device__ __forceinline__ TrItem p0_decode(const P0Ptrs& a, unsigned char* ws, int it) {
    TrItem t; int r = it, nblk;
    if (r < TR_IN) { t.W = a.w_in; t.WT = (bf16_t*)(ws + WS_WIN); t.K = D; t.N = INW; t.mode = 0; }
    else if ((r -= TR_IN) < TR_OUT) { t.W = a.w_out; t.WT = (bf16_t*)(ws + WS_WOUT); t.K = D; t.N = D; t.mode = 0; }
    else if ((r -= TR_OUT) < 16) { const int g = r >> 2; r &= 3; t.W = a.w_pool + (size_t)g * 65536; t.WT = (bf16_t*)(ws + WS_WPOOL) + (size_t)g * 65536; t.K = 256; t.N = 256; t.mode = 0; }
    else if ((r -= 16) < TR_G) { t.W = a.w_gate; t.WT = (bf16_t*)(ws + WS_WGU); t.K = D; t.N = DFF; t.mode = 1; }
    else if ((r -= TR_G) < TR_G) { t.W = a.w_up; t.WT = (bf16_t*)(ws + WS_WGU); t.K = D; t.N = DFF; t.mode = 2; }
    else { r -= TR_G; t.W = a.w_down; t.WT = (bf16_t*)(ws + WS_WD); t.K = DFF; t.N = D; t.mode = 0; }
    nblk = t.N >> 8; t.k0 = 64 * (r / nblk); t.n0 = 256 * (r % nblk);
    return t;
}
constexpr int P0_NITEMS = TR_IN + TR_OUT + 16 + 2 * TR_G + TR_D;
constexpr int TR_B = TR_IN + TR_OUT + 16 + 2 * TR_G, TR_C = P0_NITEMS;
#ifndef TR_P1_ITEMS
#define TR_P1_ITEMS 800
#endif
constexpr int TR_A = TR_B - TR_P1_ITEMS;
__device__ __forceinline__ void p0_transposes(Frame& F, int it_begin, int it_end, int worker, int nworkers) {
    P0Ptrs a; a.w_in = AIN(6); a.w_out = AIN(10); a.w_gate = AIN(13); a.w_up = AIN(14); a.w_down = AIN(15); a.w_pool = AIN(8); a.ws = AWS;
    unsigned char* ws = a.ws;
    LAS float* buf = (LAS float*)F.lds;
    const int w = F.wave, l = opaque(F.lane);
#define TR_LOAD(V, T) do { _Pragma("unroll") for (int i = 0; i < 8; ++i) V[i] = *(const GAS f32x4*)((T).W + (size_t)((T).k0 + 8 * w + i) * (T).N + (T).n0 + 4 * l); } while (0)
#define TR_STEP(V, CUR) do { \
        _Pragma("unroll") for (int i = 0; i < 8; ++i) *(LAS f32x4*)(buf + (8 * w + i) * 260 + ((4 * l) ^ (4 * (w & 7)))) = V[i]; \
        __syncthreads(); \
        const TrItem cur_ = (CUR); \
        const int nit_ = it + 2 * nworkers; \
        if (nit_ < it_end) { (CUR) = p0_decode(a, ws, nit_); TR_LOAD(V, (CUR)); } \
        const int ko = l & 7; \
        _Pragma("unroll") for (int sidx = 0; sidx < 4; ++sidx) { \
            const int nl = 32 * w + 8 * sidx + (l >> 3), n = cur_.n0 + nl; \
            const LAS float* p = buf + (8 * ko) * 260 + (nl ^ (4 * ko)); \
            u32x4 o; o.x = pk2(p[0], p[260]); o.y = pk2(p[2 * 260], p[3 * 260]); o.z = pk2(p[4 * 260], p[5 * 260]); o.w = pk2(p[6 * 260], p[7 * 260]); \
            const int row = cur_.mode == 0 ? n : (256 * (n >> 7) + (n & 127) + (cur_.mode == 2 ? 128 : 0)); \
            *(GAS u32x4*)(cur_.WT + (size_t)row * cur_.K + cur_.k0 + 8 * ko) = o; } \
        __syncthreads(); } while (0)
    int it = it_begin + worker;
    if (it >= it_end) return;
    TrItem tA = p0_decode(a, ws, it), tB = tA;
    f32x4 vA[8], vB[8];
    TR_LOAD(vA, tA);
    if (it + nworkers < it_end) { tB = p0_decode(a, ws, it + nworkers); TR_LOAD(vB, tB); }
    for (;;) {
        TR_STEP(vA, tA);
        it += nworkers; if (it >= it_end) break;
        TR_STEP(vB, tB);
        it += nworkers; if (it >= it_end) break;
    }
#undef TR_LOAD
#undef TR_STEP
}
__device__ __forceinline__ void rms_row_to_bf16(const float* xrow, const f32x4 (&ww)[8], bf16_t* orow, int lane) {
    const GAS f32x4* xr = (const GAS f32x4*)xrow + lane;
    f32x4 v[8]; float s = 0.f;
#pragma unroll
    for (int j = 0; j < 8; ++j) { v[j] = xr[64 * j]; s += (v[j].x * v[j].x + v[j].y * v[j].y) + (v[j].z * v[j].z + v[j].w * v[j].w); }
    const float rstd = 1.0f / sqrtf(wave_sum(s) * (1.f / D) + EPS);
    GAS u32x2* o8 = (GAS u32x2*)orow + lane;
#pragma unroll
    for (int j = 0; j < 8; ++j) { u32x2 o; o.x = pk2(v[j].x * rstd * ww[j].x, v[j].y * rstd * ww[j].y); o.y = pk2(v[j].z * rstd * ww[j].z, v[j].w * rstd * ww[j].w); o8[64 * j] = o; }
}
__device__ __forceinline__ const float* xrow_ptr(const float* xp, const float* xs, int m) { return m < MP ? xp + (size_t)m * D : xs + (size_t)(m - MP) * D; }

__device__ __forceinline__ void p0_prologue(Frame& F) {
    p0_transposes(F, 0, TR_A, F.vcu, F.G);
    unsigned char* ws = AWS;
    const int gw = F.vcu * NWAVES + F.wave, NGW = F.G * NWAVES;
    const float* xp_ = AIN(0); const float* xs_ = AIN(1); const float* nw_ = AIN(4);
    f32x4 ww0[8];
#pragma unroll
    for (int j = 0; j < 8; ++j) ww0[j] = *((const GAS f32x4*)nw_ + F.lane + 64 * j);
    for (int m = gw; m < M; m += NGW) rms_row_to_bf16(xrow_ptr(xp_, xs_, m), ww0, (bf16_t*)(ws + WS_H) + (size_t)m * D, F.lane);
    float* cs = (float*)(ws + WS_CS);
    for (int idx = F.vcu * NTHR + F.tid; idx < NPOS * 128; idx += F.G * NTHR) {
        const int p = idx >> 7, j = idx & 127;
        double r = 0.930572040929699, inv = 1.0;
#pragma unroll
        for (int b = 0; b < 7; ++b) { if ((j >> b) & 1) inv *= r; r *= r; }
        const float invf = (float)inv;
        const float pos = (float)(p < SEQ ? p : 16384 + (p - SEQ));
        const float ang = pos * invf;
        double t = (double)ang * 0.15915494309189535; t -= __builtin_rint(t);
        const float tf = (float)t;
        f32x2 o; o.x = __builtin_amdgcn_cosf(tf); o.y = __builtin_amdgcn_sinf(tf);
        *(f32x2*)(cs + ((size_t)(((j >> 3) * 4 + ((j & 7) >> 1)) * NPOS + p)) * 4 + (j & 1) * 2) = o;
    }
}

__device__ __forceinline__ unsigned toff(int r, int c16, int RB) { return (unsigned)(r * RB + ((((c16 & ~15) | ((c16 ^ r ^ (r >> 4)) & 15))) << 4)); }
#define MFMA32(a, b, c) __builtin_amdgcn_mfma_f32_32x32x16_bf16((a), (b), (c), 0, 0, 0)
__device__ __forceinline__ int crow(int reg, int h) { return (reg & 3) + 8 * (reg >> 2) + 4 * h; }
__device__ __forceinline__ bf16x8 frag(const LAS unsigned char* tile, int r, int c16, int RB) { return *(const LAS bf16x8*)(tile + toff(r, c16, RB)); }

__device__ __forceinline__ void load_nat128(LAS unsigned char* dst, const bf16_t* src, int ld, int tid) {
    tid = opaque(tid);
    u32x4 v[4];
#pragma unroll
    for (int it = 0; it < 4; ++it) { const int idx = tid + it * NTHR, r = idx >> 4, c = idx & 15; v[it] = *(const GAS u32x4*)(src + (size_t)r * ld + c * 8); }
#pragma unroll
    for (int it = 0; it < 4; ++it) { const int idx = tid + it * NTHR, r = idx >> 4, c = idx & 15; *(LAS u32x4*)(dst + toff(r, c, 256)) = v[it]; }
}
template <bool SCALE>
__device__ __forceinline__ void load_tr(LAS unsigned char* dst, const bf16_t* src, int ld, int tid, float sc_a, float sc_b) {
    tid = opaque(tid);
#pragma unroll
    for (int it = 0; it < 4; ++it) {
        const int T = it * NTHR + tid, ch_lo = T & 15, pp = (T >> 4) & 3, half = (T >> 6) & 1, quad = T >> 7;
        const int pair = 4 * quad + pp, chunk = 16 * half + ch_lo, j0 = 2 * pair, d0 = 8 * chunk;
        const u32x4 a = *(const GAS u32x4*)(src + (size_t)j0 * ld + d0), b = *(const GAS u32x4*)(src + (size_t)(j0 + 1) * ld + d0);
        float s0 = 1.f, s1 = 1.f;
        if (SCALE) { s0 = __builtin_amdgcn_exp2f(sc_a * (sc_b - (float)j0)); s1 = __builtin_amdgcn_exp2f(sc_a * (sc_b - (float)(j0 + 1))); }
#pragma unroll
        for (int i = 0; i < 8; ++i) {
            const unsigned wa = a[i >> 1], wb = b[i >> 1];
            unsigned w;
            if (SCALE) { const float fa = ((i & 1) ? bfhi(wa) : bflo(wa)) * s0, fb = ((i & 1) ? bfhi(wb) : bflo(wb)) * s1; w = pk2(fa, fb); }
            else w = (i & 1) ? ((wa >> 16) | (wb & 0xffff0000u)) : ((wa & 0xffffu) | (wb << 16));
            const int d = d0 + i;
            *(LAS unsigned*)(dst + toff(d, quad, 256) + pp * 4) = w;
        }
    }
}

__device__ __forceinline__ void u_item(Frame& F, const bf16_t* PROJ, bf16_t* UT, int item) {
    const int b = item >> 6, h = (item >> 4) & 3, c = item & 15, rows0 = b * SEQ + c * 128;
    const bf16_t* Ks = PROJ + (size_t)(4 + h) * PTILE + (size_t)rows0 * PLD; const bf16_t* Vs = Ks + 4 * PTILE;
    LAS unsigned char* KT = F.lds; LAS unsigned char* VT = F.lds + 65536;
    const float lg = lg2gamma(h);
    load_tr<true>(KT, Ks, PLD, F.tid, lg, 127.f);
    load_tr<false>(VT, Vs, PLD, F.tid, 0.f, 0.f);
    __syncthreads();
    const int w = F.wave, r = opaque(F.lane) & 31, hh = opaque(F.lane) >> 5;
    bf16_t* Up = UT + ((size_t)((b * 4 + h) * 16 + c) * 256) * 256;
#pragma unroll 1
    for (int eh = 0; eh < 2; ++eh) {
        f32x16 acc[4];
#pragma unroll
        for (int t = 0; t < 4; ++t)
#pragma unroll
            for (int i = 0; i < 16; ++i) acc[t][i] = 0.f;
#pragma unroll 1
        for (int ks = 0; ks < 8; ++ks) {
            const bf16x8 a = frag(KT, 32 * w + r, 2 * ks + hh, 256);
#pragma unroll
            for (int et = 0; et < 4; ++et) { const bf16x8 bb = frag(VT, 32 * (4 * eh + et) + r, 2 * ks + hh, 256); acc[et] = MFMA32(a, bb, acc[et]); }
        }
#pragma unroll
        for (int et = 0; et < 4; ++et)
#pragma unroll
            for (int g = 0; g < 4; ++g) {
                u32x2 o; o.x = cvt_pk_bf16(acc[et][4 * g], acc[et][4 * g + 1]); o.y = cvt_pk_bf16(acc[et][4 * g + 2], acc[et][4 * g + 3]);
                *(GAS u32x2*)(Up + (size_t)(32 * (4 * eh + et) + r) * 256 + 32 * w + 8 * g + 4 * hh) = o;
            }
    }
    __syncthreads();
}

__device__ __forceinline__ void o_item(Frame& F, const bf16_t* PROJ, const bf16_t* SCT, const float* retw, bf16_t* MIX, int item) {
    const int b = item >> 6, h = (item >> 4) & 3, c = item & 15, rows0 = b * SEQ + c * 128;
    const bf16_t* Qs = PROJ + (size_t)h * PTILE + (size_t)rows0 * PLD; const bf16_t* Ks = Qs + 4 * PTILE; const bf16_t* Vs = Qs + 8 * PTILE; const bf16_t* Gs = Qs + 12 * PTILE;
    LAS unsigned char* QF = F.lds; LAS unsigned char* KH = F.lds + 65536; LAS unsigned char* PB = F.lds + 98304; LAS unsigned char* VT = F.lds; LAS unsigned char* OB = F.lds;
    const float lg = lg2gamma(h);
    const int w = F.wave; int r = opaque(F.lane) & 31, hh = opaque(F.lane) >> 5; const int tid = opaque(F.tid);
    u32x4 qv[8], kv[4]; bf16x8 sfr[16];
#pragma unroll
    for (int it = 0; it < 8; ++it) { const int idx = tid + it * NTHR, rr = idx >> 5, cc = idx & 31; qv[it] = *(const GAS u32x4*)(Qs + (size_t)rr * PLD + cc * 8); }
#pragma unroll
    for (int it = 0; it < 4; ++it) { const int idx = tid + it * NTHR, rr = idx >> 4, cc = idx & 15; kv[it] = *(const GAS u32x4*)(Ks + (size_t)rr * PLD + cc * 8); }
    asm volatile("" ::: "memory");
    {
        const bf16_t* Sp = SCT + ((size_t)((b * 4 + h) * 16 + c) * 256) * 256 + (size_t)(32 * w + r) * 256 + 8 * hh;
#pragma unroll
        for (int ks = 0; ks < 16; ++ks) sfr[ks] = *(const GAS bf16x8*)(Sp + 16 * ks);
    }
    asm volatile("" ::: "memory");
#pragma unroll
    for (int it = 0; it < 8; ++it) { const int idx = tid + it * NTHR, rr = idx >> 5, cc = idx & 31; *(LAS u32x4*)(QF + toff(rr, cc, 512)) = qv[it]; }
#pragma unroll
    for (int it = 0; it < 4; ++it) { const int idx = tid + it * NTHR, rr = idx >> 4, cc = idx & 15; *(LAS u32x4*)(KH + toff(rr, cc, 256)) = kv[it]; }
    __syncthreads();
#pragma unroll
    for (int it = 0; it < 4; ++it) { const int idx = tid + it * NTHR, rr = idx >> 4, cc = idx & 15; kv[it] = *(const GAS u32x4*)(Ks + 128 + (size_t)rr * PLD + cc * 8); }
    const int ib_s = w >> 1, jb0 = 2 * (w & 1);
    f32x16 sc[2];
#pragma unroll
    for (int t = 0; t < 2; ++t)
#pragma unroll
        for (int i = 0; i < 16; ++i) sc[t][i] = 0.f;
    if (jb0 <= ib_s) {
#pragma unroll 1
        for (int ks = 0; ks < 8; ++ks) {
            const bf16x8 a = frag(QF, 32 * ib_s + r, 2 * ks + hh, 512);
            const bf16x8 b0 = frag(KH, 32 * jb0 + r, 2 * ks + hh, 256), b1 = frag(KH, 32 * (jb0 + 1) + r, 2 * ks + hh, 256);
            sc[0] = MFMA32(a, b0, sc[0]); sc[1] = MFMA32(a, b1, sc[1]);
        }
    }
    __syncthreads();
#pragma unroll
    for (int it = 0; it < 4; ++it) { const int idx = tid + it * NTHR, rr = idx >> 4, cc = idx & 15; *(LAS u32x4*)(KH + toff(rr, cc, 256)) = kv[it]; }
    __syncthreads();
    u32x4 va[4], vb[4];
#pragma unroll
    for (int it = 0; it < 4; ++it) {
        const int T = it * NTHR + tid, ch_lo = T & 15, pp = (T >> 4) & 3, half = (T >> 6) & 1, quad = T >> 7;
        const int pair = 4 * quad + pp, chunk = 16 * half + ch_lo, j0 = 2 * pair, d0 = 8 * chunk;
        va[it] = *(const GAS u32x4*)(Vs + (size_t)j0 * PLD + d0); vb[it] = *(const GAS u32x4*)(Vs + (size_t)(j0 + 1) * PLD + d0);
    }
    if (jb0 <= ib_s) {
#pragma unroll 1
        for (int ks = 0; ks < 8; ++ks) {
            const bf16x8 a = frag(QF, 32 * ib_s + r, 16 + 2 * ks + hh, 512);
            const bf16x8 b0 = frag(KH, 32 * jb0 + r, 2 * ks + hh, 256), b1 = frag(KH, 32 * (jb0 + 1) + r, 2 * ks + hh, 256);
            sc[0] = MFMA32(a, b0, sc[0]); sc[1] = MFMA32(a, b1, sc[1]);
        }
    }
    r = opaque(r); hh = opaque(hh);
#pragma unroll
    for (int t = 0; t < 2; ++t) {
        const int j = 32 * (jb0 + t) + r;
#pragma unroll
        for (int reg = 0; reg < 16; ++reg) {
            const int i = 32 * ib_s + crow(reg, hh);
            const float v = (i >= j) ? sc[t][reg] * __builtin_amdgcn_exp2f(lg * (float)(i - j)) : 0.f;
            *(LAS bf16_t*)(PB + toff(i, j >> 3, 256) + (j & 7) * 2) = (bf16_t)f2bf(v);
        }
    }
    f32x16 o[4];
#pragma unroll
    for (int t = 0; t < 4; ++t)
#pragma unroll
        for (int i = 0; i < 16; ++i) o[t][i] = 0.f;
    r = opaque(r); hh = opaque(hh);
#pragma unroll
    for (int ks = 0; ks < 16; ++ks) {
#pragma unroll
        for (int ib = 0; ib < 4; ++ib) { const bf16x8 a = frag(QF, 32 * ib + r, 2 * ks + hh, 512); o[ib] = MFMA32(a, sfr[ks], o[ib]); }
    }
#pragma unroll
    for (int ib = 0; ib < 4; ++ib)
#pragma unroll
        for (int reg = 0; reg < 16; ++reg) o[ib][reg] *= __builtin_amdgcn_exp2f(lg * (float)(32 * ib + crow(reg, hh) + 1));
    __syncthreads();
#pragma unroll
    for (int it = 0; it < 4; ++it) {
        const int T = it * NTHR + tid, ch_lo = T & 15, pp = (T >> 4) & 3, half = (T >> 6) & 1, quad = T >> 7;
        const int chunk = 16 * half + ch_lo, d0 = 8 * chunk;
#pragma unroll
        for (int i = 0; i < 8; ++i) {
            const unsigned wa = va[it][i >> 1], wb = vb[it][i >> 1];
            const unsigned wv = (i & 1) ? ((wa >> 16) | (wb & 0xffff0000u)) : ((wa & 0xffffu) | (wb << 16));
            *(LAS unsigned*)(VT + toff(d0 + i, quad, 256) + pp * 4) = wv;
        }
    }
    __syncthreads();
    u32x4 gv[8];
    { const int tid3 = opaque(F.tid);
#pragma unroll
      for (int it = 0; it < 8; ++it) gv[it] = *(const GAS u32x4*)(Gs + (size_t)((tid3 >> 5) + 16 * it) * PLD + (tid3 & 31) * 8); }
    r = opaque(r); hh = opaque(hh);
#pragma unroll 1
    for (int ks = 0; ks < 8; ++ks) {
        const bf16x8 bb = frag(VT, 32 * w + r, 2 * ks + hh, 256);
#pragma unroll
        for (int ib = 0; ib < 4; ++ib)
            if (ks < 2 * (ib + 1)) { const bf16x8 a = frag(PB, 32 * ib + r, 2 * ks + hh, 256); o[ib] = MFMA32(a, bb, o[ib]); }
    }
    __syncthreads();
    r = opaque(r); hh = opaque(hh);
#pragma unroll
    for (int ib = 0; ib < 4; ++ib)
#pragma unroll
        for (int reg = 0; reg < 16; ++reg) { const int i = 32 * ib + crow(reg, hh);
            *(LAS bf16_t*)(OB + i * 512 + (32 * w + r) * 2) = (bf16_t)f2bf(o[ib][reg]); }
    __syncthreads();
    {
        const int tid2 = opaque(F.tid), cc = tid2 & 31;
        const f32x4 wa = *(const GAS f32x4*)(retw + h * 256 + cc * 8), wb = *(const GAS f32x4*)(retw + h * 256 + cc * 8 + 4);
#pragma unroll
        for (int it = 0; it < 8; ++it) {
            const int i = (tid2 >> 5) + 16 * it;
            const u32x4 ov = *(const LAS u32x4*)(OB + i * 512 + cc * 16);
            float x[8];
#pragma unroll
            for (int k = 0; k < 4; ++k) { x[2 * k] = bflo(ov[k]); x[2 * k + 1] = bfhi(ov[k]); }
            float sq = 0.f;
#pragma unroll
            for (int k = 0; k < 8; ++k) sq += x[k] * x[k];
            sq += __shfl_xor(sq, 1); sq += __shfl_xor(sq, 2); sq += __shfl_xor(sq, 4); sq += __shfl_xor(sq, 8); sq += __shfl_xor(sq, 16);
            const float rstd = 1.0f / sqrtf(sq * (1.f / 256.f) + EPS);
            u32x4 res;
            res[0] = pk2(x[0] * rstd * wa[0] * bflo(gv[it][0]), x[1] * rstd * wa[1] * bfhi(gv[it][0]));
            res[1] = pk2(x[2] * rstd * wa[2] * bflo(gv[it][1]), x[3] * rstd * wa[3] * bfhi(gv[it][1]));
            res[2] = pk2(x[4] * rstd * wb[0] * bflo(gv[it][2]), x[5] * rstd * wb[1] * bfhi(gv[it][2]));
            res[3] = pk2(x[6] * rstd * wb[2] * bflo(gv[it][3]), x[7] * rstd * wb[3] * bfhi(gv[it][3]));
            *(GAS u32x4*)(MIX + (size_t)(rows0 + i) * D + h * 256 + cc * 8) = res;
        }
    }
    __syncthreads();
}

__device__ __forceinline__ void s_item(Frame& F, const bf16_t* PROJ, const float* state, const float* retw, float* newstate, bf16_t* MIX, int item) {
    const int sb = item >> 2, h = item & 3, rows0 = MP + sb * 8;
    const float lg = lg2gamma(h);
    LAS float* QK = (LAS float*)F.lds;
    LAS float* QR = (LAS float*)(F.lds + 16384);
    LAS float* KR = (LAS float*)(F.lds + 16384 + 8224);
    LAS float* SCP = (LAS float*)(F.lds + 16384 + 2 * 8224);
    LAS float* SCO = (LAS float*)(F.lds + 16384 + 2 * 8224 + 2048);
    LAS float* RED = (LAS float*)(F.lds + 40960);
    const int w = opaque(F.wave), l = opaque(F.lane), tid_o = opaque(F.tid);
    {
        const int isk = tid_o >> 8, i = (tid_o >> 5) & 7, d8 = (tid_o & 31) * 8;
        const u32x4 raw = *(const GAS u32x4*)(PROJ + (size_t)(isk * 4 + h) * PTILE + (size_t)(rows0 + i) * PLD + d8);
        float f[8];
#pragma unroll
        for (int q = 0; q < 4; ++q) { f[2 * q] = bflo(raw[q]); f[2 * q + 1] = bfhi(raw[q]); }
        const float sc = __builtin_amdgcn_exp2f(lg * (float)(isk ? 7 - i : i + 1));
        LAS float* R = isk ? KR : QR;
#pragma unroll
        for (int k = 0; k < 8; ++k) { R[i * 257 + d8 + k] = f[k]; QK[(d8 + k) * 16 + isk * 8 + i] = f[k] * sc; }
    }
    float v[8][4];
#pragma unroll
    for (int j = 0; j < 8; ++j) { const u32x2 t = *(const GAS u32x2*)(PROJ + (size_t)(8 + h) * PTILE + (size_t)(rows0 + j) * PLD + 4 * l); v[j][0] = bflo(t.x); v[j][1] = bfhi(t.x); v[j][2] = bflo(t.y); v[j][3] = bfhi(t.y); }
    __syncthreads();
    {
        const int i = l >> 3, j = l & 7; float s = 0.f;
#pragma unroll 8
        for (int d = 32 * w; d < 32 * w + 32; ++d) s += QR[i * 257 + d] * KR[j * 257 + d];
        SCP[w * 64 + l] = s;
    }
    float oacc[8][4];
#pragma unroll
    for (int i = 0; i < 8; ++i)
#pragma unroll
        for (int c = 0; c < 4; ++c) oacc[i][c] = 0.f;
    const float g8 = __builtin_amdgcn_exp2f(lg * 8.f);
    const GAS f32x4* Sp = (const GAS f32x4*)(state + ((size_t)(sb * 4 + h) * 256 + 32 * w) * 256) + l;
    GAS f32x4* Np = (GAS f32x4*)(newstate + ((size_t)(sb * 4 + h) * 256 + 32 * w) * 256) + l;
    f32x4 sA[4], sB[4];
#define S_LOAD4(dst, row0) do { const GAS f32x4* p0_ = Sp + (size_t)(row0) * 64; asm volatile("" : "+v"(p0_)); \
        _Pragma("unroll") for (int k = 0; k < 4; ++k) dst[k] = p0_[k * 64]; } while (0)
#define S_COMP4(src, row0) do { GAS f32x4* n0_ = Np + (size_t)(row0) * 64; asm volatile("" : "+v"(n0_)); \
        _Pragma("unroll") for (int k = 0; k < 4; ++k) { \
            const LAS f32x4* qk = (const LAS f32x4*)(QK + (32 * w + (row0) + k) * 16); \
            const f32x4 qa = qk[0], qb = qk[1], ka = qk[2], kb = qk[3]; f32x4 n; \
            _Pragma("unroll") for (int c = 0; c < 4; ++c) { const float sv = src[k][c]; \
                oacc[0][c] += qa[0] * sv; oacc[1][c] += qa[1] * sv; oacc[2][c] += qa[2] * sv; oacc[3][c] += qa[3] * sv; \
                oacc[4][c] += qb[0] * sv; oacc[5][c] += qb[1] * sv; oacc[6][c] += qb[2] * sv; oacc[7][c] += qb[3] * sv; \
                float t = g8 * sv; \
                t += ka[0] * v[0][c]; t += ka[1] * v[1][c]; t += ka[2] * v[2][c]; t += ka[3] * v[3][c]; \
                t += kb[0] * v[4][c]; t += kb[1] * v[5][c]; t += kb[2] * v[6][c]; t += kb[3] * v[7][c]; n[c] = t; } \
            n0_[k * 64] = n; \
            if (k & 1) asm volatile("" ::: "memory"); } } while (0)
    S_LOAD4(sA, 0);
#pragma unroll 1
    for (int h2 = 0; h2 < 4; ++h2) {
        S_LOAD4(sB, 8 * h2 + 4);
        S_COMP4(sA, 8 * h2);
        if (h2 < 3) S_LOAD4(sA, 8 * h2 + 8);
        S_COMP4(sB, 8 * h2 + 4);
    }
#undef S_LOAD4
#undef S_COMP4
#pragma unroll
    for (int i = 0; i < 8; ++i) *(LAS f32x4*)(RED + (w * 8 + i) * 256 + 4 * l) = (f32x4){oacc[i][0], oacc[i][1], oacc[i][2], oacc[i][3]};
    __syncthreads();
    if (tid_o < 64) { const int i = l >> 3, j = l & 7; float s = 0.f;
#pragma unroll
        for (int ww = 0; ww < 8; ++ww) s += SCP[ww * 64 + l];
        SCO[l] = (i >= j) ? s * __builtin_amdgcn_exp2f(lg * (float)(i - j)) : 0.f; }
    __syncthreads();
    {
        const int i = w; f32x4 tot = (f32x4){0.f, 0.f, 0.f, 0.f};
#pragma unroll
        for (int ww = 0; ww < 8; ++ww) tot += *(const LAS f32x4*)(RED + (ww * 8 + i) * 256 + 4 * l);
#pragma unroll
        for (int j = 0; j < 8; ++j) { const float s = SCO[i * 8 + j];
#pragma unroll
            for (int c = 0; c < 4; ++c) tot[c] += s * v[j][c]; }
        const float ss = wave_sum((tot[0] * tot[0] + tot[1] * tot[1]) + (tot[2] * tot[2] + tot[3] * tot[3]));
        const float rstd = 1.0f / sqrtf(ss * (1.f / 256.f) + EPS);
        const f32x4 wn = *(const GAS f32x4*)(retw + h * 256 + 4 * l);
        const u32x2 gv = *(const GAS u32x2*)(PROJ + (size_t)(12 + h) * PTILE + (size_t)(rows0 + i) * PLD + 4 * l);
        u32x2 res; res.x = pk2(tot[0] * rstd * wn[0] * bflo(gv.x), tot[1] * rstd * wn[1] * bfhi(gv.x)); res.y = pk2(tot[2] * rstd * wn[2] * bflo(gv.y), tot[3] * rstd * wn[3] * bfhi(gv.y));
        *(GAS u32x2*)(MIX + (size_t)(rows0 + i) * D + h * 256 + 4 * l) = res;
    }
    __syncthreads();
}

__device__ __forceinline__ void unpk8(const u32x4 v, float (&f)[8]) {
#pragma unroll
    for (int q = 0; q < 4; ++q) { f[2 * q] = bflo(v[q]); f[2 * q + 1] = bfhi(v[q]); }
}
template <int W>
__device__ __forceinline__ void pool_prompt_blk(const bf16_t* PROJ, bf16_t* POOLED, float* outp, int rb, int ch) {
    const int m0 = rb * 8, t0 = m0 & (SEQ - 1), bseq = m0 >> 11;
    const bf16_t* U = PROJ + (size_t)(16 + (ch >> 8)) * PTILE + (ch & 255);
    u32x4 x[W + 7];
#pragma unroll
    for (int i = 0; i < W + 7; ++i) { const int t = t0 - (W - 1) + i; const int mi = (t >= 0) ? m0 - (W - 1) + i : m0; x[i] = *(const GAS u32x4*)(U + (size_t)mi * PLD); }
#pragma unroll
    for (int i = 0; i < W - 1; ++i) { const int t = t0 - (W - 1) + i; if (t < 0) x[i] = (u32x4){0u, 0u, 0u, 0u}; }
    float sum[8];
#pragma unroll
    for (int k = 0; k < 8; ++k) sum[k] = 0.f;
#pragma unroll
    for (int i = 0; i < W - 1; ++i) { float f[8]; unpk8(x[i], f);
#pragma unroll
        for (int k = 0; k < 8; ++k) sum[k] += f[k]; }
#pragma unroll
    for (int r = 0; r < 8; ++r) {
        float cur[8]; unpk8(x[W - 1 + r], cur);
#pragma unroll
        for (int k = 0; k < 8; ++k) sum[k] += cur[k];
        const int t = t0 + r; const int cnt = (t + 1 < W) ? t + 1 : W; const float inv = 1.0f / (float)cnt;
        u32x4 o;
#pragma unroll
        for (int q = 0; q < 4; ++q) o[q] = pk2(sum[2 * q] * inv - cur[2 * q], sum[2 * q + 1] * inv - cur[2 * q + 1]);
        *(GAS u32x4*)(POOLED + (size_t)(m0 + r) * 1024 + ch) = o;
        float sub[8]; unpk8(x[r], sub);
#pragma unroll
        for (int k = 0; k < 8; ++k) sum[k] -= sub[k];
        if (t >= SEQ - 15) { float* op = outp + ((size_t)bseq * 15 + (t - (SEQ - 15))) * 1024 + ch;
            *(GAS f32x4*)op = (f32x4){cur[0], cur[1], cur[2], cur[3]}; *(GAS f32x4*)(op + 4) = (f32x4){cur[4], cur[5], cur[6], cur[7]}; }
    }
}
template <int W>
__device__ __forceinline__ void pool_sample_blk(const bf16_t* PROJ, const float* spool, bf16_t* POOLED, float* outs, int sb, int ch) {
    const bf16_t* U = PROJ + (size_t)(16 + (ch >> 8)) * PTILE + (size_t)(MP + sb * 8) * PLD + (ch & 255);
    const float* B = spool + (size_t)sb * 15 * 1024 + ch;
    f32x4 ba[W - 1], bb[W - 1]; u32x4 xn[8]; f32x4 ca[7], cb[7];
#pragma unroll
    for (int i = 0; i < W - 1; ++i) { ba[i] = *(const GAS f32x4*)(B + (size_t)(15 - (W - 1) + i) * 1024); bb[i] = *(const GAS f32x4*)(B + (size_t)(15 - (W - 1) + i) * 1024 + 4); }
#pragma unroll
    for (int r = 0; r < 8; ++r) xn[r] = *(const GAS u32x4*)(U + (size_t)r * PLD);
#pragma unroll
    for (int rr = 0; rr < 7; ++rr) { ca[rr] = *(const GAS f32x4*)(B + (size_t)(8 + rr) * 1024); cb[rr] = *(const GAS f32x4*)(B + (size_t)(8 + rr) * 1024 + 4); }
    float sum[8];
#pragma unroll
    for (int k = 0; k < 8; ++k) sum[k] = 0.f;
#pragma unroll
    for (int i = 0; i < W - 1; ++i)
#pragma unroll
        for (int q = 0; q < 4; ++q) { sum[q] += ba[i][q]; sum[4 + q] += bb[i][q]; }
    const float inv = 1.0f / (float)W;
#pragma unroll
    for (int r = 0; r < 8; ++r) {
        float cur[8]; unpk8(xn[r], cur);
#pragma unroll
        for (int k = 0; k < 8; ++k) sum[k] += cur[k];
        u32x4 o;
#pragma unroll
        for (int q = 0; q < 4; ++q) o[q] = pk2(sum[2 * q] * inv - cur[2 * q], sum[2 * q + 1] * inv - cur[2 * q + 1]);
        *(GAS u32x4*)(POOLED + (size_t)(MP + sb * 8 + r) * 1024 + ch) = o;
        if (r < W - 1) {
#pragma unroll
            for (int q = 0; q < 4; ++q) { sum[q] -= ba[r < W - 1 ? r : 0][q]; sum[4 + q] -= bb[r < W - 1 ? r : 0][q]; }
        } else { float sub[8]; unpk8(xn[r >= W - 1 ? r - (W - 1) : 0], sub);
#pragma unroll
            for (int k = 0; k < 8; ++k) sum[k] -= sub[k]; }
        float* op = outs + ((size_t)sb * 15 + 7 + r) * 1024 + ch;
        *(GAS f32x4*)op = (f32x4){cur[0], cur[1], cur[2], cur[3]}; *(GAS f32x4*)(op + 4) = (f32x4){cur[4], cur[5], cur[6], cur[7]};
    }
#pragma unroll
    for (int rr = 0; rr < 7; ++rr) { float* op = outs + ((size_t)sb * 15 + rr) * 1024 + ch; *(GAS f32x4*)op = ca[rr]; *(GAS f32x4*)(op + 4) = cb[rr]; }
}
__device__ __forceinline__ void pool_tasks(Frame& F, const bf16_t* PROJ, const float* spool, bf16_t* POOLED, float* outp, float* outs) {
    for (int gt = F.vcu * NTHR + opaque(F.tid); gt < 1024 * 128; gt += F.G * NTHR) {
        const int cgp = gt & 31, rbl = (gt >> 5) & 1, grp = (gt >> 6) & 3, rb = (gt >> 8) * 2 + rbl, ch = grp * 256 + cgp * 8;
        if (grp == 0) pool_prompt_blk<2>(PROJ, POOLED, outp, rb, ch); else if (grp == 1) pool_prompt_blk<4>(PROJ, POOLED, outp, rb, ch);
        else if (grp == 2) pool_prompt_blk<8>(PROJ, POOLED, outp, rb, ch); else pool_prompt_blk<16>(PROJ, POOLED, outp, rb, ch);
    }
    if (F.G * 64 >= 128 * 128 ? F.tid < 64 : true)
    for (int gt = (F.G * 64 >= 128 * 128) ? F.vcu * 64 + opaque(F.tid) : F.vcu * NTHR + opaque(F.tid); gt < 128 * 128; gt += (F.G * 64 >= 128 * 128) ? F.G * 64 : F.G * NTHR) {
        const int cgp = gt & 31, sbl = (gt >> 5) & 1, grp = (gt >> 6) & 3, sb = (gt >> 8) * 2 + sbl, ch = grp * 256 + cgp * 8;
        if (grp == 0) pool_sample_blk<2>(PROJ, spool, POOLED, outs, sb, ch); else if (grp == 1) pool_sample_blk<4>(PROJ, spool, POOLED, outs, sb, ch);
        else if (grp == 2) pool_sample_blk<8>(PROJ, spool, POOLED, outs, sb, ch); else pool_sample_blk<16>(PROJ, spool, POOLED, outs, sb, ch);
    }
}

__device__ __forceinline__ void load_row_bf16(const bf16_t* row, int nparts, size_t pstride, int lane, float (&f)[4][8]) {
#pragma unroll
    for (int j = 0; j < 4; ++j)
#pragma unroll
        for (int q = 0; q < 8; ++q) f[j][q] = 0.f;
    for (int p = 0; p < nparts; ++p) {
        u32x4 v[4];
#pragma unroll
        for (int j = 0; j < 4; ++j) v[j] = *(const GAS u32x4*)(row + (size_t)p * pstride + 8 * lane + 512 * j);
#pragma unroll
        for (int j = 0; j < 4; ++j)
#pragma unroll
            for (int q = 0; q < 4; ++q) { f[j][2 * q] += bflo(v[j][q]); f[j][2 * q + 1] += bfhi(v[j][q]); }
    }
}
__device__ __forceinline__ void n1_row(const float* xrow, const bf16_t* mo, int nparts, size_t pstride, const f32x4 (&wpa)[4], const f32x4 (&wpb)[4], const f32x4 (&wqa)[4], const f32x4 (&wqb)[4], bf16_t* x1row, bf16_t* hrow, int lane) {
    f32x4 xa[4], xb[4]; float s = 0.f;
#pragma unroll
    for (int j = 0; j < 4; ++j) { const int c = 8 * lane + 512 * j; xa[j] = *(const GAS f32x4*)(xrow + c); xb[j] = *(const GAS f32x4*)(xrow + c + 4); }
    float mf[4][8];
    load_row_bf16(mo, nparts, pstride, lane, mf);
#pragma unroll
    for (int j = 0; j < 4; ++j)
#pragma unroll
        for (int q = 0; q < 8; ++q) s += mf[j][q] * mf[j][q];
    const float r1 = 1.0f / sqrtf(wave_sum(s) * (1.f / D) + EPS);
    float s2 = 0.f;
#pragma unroll
    for (int j = 0; j < 4; ++j) { const int c = 8 * lane + 512 * j;
#pragma unroll
        for (int q = 0; q < 4; ++q) { xa[j][q] += mf[j][q] * r1 * wpa[j][q]; xb[j][q] += mf[j][4 + q] * r1 * wpb[j][q]; s2 += xa[j][q] * xa[j][q] + xb[j][q] * xb[j][q]; }
        { u32x4 o1; o1.x = pk2(xa[j][0], xa[j][1]); o1.y = pk2(xa[j][2], xa[j][3]); o1.z = pk2(xb[j][0], xb[j][1]); o1.w = pk2(xb[j][2], xb[j][3]); *(GAS u32x4*)(x1row + c) = o1; } }
    const float r2 = 1.0f / sqrtf(wave_sum(s2) * (1.f / D) + EPS);
#pragma unroll
    for (int j = 0; j < 4; ++j) { const int c = 8 * lane + 512 * j;
        u32x4 o; o.x = pk2(xa[j][0] * r2 * wqa[j][0], xa[j][1] * r2 * wqa[j][1]); o.y = pk2(xa[j][2] * r2 * wqa[j][2], xa[j][3] * r2 * wqa[j][3]);
        o.z = pk2(xb[j][0] * r2 * wqb[j][0], xb[j][1] * r2 * wqb[j][1]); o.w = pk2(xb[j][2] * r2 * wqb[j][2], xb[j][3] * r2 * wqb[j][3]);
        *(GAS u32x4*)(hrow + c) = o; }
}
__device__ __forceinline__ void n2_row(const bf16_t* ff, int nparts, size_t pstride, const f32x4 (&wpa)[4], const f32x4 (&wpb)[4], const bf16_t* x1row, float* yrow, int lane) {
    float s = 0.f; float ffl[4][8];
    u32x4 xv[4];
#pragma unroll
    for (int j = 0; j < 4; ++j) xv[j] = *(const GAS u32x4*)(x1row + 8 * lane + 512 * j);
    load_row_bf16(ff, nparts, pstride, lane, ffl);
#pragma unroll
    for (int j = 0; j < 4; ++j)
#pragma unroll
        for (int q = 0; q < 8; ++q) s += ffl[j][q] * ffl[j][q];
    const float r1 = 1.0f / sqrtf(wave_sum(s) * (1.f / D) + EPS);
#pragma unroll
    for (int j = 0; j < 4; ++j) { const int c = 8 * lane + 512 * j;
        f32x4 ya = (f32x4){bflo(xv[j].x), bfhi(xv[j].x), bflo(xv[j].y), bfhi(xv[j].y)}, yb = (f32x4){bflo(xv[j].z), bfhi(xv[j].z), bflo(xv[j].w), bfhi(xv[j].w)};
#pragma unroll
        for (int q = 0; q < 4; ++q) { ya[q] += ffl[j][q] * r1 * wpa[j][q]; yb[q] += ffl[j][4 + q] * r1 * wpb[j][q]; }
        *(GAS f32x4*)(yrow + c) = ya; *(GAS f32x4*)(yrow + c + 4) = yb; }
}

constexpr int NPH = 10;
__global__ void __launch_bounds__(NTHR, 2) hyb_fwd(Args args) {
    extern __shared__ __attribute__((aligned(16))) unsigned char lds[];
    Frame F;
    F.lds = (LAS unsigned char*)lds;
    F.tid = threadIdx.x; F.lane = F.tid & 63; F.wave = __builtin_amdgcn_readfirstlane(F.tid >> 6);
    F.G = gridDim.x; { const int bx = blockIdx.x; F.vcu = (F.G % 8 == 0) ? (bx % 8) * (F.G / 8) + bx / 8 : bx; }
    if (F.tid == 0) {
        volatile LAS unsigned long long* at = (volatile LAS unsigned long long*)(F.lds + ARG_OFF);
#pragma unroll
        for (int i = 0; i < 16; ++i) at[i] = (unsigned long long)args.in[i];
        at[16] = (unsigned long long)args.out; at[17] = (unsigned long long)args.ws;
    }
    const int lo = args.ph_lo, hi = args.ph_hi;
    if (F.tid < 32) ((volatile LAS unsigned*)(F.lds + MISC_OFF))[F.tid] = 0u;
    __syncthreads();
    if (args.use_cg) xcd_barrier_post((unsigned*)(AWS + WS_CTL) + CW_BAR);
    if (args.pad == 0x5a5a5a5a) cg::this_grid().sync();
#define IN(k) (lo <= (k) && (k) < hi)
#define BOTH(k) (IN(k) && IN((k) + 1))
#define GRID_BAR(k) xcd_barrier((unsigned*)(AWS + WS_CTL) + CW_BAR, (volatile LAS unsigned*)(F.lds + MISC_OFF) + 8)
#define WSP(off) ((bf16_t*)(ws + (off)))
    if (IN(0)) { p0_prologue(F); if (BOTH(0)) GRID_BAR(0); }
    if (IN(1)) {
        unsigned char* ws = AWS;
        const int jx = (int)blockIdx.x / 8, spare = F.G / 8 - 30;
        if (F.G != 256 || jx < 30) {
            const int GG = F.G == 256 ? 240 : F.G;
            pg8::Gemm g{WSP(WS_H), WSP(WS_WIN), D, D, D, 0}; pg8::HybridOrder S; S.init(M / 256, INW / 256, D, GG, (int)blockIdx.x, 3);
            pg8::EpiProj E{WSP(WS_PROJ), (const float*)(ws + WS_CS)};
            pg8::gemm_phase(F.lds, g, S, E, pg8::SkBuf{nullptr});
        } else p0_transposes(F, TR_A, TR_B, (jx - 30) * 8 + (int)blockIdx.x % 8, spare * 8);
        if (BOTH(1)) GRID_BAR(1);
    }
    if (IN(2)) {
        unsigned char* ws = AWS; float* out = AOUT;
#pragma unroll 1
        for (int step = 0; step < 2; ++step) {
            if (((step ^ F.vcu) & 1) == 0) {
                for (int it = F.vcu; it < 256; it += F.G) u_item(F, WSP(WS_PROJ), WSP(WS_UT), it);
                pool_tasks(F, WSP(WS_PROJ), AIN(3), WSP(WS_POOLED), out + O_POOLP, out + O_POOLS);
            } else {
                const float* st = AIN(2); const float* rw = AIN(7);
                for (int it = F.vcu; it < 512; it += F.G) s_item(F, WSP(WS_PROJ), st, rw, out + O_RETS, WSP(WS_MIX), it);
            }
        }
        if (BOTH(2)) GRID_BAR(2);
    }
    if (IN(3)) {
        unsigned char* ws = AWS;
        {
        float* out = AOUT; const bf16_t* UT = WSP(WS_UT); bf16_t* SCT = WSP(WS_SCT);
        int t_lo, t_hi;
        { const int jx = (int)blockIdx.x / 8, xx = (int)blockIdx.x % 8;
          if (F.G == 256) { const int slot = jx < 18 ? jx * 8 + xx : 144 + 5 * ((jx - 18) * 8 + xx), ns = jx < 18 ? 1 : 5;
              t_lo = (int)((long)slot * 131072 / 704); t_hi = (int)((long)(slot + ns) * 131072 / 704); }
          else { t_lo = (int)((long)blockIdx.x * 131072 / F.G); t_hi = (int)((long)(blockIdx.x + 1) * 131072 / F.G); } }
        for (int idx = t_lo + F.tid; idx < t_hi; idx += NTHR) {
            const int bh = idx >> 13, e = (idx >> 5) & 255, d8 = (idx & 31) * 8;
            const float g128 = __builtin_amdgcn_exp2f(lg2gamma(bh & 3) * 128.f);
            float s[8];
#pragma unroll
            for (int k = 0; k < 8; ++k) s[k] = 0.f;
            u32x4 uv[16];
#pragma unroll
            for (int c = 0; c < 16; ++c) uv[c] = *(const GAS u32x4*)(UT + ((size_t)(bh * 16 + c) * 256 + e) * 256 + d8);
#pragma unroll
            for (int c = 0; c < 16; ++c) {
                u32x4 o; o.x = pk2(s[0], s[1]); o.y = pk2(s[2], s[3]); o.z = pk2(s[4], s[5]); o.w = pk2(s[6], s[7]);
                *(GAS u32x4*)(SCT + ((size_t)(bh * 16 + c) * 256 + e) * 256 + d8) = o;
#pragma unroll
                for (int k = 0; k < 4; ++k) { s[2 * k] = g128 * s[2 * k] + bflo(uv[c][k]); s[2 * k + 1] = g128 * s[2 * k + 1] + bfhi(uv[c][k]); }
            }
            float* op = out + O_RETP + (size_t)bh * 65536 + e;
#pragma unroll
            for (int k = 0; k < 8; ++k) op[(size_t)(d8 + k) * 256] = s[k];
        }
        }
        {
            pg8::Gemm g{WSP(WS_POOLED), WSP(WS_WPOOL), 1024, 256, 256, 256}; pg8::HybridOrder S; S.init(M / 256, 4, 256, F.G, (int)blockIdx.x, 1);
            pg8::EpiPlain E{WSP(WS_MIX), D, 1024, AIN(9)};
            pg8::gemm_phase(F.lds, g, S, E, pg8::SkBuf{nullptr});
        }
        if (BOTH(3)) GRID_BAR(3);
    }
    if (IN(4)) {
        unsigned char* ws = AWS; const float* rw = AIN(7);
        for (int it = F.vcu; it < 256; it += F.G) o_item(F, WSP(WS_PROJ), WSP(WS_SCT), rw, WSP(WS_MIX), it);
        if (BOTH(4)) GRID_BAR(4);
    }
    if (IN(5)) {
        unsigned char* ws = AWS;
        pg8::Gemm g{WSP(WS_MIX), WSP(WS_WOUT), D, D, D, 0}; pg8::HybridOrder S; S.init(M / 256, D / 256, D, F.G, (int)blockIdx.x, 2, SPLIT_MODE);
        pg8::EpiPlain E{WSP(WS_MO), D, 0, nullptr};
        pg8::gemm_phase(F.lds, g, S, E, pg8::SkBuf{WSP(WS_PART3)});
        if (BOTH(5)) GRID_BAR(5);
    }
    if (IN(6)) {
        unsigned char* ws = AWS; float* out = AOUT;
        const float* xp_ = AIN(0); const float* xs_ = AIN(1); const float* w5 = AIN(5); const float* w11 = AIN(11);
        const int gw = F.vcu * NWAVES + F.wave, NGW = F.G * NWAVES;
        f32x4 wpa[4], wpb[4], wqa[4], wqb[4];
#pragma unroll
        for (int j = 0; j < 4; ++j) { const int c = 8 * F.lane + 512 * j; wpa[j] = *(const GAS f32x4*)(w5 + c); wpb[j] = *(const GAS f32x4*)(w5 + c + 4); wqa[j] = *(const GAS f32x4*)(w11 + c); wqb[j] = *(const GAS f32x4*)(w11 + c + 4); }
        for (int m = gw; m < M; m += NGW) { const bool sp = SPLIT_MODE && m >= MP;
            n1_row(xrow_ptr(xp_, xs_, m), sp ? WSP(WS_PART3) + (size_t)(m - MP) * D : WSP(WS_MO) + (size_t)m * D, sp ? 8 : 1, (size_t)1024 * 2048, wpa, wpb, wqa, wqb, WSP(WS_MO) + (size_t)m * D, WSP(WS_H) + (size_t)m * D, F.lane); }
        if (BOTH(6)) GRID_BAR(6);
    }
    if (IN(7)) {
        unsigned char* ws = AWS;
        const int jx = (int)blockIdx.x / 8;
        if (jx < 29) {
            pg8::Gemm g{WSP(WS_H), WSP(WS_WGU), D, D, D, 0}; pg8::HybridOrder S; S.init(M / 256, NGU / 256, D, 232, (int)blockIdx.x, 7);
            pg8::EpiGU E{WSP(WS_HID)};
            pg8::gemm_phase(F.lds, g, S, E, pg8::SkBuf{nullptr});
        } else p0_transposes(F, TR_B, TR_C, (jx - 29) * 8 + (int)blockIdx.x % 8, 24);
        if (BOTH(7)) GRID_BAR(7);
    }
    if (IN(8)) {
        unsigned char* ws = AWS;
        pg8::Gemm g{WSP(WS_HID), WSP(WS_WD), DFF, DFF, DFF, 0}; pg8::HybridOrder S; S.init(M / 256, D / 256, DFF, F.G, (int)blockIdx.x, 2, SPLIT_MODE);
        pg8::EpiPlain E{WSP(WS_FF), D, 0, nullptr};
        pg8::gemm_phase(F.lds, g, S, E, pg8::SkBuf{WSP(WS_PART5)});
        if (BOTH(8)) GRID_BAR(8);
    }
    if (IN(9)) {
        unsigned char* ws = AWS; float* out = AOUT; const float* w12 = AIN(12);
        const int gw = F.vcu * NWAVES + F.wave, NGW = F.G * NWAVES;
        f32x4 wpa[4], wpb[4];
#pragma unroll
        for (int j = 0; j < 4; ++j) { const int c = 8 * F.lane + 512 * j; wpa[j] = *(const GAS f32x4*)(w12 + c); wpb[j] = *(const GAS f32x4*)(w12 + c + 4); }
        for (int m = gw; m < M; m += NGW) { const bool sp = SPLIT_MODE && m >= MP;
            n2_row(sp ? WSP(WS_PART5) + (size_t)(m - MP) * D : WSP(WS_FF) + (size_t)m * D, sp ? 8 : 1, (size_t)1024 * 2048, wpa, wpb, WSP(WS_MO) + (size_t)m * D, out + O_Y + (size_t)m * D, F.lane); }
    }
#undef IN
#undef BOTH
}

extern "C" void kernel_launch(void* const* d_in, const int* in_sizes, int n_in, void* d_out, int out_size, void* d_ws, size_t ws_size, hipStream_t stream) {
    static int grid = 0;
    if (grid == 0) {
        if (n_in != 16 || (size_t)out_size != O_END || ws_size < WS_END) { fprintf(stderr, "kernel_launch: unexpected shapes: n_in %d out %d ws %zu (need %zu)\n", n_in, out_size, ws_size, (size_t)WS_END); grid = -1; return; }
        int dev = 0, cus = 0, per_cu = 0;
        if (hipGetDevice(&dev) != hipSuccess || hipDeviceGetAttribute(&cus, hipDeviceAttributeMultiprocessorCount, dev) != hipSuccess) { grid = -1; return; }
        if (hipFuncSetAttribute((const void*)hyb_fwd, hipFuncAttributeMaxDynamicSharedMemorySize, LDS_BYTES) != hipSuccess) { fprintf(stderr, "kernel_launch: hipFuncSetAttribute failed\n"); grid = -1; return; }
        if (hipOccupancyMaxActiveBlocksPerMultiprocessor(&per_cu, (const void*)hyb_fwd, NTHR, LDS_BYTES) != hipSuccess || per_cu < 1) { fprintf(stderr, "kernel_launch: occupancy query says %d\n", per_cu); per_cu = 1; }
        (void)hipGetLastError();
        grid = cus * 1;
        if (SPLIT_MODE && grid != 256) { fprintf(stderr, "kernel_launch: this build's unit schedule needs exactly 256 workgroups (got %d CUs); nothing launched\n", cus); grid = -1; return; }
        fprintf(stderr, "kernel_launch: grid %d (occupancy query %d per CU)\n", grid, per_cu);
    }
    if (grid < 0) return;
    Args a{};
    for (int i = 0; i < 16; ++i) a.in[i] = (const float*)d_in[i];
    a.out = (float*)d_out; a.ws = (unsigned char*)d_ws;
    if (hipMemsetAsync((char*)d_ws + WS_CTL + CTL_MS_OFF, 0, CTL_MS_BYTES, stream) != hipSuccess) { fprintf(stderr, "kernel_launch: memset failed\n"); return; }
    if (MK_N_LAUNCHES == 1) {
        a.ph_lo = 0; a.ph_hi = NPH; a.use_cg = 1;
        void* kargs[] = {&a};
        hipError_t e = hipLaunchCooperativeKernel((const void*)hyb_fwd, dim3(grid), dim3(NTHR), kargs, LDS_BYTES, stream);
        if (e != hipSuccess) fprintf(stderr, "kernel_launch: cooperative launch failed: %s (grid %d)\n", hipGetErrorString(e), grid);
    } else {
        for (int p = 0; p < NPH; ++p) {
            a.ph_lo = p; a.ph_hi = p + 1; a.use_cg = 0;
            hipLaunchKernelGGL(hyb_fwd, dim3(grid), dim3(NTHR), LDS_BYTES, stream, a);
        }
    }
}
```

```cpp
#include <hip/hip_runtime.h>
#include <cstdio>
#include <cstdint>

#ifndef MK_N_LAUNCHES
#define MK_N_LAUNCHES 1
#endif

#define GAS __attribute__((address_space(1)))
#define LAS __attribute__((address_space(3)))
typedef unsigned short bf16_t;
typedef short bf16x8 __attribute__((ext_vector_type(8)));
typedef float f32x2 __attribute__((ext_vector_type(2)));
typedef float f32x4 __attribute__((ext_vector_type(4)));
typedef float f32x16 __attribute__((ext_vector_type(16)));
typedef unsigned u32x2 __attribute__((ext_vector_type(2)));
typedef unsigned u32x4 __attribute__((ext_vector_type(4)));

constexpr int D = 2048, MP = 8192, MS = 1024, M = MP + MS, SEQ = 2048;
constexpr int INW = 5120, DFF = 5632, NGU = 2 * DFF;
constexpr int PLD = 256;
constexpr size_t PTILE = (size_t)9216 * 256;
constexpr int NPOS = 2048 + 8;
constexpr float EPS = 1e-6f;
constexpr int NWAVES = 8, NTHR = 512;

constexpr size_t O_Y = 0, O_RETP = (size_t)M * D, O_POOLP = O_RETP + 4 * 4 * 65536, O_RETS = O_POOLP + 4 * 15 * 1024, O_POOLS = O_RETS + (size_t)128 * 4 * 65536, O_END = O_POOLS + 128 * 15 * 1024;

constexpr size_t MiB = 1u << 20;
constexpr size_t WS_CTL = 0, CTL_ZERO_BYTES = 1 * MiB;
constexpr size_t CTL_MS_OFF = 16384, CTL_MS_BYTES = 16384;
constexpr size_t WS_CS = 1 * MiB;
constexpr size_t WS_WPOOL = 4 * MiB;
constexpr size_t WS_WPS = 6 * MiB;
constexpr size_t WS_WIN = 8 * MiB;
constexpr size_t WS_WOUT = 28 * MiB;
constexpr size_t WS_WGU = 36 * MiB;
constexpr size_t WS_WD = 80 * MiB;
constexpr size_t WS_H = 102 * MiB;
constexpr size_t WS_PROJ = 138 * MiB;
constexpr size_t WS_MIX = 228 * MiB;
constexpr size_t WS_UT = 264 * MiB;
constexpr size_t WS_SCT = 296 * MiB;
constexpr size_t WS_POOLED = 328 * MiB;
constexpr size_t WS_MO = 346 * MiB;
constexpr size_t WS_HID = 138 * MiB;
constexpr size_t WS_FF = 382 * MiB;
constexpr size_t WS_PART3 = 264 * MiB;
constexpr size_t WS_PART5 = 296 * MiB;
#ifndef SPLIT_MODE
#define SPLIT_MODE 1
#endif
constexpr size_t WS_END = 418 * MiB;
static_assert(WS_HID + (size_t)M * DFF * 2 <= WS_UT, "hid overlay");

constexpr int CW_BAR = 4096;
constexpr int LDS_BYTES = 147456;
constexpr int RING_BYTES = 131072, MISC_OFF = RING_BYTES + 320, ARG_OFF = RING_BYTES + 512;

__device__ __forceinline__ unsigned f2bf(float f) { unsigned u = __builtin_bit_cast(unsigned, f); return (u + 0x7fffu + ((u >> 16) & 1u)) >> 16; }
__device__ __forceinline__ unsigned cvt_pk_bf16(float lo, float hi) { unsigned r; asm volatile("v_cvt_pk_bf16_f32 %0, %1, %2" : "=v"(r) : "v"(lo), "v"(hi)); return r; }
__device__ __forceinline__ unsigned pk2(float lo, float hi) { unsigned r; asm("v_cvt_pk_bf16_f32 %0, %1, %2" : "=v"(r) : "v"(lo), "v"(hi)); return r; }
__device__ __forceinline__ float bflo(unsigned w) { return __builtin_bit_cast(float, w << 16); }
__device__ __forceinline__ float bfhi(unsigned w) { return __builtin_bit_cast(float, w & 0xffff0000u); }
__device__ __forceinline__ float bf2f(bf16_t b) { return __builtin_bit_cast(float, (unsigned)b << 16); }
__device__ __forceinline__ float wave_sum(float v) {
#pragma unroll
    for (int o = 1; o < 64; o <<= 1) v += __shfl_xor(v, o);
    return v;
}
__device__ __forceinline__ float silu(float x) { return x * __builtin_amdgcn_rcpf(1.0f + __builtin_amdgcn_exp2f(-1.4426950408889634f * x)); }
__device__ __forceinline__ float lg2gamma(int h) { return h == 0 ? -0.04580368961312479f : h == 1 ? -0.02272007650008353f : h == 2 ? -0.011315313227834146f : -0.005646563141142063f; }
#define LDS_WAIT() asm volatile("s_waitcnt lgkmcnt(0)" ::: "memory")
__device__ __forceinline__ int opaque(int x) { asm volatile("" : "+v"(x)); return x; }

constexpr int CODE_SPAN = 164000;
__device__ __forceinline__ void code_prefetch(const LAS unsigned char* lds) {
    if (threadIdx.x >= 64) {
        const volatile LAS unsigned* p = (const volatile LAS unsigned*)(lds + ARG_OFF) + 36;
        const unsigned long long cb = ((unsigned long long)p[1] << 32) | p[0];
        const unsigned o0 = (threadIdx.x - 64) * 128, o1 = o0 + 57344, o2 = o0 + 114688;
        const unsigned long long a0 = cb + o0, a1 = cb + o1, a2 = cb + (o2 < CODE_SPAN ? o2 : CODE_SPAN - 128);
        unsigned t0, t1, t2;
        asm volatile("global_load_dword %0, %3, off\n\tglobal_load_dword %1, %4, off\n\tglobal_load_dword %2, %5, off\n\ts_waitcnt vmcnt(0)"
                     : "=&v"(t0), "=&v"(t1), "=&v"(t2) : "v"(a0), "v"(a1), "v"(a2) : "memory");
    }
}
__device__ __forceinline__ void code_prefetch_all(const LAS unsigned char* lds) {
    const volatile LAS unsigned* p = (const volatile LAS unsigned*)(lds + ARG_OFF) + 36;
    const unsigned long long cb = ((unsigned long long)p[1] << 32) | p[0];
    const unsigned o0 = threadIdx.x * 128, o1 = o0 + 65536, o2 = o0 + 131072;
    const unsigned long long a0 = cb + o0, a1 = cb + o1, a2 = cb + (o2 < CODE_SPAN ? o2 : CODE_SPAN - 128);
    unsigned t0, t1, t2;
    asm volatile("global_load_dword %0, %3, off\n\tglobal_load_dword %1, %4, off\n\tglobal_load_dword %2, %5, off\n\ts_waitcnt vmcnt(0)"
                 : "=&v"(t0), "=&v"(t1), "=&v"(t2) : "v"(a0), "v"(a1), "v"(a2) : "memory");
}
__device__ __forceinline__ void code_prefetch_async(LAS unsigned char* lds) {
    const volatile LAS unsigned* p = (const volatile LAS unsigned*)(lds + ARG_OFF) + 36;
    const unsigned lo = __builtin_amdgcn_readfirstlane(p[0]), hi = __builtin_amdgcn_readfirstlane(p[1]);
    const char* cb = (const char*)(((unsigned long long)hi << 32) | lo);
    const unsigned o0 = threadIdx.x * 128, o1 = o0 + 65536, o2 = o0 + 131072;
    LAS unsigned* dst = (LAS unsigned*)(lds + RING_BYTES + 2048 + (threadIdx.x >> 6) * 256);
    __builtin_amdgcn_global_load_lds((const unsigned*)(cb + o0), dst, 4, 0, 0);
    __builtin_amdgcn_global_load_lds((const unsigned*)(cb + o1), dst, 4, 0, 0);
    __builtin_amdgcn_global_load_lds((const unsigned*)(cb + (o2 < CODE_SPAN ? o2 : CODE_SPAN - 128)), dst, 4, 0, 0);
}
namespace pg8 {
constexpr int BM = 256, BK = 64, HALF = 128, HTB = HALF * BK * 2, STAGE_BYTES = 8 * HTB, NXCD = 8, WGM = 8;
__host__ __device__ __forceinline__ int lds_byte(int r, int c) { const int st = (r >> 4) * 2 + (c >> 5), rr = r & 15, cc = c & 31, ob = rr * 64 + cc * 2; return st * 1024 + (ob ^ (((ob >> 9) & 1) << 5)); }
__host__ __device__ __forceinline__ void stage_rc(int b, int& R, int& C) { const int st = b / 1024, sb = b % 1024, swz = sb ^ (((sb >> 9) & 1) << 5); R = (st >> 1) * 16 + swz / 64; C = (st & 1) * 32 + (swz % 64) / 2; }
__host__ __device__ __forceinline__ int perm32(int rho) { const int n = rho >> 4, i = rho & 15; return 8 * (i >> 2) + 4 * n + (i & 3); }

struct Unit { int pm, pn, kt0, nkt, role; };
struct Gemm { const bf16_t* A; const bf16_t* Bt; int lda, ldb, K, a_pn_col; };
struct HybridOrder {
    int nM, nN, nwg, G, c, Rs, P, n32, q, mode;
    __device__ void init(int nM_, int nN_, int K, int G_, int c_, int Rs_, int mode_ = 0) {
        mode = mode_; nM = nM_; nN = nN_; nwg = nM * nN; G = G_; c = c_; Rs = Rs_; P = K / (2 * BK); n32 = G / NXCD; q = nwg / NXCD;
    }
    __device__ void tile(int wgid, Unit& u) const {
        const int nig = WGM * nN, gid = wgid / nig, fm = gid * WGM, gsz = (nM - fm) < WGM ? (nM - fm) : WGM;
        u.pm = fm + ((wgid % nig) % gsz); u.pn = (wgid % nig) / gsz;
    }
    __device__ bool next(int i, Unit& u) const {
        const int x = c % NXCD, j = c / NXCD;
        if (mode == 1) {
            if (i == 0) { u.pm = 8 * (x >> 1) + (j & 7); u.pn = 4 * (x & 1) + (j >> 3); u.kt0 = 0; u.nkt = 2 * P; u.role = 0; return true; }
            if (i == 1) { u.pm = 32 + (j >> 3); u.pn = j & 7; const int lo = x * P / 8, hi = (x + 1) * P / 8; u.kt0 = 2 * lo; u.nkt = 2 * (hi - lo); u.role = 3; return true; }
            return false;
        }
        if (i >= Rs || i * n32 + j >= q) return false;
        tile(x * q + i * n32 + j, u); u.kt0 = 0; u.nkt = 2 * P; u.role = 0; return true;
    }
};
struct SkBuf { bf16_t* part; };

template <class Epi>
__device__ __forceinline__ void gemm_phase(LAS unsigned char* lds, const Gemm g, const HybridOrder& S, const Epi& E, const SkBuf sk) {
    const int tid = threadIdx.x, wid = __builtin_amdgcn_readfirstlane(tid >> 6), lane = tid & 63, wr = wid >> 2, wc = wid & 3, fr = lane & 15, fq = lane >> 4;
    unsigned voffA[2], voffB[2];
#pragma unroll
    for (int i = 0; i < 2; ++i) { int R, C; stage_rc(tid * 16 + i * 8192, R, C); const int Rb = (R & ~31) + perm32(R & 31);
        voffA[i] = (unsigned)(R * g.lda + C) * 2u; voffB[i] = (unsigned)(Rb * g.ldb + C) * 2u; }
    const size_t kstep = (size_t)(BK * 2);
    const size_t hstepA = (size_t)HALF * g.lda * 2, hstepB = (size_t)HALF * g.ldb * 2;
    const unsigned ldsw = (unsigned)wid * 1024u;
    const int aoff = lds_byte(wr * 64 + fr, fq * 8), boff = lds_byte(wc * 32 + fr, fq * 8);
#define PG8_UA(u) ((const char*)g.A + ((size_t)(u).pm * BM * g.lda + (size_t)(u).pn * g.a_pn_col + (size_t)(u).kt0 * BK) * 2)
#define PG8_UB(u) ((const char*)g.Bt + ((size_t)(u).pn * BM * g.ldb + (size_t)(u).kt0 * BK) * 2)
#define PG8_SA(b, h) (((b) * 2 + (h)) * HTB)
#define PG8_SB(b, h) ((4 + (b) * 2 + (h)) * HTB)
#define PG8_STAGE(bufoff, gbase, voff) do { _Pragma("unroll") for (int _i = 0; _i < 2; ++_i) \
        __builtin_amdgcn_global_load_lds((const unsigned*)((const char*)(gbase) + (voff)[_i]), (LAS unsigned*)(lds + (bufoff) + ldsw + _i * 8192), 16, 0, 0); } while (0)
#define PG8_LDA(dst, b, h) do { _Pragma("unroll") for (int m = 0; m < 4; ++m) _Pragma("unroll") for (int k = 0; k < 2; ++k) dst[m][k] = *(const LAS bf16x8*)(lds + PG8_SA(b, h) + aoff + m * 2048 + k * 1024); } while (0)
#define PG8_LDB(dst, b, h) do { _Pragma("unroll") for (int n = 0; n < 2; ++n) _Pragma("unroll") for (int k = 0; k < 2; ++k) dst[n][k] = *(const LAS bf16x8*)(lds + PG8_SB(b, h) + boff + n * 2048 + k * 1024); } while (0)
#define PG8_MMA(ai, bj, At, Bt) do { __builtin_amdgcn_s_setprio(1); _Pragma("unroll") for (int m = 0; m < 4; ++m) _Pragma("unroll") for (int n = 0; n < 2; ++n) _Pragma("unroll") for (int k = 0; k < 2; ++k) \
        acc[ai][bj][m][n] = __builtin_amdgcn_mfma_f32_16x16x32_bf16(Bt[n][k], At[m][k], acc[ai][bj][m][n], 0, 0, 0); __builtin_amdgcn_s_setprio(0); } while (0)
#define PG8_WAIT_V(n) asm volatile("s_waitcnt vmcnt(" #n ")" ::: "memory")
#define PG8_WAIT_L(n) asm volatile("s_waitcnt lgkmcnt(" #n ")" ::: "memory")
#define PG8_BAR __builtin_amdgcn_s_barrier()
#define PG8_SCHED __builtin_amdgcn_sched_barrier(0)
    Unit cur, nxt; int ui = 0;
    if (!S.next(0, cur)) return;
    f32x4 acc[2][2][4][2];
#pragma unroll
    for (int a = 0; a < 2; ++a)
#pragma unroll
        for (int b = 0; b < 2; ++b)
#pragma unroll
            for (int m = 0; m < 4; ++m)
#pragma unroll
                for (int n = 0; n < 2; ++n) acc[a][b][m][n] = (f32x4){0.f, 0.f, 0.f, 0.f};
    bf16x8 At[4][2], B0[2][2], B1[2][2];
    const char* cA = PG8_UA(cur); const char* cB = PG8_UB(cur);
    PG8_STAGE(PG8_SB(0, 0), cB, voffB); PG8_STAGE(PG8_SB(0, 1), cB + hstepB, voffB); PG8_STAGE(PG8_SA(0, 0), cA, voffA); PG8_STAGE(PG8_SA(0, 1), cA + hstepA, voffA);
    if (wr == 1) PG8_BAR;
    PG8_WAIT_V(2); PG8_BAR;
    PG8_STAGE(PG8_SB(1, 0), cB + kstep, voffB); PG8_STAGE(PG8_SA(1, 0), cA + kstep, voffA); PG8_STAGE(PG8_SB(1, 1), cB + hstepB + kstep, voffB);
    PG8_WAIT_V(6); PG8_BAR;
    for (;;) {
        const bool has_next = S.next(ui + 1, nxt);
        const char* nA = has_next ? PG8_UA(nxt) : cA; const char* nB = has_next ? PG8_UB(nxt) : cB;
        const int nt = cur.nkt;
        for (int t = 0; t < nt; t += 2) {
            const bool last = (t == nt - 2);
            if (ui == 0 && t == nt - 4) code_prefetch_async(lds);
            const char* a1 = cA + (size_t)(t + 1) * kstep;
            const char* a2 = last ? nA : cA + (size_t)(t + 2) * kstep; const char* b2 = last ? nB : cB + (size_t)(t + 2) * kstep;
            const char* a3 = a2 + kstep; const char* b3 = b2 + kstep;
            PG8_LDB(B0, 0, 0); PG8_LDB(B1, 0, 1); PG8_SCHED; PG8_LDA(At, 0, 0); PG8_STAGE(PG8_SA(1, 1), a1 + hstepA, voffA);
            PG8_WAIT_V(8); PG8_WAIT_L(0); PG8_BAR; PG8_MMA(0, 0, At, B0); PG8_MMA(0, 1, At, B1); PG8_BAR; PG8_SCHED;
            PG8_LDA(At, 0, 1); PG8_STAGE(PG8_SB(0, 0), b2, voffB); PG8_STAGE(PG8_SB(0, 1), b2 + hstepB, voffB); PG8_STAGE(PG8_SA(0, 0), a2, voffA);
            PG8_WAIT_V(8); PG8_WAIT_L(0); PG8_BAR; PG8_MMA(1, 0, At, B0); PG8_MMA(1, 1, At, B1); PG8_BAR; PG8_SCHED;
            PG8_LDB(B0, 1, 0); PG8_LDB(B1, 1, 1); PG8_SCHED; PG8_LDA(At, 1, 0); PG8_STAGE(PG8_SA(0, 1), a2 + hstepA, voffA);
            PG8_WAIT_V(8); PG8_WAIT_L(0); PG8_BAR; PG8_MMA(0, 0, At, B0); PG8_MMA(0, 1, At, B1); PG8_BAR; PG8_SCHED;
            PG8_LDA(At, 1, 1); PG8_STAGE(PG8_SB(1, 0), b3, voffB); PG8_STAGE(PG8_SB(1, 1), b3 + hstepB, voffB); PG8_STAGE(PG8_SA(1, 0), a3, voffA);
            PG8_WAIT_V(8); PG8_WAIT_L(0); PG8_BAR; PG8_MMA(1, 0, At, B0); PG8_MMA(1, 1, At, B1); PG8_BAR; PG8_SCHED;
        }
        if (wr == 0) PG8_BAR;
        if (cur.role == 3) {
            bf16_t* O = sk.part + (size_t)(S.c % NXCD) * 1024 * 2048;
            const int row0 = (cur.pm - 32) * BM + wr * 64 + fr, col0 = cur.pn * BM + wc * 32 + 8 * fq;
#pragma unroll
            for (int ai = 0; ai < 2; ++ai)
#pragma unroll
                for (int m = 0; m < 4; ++m) {
                    bf16_t* rp = O + (size_t)(row0 + ai * HALF + m * 16) * 2048 + col0;
#pragma unroll
                    for (int bj = 0; bj < 2; ++bj) {
                        u32x4 wv; wv.x = cvt_pk_bf16(acc[ai][bj][m][0][0], acc[ai][bj][m][0][1]); wv.y = cvt_pk_bf16(acc[ai][bj][m][0][2], acc[ai][bj][m][0][3]);
                        wv.z = cvt_pk_bf16(acc[ai][bj][m][1][0], acc[ai][bj][m][1][1]); wv.w = cvt_pk_bf16(acc[ai][bj][m][1][2], acc[ai][bj][m][1][3]);
                        *(GAS u32x4*)(rp + bj * HALF) = wv;
                    }
                }
        } else {
            E(acc, cur, wr, wc, fr, fq);
        }
        if (!has_next) break;
#pragma unroll
        for (int a = 0; a < 2; ++a)
#pragma unroll
            for (int b = 0; b < 2; ++b)
#pragma unroll
                for (int m = 0; m < 4; ++m)
#pragma unroll
                    for (int n = 0; n < 2; ++n) acc[a][b][m][n] = (f32x4){0.f, 0.f, 0.f, 0.f};
        cur = nxt; cA = nA; cB = nB; ++ui;
        if (wr == 1) PG8_BAR;
    }
    PG8_WAIT_V(0);
    PG8_BAR;
#undef PG8_UA
#undef PG8_UB
#undef PG8_SA
#undef PG8_SB
#undef PG8_STAGE
#undef PG8_LDA
#undef PG8_LDB
#undef PG8_MMA
#undef PG8_WAIT_V
#undef PG8_WAIT_L
#undef PG8_BAR
#undef PG8_SCHED
}

__device__ __forceinline__ void st8(bf16_t* p, const f32x4 v0, const f32x4 v1) {
    u32x4 w; w.x = cvt_pk_bf16(v0[0], v0[1]); w.y = cvt_pk_bf16(v0[2], v0[3]); w.z = cvt_pk_bf16(v1[0], v1[1]); w.w = cvt_pk_bf16(v1[2], v1[3]);
    *(GAS u32x4*)p = w;
}
struct EpiProj {
    bf16_t* P; const float* cs;
    __device__ __forceinline__ void operator()(const f32x4 (&acc)[2][2][4][2], const Unit& u, int wr, int wc, int fr, int fq) const {
        const int row0 = u.pm * BM + wr * 64 + fr, type = u.pn >> 2, cl = wc * 32 + 8 * fq;
        bf16_t* Pt = P + (size_t)u.pn * PTILE + cl;
        if (type <= 1) {
            const float sc = type == 1 ? 0.0625f : 1.0f;
            const GAS f32x4* tb = (const GAS f32x4*)cs + (size_t)(cl >> 3) * 4 * NPOS;
#pragma unroll
            for (int ai = 0; ai < 2; ++ai) {
                u32x4 res[4][2];
                f32x4 tt[4][4];
#pragma unroll
                for (int m = 0; m < 4; ++m) { const int row = row0 + ai * HALF + m * 16; const int pidx = row < MP ? (row & (SEQ - 1)) : SEQ + ((row - MP) & 7);
#pragma unroll
                    for (int q = 0; q < 4; ++q) tt[m][q] = tb[(size_t)q * NPOS + pidx]; }
#pragma unroll
                for (int m = 0; m < 4; ++m) {
                    const f32x4 t0 = tt[m][0], t1 = tt[m][1], t2 = tt[m][2], t3 = tt[m][3];
                    const f32x4 x1a = acc[ai][0][m][0], x1b = acc[ai][0][m][1], x2a = acc[ai][1][m][0], x2b = acc[ai][1][m][1];
                    f32x4 o1a, o1b, o2a, o2b;
                    o1a[0] = (x1a[0] * t0[0] - x2a[0] * t0[1]) * sc; o2a[0] = (x2a[0] * t0[0] + x1a[0] * t0[1]) * sc;
                    o1a[1] = (x1a[1] * t0[2] - x2a[1] * t0[3]) * sc; o2a[1] = (x2a[1] * t0[2] + x1a[1] * t0[3]) * sc;
                    o1a[2] = (x1a[2] * t1[0] - x2a[2] * t1[1]) * sc; o2a[2] = (x2a[2] * t1[0] + x1a[2] * t1[1]) * sc;
                    o1a[3] = (x1a[3] * t1[2] - x2a[3] * t1[3]) * sc; o2a[3] = (x2a[3] * t1[2] + x1a[3] * t1[3]) * sc;
                    o1b[0] = (x1b[0] * t2[0] - x2b[0] * t2[1]) * sc; o2b[0] = (x2b[0] * t2[0] + x1b[0] * t2[1]) * sc;
                    o1b[1] = (x1b[1] * t2[2] - x2b[1] * t2[3]) * sc; o2b[1] = (x2b[1] * t2[2] + x1b[1] * t2[3]) * sc;
                    o1b[2] = (x1b[2] * t3[0] - x2b[2] * t3[1]) * sc; o2b[2] = (x2b[2] * t3[0] + x1b[2] * t3[1]) * sc;
                    o1b[3] = (x1b[3] * t3[2] - x2b[3] * t3[3]) * sc; o2b[3] = (x2b[3] * t3[2] + x1b[3] * t3[3]) * sc;
                    u32x4 w1, w2;
                    w1.x = cvt_pk_bf16(o1a[0], o1a[1]); w1.y = cvt_pk_bf16(o1a[2], o1a[3]); w1.z = cvt_pk_bf16(o1b[0], o1b[1]); w1.w = cvt_pk_bf16(o1b[2], o1b[3]);
                    w2.x = cvt_pk_bf16(o2a[0], o2a[1]); w2.y = cvt_pk_bf16(o2a[2], o2a[3]); w2.z = cvt_pk_bf16(o2b[0], o2b[1]); w2.w = cvt_pk_bf16(o2b[2], o2b[3]);
                    res[m][0] = w1; res[m][1] = w2;
                }
                asm volatile("" ::: "memory");
#pragma unroll
                for (int m = 0; m < 4; ++m) {
                    bf16_t* rp = Pt + (size_t)(row0 + ai * HALF + m * 16) * PLD;
                    *(GAS u32x4*)rp = res[m][0]; *(GAS u32x4*)(rp + HALF) = res[m][1];
                }
                asm volatile("" ::: "memory");
            }
        } else {
            const bool act = type == 3;
#pragma unroll
            for (int ai = 0; ai < 2; ++ai)
#pragma unroll
                for (int m = 0; m < 4; ++m) {
                    bf16_t* rp = Pt + (size_t)(row0 + ai * HALF + m * 16) * PLD;
#pragma unroll
                    for (int bj = 0; bj < 2; ++bj) {
                        f32x4 v0 = acc[ai][bj][m][0], v1 = acc[ai][bj][m][1];
                        if (act) {
#pragma unroll
                            for (int i = 0; i < 4; ++i) { v0[i] = silu(v0[i]); v1[i] = silu(v1[i]); }
                        }
                        st8(rp + bj * HALF, v0, v1);
                    }
                }
        }
    }
};
struct EpiPlain {
    bf16_t* O; int ldc, coff; const float* scale;
    __device__ __forceinline__ void operator()(const f32x4 (&acc)[2][2][4][2], const Unit& u, int wr, int wc, int fr, int fq) const {
        const int row0 = u.pm * BM + wr * 64 + fr, cl = wc * 32 + 8 * fq, col0 = u.pn * BM + cl;
        f32x4 s[2][2];
#pragma unroll
        for (int bj = 0; bj < 2; ++bj)
#pragma unroll
            for (int n = 0; n < 2; ++n) s[bj][n] = scale ? *(const GAS f32x4*)(scale + col0 + bj * HALF + 4 * n) : (f32x4){1.f, 1.f, 1.f, 1.f};
#pragma unroll
        for (int ai = 0; ai < 2; ++ai)
#pragma unroll
            for (int m = 0; m < 4; ++m) {
                bf16_t* rp = O + (size_t)(row0 + ai * HALF + m * 16) * ldc + coff + col0;
#pragma unroll
                for (int bj = 0; bj < 2; ++bj) st8(rp + bj * HALF, acc[ai][bj][m][0] * s[bj][0], acc[ai][bj][m][1] * s[bj][1]);
            }
    }
};
struct EpiGU {
    bf16_t* Hd;
    __device__ __forceinline__ void operator()(const f32x4 (&acc)[2][2][4][2], const Unit& u, int wr, int wc, int fr, int fq) const {
        const int row0 = u.pm * BM + wr * 64 + fr, cl = wc * 32 + 8 * fq, col0 = u.pn * HALF + cl;
#pragma unroll
        for (int ai = 0; ai < 2; ++ai)
#pragma unroll
            for (int m = 0; m < 4; ++m) {
                f32x4 v0, v1;
#pragma unroll
                for (int i = 0; i < 4; ++i) { v0[i] = silu(acc[ai][0][m][0][i]) * acc[ai][1][m][0][i]; v1[i] = silu(acc[ai][0][m][1][i]) * acc[ai][1][m][1][i]; }
                st8(Hd + (size_t)(row0 + ai * HALF + m * 16) * DFF + col0, v0, v1);
            }
    }
};
}

#define XB_TMO      128
#define XB_XCNT(j)  (256  + 64 * (j))
#define XB_XSUB(j)  (1280 + 64 * (j))
#define XB_XGEN(j)  (2304 + 64 * (j))
#define XB_TOP      3328
#define XB_TOPGEN   3392
#define XCD_BAR_WORDS 3456
#define XB_SPIN_CAP (1u << 18)
__device__ __forceinline__ unsigned xb_ld(unsigned* p)              { return __hip_atomic_load(p, __ATOMIC_RELAXED, __HIP_MEMORY_SCOPE_AGENT); }
__device__ __forceinline__ unsigned xb_add(unsigned* p, unsigned v) { return __hip_atomic_fetch_add(p, v, __ATOMIC_RELAXED, __HIP_MEMORY_SCOPE_AGENT); }
__device__ __forceinline__ unsigned xb_xcc_id() { return (unsigned)__builtin_amdgcn_s_getreg((3 << 11) | 20) & 0xFu; }
#define XB_SPIN(cond, bar) do { unsigned _sp = 0; while (cond) { __builtin_amdgcn_s_sleep(1); \
    if ((++_sp & 255u) == 0u) { if (xb_ld(&(bar)[XB_TMO])) break; if (_sp > XB_SPIN_CAP) { atomicAdd(&(bar)[XB_TMO], 1u); break; } } } } while (0)
__device__ __forceinline__ void xcd_barrier_post(unsigned* bar) {
    if (threadIdx.x == 0) (void)xb_add(&bar[XB_XCNT(xb_xcc_id())], 1u);
}
__device__ __forceinline__ void xcd_barrier_complete(unsigned* bar, unsigned x, unsigned& nloc, unsigned& nx) {
    const unsigned G = gridDim.x * gridDim.y * gridDim.z;
    unsigned sum, cnt, mine, sp = 0u;
    for (;;) {
        sum = 0u; cnt = 0u; mine = 0u;
#pragma unroll
        for (unsigned j = 0; j < 16; ++j) { const unsigned c = xb_ld(&bar[XB_XCNT(j)]); sum += c; cnt += (c > 0u) ? 1u : 0u; mine = (j == x) ? c : mine; }
        if (sum == G) break;
        __builtin_amdgcn_s_sleep(1);
        if ((++sp & 255u) == 0u) { if (xb_ld(&bar[XB_TMO])) break; if (sp > XB_SPIN_CAP) { atomicAdd(&bar[XB_TMO], 1u); break; } }
    }
    nloc = mine > 0u ? mine : 1u; nx = cnt > 0u ? cnt : 1u;
}
__device__ __forceinline__ void xcd_barrier(unsigned* bar, volatile LAS unsigned* st, const LAS unsigned char* lds) {
    asm volatile("s_waitcnt vmcnt(0)" ::: "memory");
    __syncthreads();
    code_prefetch(lds);
    if (threadIdx.x == 0) {
        const unsigned x = xb_xcc_id();
        __builtin_amdgcn_s_waitcnt(0);
        unsigned nloc = st[0], nx = st[1];
        if (nloc == 0u) { xcd_barrier_complete(bar, x, nloc, nx); st[0] = nloc; st[1] = nx; }
        const unsigned old = xb_add(&bar[XB_XSUB(x)], 1u);
        const unsigned gen = old / nloc;
        if (old + 1u == (gen + 1u) * nloc) {
            __builtin_amdgcn_fence(__ATOMIC_RELEASE, "agent");
            asm volatile("s_waitcnt vmcnt(0)" ::: "memory");
            const unsigned og = xb_add(&bar[XB_TOP], 1u);
            const unsigned tg = og / nx;
            if (og + 1u == (tg + 1u) * nx) xb_add(&bar[XB_TOPGEN], 1u);
            else XB_SPIN(xb_ld(&bar[XB_TOPGEN]) == tg, bar);
            __builtin_amdgcn_fence(__ATOMIC_ACQUIRE, "agent");
            xb_add(&bar[XB_XGEN(x)], 1u);
            asm volatile("s_waitcnt vmcnt(0)" ::: "memory");
        } else {
            XB_SPIN(xb_ld(&bar[XB_XGEN(x)]) == gen, bar);
            __builtin_amdgcn_fence(__ATOMIC_ACQUIRE, "agent");
            asm volatile("s_waitcnt vmcnt(0)" ::: "memory");
        }
    }
    __syncthreads();
}

struct Args { const float* in[16]; float* out; unsigned char* ws; int ph_lo, ph_hi, use_cg, pad; };

struct Frame {
    LAS unsigned char* lds;
    int tid, lane, wave, vcu, G;
};
__device__ __forceinline__ const float* ldarg(const Frame& F, int k) {
    const volatile LAS unsigned* p = (const volatile LAS unsigned*)(F.lds + ARG_OFF) + 2 * k;
    const unsigned lo = __builtin_amdgcn_readfirstlane(p[0]), hi = __builtin_amdgcn_readfirstlane(p[1]);
    return (const float*)(((unsigned long long)hi << 32) | lo);
}
#define AIN(k) ldarg(F, (k))
#define AOUT ((float*)ldarg(F, 16))
#define AWS ((unsigned char*)ldarg(F, 17))

struct TrItem { const float* W; bf16_t* WT; int K, N, mode, k0, n0; };
constexpr int TR_IN = (D / 64) * (INW / 256), TR_OUT = (D / 64) * (D / 256), TR_G = (D / 64) * (DFF / 256), TR_D = (DFF / 64) * (D / 256);
struct P0Ptrs { const float *w_in, *w_out, *w_gate, *w_up, *w_down, *w_pool; unsigned char* ws; };
__device__ __forceinline__ TrItem p0_decode(const P0Ptrs& a, unsigned char* ws, int it) {
    TrItem t; int r = it, nblk;
    if (r < TR_IN) { t.W = a.w_in; t.WT = (bf16_t*)(ws + WS_WIN); t.K = D; t.N = INW; t.mode = 0; }
    else if ((r -= TR_IN) < TR_OUT) { t.W = a.w_out; t.WT = (bf16_t*)(ws + WS_WOUT); t.K = D; t.N = D; t.mode = 0; }
    else if ((r -= TR_OUT) < 16) { const int g = r >> 2; r &= 3; t.W = a.w_pool + (size_t)g * 65536; t.WT = (bf16_t*)(ws + WS_WPOOL) + (size_t)g * 65536; t.K = 256; t.N = 256; t.mode = 0; }
    else if ((r -= 16) < TR_G) { t.W = a.w_gate; t.WT = (bf16_t*)(ws + WS_WGU); t.K = D; t.N = DFF; t.mode = 1; }
    else if ((r -= TR_G) < TR_G) { t.W = a.w_up; t.WT = (bf16_t*)(ws + WS_WGU); t.K = D; t.N = DFF; t.mode = 2; }
    else { r -= TR_G; t.W = a.w_down; t.WT = (bf16_t*)(ws + WS_WD); t.K = DFF; t.N = D; t.mode = 0; }
    nblk = t.N >> 8; t.k0 = 64 * (r / nblk); t.n0 = 256 * (r % nblk);
    return t;
}
constexpr int P0_NITEMS = TR_IN + TR_OUT + 16 + 2 * TR_G + TR_D;
constexpr int TR_B = TR_IN + TR_OUT + 16 + 2 * TR_G, TR_C = P0_NITEMS;
#ifndef TR_P1_ITEMS
#define TR_P1_ITEMS 640
#endif
constexpr int TR_A = TR_B - TR_P1_ITEMS;
__device__ __forceinline__ void p0_transposes(Frame& F, int it_begin, int it_end, int worker, int nworkers) {
    P0Ptrs a; a.w_in = AIN(6); a.w_out = AIN(10); a.w_gate = AIN(13); a.w_up = AIN(14); a.w_down = AIN(15); a.w_pool = AIN(8); a.ws = AWS;
    unsigned char* ws = a.ws;
    LAS float* buf = (LAS float*)F.lds;
    const int w = F.wave, l = opaque(F.lane);
#define TR_LOAD(V, T) do { _Pragma("unroll") for (int i = 0; i < 8; ++i) V[i] = __builtin_nontemporal_load((const GAS f32x4*)((T).W + (size_t)((T).k0 + 8 * w + i) * (T).N + (T).n0 + 4 * l)); } while (0)
#define TR_STEP(V, CUR) do { \
        _Pragma("unroll") for (int i = 0; i < 8; ++i) *(LAS f32x4*)(buf + (8 * w + i) * 260 + ((4 * l) ^ (4 * (w & 7)))) = V[i]; \
        __syncthreads(); \
        const TrItem cur_ = (CUR); \
        const int nit_ = it + 2 * nworkers; \
        if (nit_ < it_end) { (CUR) = p0_decode(a, ws, nit_); TR_LOAD(V, (CUR)); } \
        const int ko = l & 7; \
        _Pragma("unroll") for (int sidx = 0; sidx < 4; ++sidx) { \
            const int nl = 32 * w + 8 * sidx + (l >> 3), n = cur_.n0 + nl; \
            const LAS float* p = buf + (8 * ko) * 260 + (nl ^ (4 * ko)); \
            u32x4 o; o.x = pk2(p[0], p[260]); o.y = pk2(p[2 * 260], p[3 * 260]); o.z = pk2(p[4 * 260], p[5 * 260]); o.w = pk2(p[6 * 260], p[7 * 260]); \
            const int row = cur_.mode == 0 ? n : (256 * (n >> 7) + (n & 127) + (cur_.mode == 2 ? 128 : 0)); \
            if (cur_.mode != 0 || cur_.K == DFF) __builtin_nontemporal_store(o, (GAS u32x4*)(cur_.WT + (size_t)row * cur_.K + cur_.k0 + 8 * ko));   \
            else *(GAS u32x4*)(cur_.WT + (size_t)row * cur_.K + cur_.k0 + 8 * ko) = o; } \
        __syncthreads(); } while (0)
    int it = it_begin + worker;
    if (it >= it_end) return;
    TrItem tA = p0_decode(a, ws, it), tB = tA;
    f32x4 vA[8], vB[8];
    TR_LOAD(vA, tA);
    if (it + nworkers < it_end) { tB = p0_decode(a, ws, it + nworkers); TR_LOAD(vB, tB); }
    for (;;) {
        TR_STEP(vA, tA);
        it += nworkers; if (it >= it_end) break;
        TR_STEP(vB, tB);
        it += nworkers; if (it >= it_end) break;
    }
#undef TR_LOAD
#undef TR_STEP
}
__device__ __forceinline__ void rms_row_to_bf16(const float* xrow, const f32x4 (&ww)[8], bf16_t* orow, int lane) {
    const GAS f32x4* xr = (const GAS f32x4*)xrow + lane;
    f32x4 v[8]; float s = 0.f;
#pragma unroll
    for (int j = 0; j < 8; ++j) { v[j] = __builtin_nontemporal_load(xr + 64 * j); s += (v[j].x * v[j].x + v[j].y * v[j].y) + (v[j].z * v[j].z + v[j].w * v[j].w); }
    const float rstd = 1.0f / sqrtf(wave_sum(s) * (1.f / D) + EPS);
    GAS u32x2* o8 = (GAS u32x2*)orow + lane;
#pragma unroll
    for (int j = 0; j < 8; ++j) { u32x2 o; o.x = pk2(v[j].x * rstd * ww[j].x, v[j].y * rstd * ww[j].y); o.y = pk2(v[j].z * rstd * ww[j].z, v[j].w * rstd * ww[j].w); o8[64 * j] = o; }
}
__device__ __forceinline__ const float* xrow_ptr(const float* xp, const float* xs, int m) { return m < MP ? xp + (size_t)m * D : xs + (size_t)(m - MP) * D; }

__device__ __forceinline__ void p0_prologue(Frame& F) {
    p0_transposes(F, 0, TR_A, F.vcu, F.G);
    unsigned char* ws = AWS;
    const int gw = F.vcu * NWAVES + F.wave, NGW = F.G * NWAVES;
    const float* xp_ = AIN(0); const float* xs_ = AIN(1); const float* nw_ = AIN(4);
    f32x4 ww0[8];
#pragma unroll
    for (int j = 0; j < 8; ++j) ww0[j] = *((const GAS f32x4*)nw_ + F.lane + 64 * j);
    for (int m = gw; m < M; m += NGW) rms_row_to_bf16(xrow_ptr(xp_, xs_, m), ww0, (bf16_t*)(ws + WS_H) + (size_t)m * D, F.lane);
    { const float* wp = AIN(8); const float* psc = AIN(9); bf16_t* wps = (bf16_t*)(ws + WS_WPS);
      for (int idx = (F.vcu * NTHR + F.tid) * 2; idx < 4 * 65536; idx += F.G * NTHR * 2) {
          const f32x2 v = *(const GAS f32x2*)(wp + idx); const int sc0 = 256 * (idx >> 16) + (idx & 255);
          *(GAS unsigned*)(wps + idx) = pk2(v.x * psc[sc0], v.y * psc[sc0 + 1]); } }
    float* cs = (float*)(ws + WS_CS);
    for (int idx = F.vcu * NTHR + F.tid; idx < NPOS * 128; idx += F.G * NTHR) {
        const int p = idx >> 7, j = idx & 127;
        double r = 0.930572040929699, inv = 1.0;
#pragma unroll
        for (int b = 0; b < 7; ++b) { if ((j >> b) & 1) inv *= r; r *= r; }
        const float invf = (float)inv;
        const float pos = (float)(p < SEQ ? p : 16384 + (p - SEQ));
        const float ang = pos * invf;
        double t = (double)ang * 0.15915494309189535; t -= __builtin_rint(t);
        const float tf = (float)t;
        f32x2 o; o.x = __builtin_amdgcn_cosf(tf); o.y = __builtin_amdgcn_sinf(tf);
        *(f32x2*)(cs + ((size_t)(((j >> 3) * 4 + ((j & 7) >> 1)) * NPOS + p)) * 4 + (j & 1) * 2) = o;
    }
}

__device__ __forceinline__ unsigned toff(int r, int c16, int RB) { return (unsigned)(r * RB + ((((c16 & ~15) | ((c16 ^ r ^ (r >> 4)) & 15))) << 4)); }
#define MFMA32(a, b, c) __builtin_amdgcn_mfma_f32_32x32x16_bf16((a), (b), (c), 0, 0, 0)
__device__ __forceinline__ int crow(int reg, int h) { return (reg & 3) + 8 * (reg >> 2) + 4 * h; }
__device__ __forceinline__ bf16x8 frag(const LAS unsigned char* tile, int r, int c16, int RB) { return *(const LAS bf16x8*)(tile + toff(r, c16, RB)); }

__device__ __forceinline__ void load_nat128(LAS unsigned char* dst, const bf16_t* src, int ld, int tid) {
    tid = opaque(tid);
    u32x4 v[4];
#pragma unroll
    for (int it = 0; it < 4; ++it) { const int idx = tid + it * NTHR, r = idx >> 4, c = idx & 15; v[it] = *(const GAS u32x4*)(src + (size_t)r * ld + c * 8); }
#pragma unroll
    for (int it = 0; it < 4; ++it) { const int idx = tid + it * NTHR, r = idx >> 4, c = idx & 15; *(LAS u32x4*)(dst + toff(r, c, 256)) = v[it]; }
}
template <bool SCALE>
__device__ __forceinline__ void load_tr(LAS unsigned char* dst, const bf16_t* src, int ld, int tid, float sc_a, float sc_b) {
    tid = opaque(tid);
#pragma unroll
    for (int it = 0; it < 4; ++it) {
        const int T = it * NTHR + tid, ch_lo = T & 15, pp = (T >> 4) & 3, half = (T >> 6) & 1, quad = T >> 7;
        const int pair = 4 * quad + pp, chunk = 16 * half + ch_lo, j0 = 2 * pair, d0 = 8 * chunk;
        const u32x4 a = *(const GAS u32x4*)(src + (size_t)j0 * ld + d0), b = *(const GAS u32x4*)(src + (size_t)(j0 + 1) * ld + d0);
        float s0 = 1.f, s1 = 1.f;
        if (SCALE) { s0 = __builtin_amdgcn_exp2f(sc_a * (sc_b - (float)j0)); s1 = __builtin_amdgcn_exp2f(sc_a * (sc_b - (float)(j0 + 1))); }
#pragma unroll
        for (int i = 0; i < 8; ++i) {
            const unsigned wa = a[i >> 1], wb = b[i >> 1];
            unsigned w;
            if (SCALE) { const float fa = ((i & 1) ? bfhi(wa) : bflo(wa)) * s0, fb = ((i & 1) ? bfhi(wb) : bflo(wb)) * s1; w = pk2(fa, fb); }
            else w = (i & 1) ? ((wa >> 16) | (wb & 0xffff0000u)) : ((wa & 0xffffu) | (wb << 16));
            const int d = d0 + i;
            *(LAS unsigned*)(dst + toff(d, quad, 256) + pp * 4) = w;
        }
    }
}

__device__ __forceinline__ void u_item(Frame& F, const bf16_t* PROJ, bf16_t* UT, int item) {
    const int b = item >> 6, h = (item >> 4) & 3, c = item & 15, rows0 = b * SEQ + c * 128;
    const bf16_t* Ks = PROJ + (size_t)(4 + h) * PTILE + (size_t)rows0 * PLD; const bf16_t* Vs = Ks + 4 * PTILE;
    LAS unsigned char* KT = F.lds; LAS unsigned char* VT = F.lds + 65536;
    const float lg = lg2gamma(h);
    load_tr<true>(KT, Ks, PLD, F.tid, lg, 127.f);
    load_tr<false>(VT, Vs, PLD, F.tid, 0.f, 0.f);
    __syncthreads();
    const int w = F.wave, r = opaque(F.lane) & 31, hh = opaque(F.lane) >> 5;
    bf16_t* Up = UT + ((size_t)((b * 4 + h) * 16 + c) * 256) * 256;
#pragma unroll 1
    for (int eh = 0; eh < 2; ++eh) {
        f32x16 acc[4];
#pragma unroll
        for (int t = 0; t < 4; ++t)
#pragma unroll
            for (int i = 0; i < 16; ++i) acc[t][i] = 0.f;
#pragma unroll 1
        for (int ks = 0; ks < 8; ++ks) {
            const bf16x8 a = frag(KT, 32 * w + r, 2 * ks + hh, 256);
#pragma unroll
            for (int et = 0; et < 4; ++et) { const bf16x8 bb = frag(VT, 32 * (4 * eh + et) + r, 2 * ks + hh, 256); acc[et] = MFMA32(a, bb, acc[et]); }
        }
#pragma unroll
        for (int et = 0; et < 4; ++et)
#pragma unroll
            for (int g = 0; g < 4; ++g) {
                u32x2 o; o.x = cvt_pk_bf16(acc[et][4 * g], acc[et][4 * g + 1]); o.y = cvt_pk_bf16(acc[et][4 * g + 2], acc[et][4 * g + 3]);
                *(GAS u32x2*)(Up + (size_t)((((4 * eh + et) * 16 + 2 * w + (g >> 1)) * 64 + (g & 1) * 32 + r) * 8 + 4 * hh)) = o;
            }
    }
    __syncthreads();
}

#define OI_SCHED __builtin_amdgcn_sched_barrier(0)
__device__ __forceinline__ void o_item(Frame& F, const bf16_t* PROJ, const bf16_t* SCT, const float* retw, bf16_t* MIX, int item) {
    const int b = item >> 6, h = (item >> 4) & 3, c = item & 15, rows0 = b * SEQ + c * 128;
    const bf16_t* Qs = PROJ + (size_t)h * PTILE + (size_t)rows0 * PLD; const bf16_t* Ks = Qs + 4 * PTILE; const bf16_t* Vs = Qs + 8 * PTILE; const bf16_t* Gs = Qs + 12 * PTILE;
    LAS unsigned char* QF = F.lds; LAS unsigned char* KH = F.lds + 65536; LAS unsigned char* PB = F.lds + 98304; LAS unsigned char* VT = F.lds; LAS unsigned char* OB = F.lds;
    const float lg = lg2gamma(h);
    const int w = F.wave; int r = opaque(F.lane) & 31, hh = opaque(F.lane) >> 5; const int tid = opaque(F.tid);
    u32x4 qv[8], kv[4], kw[4]; bf16x8 sfr[16];
#pragma unroll
    for (int it = 0; it < 8; ++it) { const int idx = tid + it * NTHR, rr = idx >> 5, cc = idx & 31; qv[it] = __builtin_nontemporal_load((const GAS u32x4*)(Qs + (size_t)rr * PLD + cc * 8)); }
#pragma unroll
    for (int it = 0; it < 4; ++it) { const int idx = tid + it * NTHR, rr = idx >> 4, cc = idx & 15; kv[it] = __builtin_nontemporal_load((const GAS u32x4*)(Ks + (size_t)rr * PLD + cc * 8)); }
#pragma unroll
    for (int it = 0; it < 4; ++it) { const int idx = tid + it * NTHR, rr = idx >> 4, cc = idx & 15; kw[it] = __builtin_nontemporal_load((const GAS u32x4*)(Ks + 128 + (size_t)rr * PLD + cc * 8)); }
    {
        const bf16_t* Sp = SCT + ((size_t)((b * 4 + h) * 16 + c) * 256) * 256 + (size_t)(w * 1024 + hh * 32 + r) * 8;
#pragma unroll
        for (int ks = 0; ks < 16; ++ks) sfr[ks] = __builtin_nontemporal_load((const GAS bf16x8*)(Sp + 512 * ks));
    }
#pragma unroll
    for (int it = 0; it < 8; ++it) { const int idx = tid + it * NTHR, rr = idx >> 5, cc = idx & 31; *(LAS u32x4*)(QF + toff(rr, cc, 512)) = qv[it]; }
#pragma unroll
    for (int it = 0; it < 4; ++it) { const int idx = tid + it * NTHR, rr = idx >> 4, cc = idx & 15; *(LAS u32x4*)(KH + toff(rr, cc, 256)) = kv[it]; }
    __syncthreads();
    u32x4 va[4], vb[4];
#pragma unroll
    for (int it = 0; it < 4; ++it) {
        const int T = it * NTHR + tid, ch_lo = T & 15, pp = (T >> 4) & 3, half = (T >> 6) & 1, quad = T >> 7;
        const int pair = 4 * quad + pp, chunk = 16 * half + ch_lo, j0 = 2 * pair, d0 = 8 * chunk;
        va[it] = __builtin_nontemporal_load((const GAS u32x4*)(Vs + (size_t)j0 * PLD + d0)); vb[it] = __builtin_nontemporal_load((const GAS u32x4*)(Vs + (size_t)(j0 + 1) * PLD + d0));
    }
    const int ib_s = w >> 1, jb0 = 2 * (w & 1);
    f32x16 sc[2];
#pragma unroll
    for (int t = 0; t < 2; ++t)
#pragma unroll
        for (int i = 0; i < 16; ++i) sc[t][i] = 0.f;
#pragma unroll 1
    for (int dh = 0; dh < 2; ++dh) {
        if (dh == 1) {
            __syncthreads();
#pragma unroll
            for (int it = 0; it < 4; ++it) { const int idx = tid + it * NTHR, rr = idx >> 4, cc = idx & 15; *(LAS u32x4*)(KH + toff(rr, cc, 256)) = kw[it]; }
            __syncthreads();
        }
        if (jb0 <= ib_s) {
            const int rq = 32 * ib_s + r, rk0 = 32 * jb0 + r, rk1 = rk0 + 32, cq = 16 * dh + hh;
            bf16x8 fa[3], fb0[3], fb1[3];
#pragma unroll
            for (int k = 0; k < 2; ++k) { fa[k] = frag(QF, rq, cq + 2 * k, 512); fb0[k] = frag(KH, rk0, 2 * k + hh, 256); fb1[k] = frag(KH, rk1, 2 * k + hh, 256); }
#pragma unroll
            for (int ks = 0; ks < 8; ++ks) {
                if (ks + 2 < 8) { const int n = (ks + 2) % 3; fa[n] = frag(QF, rq, cq + 2 * (ks + 2), 512); fb0[n] = frag(KH, rk0, 2 * (ks + 2) + hh, 256); fb1[n] = frag(KH, rk1, 2 * (ks + 2) + hh, 256); }
                OI_SCHED;
                sc[0] = MFMA32(fa[ks % 3], fb0[ks % 3], sc[0]); sc[1] = MFMA32(fa[ks % 3], fb1[ks % 3], sc[1]);
                OI_SCHED;
            }
        }
    }
    r = opaque(r); hh = opaque(hh);
    {
        const int odd = r & 1, jsel = 32 * (jb0 + odd) + (r & ~1), cxs = jsel >> 3, jos = (jsel & 7) * 2;
        float cp[2];
#pragma unroll
        for (int t = 0; t < 2; ++t) cp[t] = __builtin_amdgcn_exp2f(lg * (float)(32 * (ib_s - jb0 - t) - r));
#pragma unroll
        for (int reg = 0; reg < 16; ++reg) {
            const int il = crow(reg, hh), i = 32 * ib_s + il, rterm = (i ^ (i >> 4)) & 15;
            const float rp = __builtin_amdgcn_exp2f(lg * (float)il);
            const float v0 = (il >= 32 * (jb0 - ib_s) + r) ? sc[0][reg] * rp * cp[0] : 0.f;
            const float v1 = (il >= 32 * (jb0 + 1 - ib_s) + r) ? sc[1][reg] * rp * cp[1] : 0.f;
            const float send = odd ? v0 : v1;
            const float recv = __builtin_bit_cast(float, __builtin_amdgcn_mov_dpp(__builtin_bit_cast(int, send), 0xB1, 0xf, 0xf, true));
            const unsigned dw = odd ? pk2(recv, v1) : pk2(v0, recv);
            *(LAS unsigned*)(PB + i * 256 + (((cxs ^ rterm) & 15) << 4) + jos) = dw;
        }
    }
    f32x16 o[4];
#pragma unroll
    for (int t = 0; t < 4; ++t)
#pragma unroll
        for (int i = 0; i < 16; ++i) o[t][i] = 0.f;
    r = opaque(r); hh = opaque(hh);
    {
        bf16x8 qa[2][4];
#pragma unroll
        for (int ib = 0; ib < 4; ++ib) qa[0][ib] = frag(QF, 32 * ib + r, hh, 512);
#pragma unroll
        for (int ks = 0; ks < 16; ++ks) {
            if (ks + 1 < 16) {
#pragma unroll
                for (int ib = 0; ib < 4; ++ib) qa[(ks + 1) & 1][ib] = frag(QF, 32 * ib + r, 2 * (ks + 1) + hh, 512);
            }
            OI_SCHED;
#pragma unroll
            for (int ib = 0; ib < 4; ++ib) o[ib] = MFMA32(qa[ks & 1][ib], sfr[ks], o[ib]);
            OI_SCHED;
        }
    }
    u32x4 gv[8]; f32x4 nwa, nwb;
    { const int tid3 = opaque(F.tid);
#pragma unroll
      for (int it = 0; it < 8; ++it) gv[it] = __builtin_nontemporal_load((const GAS u32x4*)(Gs + (size_t)((tid3 >> 5) + 16 * it) * PLD + (tid3 & 31) * 8));
      nwa = *(const GAS f32x4*)(retw + h * 256 + (tid3 & 31) * 8); nwb = *(const GAS f32x4*)(retw + h * 256 + (tid3 & 31) * 8 + 4); }
    {
        float rp[16];
#pragma unroll
        for (int reg = 0; reg < 16; ++reg) rp[reg] = __builtin_amdgcn_exp2f(lg * (float)(crow(reg, hh) + 1));
#pragma unroll
        for (int ib = 0; ib < 4; ++ib) { const float bs = __builtin_amdgcn_exp2f(lg * (float)(32 * ib));
#pragma unroll
            for (int reg = 0; reg < 16; ++reg) o[ib][reg] *= rp[reg] * bs; }
    }
    __syncthreads();
#pragma unroll
    for (int it = 0; it < 4; ++it) {
        const int T = it * NTHR + tid, ch_lo = T & 15, pp = (T >> 4) & 3, half = (T >> 6) & 1, quad = T >> 7;
        const int chunk = 16 * half + ch_lo, d0 = 8 * chunk;
#pragma unroll
        for (int i = 0; i < 8; ++i) {
            const unsigned wa = va[it][i >> 1], wb = vb[it][i >> 1];
            const unsigned wv = (i & 1) ? ((wa >> 16) | (wb & 0xffff0000u)) : ((wa & 0xffffu) | (wb << 16));
            *(LAS unsigned*)(VT + toff(d0 + i, quad, 256) + pp * 4) = wv;
        }
    }
    __syncthreads();
    r = opaque(r); hh = opaque(hh);
    {
        bf16x8 pv[2], pa[2][4];
        pv[0] = frag(VT, 32 * w + r, hh, 256);
#pragma unroll
        for (int ib = 0; ib < 4; ++ib) pa[0][ib] = frag(PB, 32 * ib + r, hh, 256);
#pragma unroll
        for (int ks = 0; ks < 8; ++ks) {
            if (ks + 1 < 8) {
                pv[(ks + 1) & 1] = frag(VT, 32 * w + r, 2 * (ks + 1) + hh, 256);
#pragma unroll
                for (int ib = 0; ib < 4; ++ib) if (ib >= ((ks + 1) >> 1)) pa[(ks + 1) & 1][ib] = frag(PB, 32 * ib + r, 2 * (ks + 1) + hh, 256);
            }
            OI_SCHED;
#pragma unroll
            for (int ib = 0; ib < 4; ++ib) if (ib >= (ks >> 1)) o[ib] = MFMA32(pa[ks & 1][ib], pv[ks & 1], o[ib]);
            OI_SCHED;
        }
    }
    __syncthreads();
    r = opaque(r); hh = opaque(hh);
    {
        const int odd = r & 1; LAS unsigned char* colp = OB + (32 * w + (r & ~1)) * 2;
#pragma unroll
        for (int ib = 0; ib < 4; ++ib)
#pragma unroll
            for (int m = 0; m < 8; ++m) {
                const float xa = o[ib][2 * m], xb = o[ib][2 * m + 1];
                const float send = odd ? xa : xb;
                const float recv = __builtin_bit_cast(float, __builtin_amdgcn_mov_dpp(__builtin_bit_cast(int, send), 0xB1, 0xf, 0xf, true));
                const unsigned dw = odd ? pk2(recv, xb) : pk2(xa, recv);
                const int i = 32 * ib + crow(2 * m + odd, hh);
                *(LAS unsigned*)(colp + i * 512) = dw;
            }
    }
    __syncthreads();
    {
        const int tid2 = opaque(F.tid), cc = tid2 & 31;
        u32x4 ov[8]; float sq[8];
#pragma unroll
        for (int it = 0; it < 8; ++it) ov[it] = *(const LAS u32x4*)(OB + ((tid2 >> 5) + 16 * it) * 512 + cc * 16);
#pragma unroll
        for (int it = 0; it < 8; ++it) { float q = 0.f;
#pragma unroll
            for (int k = 0; k < 4; ++k) { const float lo = bflo(ov[it][k]), hi = bfhi(ov[it][k]); q += lo * lo + hi * hi; }
            sq[it] = q; }
#pragma unroll
        for (int sh = 1; sh < 32; sh <<= 1) {
#pragma unroll
            for (int it = 0; it < 8; ++it) sq[it] += __shfl_xor(sq[it], sh);
            OI_SCHED;
        }
#pragma unroll
        for (int it = 0; it < 8; ++it) {
            const int i = (tid2 >> 5) + 16 * it;
            const float rstd = 1.0f / sqrtf(sq[it] * (1.f / 256.f) + EPS);
            float x[8];
#pragma unroll
            for (int k = 0; k < 4; ++k) { x[2 * k] = bflo(ov[it][k]); x[2 * k + 1] = bfhi(ov[it][k]); }
            u32x4 res;
            res[0] = pk2(x[0] * rstd * nwa[0] * bflo(gv[it][0]), x[1] * rstd * nwa[1] * bfhi(gv[it][0]));
            res[1] = pk2(x[2] * rstd * nwa[2] * bflo(gv[it][1]), x[3] * rstd * nwa[3] * bfhi(gv[it][1]));
            res[2] = pk2(x[4] * rstd * nwb[0] * bflo(gv[it][2]), x[5] * rstd * nwb[1] * bfhi(gv[it][2]));
            res[3] = pk2(x[6] * rstd * nwb[2] * bflo(gv[it][3]), x[7] * rstd * nwb[3] * bfhi(gv[it][3]));
            *(GAS u32x4*)(MIX + (size_t)(rows0 + i) * D + h * 256 + cc * 8) = res;
        }
    }
    __syncthreads();
}

__device__ __forceinline__ void s_item(Frame& F, const bf16_t* PROJ, const float* state, const float* retw, float* newstate, bf16_t* MIX, int item) {
    const int sb = item >> 2, h = item & 3, rows0 = MP + sb * 8;
    const float lg = lg2gamma(h);
    LAS float* QK = (LAS float*)F.lds;
    LAS float* QR = (LAS float*)(F.lds + 16384);
    LAS float* KR = (LAS float*)(F.lds + 16384 + 8224);
    LAS float* SCP = (LAS float*)(F.lds + 16384 + 2 * 8224);
    LAS float* SCO = (LAS float*)(F.lds + 16384 + 2 * 8224 + 2048);
    LAS float* RED = (LAS float*)(F.lds + 40960);
    const int w = opaque(F.wave), l = opaque(F.lane), tid_o = opaque(F.tid);
    {
        const int isk = tid_o >> 8, i = (tid_o >> 5) & 7, d8 = (tid_o & 31) * 8;
        const u32x4 raw = *(const GAS u32x4*)(PROJ + (size_t)(isk * 4 + h) * PTILE + (size_t)(rows0 + i) * PLD + d8);
        float f[8];
#pragma unroll
        for (int q = 0; q < 4; ++q) { f[2 * q] = bflo(raw[q]); f[2 * q + 1] = bfhi(raw[q]); }
        const float sc = __builtin_amdgcn_exp2f(lg * (float)(isk ? 7 - i : i + 1));
        LAS float* R = isk ? KR : QR;
#pragma unroll
        for (int k = 0; k < 8; ++k) { R[i * 257 + d8 + k] = f[k]; QK[(d8 + k) * 16 + isk * 8 + i] = f[k] * sc; }
    }
    float v[8][4];
#pragma unroll
    for (int j = 0; j < 8; ++j) { const u32x2 t = *(const GAS u32x2*)(PROJ + (size_t)(8 + h) * PTILE + (size_t)(rows0 + j) * PLD + 4 * l); v[j][0] = bflo(t.x); v[j][1] = bfhi(t.x); v[j][2] = bflo(t.y); v[j][3] = bfhi(t.y); }
    __syncthreads();
    {
        const int i = l >> 3, j = l & 7; float s = 0.f;
#pragma unroll 8
        for (int d = 32 * w; d < 32 * w + 32; ++d) s += QR[i * 257 + d] * KR[j * 257 + d];
        SCP[w * 64 + l] = s;
    }
    float oacc[8][4];
#pragma unroll
    for (int i = 0; i < 8; ++i)
#pragma unroll
        for (int c = 0; c < 4; ++c) oacc[i][c] = 0.f;
    const float g8 = __builtin_amdgcn_exp2f(lg * 8.f);
    const GAS f32x4* Sp = (const GAS f32x4*)(state + ((size_t)(sb * 4 + h) * 256 + 32 * w) * 256) + l;
    GAS f32x4* Np = (GAS f32x4*)(newstate + ((size_t)(sb * 4 + h) * 256 + 32 * w) * 256) + l;
    f32x4 sA[4], sB[4];
#define S_LOAD4(dst, row0) do { const GAS f32x4* p0_ = Sp + (size_t)(row0) * 64; asm volatile("" : "+v"(p0_)); \
        _Pragma("unroll") for (int k = 0; k < 4; ++k) dst[k] = __builtin_nontemporal_load(p0_ + k * 64); } while (0)
#define S_COMP4(src, row0) do { GAS f32x4* n0_ = Np + (size_t)(row0) * 64; asm volatile("" : "+v"(n0_)); \
        _Pragma("unroll") for (int k = 0; k < 4; ++k) { \
            const LAS f32x4* qk = (const LAS f32x4*)(QK + (32 * w + (row0) + k) * 16); \
            const f32x4 qa = qk[0], qb = qk[1], ka = qk[2], kb = qk[3]; f32x4 n; \
            _Pragma("unroll") for (int c = 0; c < 4; ++c) { const float sv = src[k][c]; \
                oacc[0][c] += qa[0] * sv; oacc[1][c] += qa[1] * sv; oacc[2][c] += qa[2] * sv; oacc[3][c] += qa[3] * sv; \
                oacc[4][c] += qb[0] * sv; oacc[5][c] += qb[1] * sv; oacc[6][c] += qb[2] * sv; oacc[7][c] += qb[3] * sv; \
                float t = g8 * sv; \
                t += ka[0] * v[0][c]; t += ka[1] * v[1][c]; t += ka[2] * v[2][c]; t += ka[3] * v[3][c]; \
                t += kb[0] * v[4][c]; t += kb[1] * v[5][c]; t += kb[2] * v[6][c]; t += kb[3] * v[7][c]; n[c] = t; } \
            __builtin_nontemporal_store(n, n0_ + k * 64); \
            if (k & 1) asm volatile("" ::: "memory"); } } while (0)
    S_LOAD4(sA, 0);
#pragma unroll 1
    for (int h2 = 0; h2 < 4; ++h2) {
        S_LOAD4(sB, 8 * h2 + 4);
        S_COMP4(sA, 8 * h2);
        if (h2 < 3) S_LOAD4(sA, 8 * h2 + 8);
        S_COMP4(sB, 8 * h2 + 4);
    }
#undef S_LOAD4
#undef S_COMP4
#pragma unroll
    for (int i = 0; i < 8; ++i) *(LAS f32x4*)(RED + (w * 8 + i) * 256 + 4 * l) = (f32x4){oacc[i][0], oacc[i][1], oacc[i][2], oacc[i][3]};
    __syncthreads();
    if (tid_o < 64) { const int i = l >> 3, j = l & 7; float s = 0.f;
#pragma unroll
        for (int ww = 0; ww < 8; ++ww) s += SCP[ww * 64 + l];
        SCO[l] = (i >= j) ? s * __builtin_amdgcn_exp2f(lg * (float)(i - j)) : 0.f; }
    __syncthreads();
    {
        const int i = w; f32x4 tot = (f32x4){0.f, 0.f, 0.f, 0.f};
#pragma unroll
        for (int ww = 0; ww < 8; ++ww) tot += *(const LAS f32x4*)(RED + (ww * 8 + i) * 256 + 4 * l);
#pragma unroll
        for (int j = 0; j < 8; ++j) { const float s = SCO[i * 8 + j];
#pragma unroll
            for (int c = 0; c < 4; ++c) tot[c] += s * v[j][c]; }
        const float ss = wave_sum((tot[0] * tot[0] + tot[1] * tot[1]) + (tot[2] * tot[2] + tot[3] * tot[3]));
        const float rstd = 1.0f / sqrtf(ss * (1.f / 256.f) + EPS);
        const f32x4 wn = *(const GAS f32x4*)(retw + h * 256 + 4 * l);
        const u32x2 gv = *(const GAS u32x2*)(PROJ + (size_t)(12 + h) * PTILE + (size_t)(rows0 + i) * PLD + 4 * l);
        u32x2 res; res.x = pk2(tot[0] * rstd * wn[0] * bflo(gv.x), tot[1] * rstd * wn[1] * bfhi(gv.x)); res.y = pk2(tot[2] * rstd * wn[2] * bflo(gv.y), tot[3] * rstd * wn[3] * bfhi(gv.y));
        *(GAS u32x2*)(MIX + (size_t)(rows0 + i) * D + h * 256 + 4 * l) = res;
    }
    __syncthreads();
}

__device__ __forceinline__ void unpk8(const u32x4 v, float (&f)[8]) {
#pragma unroll
    for (int q = 0; q < 4; ++q) { f[2 * q] = bflo(v[q]); f[2 * q + 1] = bfhi(v[q]); }
}
template <int W>
__device__ __forceinline__ void pool_prompt_blk(const bf16_t* PROJ, bf16_t* POOLED, float* outp, int rb, int ch) {
    const int m0 = rb * 8, t0 = m0 & (SEQ - 1), bseq = m0 >> 11;
    const bf16_t* U = PROJ + (size_t)(16 + (ch >> 8)) * PTILE + (ch & 255);
    u32x4 x[W + 7];
#pragma unroll
    for (int i = 0; i < W + 7; ++i) { const int t = t0 - (W - 1) + i; const int mi = (t >= 0) ? m0 - (W - 1) + i : m0; x[i] = *(const GAS u32x4*)(U + (size_t)mi * PLD); }
#pragma unroll
    for (int i = 0; i < W - 1; ++i) { const int t = t0 - (W - 1) + i; if (t < 0) x[i] = (u32x4){0u, 0u, 0u, 0u}; }
    float sum[8];
#pragma unroll
    for (int k = 0; k < 8; ++k) sum[k] = 0.f;
#pragma unroll
    for (int i = 0; i < W - 1; ++i) { float f[8]; unpk8(x[i], f);
#pragma unroll
        for (int k = 0; k < 8; ++k) sum[k] += f[k]; }
#pragma unroll
    for (int r = 0; r < 8; ++r) {
        float cur[8]; unpk8(x[W - 1 + r], cur);
#pragma unroll
        for (int k = 0; k < 8; ++k) sum[k] += cur[k];
        const int t = t0 + r; const int cnt = (t + 1 < W) ? t + 1 : W; const float inv = 1.0f / (float)cnt;
        u32x4 o;
#pragma unroll
        for (int q = 0; q < 4; ++q) o[q] = pk2(sum[2 * q] * inv - cur[2 * q], sum[2 * q + 1] * inv - cur[2 * q + 1]);
        *(GAS u32x4*)(POOLED + (size_t)(m0 + r) * 2048 + ch) = o;
        float sub[8]; unpk8(x[r], sub);
#pragma unroll
        for (int k = 0; k < 8; ++k) sum[k] -= sub[k];
        if (t >= SEQ - 15) { float* op = outp + ((size_t)bseq * 15 + (t - (SEQ - 15))) * 1024 + ch;
            *(GAS f32x4*)op = (f32x4){cur[0], cur[1], cur[2], cur[3]}; *(GAS f32x4*)(op + 4) = (f32x4){cur[4], cur[5], cur[6], cur[7]}; }
    }
}
template <int W>
__device__ __forceinline__ void pool_sample_blk(const bf16_t* PROJ, const float* spool, bf16_t* POOLED, float* outs, int sb, int ch) {
    const bf16_t* U = PROJ + (size_t)(16 + (ch >> 8)) * PTILE + (size_t)(MP + sb * 8) * PLD + (ch & 255);
    const float* B = spool + (size_t)sb * 15 * 1024 + ch;
    f32x4 ba[W - 1], bb[W - 1]; u32x4 xn[8]; f32x4 ca[7], cb[7];
#pragma unroll
    for (int i = 0; i < W - 1; ++i) { ba[i] = *(const GAS f32x4*)(B + (size_t)(15 - (W - 1) + i) * 1024); bb[i] = *(const GAS f32x4*)(B + (size_t)(15 - (W - 1) + i) * 1024 + 4); }
#pragma unroll
    for (int r = 0; r < 8; ++r) xn[r] = *(const GAS u32x4*)(U + (size_t)r * PLD);
#pragma unroll
    for (int rr = 0; rr < 7; ++rr) { ca[rr] = *(const GAS f32x4*)(B + (size_t)(8 + rr) * 1024); cb[rr] = *(const GAS f32x4*)(B + (size_t)(8 + rr) * 1024 + 4); }
    float sum[8];
#pragma unroll
    for (int k = 0; k < 8; ++k) sum[k] = 0.f;
#pragma unroll
    for (int i = 0; i < W - 1; ++i)
#pragma unroll
        for (int q = 0; q < 4; ++q) { sum[q] += ba[i][q]; sum[4 + q] += bb[i][q]; }
    const float inv = 1.0f / (float)W;
#pragma unroll
    for (int r = 0; r < 8; ++r) {
        float cur[8]; unpk8(xn[r], cur);
#pragma unroll
        for (int k = 0; k < 8; ++k) sum[k] += cur[k];
        u32x4 o;
#pragma unroll
        for (int q = 0; q < 4; ++q) o[q] = pk2(sum[2 * q] * inv - cur[2 * q], sum[2 * q + 1] * inv - cur[2 * q + 1]);
        *(GAS u32x4*)(POOLED + (size_t)(MP + sb * 8 + r) * 2048 + ch) = o;
        if (r < W - 1) {
#pragma unroll
            for (int q = 0; q < 4; ++q) { sum[q] -= ba[r < W - 1 ? r : 0][q]; sum[4 + q] -= bb[r < W - 1 ? r : 0][q]; }
        } else { float sub[8]; unpk8(xn[r >= W - 1 ? r - (W - 1) : 0], sub);
#pragma unroll
            for (int k = 0; k < 8; ++k) sum[k] -= sub[k]; }
        float* op = outs + ((size_t)sb * 15 + 7 + r) * 1024 + ch;
        *(GAS f32x4*)op = (f32x4){cur[0], cur[1], cur[2], cur[3]}; *(GAS f32x4*)(op + 4) = (f32x4){cur[4], cur[5], cur[6], cur[7]};
    }
#pragma unroll
    for (int rr = 0; rr < 7; ++rr) { float* op = outs + ((size_t)sb * 15 + rr) * 1024 + ch; *(GAS f32x4*)op = ca[rr]; *(GAS f32x4*)(op + 4) = cb[rr]; }
}
__device__ __forceinline__ void pool_tasks(Frame& F, const bf16_t* PROJ, const float* spool, bf16_t* POOLED, float* outp, float* outs) {
    for (int gt = F.vcu * NTHR + opaque(F.tid); gt < 1024 * 128; gt += F.G * NTHR) {
        const int cgp = gt & 31, rbl = (gt >> 5) & 1, grp = (gt >> 6) & 3, rb = (gt >> 8) * 2 + rbl, ch = grp * 256 + cgp * 8;
        if (grp == 0) pool_prompt_blk<2>(PROJ, POOLED, outp, rb, ch); else if (grp == 1) pool_prompt_blk<4>(PROJ, POOLED, outp, rb, ch);
        else if (grp == 2) pool_prompt_blk<8>(PROJ, POOLED, outp, rb, ch); else pool_prompt_blk<16>(PROJ, POOLED, outp, rb, ch);
    }
    if (F.G * 64 >= 128 * 128 ? F.tid < 64 : true)
    for (int gt = (F.G * 64 >= 128 * 128) ? F.vcu * 64 + opaque(F.tid) : F.vcu * NTHR + opaque(F.tid); gt < 128 * 128; gt += (F.G * 64 >= 128 * 128) ? F.G * 64 : F.G * NTHR) {
        const int cgp = gt & 31, sbl = (gt >> 5) & 1, grp = (gt >> 6) & 3, sb = (gt >> 8) * 2 + sbl, ch = grp * 256 + cgp * 8;
        if (grp == 0) pool_sample_blk<2>(PROJ, spool, POOLED, outs, sb, ch); else if (grp == 1) pool_sample_blk<4>(PROJ, spool, POOLED, outs, sb, ch);
        else if (grp == 2) pool_sample_blk<8>(PROJ, spool, POOLED, outs, sb, ch); else pool_sample_blk<16>(PROJ, spool, POOLED, outs, sb, ch);
    }
}

__device__ __forceinline__ void load_row_bf16(const bf16_t* row, int nparts, size_t pstride, int lane, float (&f)[4][8]) {
#pragma unroll
    for (int j = 0; j < 4; ++j)
#pragma unroll
        for (int q = 0; q < 8; ++q) f[j][q] = 0.f;
    for (int p = 0; p < nparts; ++p) {
        u32x4 v[4];
#pragma unroll
        for (int j = 0; j < 4; ++j) v[j] = __builtin_nontemporal_load((const GAS u32x4*)(row + (size_t)p * pstride + 8 * lane + 512 * j));
#pragma unroll
        for (int j = 0; j < 4; ++j)
#pragma unroll
            for (int q = 0; q < 4; ++q) { f[j][2 * q] += bflo(v[j][q]); f[j][2 * q + 1] += bfhi(v[j][q]); }
    }
}
__device__ __forceinline__ void n1_row(const float* xrow, const bf16_t* mo, int nparts, size_t pstride, const f32x4 (&wpa)[4], const f32x4 (&wpb)[4], const f32x4 (&wqa)[4], const f32x4 (&wqb)[4], bf16_t* x1row, bf16_t* hrow, int lane) {
    f32x4 xa[4], xb[4]; float s = 0.f;
#pragma unroll
    for (int j = 0; j < 4; ++j) { const int c = 8 * lane + 512 * j; xa[j] = __builtin_nontemporal_load((const GAS f32x4*)(xrow + c)); xb[j] = __builtin_nontemporal_load((const GAS f32x4*)(xrow + c + 4)); }
    float mf[4][8];
    load_row_bf16(mo, nparts, pstride, lane, mf);
#pragma unroll
    for (int j = 0; j < 4; ++j)
#pragma unroll
        for (int q = 0; q < 8; ++q) s += mf[j][q] * mf[j][q];
    const float r1 = 1.0f / sqrtf(wave_sum(s) * (1.f / D) + EPS);
    float s2 = 0.f;
#pragma unroll
    for (int j = 0; j < 4; ++j) { const int c = 8 * lane + 512 * j;
#pragma unroll
        for (int q = 0; q < 4; ++q) { xa[j][q] += mf[j][q] * r1 * wpa[j][q]; xb[j][q] += mf[j][4 + q] * r1 * wpb[j][q]; s2 += xa[j][q] * xa[j][q] + xb[j][q] * xb[j][q]; }
        { u32x4 o1; o1.x = pk2(xa[j][0], xa[j][1]); o1.y = pk2(xa[j][2], xa[j][3]); o1.z = pk2(xb[j][0], xb[j][1]); o1.w = pk2(xb[j][2], xb[j][3]); __builtin_nontemporal_store(o1, (GAS u32x4*)(x1row + c)); } }
    const float r2 = 1.0f / sqrtf(wave_sum(s2) * (1.f / D) + EPS);
#pragma unroll
    for (int j = 0; j < 4; ++j) { const int c = 8 * lane + 512 * j;
        u32x4 o; o.x = pk2(xa[j][0] * r2 * wqa[j][0], xa[j][1] * r2 * wqa[j][1]); o.y = pk2(xa[j][2] * r2 * wqa[j][2], xa[j][3] * r2 * wqa[j][3]);
        o.z = pk2(xb[j][0] * r2 * wqb[j][0], xb[j][1] * r2 * wqb[j][1]); o.w = pk2(xb[j][2] * r2 * wqb[j][2], xb[j][3] * r2 * wqb[j][3]);
        *(GAS u32x4*)(hrow + c) = o; }
}
__device__ __forceinline__ void n2_row(const bf16_t* ff, int nparts, size_t pstride, const f32x4 (&wpa)[4], const f32x4 (&wpb)[4], const bf16_t* x1row, float* yrow, int lane) {
    float s = 0.f; float ffl[4][8];
    u32x4 xv[4];
#pragma unroll
    for (int j = 0; j < 4; ++j) xv[j] = __builtin_nontemporal_load((const GAS u32x4*)(x1row + 8 * lane + 512 * j));
    load_row_bf16(ff, nparts, pstride, lane, ffl);
#pragma unroll
    for (int j = 0; j < 4; ++j)
#pragma unroll
        for (int q = 0; q < 8; ++q) s += ffl[j][q] * ffl[j][q];
    const float r1 = 1.0f / sqrtf(wave_sum(s) * (1.f / D) + EPS);
#pragma unroll
    for (int j = 0; j < 4; ++j) { const int c = 8 * lane + 512 * j;
        f32x4 ya = (f32x4){bflo(xv[j].x), bfhi(xv[j].x), bflo(xv[j].y), bfhi(xv[j].y)}, yb = (f32x4){bflo(xv[j].z), bfhi(xv[j].z), bflo(xv[j].w), bfhi(xv[j].w)};
#pragma unroll
        for (int q = 0; q < 4; ++q) { ya[q] += ffl[j][q] * r1 * wpa[j][q]; yb[q] += ffl[j][4 + q] * r1 * wpb[j][q]; }
        __builtin_nontemporal_store(ya, (GAS f32x4*)(yrow + c)); __builtin_nontemporal_store(yb, (GAS f32x4*)(yrow + c + 4)); }
}

constexpr int NPH = 10;
__global__ void __launch_bounds__(NTHR, 2) hyb_fwd(Args args) {
    extern __shared__ __attribute__((aligned(16))) unsigned char lds[];
    const unsigned long long pc0 = (unsigned long long)__builtin_amdgcn_s_getpc() & ~255ull;
    unsigned pf0, pf1, pf2;
    { const unsigned o0 = threadIdx.x * 128, o1 = o0 + 65536, o2 = o0 + 131072;
      const unsigned long long a0 = pc0 + o0, a1 = pc0 + o1, a2 = pc0 + (o2 < CODE_SPAN ? o2 : CODE_SPAN - 128);
      asm volatile("global_load_dword %0, %3, off\n\tglobal_load_dword %1, %4, off\n\tglobal_load_dword %2, %5, off"
                   : "=&v"(pf0), "=&v"(pf1), "=&v"(pf2) : "v"(a0), "v"(a1), "v"(a2) : "memory"); }
    Frame F;
    F.lds = (LAS unsigned char*)lds;
    F.tid = threadIdx.x; F.lane = F.tid & 63; F.wave = __builtin_amdgcn_readfirstlane(F.tid >> 6);
    F.G = gridDim.x; { const int bx = blockIdx.x; F.vcu = (F.G % 8 == 0) ? (bx % 8) * (F.G / 8) + bx / 8 : bx; }
    if (F.tid == 0) {
        volatile LAS unsigned long long* at = (volatile LAS unsigned long long*)(F.lds + ARG_OFF);
#pragma unroll
        for (int i = 0; i < 16; ++i) at[i] = (unsigned long long)args.in[i];
        at[16] = (unsigned long long)args.out; at[17] = (unsigned long long)args.ws;
        at[18] = pc0;
    }
    const int lo = args.ph_lo, hi = args.ph_hi;
    if (F.tid < 32) ((volatile LAS unsigned*)(F.lds + MISC_OFF))[F.tid] = 0u;
    __syncthreads();
    if (args.use_cg) xcd_barrier_post((unsigned*)(AWS + WS_CTL) + CW_BAR);
    asm volatile("s_waitcnt vmcnt(0)" :: "v"(pf0), "v"(pf1), "v"(pf2) : "memory");
#define IN(k) (lo <= (k) && (k) < hi)
#define BOTH(k) (IN(k) && IN((k) + 1))
#define GRID_BAR(k) xcd_barrier((unsigned*)(AWS + WS_CTL) + CW_BAR, (volatile LAS unsigned*)(F.lds + MISC_OFF) + 8, F.lds)
#define WSP(off) ((bf16_t*)(ws + (off)))
    if (IN(0)) { p0_prologue(F); if (BOTH(0)) GRID_BAR(0); }
    if (IN(1)) {
        unsigned char* ws = AWS;
        const int jx = (int)blockIdx.x / 8, spare = F.G / 8 - 30;
        if (F.G != 256 || jx < 30) {
            const int GG = F.G == 256 ? 240 : F.G;
            pg8::Gemm g{WSP(WS_H), WSP(WS_WIN), D, D, D, 0}; pg8::HybridOrder S; S.init(M / 256, INW / 256, D, GG, (int)blockIdx.x, 3);
            pg8::EpiProj E{WSP(WS_PROJ), (const float*)(ws + WS_CS)};
            pg8::gemm_phase(F.lds, g, S, E, pg8::SkBuf{nullptr});
        } else {
            const int worker = (jx - 30) * 8 + (int)blockIdx.x % 8;
            { pg8::Gemm g{WSP(WS_WOUT) + 1024, (const bf16_t*)(ws + WS_WPS), D, 256, 256, 256}; pg8::HybridOrder S; S.init(D / 256, 4, 256, spare * 8, worker, 2);
              pg8::EpiPlain E{WSP(WS_WOUT), D, 1024, nullptr};
              pg8::gemm_phase(F.lds, g, S, E, pg8::SkBuf{nullptr}); }
            __syncthreads();
            p0_transposes(F, TR_A, TR_B, worker, spare * 8);
        }
        if (BOTH(1)) GRID_BAR(1);
    }
    if (IN(2)) {
        unsigned char* ws = AWS; float* out = AOUT;
#pragma unroll 1
        for (int step = 0; step < 2; ++step) {
            if (step == 1) code_prefetch_all(F.lds);
            if (((step ^ F.vcu) & 1) == 0) {
                for (int it = F.vcu; it < 256; it += F.G) u_item(F, WSP(WS_PROJ), WSP(WS_UT), it);
                code_prefetch_all(F.lds);
                pool_tasks(F, WSP(WS_PROJ), AIN(3), WSP(WS_MIX) + 1024, out + O_POOLP, out + O_POOLS);
            } else {
                const float* st = AIN(2); const float* rw = AIN(7);
                for (int it = F.vcu; it < 512; it += F.G) s_item(F, WSP(WS_PROJ), st, rw, out + O_RETS, WSP(WS_MIX), it);
            }
        }
        if (BOTH(2)) GRID_BAR(2);
    }
    if (IN(3)) {
        unsigned char* ws = AWS;
        {
        float* out = AOUT; const bf16_t* UT = WSP(WS_UT); bf16_t* SCT = WSP(WS_SCT);
        const int t_lo = (int)((long)blockIdx.x * 131072 / F.G), t_hi = (int)((long)(blockIdx.x + 1) * 131072 / F.G);
        for (int idx = t_lo + F.tid; idx < t_hi; idx += NTHR) {
            const int bh = idx >> 13, pc = idx & 8191, e = 32 * (pc >> 10) + (pc & 31), d8 = 16 * ((pc >> 6) & 15) + 8 * ((pc >> 5) & 1);
            const float g128 = __builtin_amdgcn_exp2f(lg2gamma(bh & 3) * 128.f);
            float s[8];
#pragma unroll
            for (int k = 0; k < 8; ++k) s[k] = 0.f;
            u32x4 uv[16];
#pragma unroll
            for (int c = 0; c < 16; ++c) uv[c] = __builtin_nontemporal_load((const GAS u32x4*)(UT + ((size_t)(bh * 16 + c) * 8192 + pc) * 8));
#pragma unroll
            for (int c = 0; c < 16; ++c) {
                u32x4 o; o.x = pk2(s[0], s[1]); o.y = pk2(s[2], s[3]); o.z = pk2(s[4], s[5]); o.w = pk2(s[6], s[7]);
                *(GAS u32x4*)(SCT + ((size_t)(bh * 16 + c) * 8192 + pc) * 8) = o;
#pragma unroll
                for (int k = 0; k < 4; ++k) { s[2 * k] = g128 * s[2 * k] + bflo(uv[c][k]); s[2 * k + 1] = g128 * s[2 * k + 1] + bfhi(uv[c][k]); }
            }
            float* op = out + O_RETP + (size_t)bh * 65536 + e;
#pragma unroll
            for (int k = 0; k < 8; ++k) __builtin_nontemporal_store(s[k], op + (size_t)(d8 + k) * 256);
        }
        }
        {
            if (F.G != 256) {
            pg8::Gemm g{WSP(WS_WOUT) + 1024, (const bf16_t*)(ws + WS_WPS), D, 256, 256, 256}; pg8::HybridOrder S; S.init(D / 256, 4, 256, F.G, (int)blockIdx.x, 1);
            pg8::EpiPlain E{WSP(WS_WOUT), D, 1024, nullptr};
            pg8::gemm_phase(F.lds, g, S, E, pg8::SkBuf{nullptr});
            }
        }
        if (BOTH(3)) GRID_BAR(3);
    }
    if (IN(4)) {
        unsigned char* ws = AWS; const float* rw = AIN(7);
        for (int it = F.vcu; it < 256; it += F.G) o_item(F, WSP(WS_PROJ), WSP(WS_SCT), rw, WSP(WS_MIX), it);
        if (BOTH(4)) GRID_BAR(4);
    }
    if (IN(5)) {
        unsigned char* ws = AWS;
        pg8::Gemm g{WSP(WS_MIX), WSP(WS_WOUT), D, D, D, 0}; pg8::HybridOrder S; S.init(M / 256, D / 256, D, F.G, (int)blockIdx.x, 2, SPLIT_MODE);
        pg8::EpiPlain E{WSP(WS_MO), D, 0, nullptr};
        pg8::gemm_phase(F.lds, g, S, E, pg8::SkBuf{WSP(WS_PART3)});
        if (BOTH(5)) GRID_BAR(5);
    }
    if (IN(6)) {
        unsigned char* ws = AWS; float* out = AOUT;
        const float* xp_ = AIN(0); const float* xs_ = AIN(1); const float* w5 = AIN(5); const float* w11 = AIN(11);
        const int gw = F.vcu * NWAVES + F.wave, NGW = F.G * NWAVES;
        f32x4 wpa[4], wpb[4], wqa[4], wqb[4];
#pragma unroll
        for (int j = 0; j < 4; ++j) { const int c = 8 * F.lane + 512 * j; wpa[j] = *(const GAS f32x4*)(w5 + c); wpb[j] = *(const GAS f32x4*)(w5 + c + 4); wqa[j] = *(const GAS f32x4*)(w11 + c); wqb[j] = *(const GAS f32x4*)(w11 + c + 4); }
        const bool bal = (NGW * 4 == MP) && (NGW == 2 * (M - MP));
        for (int k = 0; ; ++k) {
            int m;
            if (bal) { if (k < 4) m = gw + k * NGW; else if (k == 4 && (gw & 1)) m = MP + (gw >> 1); else break; }
            else { m = gw + k * NGW; if (m >= M) break; }
            const bool sp = SPLIT_MODE && m >= MP;
            n1_row(xrow_ptr(xp_, xs_, m), sp ? WSP(WS_PART3) + (size_t)(m - MP) * D : WSP(WS_MO) + (size_t)m * D, sp ? 8 : 1, (size_t)1024 * 2048, wpa, wpb, wqa, wqb, WSP(WS_MO) + (size_t)m * D, WSP(WS_H) + (size_t)m * D, F.lane); }
        if (BOTH(6)) GRID_BAR(6);
    }
    if (IN(7)) {
        unsigned char* ws = AWS;
        const int jx = (int)blockIdx.x / 8;
        if (jx < 29) {
            pg8::Gemm g{WSP(WS_H), WSP(WS_WGU), D, D, D, 0}; pg8::HybridOrder S; S.init(M / 256, NGU / 256, D, 232, (int)blockIdx.x, 7);
            pg8::EpiGU E{WSP(WS_HID)};
            pg8::gemm_phase(F.lds, g, S, E, pg8::SkBuf{nullptr});
        } else p0_transposes(F, TR_B, TR_C, (jx - 29) * 8 + (int)blockIdx.x % 8, 24);
        if (BOTH(7)) GRID_BAR(7);
    }
    if (IN(8)) {
        unsigned char* ws = AWS;
        pg8::Gemm g{WSP(WS_HID), WSP(WS_WD), DFF, DFF, DFF, 0}; pg8::HybridOrder S; S.init(M / 256, D / 256, DFF, F.G, (int)blockIdx.x, 2, SPLIT_MODE);
        pg8::EpiPlain E{WSP(WS_FF), D, 0, nullptr};
        pg8::gemm_phase(F.lds, g, S, E, pg8::SkBuf{WSP(WS_PART5)});
        if (BOTH(8)) GRID_BAR(8);
    }
    if (IN(9)) {
        unsigned char* ws = AWS; float* out = AOUT; const float* w12 = AIN(12);
        const int gw = F.vcu * NWAVES + F.wave, NGW = F.G * NWAVES;
        f32x4 wpa[4], wpb[4];
#pragma unroll
        for (int j = 0; j < 4; ++j) { const int c = 8 * F.lane + 512 * j; wpa[j] = *(const GAS f32x4*)(w12 + c); wpb[j] = *(const GAS f32x4*)(w12 + c + 4); }
        const bool bal = (NGW * 4 == MP) && (NGW == 2 * (M - MP));
        for (int k = 0; ; ++k) {
            int m;
            if (bal) { if (k < 4) m = gw + k * NGW; else if (k == 4 && (gw & 1)) m = MP + (gw >> 1); else break; }
            else { m = gw + k * NGW; if (m >= M) break; }
            const bool sp = SPLIT_MODE && m >= MP;
            n2_row(sp ? WSP(WS_PART5) + (size_t)(m - MP) * D : WSP(WS_FF) + (size_t)m * D, sp ? 8 : 1, (size_t)1024 * 2048, wpa, wpb, WSP(WS_MO) + (size_t)m * D, out + O_Y + (size_t)m * D, F.lane); }
    }
#undef IN
#undef BOTH
}

extern "C" void kernel_launch(void* const* d_in, const int* in_sizes, int n_in, void* d_out, int out_size, void* d_ws, size_t ws_size, hipStream_t stream) {
    static int grid = 0;
    if (grid == 0) {
        if (n_in != 16 || (size_t)out_size != O_END || ws_size < WS_END) { fprintf(stderr, "kernel_launch: unexpected shapes: n_in %d out %d ws %zu (need %zu)\n", n_in, out_size, ws_size, (size_t)WS_END); grid = -1; return; }
        int dev = 0, cus = 0, per_cu = 0;
        if (hipGetDevice(&dev) != hipSuccess || hipDeviceGetAttribute(&cus, hipDeviceAttributeMultiprocessorCount, dev) != hipSuccess) { grid = -1; return; }
        if (hipFuncSetAttribute((const void*)hyb_fwd, hipFuncAttributeMaxDynamicSharedMemorySize, LDS_BYTES) != hipSuccess) { fprintf(stderr, "kernel_launch: hipFuncSetAttribute failed\n"); grid = -1; return; }
        if (hipOccupancyMaxActiveBlocksPerMultiprocessor(&per_cu, (const void*)hyb_fwd, NTHR, LDS_BYTES) != hipSuccess || per_cu < 1) { fprintf(stderr, "kernel_launch: occupancy query says %d\n", per_cu); per_cu = 1; }
        (void)hipGetLastError();
        grid = cus * 1;
        if (SPLIT_MODE && grid != 256) { fprintf(stderr, "kernel_launch: this build's unit schedule needs exactly 256 workgroups (got %d CUs); nothing launched\n", cus); grid = -1; return; }
        fprintf(stderr, "kernel_launch: grid %d (occupancy query %d per CU)\n", grid, per_cu);
    }
    if (grid < 0) return;
    Args a{};
    for (int i = 0; i < 16; ++i) a.in[i] = (const float*)d_in[i];
    a.out = (float*)d_out; a.ws = (unsigned char*)d_ws;
    if (hipMemsetAsync((char*)d_ws + WS_CTL + CTL_MS_OFF, 0, CTL_MS_BYTES, stream) != hipSuccess) { fprintf(stderr, "kernel_launch: memset failed\n"); return; }
    if (MK_N_LAUNCHES == 1) {
        a.ph_lo = 0; a.ph_hi = NPH; a.use_cg = 1;
        void* kargs[] = {&a};
        hipError_t e = hipLaunchCooperativeKernel((const void*)hyb_fwd, dim3(grid), dim3(NTHR), kargs, LDS_BYTES, stream);
        if (e != hipSuccess) fprintf(stderr, "kernel_launch: cooperative launch failed: %s (grid %d)\n", hipGetErrorString(e), grid);
    } else {
        for (int p = 0; p < NPH; ++p) {
            a.ph_lo = p; a.ph_hi = p + 1; a.use_cg = 0;
            hipLaunchKernelGGL(hyb_fwd, dim3(grid), dim3(NTHR), LDS_BYTES, stream, a);
        }
    }
}
```
